# Optimizing an MI355X kernel written in HIP

```python
import math
import jax
import jax.numpy as jnp
from jax import lax
import numpy as np

D_MODEL = 1024
BATCH = 4
SEQ = 4096
DEPTH = 1

N_HEADS = 8
HEAD_DIM = 64
N_KV = 2
GQA_RATIO = N_HEADS // N_KV
CMP_BLOCK = 32
CMP_STRIDE = 16
CMP_HIDDEN = 256
SEL_BLOCK = 64
N_SELECT = 16
WINDOW = 512
Q_BLOCK = 128
ATTN_SCALE = HEAD_DIM ** -0.5
NSA_WIDTH = N_HEADS * HEAD_DIM
KV_WIDTH = N_KV * HEAD_DIM
SSM_WIDTH = 512
GROUP = 16
N_GROUPS = SSM_WIDTH // GROUP
STATE = 64
DT_MIN = 1e-3
DT_MAX = 1e-1
N_EXPERTS = 256
TOP_K = 8
D_EXPERT = 256
N_EXPERT_GROUPS = 8
TOPK_GROUPS = 4
ROUTE_SCALE = 2.5
DISPATCH_BLOCK = 128
EPS = 1e-6
ADA_SCALE = 0.3
IN_SPLITS = (NSA_WIDTH,) + (KV_WIDTH,) * 6 + (3 * N_HEADS, SSM_WIDTH, D_MODEL, D_MODEL)
IN_COLS = sum(IN_SPLITS)

kernel_name = 'hybrid_nsa_s5_moe_block'


def rms_norm(x, g):
    xf = x.astype(jnp.float32)
    y = xf * lax.rsqrt(jnp.mean(xf * xf, axis=-1, keepdims=True) + EPS)
    return (y * g.astype(jnp.float32)).astype(x.dtype)


def masked_softmax(s, mask):
    s = jnp.where(mask, s.astype(jnp.float32), -1e30)
    return jax.nn.softmax(s, axis=-1) * mask


def swiglu(x, wg, wu, wd):
    return (jax.nn.silu(x @ wg) * (x @ wu)) @ wd


def compress_blocks(k, pe, w1, w2):
    B, S, G, Dh = k.shape
    nc = (S - CMP_BLOCK) // CMP_STRIDE + 1
    idx = CMP_STRIDE * jnp.arange(nc)[:, None] + jnp.arange(CMP_BLOCK)[None, :]
    kb = k[:, idx] + pe[None, None, :, None, :]
    kb = jnp.transpose(kb, (0, 1, 3, 2, 4)).reshape(B, nc, G, CMP_BLOCK * Dh)
    return jax.nn.gelu(kb @ w1) @ w2


def compressed_attention(q, kc, vc):
    S = q.shape[1]
    nc = kc.shape[1]
    t = jnp.arange(S)
    block_end = CMP_STRIDE * jnp.arange(nc) + CMP_BLOCK - 1
    mask = block_end[None, :] <= t[:, None]
    s = jnp.einsum('bsgrd,bngd->bgrsn', q, kc) * ATTN_SCALE
    p = masked_softmax(s, mask)
    o = jnp.einsum('bgrsn,bngd->bsgrd', p.astype(vc.dtype), vc)
    return o, p


def select_blocks(p_cmp, S):
    nc = p_cmp.shape[-1]
    nsb = S // SEL_BLOCK
    cstart = CMP_STRIDE * jnp.arange(nc)
    sstart = SEL_BLOCK * jnp.arange(nsb)
    overlap = ((cstart[:, None] < sstart[None, :] + SEL_BLOCK)
               & (cstart[:, None] + CMP_BLOCK > sstart[None, :])).astype(jnp.float32)
    imp = jnp.einsum('bgrsn,nj->bgsj', p_cmp, overlap)
    cur = (jnp.arange(S) // SEL_BLOCK)[:, None]
    j = jnp.arange(nsb)[None, :]
    valid = j <= cur
    forced = (j == 0) | (j == cur) | (j == cur - 1)
    imp = jnp.where(forced, jnp.inf, jnp.where(valid, imp, -jnp.inf))
    n_sel = min(N_SELECT, nsb)
    _, idx = lax.top_k(imp, n_sel)
    return idx


def selected_attention(q, ks, vs, idx):
    B, S, G, R, Dh = q.shape
    nsb = S // SEL_BLOCK
    kb = ks.reshape(B, nsb, SEL_BLOCK, G, Dh).transpose(0, 3, 1, 2, 4)
    vb = vs.reshape(B, nsb, SEL_BLOCK, G, Dh).transpose(0, 3, 1, 2, 4)
    qc = q.reshape(B, nsb, SEL_BLOCK, G, R, Dh).transpose(1, 0, 2, 3, 4, 5)
    ic = idx.reshape(B, G, nsb, SEL_BLOCK, -1).transpose(2, 0, 1, 3, 4)
    bi = jnp.arange(B)[:, None, None, None]
    gi = jnp.arange(G)[None, :, None, None]
    offs = jnp.arange(SEL_BLOCK)

    def chunk(args):
        qb, ib, ci = args
        kg = kb[bi, gi, ib]
        vg = vb[bi, gi, ib]
        t = ci * SEL_BLOCK + offs
        kpos = ib[..., None] * SEL_BLOCK + offs
        mask = kpos <= t[None, None, :, None, None]
        s = jnp.einsum('bqgrd,bgqnkd->bgrqnk', qb, kg) * ATTN_SCALE
        shp = s.shape
        m = jnp.broadcast_to(mask[:, :, None], shp).reshape(shp[:4] + (-1,))
        p = masked_softmax(s.reshape(shp[:4] + (-1,)), m).reshape(shp)
        return jnp.einsum('bgrqnk,bgqnkd->bqgrd', p.astype(vg.dtype), vg)

    o = lax.map(chunk, (qc, ic, jnp.arange(nsb)))
    return o.transpose(1, 0, 2, 3, 4, 5).reshape(B, S, G, R, Dh)


def window_attention(q, kw, vw):
    B, S, G, R, Dh = q.shape
    nq = S // Q_BLOCK
    nback = WINDOW // Q_BLOCK
    pad = ((0, 0), (WINDOW, 0), (0, 0), (0, 0))
    kp = jnp.pad(kw, pad).reshape(B, nq + nback, Q_BLOCK, G, Dh)
    vp = jnp.pad(vw, pad).reshape(B, nq + nback, Q_BLOCK, G, Dh)
    kwin = jnp.concatenate([kp[:, j:j + nq] for j in range(nback + 1)], axis=2)
    vwin = jnp.concatenate([vp[:, j:j + nq] for j in range(nback + 1)], axis=2)
    qb = q.reshape(B, nq, Q_BLOCK, G, R, Dh)
    blk = jnp.arange(nq)[:, None] * Q_BLOCK
    t = blk + jnp.arange(Q_BLOCK)[None, :]
    kpos = blk - WINDOW + jnp.arange((nback + 1) * Q_BLOCK)[None, :]
    diff = t[:, :, None] - kpos[:, None, :]
    mask = (diff >= 0) & (diff < WINDOW) & (kpos[:, None, :] >= 0)
    s = jnp.einsum('bnqgrd,bnkgd->bgrnqk', qb, kwin) * ATTN_SCALE
    p = masked_softmax(s, mask)
    o = jnp.einsum('bgrnqk,bnkgd->bnqgrd', p.astype(vwin.dtype), vwin)
    return o.reshape(B, S, G, R, Dh)


def s5_mixer(u, a_re, a_im, log_dt, b_re, b_im, c_re, c_im, d_skip, w_glu, b_glu):
    B, S, _ = u.shape
    f32 = jnp.float32
    lam = lax.complex(a_re.astype(f32), a_im.astype(f32))
    dt = jnp.exp(log_dt.astype(f32))[:, None]
    lam_bar = jnp.exp(lam * dt)
    b_mat = lax.complex(b_re.astype(f32), b_im.astype(f32))
    b_bar = ((lam_bar - 1.0) / lam)[..., None] * b_mat
    c_mat = lax.complex(c_re.astype(f32), c_im.astype(f32))
    uf = u.astype(f32)
    ug = uf.reshape(B, S, N_GROUPS, GROUP).astype(jnp.complex64)
    bu = jnp.einsum('bsgp,gnp->bsgn', ug, b_bar)
    a = jnp.broadcast_to(lam_bar, bu.shape)

    def combine(left, right):
        a1, b1 = left
        a2, b2 = right
        return a1 * a2, a2 * b1 + b2

    _, states = lax.associative_scan(combine, (a, bu), axis=1)
    y = jnp.einsum('bsgn,gpn->bsgp', states, c_mat).real.reshape(B, S, SSM_WIDTH)
    y = (y + d_skip.astype(f32) * uf).astype(u.dtype)
    z = jax.nn.gelu(y)
    return z * jax.nn.sigmoid(z @ w_glu + b_glu)


def route(h, w_router, router_bias):
    f32 = jnp.float32
    n = h.shape[0]
    scores = jax.nn.sigmoid(h.astype(f32) @ w_router.astype(f32))
    biased = scores + router_bias.astype(f32)
    grp = biased.reshape(n, N_EXPERT_GROUPS, N_EXPERTS // N_EXPERT_GROUPS)
    grp_score = jnp.sum(lax.top_k(grp, 2)[0], axis=-1)
    _, gidx = lax.top_k(grp_score, TOPK_GROUPS)
    gmask = jnp.any(gidx[:, :, None] == jnp.arange(N_EXPERT_GROUPS)[None, None, :], axis=1)
    emask = jnp.repeat(gmask, N_EXPERTS // N_EXPERT_GROUPS, axis=1)
    _, eidx = lax.top_k(jnp.where(emask, biased, -jnp.inf), TOP_K)
    w = jnp.take_along_axis(scores, eidx, axis=1)
    w = w / jnp.sum(w, axis=-1, keepdims=True) * ROUTE_SCALE
    return eidx, w


def routed_experts(h, eidx, w, w_gate, w_up, w_down):
    n, d = h.shape
    nk = n * TOP_K
    e_flat = eidx.reshape(-1)
    tok_flat = jnp.repeat(jnp.arange(n, dtype=jnp.int32), TOP_K)
    w_flat = w.reshape(-1)
    order = jnp.argsort(e_flat)
    se = e_flat[order]
    stok = tok_flat[order]
    sw = w_flat[order]
    counts = jax.ops.segment_sum(jnp.ones_like(se), se, num_segments=N_EXPERTS)
    start = jnp.cumsum(counts) - counts
    padded = (counts + DISPATCH_BLOCK - 1) // DISPATCH_BLOCK * DISPATCH_BLOCK
    pad_end = jnp.cumsum(padded)
    pad_start = pad_end - padded
    dest = pad_start[se] + jnp.arange(nk, dtype=jnp.int32) - start[se]
    cap = (nk + N_EXPERTS * DISPATCH_BLOCK + DISPATCH_BLOCK - 1) // DISPATCH_BLOCK * DISPATCH_BLOCK
    nb = cap // DISPATCH_BLOCK
    buf_tok = jnp.full((cap,), n, jnp.int32).at[dest].set(stok)
    buf_w = jnp.zeros((cap,), h.dtype).at[dest].set(sw.astype(h.dtype))
    blk_e = jnp.minimum(jnp.searchsorted(pad_end, jnp.arange(nb, dtype=jnp.int32) * DISPATCH_BLOCK,
                                         side='right'), N_EXPERTS - 1)
    hp = jnp.concatenate([h, jnp.zeros((1, d), h.dtype)], axis=0)

    def run(args):
        toks, e = args
        return swiglu(hp[toks], w_gate[e], w_up[e], w_down[e])

    y = lax.map(run, (buf_tok.reshape(nb, DISPATCH_BLOCK), blk_e)).reshape(cap, d)
    y = y * buf_w[:, None]
    return jnp.zeros((n + 1, d), h.dtype).at[buf_tok].add(y)[:n]


def hybrid_block(x, c, w_ada, b_ada, g_norm1, g_norm2, w_in, q_gain, kc_gain, ks_gain, kw_gain,
                 pe_k, pe_v, w_cmp_k1, w_cmp_k2, w_cmp_v1, w_cmp_v2,
                 a_re, a_im, log_dt, b_re, b_im, c_re, c_im, d_skip, w_glu, b_glu,
                 w_up_attn, w_up_ssm, w_out, w_router, router_bias,
                 w_gate, w_up, w_down, ws_gate, ws_up, ws_down):
    B, S, D = x.shape
    mod = jax.nn.silu(c) @ w_ada + b_ada
    sh1, sc1, gt1, sh2, sc2, gt2 = jnp.split(mod[:, None, :], 6, axis=-1)

    h = rms_norm(x, g_norm1) * (1.0 + sc1) + sh1
    parts = jnp.split(h @ w_in, np.cumsum(IN_SPLITS)[:-1].tolist(), axis=-1)
    q, kc, vc, ks, vs, kw, vw, g_nsa, u, g_attn, g_ssm = parts
    q = rms_norm(q.reshape(B, S, N_HEADS, HEAD_DIM), q_gain).reshape(B, S, N_KV, GQA_RATIO, HEAD_DIM)
    kc = rms_norm(compress_blocks(kc.reshape(B, S, N_KV, HEAD_DIM), pe_k, w_cmp_k1, w_cmp_k2), kc_gain)
    vc = compress_blocks(vc.reshape(B, S, N_KV, HEAD_DIM), pe_v, w_cmp_v1, w_cmp_v2)
    ks = rms_norm(ks.reshape(B, S, N_KV, HEAD_DIM), ks_gain)
    vs = vs.reshape(B, S, N_KV, HEAD_DIM)
    kw = rms_norm(kw.reshape(B, S, N_KV, HEAD_DIM), kw_gain)
    vw = vw.reshape(B, S, N_KV, HEAD_DIM)
    o_cmp, p_cmp = compressed_attention(q, kc, vc)
    sel_idx = select_blocks(p_cmp, S)
    o_sel = selected_attention(q, ks, vs, sel_idx)
    o_win = window_attention(q, kw, vw)
    g = jax.nn.sigmoid(g_nsa).reshape(B, S, N_KV, GQA_RATIO, 3)
    o_nsa = (g[..., 0:1] * o_cmp + g[..., 1:2] * o_sel + g[..., 2:3] * o_win).reshape(B, S, NSA_WIDTH)
    y_ssm = s5_mixer(u, a_re, a_im, log_dt, b_re, b_im, c_re, c_im, d_skip, w_glu, b_glu)
    merged = (jax.nn.sigmoid(g_attn) * (o_nsa @ w_up_attn)
              + jax.nn.sigmoid(g_ssm) * (y_ssm @ w_up_ssm))
    x = x + gt1 * (merged @ w_out)

    h2 = rms_norm(x, g_norm2) * (1.0 + sc2) + sh2
    hf = h2.reshape(B * S, D)
    eidx, ew = route(hf, w_router, router_bias)
    y = swiglu(hf, ws_gate, ws_up, ws_down) + routed_experts(hf, eidx, ew, w_gate, w_up, w_down)
    return x + gt2 * y.reshape(B, S, D)


def setup_inputs(seed: int = 0) -> dict:
    key = jax.random.key(seed)
    keys = iter(jax.random.split(key, 48))
    f32 = jnp.float32
    L = DEPTH

    def nrm(shape, scale):
        return scale * jax.random.normal(next(keys), shape, f32)

    def gain(shape):
        return 1.0 + nrm(shape, 0.01)

    D = D_MODEL
    inp = {}
    inp['x'] = nrm((BATCH, SEQ, D), 1.0)
    inp['c'] = nrm((BATCH, D), 1.0)
    inp['w_ada'] = nrm((L, D, 6 * D), ADA_SCALE * D ** -0.5)
    inp['b_ada'] = nrm((L, 6 * D), 0.01)
    inp['g_norm1'] = gain((L, D))
    inp['g_norm2'] = gain((L, D))
    inp['w_in'] = nrm((L, D, IN_COLS), D ** -0.5)
    inp['q_gain'] = gain((L, HEAD_DIM))
    inp['kc_gain'] = gain((L, HEAD_DIM))
    inp['ks_gain'] = gain((L, HEAD_DIM))
    inp['kw_gain'] = gain((L, HEAD_DIM))
    inp['pe_k'] = nrm((L, CMP_BLOCK, HEAD_DIM), 0.02)
    inp['pe_v'] = nrm((L, CMP_BLOCK, HEAD_DIM), 0.02)
    inp['w_cmp_k1'] = nrm((L, CMP_BLOCK * HEAD_DIM, CMP_HIDDEN), (CMP_BLOCK * HEAD_DIM) ** -0.5)
    inp['w_cmp_k2'] = nrm((L, CMP_HIDDEN, HEAD_DIM), CMP_HIDDEN ** -0.5)
    inp['w_cmp_v1'] = nrm((L, CMP_BLOCK * HEAD_DIM, CMP_HIDDEN), (CMP_BLOCK * HEAD_DIM) ** -0.5)
    inp['w_cmp_v2'] = nrm((L, CMP_HIDDEN, HEAD_DIM), CMP_HIDDEN ** -0.5)
    inp['a_re'] = -0.5 + nrm((L, N_GROUPS, STATE), 0.01)
    inp['a_im'] = math.pi * jnp.arange(STATE, dtype=f32)[None, None, :] + nrm((L, N_GROUPS, STATE), 0.01)
    inp['log_dt'] = jax.random.uniform(next(keys), (L, N_GROUPS), f32,
                                       minval=math.log(DT_MIN), maxval=math.log(DT_MAX))
    inp['b_re'] = nrm((L, N_GROUPS, STATE, GROUP), (2 * GROUP) ** -0.5)
    inp['b_im'] = nrm((L, N_GROUPS, STATE, GROUP), (2 * GROUP) ** -0.5)
    inp['c_re'] = nrm((L, N_GROUPS, GROUP, STATE), STATE ** -0.5)
    inp['c_im'] = nrm((L, N_GROUPS, GROUP, STATE), STATE ** -0.5)
    inp['d_skip'] = nrm((L, SSM_WIDTH), 1.0)
    inp['w_glu'] = nrm((L, SSM_WIDTH, SSM_WIDTH), SSM_WIDTH ** -0.5)
    inp['b_glu'] = nrm((L, SSM_WIDTH), 0.01)
    inp['w_up_attn'] = nrm((L, NSA_WIDTH, D), NSA_WIDTH ** -0.5)
    inp['w_up_ssm'] = nrm((L, SSM_WIDTH, D), SSM_WIDTH ** -0.5)
    inp['w_out'] = nrm((L, D, D), D ** -0.5)
    inp['w_router'] = nrm((L, D, N_EXPERTS), D ** -0.5)
    inp['router_bias'] = nrm((L, N_EXPERTS), 0.01)
    inp['w_gate'] = nrm((L, N_EXPERTS, D, D_EXPERT), D ** -0.5)
    inp['w_up'] = nrm((L, N_EXPERTS, D, D_EXPERT), D ** -0.5)
    inp['w_down'] = nrm((L, N_EXPERTS, D_EXPERT, D), D_EXPERT ** -0.5)
    inp['ws_gate'] = nrm((L, D, D_EXPERT), D ** -0.5)
    inp['ws_up'] = nrm((L, D, D_EXPERT), D ** -0.5)
    inp['ws_down'] = nrm((L, D_EXPERT, D), D_EXPERT ** -0.5)
    return inp


def reference(x, c, w_ada, b_ada, g_norm1, g_norm2, w_in, q_gain, kc_gain, ks_gain, kw_gain,
              pe_k, pe_v, w_cmp_k1, w_cmp_k2, w_cmp_v1, w_cmp_v2,
              a_re, a_im, log_dt, b_re, b_im, c_re, c_im, d_skip, w_glu, b_glu,
              w_up_attn, w_up_ssm, w_out, w_router, router_bias,
              w_gate, w_up, w_down, ws_gate, ws_up, ws_down):
    layer_params = (w_ada, b_ada, g_norm1, g_norm2, w_in, q_gain, kc_gain, ks_gain, kw_gain,
                    pe_k, pe_v, w_cmp_k1, w_cmp_k2, w_cmp_v1, w_cmp_v2,
                    a_re, a_im, log_dt, b_re, b_im, c_re, c_im, d_skip, w_glu, b_glu,
                    w_up_attn, w_up_ssm, w_out, w_router, router_bias,
                    w_gate, w_up, w_down, ws_gate, ws_up, ws_down)
    for layer in range(DEPTH):
        x = hybrid_block(x, c, *[p[layer] for p in layer_params])
    return x
```

```cpp
#include <hip/hip_runtime.h>
#include <hip/hip_cooperative_groups.h>
#include <cstdio>
#include <cstdint>
namespace cg = cooperative_groups;

constexpr int D = 1024;
constexpr int NB = 4;
constexpr int S = 4096;
constexpr int NT = NB * S;
constexpr int INC = 3864;
constexpr int C_Q = 0, C_KC = 512, C_VC = 640, C_KS = 768, C_VS = 896, C_KW = 1024, C_VW = 1152,
              C_GN = 1280, C_U = 1304, C_GA = 1816, C_GS = 2840;
constexpr int NCMP = 255;
constexpr int NE = 256;
constexpr int TOPK = 8;
constexpr int DE = 256;
constexpr int NASSIGN = NT * TOPK;
constexpr float EPS = 1e-6f;
constexpr float ATT_SCALE = 0.125f;

struct Params {
  const float* x; const float* c; const float* w_ada; const float* b_ada; const float* g_norm1;
  const float* g_norm2; const float* w_in; const float* q_gain; const float* kc_gain;
  const float* ks_gain; const float* kw_gain; const float* pe_k; const float* pe_v;
  const float* w_cmp_k1; const float* w_cmp_k2; const float* w_cmp_v1; const float* w_cmp_v2;
  const float* a_re; const float* a_im; const float* log_dt; const float* b_re; const float* b_im;
  const float* c_re; const float* c_im; const float* d_skip; const float* w_glu; const float* b_glu;
  const float* w_up_attn; const float* w_up_ssm; const float* w_out; const float* w_router;
  const float* router_bias; const float* w_gate; const float* w_up; const float* w_down;
  const float* ws_gate; const float* ws_up; const float* ws_down;
  float* out;
  float* mod;
  float* h;
  float* proj;
  float* hidk;
  float* hidv;
  float* kcmp;
  float* vcmp;
  float* onsa;
  float* lamb;
  float* lam64;
  float* bbar;
  float* cstate;
  float* cin;
  float* z;
  float* yssm;
  float* merged;
  float* xmid;
  float* scores;
  int* eidx;
  float* ew;
  int* cnt;
  int* cursor;
  int* off;
  int* rts;
  int* stok;
  float* sw;
  float* hs;
  float* hr;
};

__device__ __forceinline__ float wsum(float v) {
#pragma unroll
  for (int o = 32; o > 0; o >>= 1) v += __shfl_xor(v, o);
  return v;
}
__device__ __forceinline__ float wmax(float v) {
#pragma unroll
  for (int o = 32; o > 0; o >>= 1) v = fmaxf(v, __shfl_xor(v, o));
  return v;
}
#define WSYNC() do { __builtin_amdgcn_fence(__ATOMIC_ACQ_REL, "wavefront"); __builtin_amdgcn_wave_barrier(); } while (0)
__device__ __forceinline__ float sigmoidf_(float x) { return 1.0f / (1.0f + expf(-x)); }
__device__ __forceinline__ float siluf_(float x) { return x / (1.0f + expf(-x)); }
__device__ __forceinline__ float geluf_(float x) {
  return 0.5f * x * (1.0f + tanhf(0.7978845608028654f * (x + 0.044715f * x * x * x)));
}

template <class AL, class BL, class EP>
__device__ __forceinline__ void gemm_tile64(int mvalid, int nvalid, int K, AL aload, BL bload, EP epi,
                                            float* smem) {
  float acc[4][4];
#pragma unroll
  for (int i = 0; i < 4; ++i)
#pragma unroll
    for (int j = 0; j < 4; ++j) acc[i][j] = 0.f;
  const int t = threadIdx.x;
  const int tx = t & 15, ty = t >> 4;
  float* As = smem;
  float* Bs = smem + 16 * 68;
  for (int k0 = 0; k0 < K; k0 += 16) {
    {
      const int m = t >> 2, kk = (t & 3) * 4;
#pragma unroll
      for (int i = 0; i < 4; ++i) As[(kk + i) * 68 + m] = (m < mvalid) ? aload(m, k0 + kk + i) : 0.f;
    }
    {
      const int k = t >> 4, n = (t & 15) * 4;
#pragma unroll
      for (int i = 0; i < 4; ++i) Bs[k * 68 + n + i] = (n + i < nvalid) ? bload(k0 + k, n + i) : 0.f;
    }
    __syncthreads();
#pragma unroll
    for (int kk = 0; kk < 16; ++kk) {
      const float4 a = *reinterpret_cast<const float4*>(&As[kk * 68 + ty * 4]);
      const float4 b = *reinterpret_cast<const float4*>(&Bs[kk * 68 + tx * 4]);
      const float av[4] = {a.x, a.y, a.z, a.w};
      const float bv[4] = {b.x, b.y, b.z, b.w};
#pragma unroll
      for (int i = 0; i < 4; ++i)
#pragma unroll
        for (int j = 0; j < 4; ++j) acc[i][j] = fmaf(av[i], bv[j], acc[i][j]);
    }
    __syncthreads();
  }
#pragma unroll
  for (int i = 0; i < 4; ++i)
#pragma unroll
    for (int j = 0; j < 4; ++j) {
      const int m = ty * 4 + i, n = tx * 4 + j;
      if (m < mvalid && n < nvalid) epi(m, n, acc[i][j]);
    }
}

template <class AL, class BL, class EP>
__device__ __forceinline__ void gemm_phase(int M, int N, int K, AL al, BL bl, EP ep, float* smem) {
  const int tn = (N + 63) / 64, tm = (M + 63) / 64;
  for (int tile = blockIdx.x; tile < tm * tn; tile += gridDim.x) {
    const int m0 = (tile / tn) * 64, n0 = (tile % tn) * 64;
    gemm_tile64(
        min(64, M - m0), min(64, N - n0), K, [&](int m, int k) { return al(m0 + m, k); },
        [&](int k, int n) { return bl(k, n0 + n); }, [&](int m, int n, float v) { ep(m0 + m, n0 + n, v); },
        smem);
  }
}

__device__ __forceinline__ int find_expert(const int* rts, int rt) {
  int lo = 0, hi = NE;
  while (hi - lo > 1) {
    const int mid = (lo + hi) >> 1;
    if (rts[mid] <= rt) lo = mid; else hi = mid;
  }
  return lo;
}

constexpr int SMEM_FLOATS = 10240;

__global__ void __launch_bounds__(256) mega(Params p) {
  cg::grid_group grid = cg::this_grid();
  __shared__ __attribute__((aligned(16))) float smem[SMEM_FLOATS];
  const int tid = threadIdx.x;
  const int lane = tid & 63;
  const int wib = tid >> 6;
  const int gthreads = gridDim.x * 256;
  const int gtid = blockIdx.x * 256 + tid;
  const int gwaves = gridDim.x * 4;
  const int gwave = blockIdx.x * 4 + wib;

  {
    for (int i = tid; i < NB * D; i += 256) smem[i] = siluf_(p.c[i]);
    __syncthreads();
    for (int idx = gtid; idx < NB * 6 * D; idx += gthreads) {
      const int b = idx / (6 * D), j = idx % (6 * D);
      float acc = p.b_ada[j];
      const float* sc = smem + b * D;
      for (int k = 0; k < D; ++k) acc = fmaf(sc[k], p.w_ada[(size_t)k * (6 * D) + j], acc);
      p.mod[idx] = acc;
    }
    for (int idx = gtid; idx < 32 * 64; idx += gthreads) {
      const int g = idx / 64;
      const double dt = exp((double)p.log_dt[g]);
      const double lr = p.a_re[idx], li = p.a_im[idx];
      const double mag = exp(lr * dt);
      const double br = mag * cos(li * dt), bi = mag * sin(li * dt);
      p.lamb[idx * 2] = (float)br;
      p.lamb[idx * 2 + 1] = (float)bi;
      const double mag64 = exp(lr * dt * 64.0);
      p.lam64[idx * 2] = (float)(mag64 * cos(li * dt * 64.0));
      p.lam64[idx * 2 + 1] = (float)(mag64 * sin(li * dt * 64.0));
      const double nr = br - 1.0, ni = bi;
      const double den = lr * lr + li * li;
      const double cr = (nr * lr + ni * li) / den, ci = (ni * lr - nr * li) / den;
      for (int q = 0; q < 16; ++q) {
        const double wr = p.b_re[idx * 16 + q], wi = p.b_im[idx * 16 + q];
        p.bbar[(idx * 16 + q) * 2] = (float)(cr * wr - ci * wi);
        p.bbar[(idx * 16 + q) * 2 + 1] = (float)(cr * wi + ci * wr);
      }
    }
    for (int idx = gtid; idx < NE; idx += gthreads) { p.cnt[idx] = 0; p.cursor[idx] = 0; }
  }
  grid.sync();

  for (int row = gwave; row < NT; row += gwaves) {
    const int b = row / S;
    const float* xr = p.x + (size_t)row * D;
    float v[16];
    float ss = 0.f;
#pragma unroll
    for (int i = 0; i < 16; ++i) { v[i] = xr[i * 64 + lane]; ss = fmaf(v[i], v[i], ss); }
    ss = wsum(ss);
    const float r = rsqrtf(ss * (1.0f / D) + EPS);
    const float* md = p.mod + b * 6 * D;
#pragma unroll
    for (int i = 0; i < 16; ++i) {
      const int col = i * 64 + lane;
      p.h[(size_t)row * D + col] = v[i] * r * p.g_norm1[col] * (1.0f + md[D + col]) + md[col];
    }
  }
  grid.sync();

  gemm_phase(
      NT, INC, D, [&](int m, int k) { return p.h[(size_t)m * D + k]; },
      [&](int k, int n) { return p.w_in[(size_t)k * INC + n]; },
      [&](int m, int n, float v) {
        if ((n >= C_GN && n < C_U) || n >= C_GA) v = sigmoidf_(v);
        p.proj[(size_t)m * INC + n] = v;
      },
      smem);
  grid.sync();

  for (int row = gwave; row < NT; row += gwaves) {
    float* pr = p.proj + (size_t)row * INC;
#pragma unroll 1
    for (int vi = 0; vi < 12; ++vi) {
      int col; const float* gain;
      if (vi < 8) { col = C_Q + vi * 64; gain = p.q_gain; }
      else if (vi < 10) { col = C_KS + (vi - 8) * 64; gain = p.ks_gain; }
      else { col = C_KW + (vi - 10) * 64; gain = p.kw_gain; }
      const float v = pr[col + lane];
      const float ss = wsum(v * v);
      pr[col + lane] = v * rsqrtf(ss * (1.0f / 64) + EPS) * gain[lane];
    }
  }
  grid.sync();

  for (int kv = 0; kv < 2; ++kv) {
    const int ccol = kv ? C_VC : C_KC;
    const float* pe = kv ? p.pe_v : p.pe_k;
    const float* w1 = kv ? p.w_cmp_v1 : p.w_cmp_k1;
    float* hid = kv ? p.hidv : p.hidk;
    gemm_phase(
        NB * NCMP * 2, 256, 2048,
        [&](int r, int k) {
          const int b = r / (NCMP * 2), n = (r >> 1) % NCMP, g = r & 1;
          const int l = k >> 6, d = k & 63;
          return p.proj[(size_t)(b * S + 16 * n + l) * INC + ccol + g * 64 + d] + pe[l * 64 + d];
        },
        [&](int k, int n) { return w1[(size_t)k * 256 + n]; },
        [&](int r, int n, float v) { hid[(size_t)r * 256 + n] = geluf_(v); }, smem);
  }
  grid.sync();

  for (int wv = gwave; wv < 2 * NB * NCMP * 2; wv += gwaves) {
    const int kv = wv / (NB * NCMP * 2), r = wv % (NB * NCMP * 2);
    const float* hid = (kv ? p.hidv : p.hidk) + (size_t)r * 256;
    const float* w2 = kv ? p.w_cmp_v2 : p.w_cmp_k2;
    float acc = 0.f;
    for (int j = 0; j < 256; ++j) acc = fmaf(hid[j], w2[j * 64 + lane], acc);
    if (kv == 0) {
      const float ss = wsum(acc * acc);
      p.kcmp[(size_t)r * 64 + lane] = acc * rsqrtf(ss * (1.0f / 64) + EPS) * p.kc_gain[lane];
    } else {
      p.vcmp[(size_t)r * 64 + lane] = acc;
    }
  }
  grid.sync();

  {
    float* wq = smem + wib * 2560;
    float* wpc = wq + 256;
    float* wsc = wpc + 1024;
    float* wo = wsc + 1024;
    for (int item = gwave; item < NT * 2; item += gwaves) {
      const int tok = item >> 1, g = item & 1;
      const int b = tok / S, s = tok % S;
      const float* prow = p.proj + (size_t)tok * INC;
#pragma unroll
      for (int r = 0; r < 4; ++r) wq[r * 64 + lane] = prow[C_Q + (g * 4 + r) * 64 + lane];
      const int nvis = (s >= 31) ? ((s - 31) / 16 + 1) : 0;
      WSYNC();
#pragma unroll 1
      for (int r = 0; r < 4; ++r) {
        float sc[4];
        float mx = -INFINITY;
#pragma unroll
        for (int i = 0; i < 4; ++i) {
          const int n = i * 64 + lane;
          float a = -INFINITY;
          if (n < nvis) {
            const float* kr = p.kcmp + (size_t)((b * NCMP + n) * 2 + g) * 64;
            a = 0.f;
            for (int d = 0; d < 64; ++d) a = fmaf(wq[r * 64 + d], kr[d], a);
            a *= ATT_SCALE;
          }
          sc[i] = a;
          mx = fmaxf(mx, a);
        }
        mx = wmax(mx);
        float sum = 0.f;
#pragma unroll
        for (int i = 0; i < 4; ++i) {
          const int n = i * 64 + lane;
          sc[i] = (n < nvis) ? expf(sc[i] - mx) : 0.f;
          sum += sc[i];
        }
        sum = wsum(sum);
        const float inv = (nvis > 0) ? 1.0f / sum : 0.f;
#pragma unroll
        for (int i = 0; i < 4; ++i) wpc[r * 256 + i * 64 + lane] = sc[i] * inv;
        WSYNC();
        float o = 0.f;
        for (int n = 0; n < nvis; ++n)
          o = fmaf(wpc[r * 256 + n], p.vcmp[(size_t)((b * NCMP + n) * 2 + g) * 64 + lane], o);
        wo[r * 64 + lane] = o;
      }
      unsigned long long selmask;
      {
        const int j = lane;
        const int cur = s >> 6;
        float imp = 0.f;
        const int nlo = max(0, 4 * j - 1), nhi = min(NCMP - 1, 4 * j + 3);
        for (int r = 0; r < 4; ++r)
          for (int n = nlo; n <= nhi; ++n) imp += wpc[r * 256 + n];
        const bool forced = (j == 0) || (j == cur) || (j == cur - 1);
        const bool valid = j <= cur;
        const float key = forced ? INFINITY : (valid ? imp : -INFINITY);
        int rank = 0;
        for (int k = 0; k < 64; ++k) {
          const float ok = __shfl(key, k);
          rank += (ok > key || (ok == key && k < j)) ? 1 : 0;
        }
        selmask = __ballot(rank < 16);
      }
      const int wlo = max(0, s - 511);
      const int nwin = s - wlo + 1;
#pragma unroll 1
      for (int r = 0; r < 4; ++r) {
        float mx = -INFINITY;
        int nb = 0;
        unsigned long long mm = selmask;
        while (mm) {
          const int j = __ffsll((long long)mm) - 1;
          mm &= mm - 1;
          const int kpos = j * 64 + lane;
          float a = -INFINITY;
          if (kpos <= s) {
            const float* kr = p.proj + (size_t)(b * S + kpos) * INC + C_KS + g * 64;
            a = 0.f;
            for (int d = 0; d < 64; ++d) a = fmaf(wq[r * 64 + d], kr[d], a);
            a *= ATT_SCALE;
          }
          wsc[nb * 64 + lane] = a;
          mx = fmaxf(mx, a);
          ++nb;
        }
        mx = wmax(mx);
        WSYNC();
        float sum = 0.f;
        for (int i = 0; i < nb; ++i) {
          const float a = wsc[i * 64 + lane];
          const float e = (a == -INFINITY) ? 0.f : expf(a - mx);
          wsc[i * 64 + lane] = e;
          sum += e;
        }
        sum = wsum(sum);
        WSYNC();
        float osel = 0.f;
        mm = selmask;
        int bi = 0;
        while (mm) {
          const int j = __ffsll((long long)mm) - 1;
          mm &= mm - 1;
          if (j * 64 <= s) {
            const float* vr = p.proj + (size_t)(b * S + j * 64) * INC + C_VS + g * 64 + lane;
            const int lim = min(64, s - j * 64 + 1);
            for (int l = 0; l < lim; ++l) osel = fmaf(wsc[bi * 64 + l], vr[(size_t)l * INC], osel);
          }
          ++bi;
        }
        osel /= sum;
        WSYNC();
        mx = -INFINITY;
#pragma unroll 1
        for (int i = 0; i < 8; ++i) {
          const int ki = i * 64 + lane;
          float a = -INFINITY;
          if (ki < nwin) {
            const float* kr = p.proj + (size_t)(b * S + wlo + ki) * INC + C_KW + g * 64;
            a = 0.f;
            for (int d = 0; d < 64; ++d) a = fmaf(wq[r * 64 + d], kr[d], a);
            a *= ATT_SCALE;
          }
          wsc[ki] = a;
          mx = fmaxf(mx, a);
        }
        mx = wmax(mx);
        sum = 0.f;
#pragma unroll 1
        for (int i = 0; i < 8; ++i) {
          const int ki = i * 64 + lane;
          const float a = wsc[ki];
          const float e = (ki < nwin) ? expf(a - mx) : 0.f;
          wsc[ki] = e;
          sum += e;
        }
        sum = wsum(sum);
        WSYNC();
        float owin = 0.f;
        {
          const float* vr = p.proj + (size_t)(b * S + wlo) * INC + C_VW + g * 64 + lane;
          for (int l = 0; l < nwin; ++l) owin = fmaf(wsc[l], vr[(size_t)l * INC], owin);
        }
        owin /= sum;
        WSYNC();
        const int head = g * 4 + r;
        const float g0 = prow[C_GN + head * 3 + 0], g1 = prow[C_GN + head * 3 + 1], g2 = prow[C_GN + head * 3 + 2];
        p.onsa[(size_t)tok * 512 + head * 64 + lane] = g0 * wo[r * 64 + lane] + g1 * osel + g2 * owin;
      }
    }
  }
  grid.sync();

  for (int item = gwave; item < NB * 32 * 64; item += gwaves) {
    const int c = item & 63, g = (item >> 6) & 31, b = item >> 11;
    const int gn = g * 64 + lane;
    float bbr[16], bbi[16];
#pragma unroll
    for (int q = 0; q < 16; ++q) { bbr[q] = p.bbar[(gn * 16 + q) * 2]; bbi[q] = p.bbar[(gn * 16 + q) * 2 + 1]; }
    const float lr = p.lamb[gn * 2], li = p.lamb[gn * 2 + 1];
    float xr = 0.f, xi = 0.f;
    for (int t = 0; t < 64; ++t) {
      const float* up = p.proj + (size_t)(b * S + c * 64 + t) * INC + C_U + g * 16;
      float br = 0.f, bi = 0.f;
#pragma unroll
      for (int q = 0; q < 16; ++q) { const float u = up[q]; br = fmaf(bbr[q], u, br); bi = fmaf(bbi[q], u, bi); }
      const float nr = lr * xr - li * xi + br;
      const float ni = lr * xi + li * xr + bi;
      xr = nr; xi = ni;
    }
    p.cstate[(size_t)item * 128 + lane * 2] = xr;
    p.cstate[(size_t)item * 128 + lane * 2 + 1] = xi;
  }
  grid.sync();

  for (int idx = gtid; idx < NB * 32 * 64; idx += gthreads) {
    const int n = idx & 63, g = (idx >> 6) & 31, b = idx >> 11;
    const int gn = g * 64 + n;
    const float lr = p.lam64[gn * 2], li = p.lam64[gn * 2 + 1];
    float hr_ = 0.f, hi_ = 0.f;
    for (int c = 0; c < 64; ++c) {
      const size_t o = ((size_t)((b * 32 + g) * 64 + c)) * 128 + n * 2;
      p.cin[o] = hr_;
      p.cin[o + 1] = hi_;
      const float sr = p.cstate[o], si = p.cstate[o + 1];
      const float nr = lr * hr_ - li * hi_ + sr;
      const float ni = lr * hi_ + li * hr_ + si;
      hr_ = nr; hi_ = ni;
    }
  }
  grid.sync();

  for (int item = gwave; item < NB * 32 * 64; item += gwaves) {
    const int c = item & 63, g = (item >> 6) & 31, b = item >> 11;
    const int gn = g * 64 + lane;
    float bbr[16], bbi[16], ccr[16], cci[16];
#pragma unroll
    for (int q = 0; q < 16; ++q) {
      bbr[q] = p.bbar[(gn * 16 + q) * 2];
      bbi[q] = p.bbar[(gn * 16 + q) * 2 + 1];
      ccr[q] = p.c_re[(g * 16 + q) * 64 + lane];
      cci[q] = p.c_im[(g * 16 + q) * 64 + lane];
    }
    const float lr = p.lamb[gn * 2], li = p.lamb[gn * 2 + 1];
    float xr = p.cin[(size_t)item * 128 + lane * 2], xi = p.cin[(size_t)item * 128 + lane * 2 + 1];
    const float dsk = (lane < 16) ? p.d_skip[g * 16 + lane] : 0.f;
    for (int t = 0; t < 64; ++t) {
      const int tok = b * S + c * 64 + t;
      const float* up = p.proj + (size_t)tok * INC + C_U + g * 16;
      float br = 0.f, bi = 0.f;
#pragma unroll
      for (int q = 0; q < 16; ++q) { const float u = up[q]; br = fmaf(bbr[q], u, br); bi = fmaf(bbi[q], u, bi); }
      const float nr = lr * xr - li * xi + br;
      const float ni = lr * xi + li * xr + bi;
      xr = nr; xi = ni;
      float yv = 0.f;
#pragma unroll
      for (int q = 0; q < 16; ++q) {
        const float v = wsum(ccr[q] * xr - cci[q] * xi);
        if (lane == q) yv = v;
      }
      if (lane < 16) {
        const float y = yv + dsk * up[lane];
        p.z[(size_t)tok * 512 + g * 16 + lane] = geluf_(y);
      }
    }
  }
  grid.sync();

  gemm_phase(
      NT, 512, 512, [&](int m, int k) { return p.z[(size_t)m * 512 + k]; },
      [&](int k, int n) { return p.w_glu[(size_t)k * 512 + n]; },
      [&](int m, int n, float v) {
        p.yssm[(size_t)m * 512 + n] = p.z[(size_t)m * 512 + n] * sigmoidf_(v + p.b_glu[n]);
      },
      smem);
  grid.sync();

  gemm_phase(
      NT, D, 512, [&](int m, int k) { return p.onsa[(size_t)m * 512 + k]; },
      [&](int k, int n) { return p.w_up_attn[(size_t)k * D + n]; },
      [&](int m, int n, float v) { p.merged[(size_t)m * D + n] = p.proj[(size_t)m * INC + C_GA + n] * v; }, smem);
  grid.sync();
  gemm_phase(
      NT, D, 512, [&](int m, int k) { return p.yssm[(size_t)m * 512 + k]; },
      [&](int k, int n) { return p.w_up_ssm[(size_t)k * D + n]; },
      [&](int m, int n, float v) { p.merged[(size_t)m * D + n] += p.proj[(size_t)m * INC + C_GS + n] * v; }, smem);
  grid.sync();
  gemm_phase(
      NT, D, D, [&](int m, int k) { return p.merged[(size_t)m * D + k]; },
      [&](int k, int n) { return p.w_out[(size_t)k * D + n]; },
      [&](int m, int n, float v) {
        const int b = m / S;
        p.xmid[(size_t)m * D + n] = p.x[(size_t)m * D + n] + p.mod[b * 6 * D + 2 * D + n] * v;
      },
      smem);
  grid.sync();

  for (int row = gwave; row < NT; row += gwaves) {
    const int b = row / S;
    const float* xr = p.xmid + (size_t)row * D;
    float v[16];
    float ss = 0.f;
#pragma unroll
    for (int i = 0; i < 16; ++i) { v[i] = xr[i * 64 + lane]; ss = fmaf(v[i], v[i], ss); }
    ss = wsum(ss);
    const float r = rsqrtf(ss * (1.0f / D) + EPS);
    const float* md = p.mod + b * 6 * D;
#pragma unroll
    for (int i = 0; i < 16; ++i) {
      const int col = i * 64 + lane;
      p.h[(size_t)row * D + col] = v[i] * r * p.g_norm2[col] * (1.0f + md[4 * D + col]) + md[3 * D + col];
    }
  }
  grid.sync();

  gemm_phase(
      NT, NE, D, [&](int m, int k) { return p.h[(size_t)m * D + k]; },
      [&](int k, int n) { return p.w_router[(size_t)k * NE + n]; },
      [&](int m, int n, float v) { p.scores[(size_t)m * NE + n] = sigmoidf_(v); }, smem);
  grid.sync();

  for (int tok = gwave; tok < NT; tok += gwaves) {
    const float4 sc4 = *reinterpret_cast<const float4*>(p.scores + (size_t)tok * NE + lane * 4);
    const float4 bi4 = *reinterpret_cast<const float4*>(p.router_bias + lane * 4);
    const float sc[4] = {sc4.x, sc4.y, sc4.z, sc4.w};
    float bz[4] = {sc4.x + bi4.x, sc4.y + bi4.y, sc4.z + bi4.z, sc4.w + bi4.w};
    float m1 = -INFINITY, m2 = -INFINITY;
#pragma unroll
    for (int i = 0; i < 4; ++i) {
      const float v = bz[i];
      if (v > m1) { m2 = m1; m1 = v; } else if (v > m2) { m2 = v; }
    }
#pragma unroll
    for (int o = 1; o < 8; o <<= 1) {
      const float o1 = __shfl_xor(m1, o), o2 = __shfl_xor(m2, o);
      const float n1 = fmaxf(m1, o1);
      const float n2 = fmaxf(fminf(m1, o1), fmaxf(m2, o2));
      m1 = n1; m2 = n2;
    }
    const float gs = m1 + m2;
    const int mygrp = lane >> 3;
    int grank = 0;
#pragma unroll
    for (int g2 = 0; g2 < 8; ++g2) {
      const float og = __shfl(gs, g2 * 8);
      grank += (og > gs || (og == gs && g2 < mygrp)) ? 1 : 0;
    }
    const bool gsel = grank < 4;
#pragma unroll
    for (int i = 0; i < 4; ++i) if (!gsel) bz[i] = -INFINITY;
    unsigned taken = 0;
    float wsel = 0.f;
    int esel = 0;
    float wtot = 0.f;
#pragma unroll 1
    for (int k = 0; k < TOPK; ++k) {
      float bv = -INFINITY; int bidx = 1 << 30;
#pragma unroll
      for (int i = 0; i < 4; ++i) {
        if (!((taken >> i) & 1u) && bz[i] > bv) { bv = bz[i]; bidx = lane * 4 + i; }
      }
#pragma unroll
      for (int o = 32; o > 0; o >>= 1) {
        const float ov = __shfl_xor(bv, o);
        const int oi = __shfl_xor(bidx, o);
        if (ov > bv || (ov == bv && oi < bidx)) { bv = ov; bidx = oi; }
      }
      const int owner = bidx >> 2, slot = bidx & 3;
      float sv = 0.f;
      if (lane == owner) {
        taken |= 1u << slot;
        sv = (slot == 0) ? sc[0] : (slot == 1) ? sc[1] : (slot == 2) ? sc[2] : sc[3];
      }
      sv = __shfl(sv, owner);
      wtot += sv;
      if (lane == k) { wsel = sv; esel = bidx; }
    }
    if (lane < TOPK) {
      p.eidx[tok * TOPK + lane] = esel;
      p.ew[tok * TOPK + lane] = wsel / wtot * 2.5f;
      atomicAdd(&p.cnt[esel], 1);
    }
  }
  grid.sync();

  if (blockIdx.x == 0 && tid == 0) {
    int o = 0, r = 0;
    for (int e = 0; e < NE; ++e) {
      p.off[e] = o; p.rts[e] = r;
      const int cc = p.cnt[e];
      o += cc; r += (cc + 63) / 64;
    }
    p.off[NE] = o; p.rts[NE] = r;
  }
  grid.sync();

  for (int idx = gtid; idx < NASSIGN; idx += gthreads) {
    const int e = p.eidx[idx];
    const int pos = p.off[e] + atomicAdd(&p.cursor[e], 1);
    p.stok[pos] = idx / TOPK;
    p.sw[pos] = p.ew[idx];
  }
  grid.sync();

  gemm_phase(
      NT, DE, D, [&](int m, int k) { return p.h[(size_t)m * D + k]; },
      [&](int k, int n) { return p.ws_gate[(size_t)k * DE + n]; },
      [&](int m, int n, float v) { p.hs[(size_t)m * DE + n] = v; }, smem);
  grid.sync();
  gemm_phase(
      NT, DE, D, [&](int m, int k) { return p.h[(size_t)m * D + k]; },
      [&](int k, int n) { return p.ws_up[(size_t)k * DE + n]; },
      [&](int m, int n, float v) { p.hs[(size_t)m * DE + n] = siluf_(p.hs[(size_t)m * DE + n]) * v; }, smem);
  grid.sync();
  gemm_phase(
      NT, D, DE, [&](int m, int k) { return p.hs[(size_t)m * DE + k]; },
      [&](int k, int n) { return p.ws_down[(size_t)k * D + n]; },
      [&](int m, int n, float v) {
        const int b = m / S;
        p.out[(size_t)m * D + n] = p.xmid[(size_t)m * D + n] + p.mod[b * 6 * D + 5 * D + n] * v;
      },
      smem);
  grid.sync();

  {
    const int total_rt = p.rts[NE];
    for (int pass = 0; pass < 2; ++pass) {
      for (int tile = blockIdx.x; tile < total_rt * 4; tile += gridDim.x) {
        const int rt = tile >> 2, ct = tile & 3;
        const int e = find_expert(p.rts, rt);
        const int pos0 = p.off[e] + (rt - p.rts[e]) * 64;
        const int mvalid = min(64, p.off[e] + p.cnt[e] - pos0);
        const float* wmat = (pass ? p.w_up : p.w_gate) + (size_t)e * D * DE;
        gemm_tile64(
            mvalid, 64, D, [&](int m, int k) { return p.h[(size_t)p.stok[pos0 + m] * D + k]; },
            [&](int k, int n) { return wmat[(size_t)k * DE + ct * 64 + n]; },
            [&](int m, int n, float v) {
              float* dst = p.hr + (size_t)(pos0 + m) * DE + ct * 64 + n;
              if (pass == 0) *dst = v; else *dst = siluf_(*dst) * v;
            },
            smem);
      }
      grid.sync();
    }
    for (int tile = blockIdx.x; tile < total_rt * 16; tile += gridDim.x) {
      const int rt = tile >> 4, ct = tile & 15;
      const int e = find_expert(p.rts, rt);
      const int pos0 = p.off[e] + (rt - p.rts[e]) * 64;
      const int mvalid = min(64, p.off[e] + p.cnt[e] - pos0);
      const float* wmat = p.w_down + (size_t)e * DE * D;
      gemm_tile64(
          mvalid, 64, DE, [&](int m, int k) { return p.hr[(size_t)(pos0 + m) * DE + k]; },
          [&](int k, int n) { return wmat[(size_t)k * D + ct * 64 + n]; },
          [&](int m, int n, float v) {
            const int tok = p.stok[pos0 + m];
            const int b = tok / S;
            const int col = ct * 64 + n;
            atomicAdd(&p.out[(size_t)tok * D + col], p.mod[b * 6 * D + 5 * D + col] * p.sw[pos0 + m] * v);
          },
          smem);
    }
  }
}

extern "C" void kernel_launch(void* const* d_in, const int* in_sizes, int n_in, void* d_out, int out_size,
                              void* d_ws, size_t ws_size, hipStream_t stream) {
  (void)in_sizes; (void)n_in; (void)out_size; (void)ws_size;
  Params p{};
  const float* const* in = reinterpret_cast<const float* const*>(d_in);
  p.x = in[0]; p.c = in[1]; p.w_ada = in[2]; p.b_ada = in[3]; p.g_norm1 = in[4]; p.g_norm2 = in[5];
  p.w_in = in[6]; p.q_gain = in[7]; p.kc_gain = in[8]; p.ks_gain = in[9]; p.kw_gain = in[10];
  p.pe_k = in[11]; p.pe_v = in[12]; p.w_cmp_k1 = in[13]; p.w_cmp_k2 = in[14]; p.w_cmp_v1 = in[15];
  p.w_cmp_v2 = in[16]; p.a_re = in[17]; p.a_im = in[18]; p.log_dt = in[19]; p.b_re = in[20];
  p.b_im = in[21]; p.c_re = in[22]; p.c_im = in[23]; p.d_skip = in[24]; p.w_glu = in[25];
  p.b_glu = in[26]; p.w_up_attn = in[27]; p.w_up_ssm = in[28]; p.w_out = in[29]; p.w_router = in[30];
  p.router_bias = in[31]; p.w_gate = in[32]; p.w_up = in[33]; p.w_down = in[34]; p.ws_gate = in[35];
  p.ws_up = in[36]; p.ws_down = in[37];
  p.out = (float*)d_out;

  char* base = (char*)d_ws;
  size_t o = 0;
  auto take = [&](size_t bytes) { void* r = base + o; o += (bytes + 255) & ~(size_t)255; return r; };
  p.mod = (float*)take(sizeof(float) * NB * 6 * D);
  p.h = (float*)take(sizeof(float) * (size_t)NT * D);
  p.proj = (float*)take(sizeof(float) * (size_t)NT * INC);
  p.hidk = (float*)take(sizeof(float) * 2040 * 256);
  p.hidv = (float*)take(sizeof(float) * 2040 * 256);
  p.kcmp = (float*)take(sizeof(float) * 2040 * 64);
  p.vcmp = (float*)take(sizeof(float) * 2040 * 64);
  p.onsa = (float*)take(sizeof(float) * (size_t)NT * 512);
  p.lamb = (float*)take(sizeof(float) * 2048 * 2);
  p.lam64 = (float*)take(sizeof(float) * 2048 * 2);
  p.bbar = (float*)take(sizeof(float) * 2048 * 32);
  p.cstate = (float*)take(sizeof(float) * NB * 32 * 64 * 128);
  p.cin = (float*)take(sizeof(float) * NB * 32 * 64 * 128);
  p.z = (float*)take(sizeof(float) * (size_t)NT * 512);
  p.yssm = (float*)take(sizeof(float) * (size_t)NT * 512);
  p.merged = (float*)take(sizeof(float) * (size_t)NT * D);
  p.xmid = (float*)take(sizeof(float) * (size_t)NT * D);
  p.scores = (float*)take(sizeof(float) * (size_t)NT * NE);
  p.eidx = (int*)take(sizeof(int) * NASSIGN);
  p.ew = (float*)take(sizeof(float) * NASSIGN);
  p.cnt = (int*)take(sizeof(int) * NE);
  p.cursor = (int*)take(sizeof(int) * NE);
  p.off = (int*)take(sizeof(int) * (NE + 1));
  p.rts = (int*)take(sizeof(int) * (NE + 1));
  p.stok = (int*)take(sizeof(int) * NASSIGN);
  p.sw = (float*)take(sizeof(float) * NASSIGN);
  p.hs = (float*)take(sizeof(float) * (size_t)NT * DE);
  p.hr = (float*)take(sizeof(float) * (size_t)NASSIGN * DE);
  if (o > ws_size) fprintf(stderr, "workspace too small: need %zu have %zu\n", o, ws_size);

  static int grid_blocks = 0;
  if (!grid_blocks) {
    int dev = 0, cus = 0, per_cu = 0;
    hipGetDevice(&dev);
    hipDeviceGetAttribute(&cus, hipDeviceAttributeMultiprocessorCount, dev);
    hipOccupancyMaxActiveBlocksPerMultiprocessor(&per_cu, mega, 256, 0);
    if (per_cu > 2) per_cu = 2;
    if (per_cu < 1) per_cu = 1;
    grid_blocks = cus * per_cu;
  }
  void* args[] = {&p};
  hipError_t e = hipLaunchCooperativeKernel((void*)mega, dim3(grid_blocks), dim3(256), args, 0, stream);
  if (e != hipSuccess) fprintf(stderr, "cooperative launch failed: %s (grid %d)\n", hipGetErrorString(e), grid_blocks);
}
```

```cpp
#include <hip/hip_runtime.h>
#include <hip/hip_cooperative_groups.h>
#include <cstdio>
#include <cstdint>
namespace cg = cooperative_groups;

constexpr int D = 1024;
constexpr int NB = 4;
constexpr int S = 4096;
constexpr int NT = NB * S;
constexpr int INC = 3864;
constexpr int C_Q = 0, C_KC = 512, C_VC = 640, C_KS = 768, C_VS = 896, C_KW = 1024, C_VW = 1152,
              C_GN = 1280, C_U = 1304, C_GA = 1816, C_GS = 2840;
constexpr int NCMP = 255;
constexpr int NE = 256;
constexpr int TOPK = 8;
constexpr int DE = 256;
constexpr int NASSIGN = NT * TOPK;
constexpr float EPS = 1e-6f;
constexpr float ATT_SCALE = 0.125f;

struct Params {
  const float* x; const float* c; const float* w_ada; const float* b_ada; const float* g_norm1;
  const float* g_norm2; const float* w_in; const float* q_gain; const float* kc_gain;
  const float* ks_gain; const float* kw_gain; const float* pe_k; const float* pe_v;
  const float* w_cmp_k1; const float* w_cmp_k2; const float* w_cmp_v1; const float* w_cmp_v2;
  const float* a_re; const float* a_im; const float* log_dt; const float* b_re; const float* b_im;
  const float* c_re; const float* c_im; const float* d_skip; const float* w_glu; const float* b_glu;
  const float* w_up_attn; const float* w_up_ssm; const float* w_out; const float* w_router;
  const float* router_bias; const float* w_gate; const float* w_up; const float* w_down;
  const float* ws_gate; const float* ws_up; const float* ws_down;
  float* out;
  float* mod;
  float* cbias;
  float* h;
  unsigned short* qb;
  unsigned short* kvb;
  unsigned short* cmpb;
  float* gn;
  float* u;
  float* ga;
  float* gs;
  float* hidk;
  float* hidv;
  float* onsa;
  float* lamb;
  float* lam64;
  float* bbar;
  float* cstate;
  float* cin;
  float* z;
  float* yssm;
  float* merged;
  float* xmid;
  float* scores;
  int* eidx;
  float* ew;
  int* cnt;
  int* cursor;
  int* off;
  int* rts;
  int* stok;
  float* sw;
  float* hs;
  float* hr;
};

__device__ __forceinline__ float wsum(float v) {
#pragma unroll
  for (int o = 32; o > 0; o >>= 1) v += __shfl_xor(v, o);
  return v;
}
__device__ __forceinline__ float wmax(float v) {
#pragma unroll
  for (int o = 32; o > 0; o >>= 1) v = fmaxf(v, __shfl_xor(v, o));
  return v;
}
#define WSYNC() do { __builtin_amdgcn_fence(__ATOMIC_ACQ_REL, "wavefront"); __builtin_amdgcn_wave_barrier(); } while (0)
__device__ __forceinline__ float sigmoidf_(float x) { return 1.0f / (1.0f + expf(-x)); }
__device__ __forceinline__ float siluf_(float x) { return x / (1.0f + expf(-x)); }
__device__ __forceinline__ float geluf_(float x) {
  return 0.5f * x * (1.0f + tanhf(0.7978845608028654f * (x + 0.044715f * x * x * x)));
}

typedef short bf16x8 __attribute__((ext_vector_type(8)));
typedef float f32x4 __attribute__((ext_vector_type(4)));
typedef unsigned u32x4 __attribute__((ext_vector_type(4)));
#define LAS __attribute__((address_space(3)))

__device__ __forceinline__ unsigned cvt_pk_bf16(float lo, float hi) {
  unsigned r;
  asm("v_cvt_pk_bf16_f32 %0, %1, %2" : "=v"(r) : "v"(lo), "v"(hi));
  return r;
}
__device__ __forceinline__ int lds_byte(int r, int c) {
  const int st = (r >> 4) * 2 + (c >> 5), rr = r & 15, cc = c & 31, ob = rr * 64 + cc * 2;
  return st * 1024 + (ob ^ (((ob >> 9) & 1) << 5));
}

template <bool ABF, class AF, class BF, class EPW>
__device__ __forceinline__ void gemm128(int K, AF arow, BF bcol, size_t ldb, EPW epiw, LAS unsigned char* lds) {
  const int t = threadIdx.x, wid = t >> 6, lane = t & 63, wr = wid >> 1, wc = wid & 1, fr = lane & 15, fq = lane >> 4;
  LAS unsigned char* ldsA = lds;
  LAS unsigned char* ldsB = lds + 16384;
  const int ar0 = t >> 3, ac = (t & 7) * 8;
  const int n4 = t & 31, kg = t >> 5;
  const float* bp = bcol(n4 * 4);
  f32x4 acc[4][4];
#pragma unroll
  for (int m = 0; m < 4; ++m)
#pragma unroll
    for (int n = 0; n < 4; ++n) acc[m][n] = (f32x4){0.f, 0.f, 0.f, 0.f};
  f32x4 ra[4][ABF ? 1 : 2], rb[8];
  auto gload = [&](int k0) {
#pragma unroll
    for (int i = 0; i < 4; ++i) {
      const void* pa = arow(ar0 + 32 * i, k0 + ac);
      if (ABF) {
        if (pa) ra[i][0] = *(const f32x4*)pa; else ra[i][0] = (f32x4){0.f, 0.f, 0.f, 0.f};
      } else {
        if (pa) { ra[i][0] = *(const f32x4*)pa; ra[i][ABF ? 0 : 1] = *((const f32x4*)pa + 1); }
        else { ra[i][0] = (f32x4){0.f, 0.f, 0.f, 0.f}; ra[i][ABF ? 0 : 1] = (f32x4){0.f, 0.f, 0.f, 0.f}; }
      }
    }
#pragma unroll
    for (int j = 0; j < 8; ++j) {
      if (bp) rb[j] = *(const f32x4*)(bp + (size_t)(k0 + kg * 8 + j) * ldb);
      else rb[j] = (f32x4){0.f, 0.f, 0.f, 0.f};
    }
  };
  gload(0);
  const int aoff = lds_byte(wr * 64 + fr, fq * 8), boff = lds_byte(wc * 64 + fr, fq * 8);
  const int nk = K >> 6;
  for (int kt = 0; kt < nk; ++kt) {
#pragma unroll
    for (int i = 0; i < 4; ++i) {
      if (ABF) {
        *(LAS f32x4*)(ldsA + lds_byte(ar0 + 32 * i, ac)) = ra[i][0];
      } else {
        u32x4 w;
        w.x = cvt_pk_bf16(ra[i][0][0], ra[i][0][1]); w.y = cvt_pk_bf16(ra[i][0][2], ra[i][0][3]);
        w.z = cvt_pk_bf16(ra[i][ABF ? 0 : 1][0], ra[i][ABF ? 0 : 1][1]); w.w = cvt_pk_bf16(ra[i][ABF ? 0 : 1][2], ra[i][ABF ? 0 : 1][3]);
        *(LAS u32x4*)(ldsA + lds_byte(ar0 + 32 * i, ac)) = w;
      }
    }
#pragma unroll
    for (int c = 0; c < 4; ++c) {
      u32x4 w;
      w.x = cvt_pk_bf16(rb[0][c], rb[1][c]); w.y = cvt_pk_bf16(rb[2][c], rb[3][c]);
      w.z = cvt_pk_bf16(rb[4][c], rb[5][c]); w.w = cvt_pk_bf16(rb[6][c], rb[7][c]);
      *(LAS u32x4*)(ldsB + lds_byte(n4 * 4 + c, kg * 8)) = w;
    }
    __syncthreads();
    if (kt + 1 < nk) gload((kt + 1) * 64);
#pragma unroll
    for (int ks = 0; ks < 2; ++ks) {
      bf16x8 af[4], bf[4];
#pragma unroll
      for (int m = 0; m < 4; ++m) af[m] = *(const LAS bf16x8*)(ldsA + aoff + m * 2048 + ks * 1024);
#pragma unroll
      for (int n = 0; n < 4; ++n) bf[n] = *(const LAS bf16x8*)(ldsB + boff + n * 2048 + ks * 1024);
#pragma unroll
      for (int m = 0; m < 4; ++m)
#pragma unroll
        for (int n = 0; n < 4; ++n)
          acc[m][n] = __builtin_amdgcn_mfma_f32_16x16x32_bf16(bf[n], af[m], acc[m][n], 0, 0, 0);
    }
    __syncthreads();
  }
  epiw(acc, wr, wc, fr, fq);
}

template <bool ABF, class AL, class BL, class EP>
__device__ __forceinline__ void gemm_phase(int M, int N, int K, AL al, BL bl, size_t ldb, EP ep, LAS unsigned char* lds) {
  const int tn = (N + 127) / 128, tm = (M + 127) / 128;
  for (int tile = blockIdx.x; tile < tm * tn; tile += gridDim.x) {
    const int m0 = (tile / tn) * 128, n0 = (tile % tn) * 128;
    gemm128<ABF>(
        K, [&](int r, int k) -> const void* { return (m0 + r < M) ? (const void*)al(m0 + r, k) : nullptr; },
        [&](int c) -> const float* { return (n0 + c < N) ? bl(n0 + c) : nullptr; }, ldb,
        [&](const f32x4 (&acc)[4][4], int wr, int wc, int fr, int fq) {
#pragma unroll
          for (int m = 0; m < 4; ++m)
#pragma unroll
            for (int n = 0; n < 4; ++n) {
              const int r = m0 + wr * 64 + m * 16 + fr, c = n0 + wc * 64 + n * 16 + 4 * fq;
              if (r < M && c < N) ep(r, c, acc[m][n]);
            }
        },
        lds);
  }
}

__device__ __forceinline__ int find_expert(const int* rts, int rt) {
  int lo = 0, hi = NE;
  while (hi - lo > 1) {
    const int mid = (lo + hi) >> 1;
    if (rts[mid] <= rt) lo = mid; else hi = mid;
  }
  return lo;
}


typedef short s16x4 __attribute__((ext_vector_type(4)));
#define OPAQUE(x) asm volatile("" : "+v"(x))
#define REDERIVE() do { OPAQUE(t); w = t >> 6; lane = t & 63; fr = lane & 15; fq = lane >> 4; rloc = w * 16 + fr; } while (0)
constexpr int VROW = 160;

__device__ __forceinline__ bf16x8 pack8(const f32x4 a, const f32x4 b) {
  u32x4 w;
  w.x = cvt_pk_bf16(a[0], a[1]); w.y = cvt_pk_bf16(a[2], a[3]);
  w.z = cvt_pk_bf16(b[0], b[1]); w.w = cvt_pk_bf16(b[2], b[3]);
  return __builtin_bit_cast(bf16x8, w);
}
__device__ __forceinline__ void tile_fetch(bf16x8 (&r)[2], const unsigned short* base, int t) {
  const bf16x8* q = (const bf16x8*)(base + t * 16);
  r[0] = q[0];
  r[1] = q[1];
}
__device__ __forceinline__ void stage_k(const bf16x8 (&r)[2], LAS unsigned char* ldsK, int t) {
  const int row = t >> 2, c0 = (t & 3) * 16;
  *(LAS bf16x8*)(ldsK + lds_byte(row, c0)) = r[0];
  *(LAS bf16x8*)(ldsK + lds_byte(row, c0 + 8)) = r[1];
}
__device__ __forceinline__ void stage_v(const bf16x8 (&r)[2], LAS unsigned char* ldsV, int t) {
  const int row = t >> 2, c0 = (t & 3) * 16;
  *(LAS bf16x8*)(ldsV + row * VROW + c0 * 2) = r[0];
  *(LAS bf16x8*)(ldsV + row * VROW + c0 * 2 + 16) = r[1];
}
template <int H>
__device__ __forceinline__ void attn_qk_h(f32x4 (&s)[4][2], const bf16x8 (&qf)[4][2], LAS unsigned char* ldsK, int fr, int fq) {
  const int koff = lds_byte(fr, fq * 8);
#pragma unroll
  for (int m = 0; m < 4; ++m)
#pragma unroll
    for (int nn = 0; nn < 2; ++nn) s[m][nn] = (f32x4){0.f, 0.f, 0.f, 0.f};
#pragma unroll
  for (int nn = 0; nn < 2; ++nn)
#pragma unroll
    for (int ks = 0; ks < 2; ++ks) {
      const bf16x8 kf = *(const LAS bf16x8*)(ldsK + koff + (2 * H + nn) * 2048 + ks * 1024);
#pragma unroll
      for (int m = 0; m < 4; ++m) s[m][nn] = __builtin_amdgcn_mfma_f32_16x16x32_bf16(kf, qf[m][ks], s[m][nn], 0, 0, 0);
    }
}
template <int H>
__device__ __forceinline__ void attn_pv_h(f32x4 (&o)[4][4], const bf16x8 (&pf)[4], LAS unsigned char* ldsV, int lane) {
  const int fq = lane >> 4, i = lane & 15;
  const int vbase = (4 * fq + (i >> 2)) * VROW + (i & 3) * 8;
#pragma unroll
  for (int dt = 0; dt < 4; ++dt) {
    LAS unsigned char* a0 = ldsV + vbase + H * 32 * VROW + dt * 32;
    const s16x4 v0 = __builtin_amdgcn_ds_read_tr16_b64_v4i16((LAS s16x4*)a0);
    const s16x4 v1 = __builtin_amdgcn_ds_read_tr16_b64_v4i16((LAS s16x4*)(a0 + 16 * VROW));
    bf16x8 vf;
    vf[0] = v0[0]; vf[1] = v0[1]; vf[2] = v0[2]; vf[3] = v0[3];
    vf[4] = v1[0]; vf[5] = v1[1]; vf[6] = v1[2]; vf[7] = v1[3];
#pragma unroll
    for (int m = 0; m < 4; ++m) o[m][dt] = __builtin_amdgcn_mfma_f32_16x16x32_bf16(vf, pf[m], o[m][dt], 0, 0, 0);
  }
}
template <int H, bool EM>
__device__ __forceinline__ void attn_softmax_h(f32x4 (&s)[4][2], f32x4 (&o)[4][4], float (&mrow)[4], float (&lrow)[4],
                                               bf16x8 (&pf)[4], bool rowok, int lo, int hi, int fq) {
#pragma unroll
  for (int m = 0; m < 4; ++m) {
    float mx = -INFINITY;
#pragma unroll
    for (int nn = 0; nn < 2; ++nn)
#pragma unroll
      for (int jj = 0; jj < 4; ++jj) {
        constexpr int dummy2 = 0; (void)dummy2;
        const int kc = 16 * (2 * H + nn) + jj;
        const bool ok = rowok && (!EM || (lo < kc && hi >= kc));
        const float v = ok ? s[m][nn][jj] : -INFINITY;
        s[m][nn][jj] = v;
        mx = fmaxf(mx, v);
      }
    mx = fmaxf(mx, __shfl_xor(mx, 16));
    mx = fmaxf(mx, __shfl_xor(mx, 32));
    const float mnew = fmaxf(mrow[m], mx);
    const float msafe = (mnew == -INFINITY) ? 0.f : mnew;
    const float alpha = __builtin_amdgcn_exp2f(mrow[m] - msafe);
    mrow[m] = mnew;
    float ls = 0.f;
#pragma unroll
    for (int nn = 0; nn < 2; ++nn)
#pragma unroll
      for (int jj = 0; jj < 4; ++jj) {
        const float pv = __builtin_amdgcn_exp2f(s[m][nn][jj] - msafe);
        s[m][nn][jj] = pv;
        ls += pv;
      }
    lrow[m] = lrow[m] * alpha + ls;
#pragma unroll
    for (int dt = 0; dt < 4; ++dt) o[m][dt] = o[m][dt] * alpha;
    pf[m] = pack8(s[m][0], s[m][1]);
  }
}
template <int H, bool EM>
__device__ __forceinline__ void attn_sub(f32x4 (&o)[4][4], float (&mrow)[4], float (&lrow)[4], const bf16x8 (&qf)[4][2],
                                         LAS unsigned char* ldsK, LAS unsigned char* ldsV, bool rowok, int lo, int hi, int lane) {
  f32x4 s[4][2];
  bf16x8 pf[4];
  __builtin_amdgcn_sched_barrier(0);
  attn_qk_h<H>(s, qf, ldsK, lane & 15, lane >> 4);
  __builtin_amdgcn_sched_barrier(0);
  attn_softmax_h<H, EM>(s, o, mrow, lrow, pf, rowok, lo, hi, lane >> 4);
  __builtin_amdgcn_sched_barrier(0);
  attn_pv_h<H>(o, pf, ldsV, lane);
  __builtin_amdgcn_sched_barrier(0);
}
template <bool EM>
__device__ __forceinline__ void attn_tile(f32x4 (&o)[4][4], float (&mrow)[4], float (&lrow)[4], const bf16x8 (&qf)[4][2],
                                          LAS unsigned char* ldsK, LAS unsigned char* ldsV, bool rowok, int lo, int hi, int lane) {
  attn_sub<0, EM>(o, mrow, lrow, qf, ldsK, ldsV, rowok, lo, hi, lane);
  attn_sub<1, EM>(o, mrow, lrow, qf, ldsK, ldsV, rowok, lo, hi, lane);
}
template <int H>
__device__ __forceinline__ void cmp_stats(float (&mrow)[4], float (&lrow)[4], const bf16x8 (&qf)[4][2], LAS unsigned char* ldsK, int hi, int lane) {
  const int fq = lane >> 4;
  f32x4 s[4][2];
  __builtin_amdgcn_sched_barrier(0);
  attn_qk_h<H>(s, qf, ldsK, lane & 15, fq);
  __builtin_amdgcn_sched_barrier(0);
#pragma unroll
  for (int m = 0; m < 4; ++m) {
    float mx = -INFINITY;
#pragma unroll
    for (int nn = 0; nn < 2; ++nn)
#pragma unroll
      for (int jj = 0; jj < 4; ++jj) {
        const int kc = 16 * (2 * H + nn) + jj;
        const float v = (hi >= kc) ? s[m][nn][jj] : -INFINITY;
        s[m][nn][jj] = v;
        mx = fmaxf(mx, v);
      }
    mx = fmaxf(mx, __shfl_xor(mx, 16));
    mx = fmaxf(mx, __shfl_xor(mx, 32));
    const float mnew = fmaxf(mrow[m], mx);
    const float msafe = (mnew == -INFINITY) ? 0.f : mnew;
    float ls = 0.f;
#pragma unroll
    for (int nn = 0; nn < 2; ++nn)
#pragma unroll
      for (int jj = 0; jj < 4; ++jj) ls += __builtin_amdgcn_exp2f(s[m][nn][jj] - msafe);
    lrow[m] = lrow[m] * __builtin_amdgcn_exp2f(mrow[m] - msafe) + ls;
    mrow[m] = mnew;
  }
  __builtin_amdgcn_sched_barrier(0);
}
template <int H>
__device__ __forceinline__ void cmp_apply(f32x4 (&o)[4][4], const float (&msf)[4], const float (&linv)[4], float& lastprev, LAS float* improw,
                                          const bf16x8 (&qf)[4][2], LAS unsigned char* ldsK, LAS unsigned char* ldsV, int hi, int lane) {
  const int fq = lane >> 4;
  f32x4 s[4][2];
  bf16x8 pf[4];
  __builtin_amdgcn_sched_barrier(0);
  attn_qk_h<H>(s, qf, ldsK, lane & 15, fq);
  __builtin_amdgcn_sched_barrier(0);
#pragma unroll
  for (int m = 0; m < 4; ++m) {
#pragma unroll
    for (int nn = 0; nn < 2; ++nn)
#pragma unroll
      for (int jj = 0; jj < 4; ++jj) {
        const int kc = 16 * (2 * H + nn) + jj;
        s[m][nn][jj] = (hi >= kc) ? __builtin_amdgcn_exp2f(s[m][nn][jj] - msf[m]) * linv[m] : 0.f;
      }
    pf[m] = pack8(s[m][0], s[m][1]);
  }
#pragma unroll
  for (int nn = 0; nn < 2; ++nn) {
    float gs = 0.f, last = 0.f;
#pragma unroll
    for (int m = 0; m < 4; ++m) {
      gs += (s[m][nn][0] + s[m][nn][1]) + (s[m][nn][2] + s[m][nn][3]);
      last += s[m][nn][3];
    }
    const float pa = __shfl(last, (lane + 48) & 63);
    const float pb = __shfl(lastprev, (lane + 48) & 63);
    improw[(2 * H + nn) * 4 + fq] = gs + ((fq > 0) ? pa : pb);
    lastprev = last;
  }
  __builtin_amdgcn_sched_barrier(0);
  attn_pv_h<H>(o, pf, ldsV, lane);
  __builtin_amdgcn_sched_barrier(0);
}

__device__ __forceinline__ void attn_chunk(const Params& p, LAS unsigned char* lds, int b, int g, int ci) {
  int t = threadIdx.x;
  OPAQUE(t);
  int w = t >> 6, lane = t & 63, fr = lane & 15, fq = lane >> 4;
  LAS unsigned char* ldsK = lds;
  LAS unsigned char* ldsV = lds + 8192;
  LAS float* impb = (LAS float*)(lds + 18432) + w * 1024;
  LAS unsigned* unib = (LAS unsigned*)(lds + 18432 + 16384);
  int rloc = w * 16 + fr;
  const int tq = ci * 64 + rloc;
  const size_t tok = (size_t)b * S + tq;
  const float* grow = p.gn + tok * 24 + g * 12;
  float* orow = p.onsa + tok * 512 + g * 256;
  bf16x8 qf[4][2];
#pragma unroll
  for (int m = 0; m < 4; ++m)
#pragma unroll
    for (int ks = 0; ks < 2; ++ks)
      qf[m][ks] = *(const bf16x8*)(p.qb + tok * 512 + (g * 4 + m) * 64 + ks * 32 + fq * 8);
  f32x4 o[4][4];
  float mrow[4], lrow[4];
  bf16x8 rk[2], rv[2];

  const int nvis = (tq >= 31) ? ((tq - 31) / 16 + 1) : 0;
  const int nvmax = 4 * ci + 3;
  const int ntc = (nvmax + 63) >> 6;
  const unsigned short* kcb = p.cmpb + (size_t)((0 * NB + b) * 2 + g) * 256 * 64;
  const unsigned short* vcb = p.cmpb + (size_t)((1 * NB + b) * 2 + g) * 256 * 64;
#pragma unroll
  for (int m = 0; m < 4; ++m) { mrow[m] = -INFINITY; lrow[m] = 0.f; }
  REDERIVE();
  for (int tc = 0; tc < ntc; ++tc) {
    tile_fetch(rk, kcb + (size_t)tc * 4096, t);
    stage_k(rk, ldsK, t);
    __syncthreads();
    const int hi = nvis - 1 - tc * 64 - 4 * fq;
    cmp_stats<0>(mrow, lrow, qf, ldsK, hi, lane);
    cmp_stats<1>(mrow, lrow, qf, ldsK, hi, lane);
    __syncthreads();
  }
  {
    float linv[4], msf[4];
#pragma unroll
    for (int m = 0; m < 4; ++m) {
      float l = lrow[m];
      l += __shfl_xor(l, 16);
      l += __shfl_xor(l, 32);
      linv[m] = (l > 0.f) ? 1.0f / l : 0.f;
      msf[m] = (mrow[m] == -INFINITY) ? 0.f : mrow[m];
    }
    REDERIVE();
#pragma unroll
    for (int m = 0; m < 4; ++m)
#pragma unroll
      for (int dt = 0; dt < 4; ++dt) o[m][dt] = (f32x4){0.f, 0.f, 0.f, 0.f};
    float lastprev = 0.f;
    for (int tc = 0; tc < ntc; ++tc) {
      tile_fetch(rk, kcb + (size_t)tc * 4096, t);
      tile_fetch(rv, vcb + (size_t)tc * 4096, t);
      stage_k(rk, ldsK, t);
      stage_v(rv, ldsV, t);
      __syncthreads();
      const int hi = nvis - 1 - tc * 64 - 4 * fq;
      cmp_apply<0>(o, msf, linv, lastprev, impb + fr * 64 + tc * 16, qf, ldsK, ldsV, hi, lane);
      cmp_apply<1>(o, msf, linv, lastprev, impb + fr * 64 + tc * 16, qf, ldsK, ldsV, hi, lane);
      __syncthreads();
    }
  }
#pragma unroll
  for (int m = 0; m < 4; ++m) {
    const float gate = grow[m * 3 + 0];
#pragma unroll
    for (int dt = 0; dt < 4; ++dt) *(f32x4*)(orow + m * 64 + dt * 16 + 4 * fq) = o[m][dt] * gate;
  }
  unsigned mlo, mhi;
  REDERIVE();
  {
    WSYNC();
    float kv[16];
    const int c0 = -fq * 16, c1 = ci - fq * 16;
#pragma unroll
    for (int i = 0; i < 16; ++i) {
      const bool forced = (c0 == i) || (c1 == i) || (c1 == i + 1);
      float v = (c1 >= i) ? impb[fr * 64 + fq * 16 + i] : -INFINITY;
      if (forced) v = INFINITY;
      kv[i] = v;
    }
    WSYNC();
#pragma unroll
    for (int i = 0; i < 16; ++i) impb[fr * 64 + fq * 16 + i] = kv[i];
    WSYNC();
    int rank[16];
#pragma unroll
    for (int i = 0; i < 16; ++i) rank[i] = 0;
#pragma unroll 2
    for (int k = 0; k < 64; ++k) {
      const float ok = impb[fr * 64 + k];
      const int kq = k - fq * 16;
#pragma unroll
      for (int i = 0; i < 16; ++i) rank[i] += (ok > kv[i] || (ok == kv[i] && kq < i)) ? 1 : 0;
    }
    unsigned piece = 0;
#pragma unroll
    for (int i = 0; i < 16; ++i) piece |= (rank[i] < 16) ? (1u << i) : 0u;
    unsigned lo32 = (fq == 0) ? piece : (fq == 1) ? (piece << 16) : 0u;
    unsigned hi32 = (fq == 2) ? piece : (fq == 3) ? (piece << 16) : 0u;
    lo32 |= __shfl_xor(lo32, 16); lo32 |= __shfl_xor(lo32, 32);
    hi32 |= __shfl_xor(hi32, 16); hi32 |= __shfl_xor(hi32, 32);
    mlo = lo32; mhi = hi32;
    unsigned ulo = lo32, uhi = hi32;
#pragma unroll
    for (int off = 1; off < 16; off <<= 1) { ulo |= __shfl_xor(ulo, off); uhi |= __shfl_xor(uhi, off); }
    if (lane == 0) { unib[w * 2] = ulo; unib[w * 2 + 1] = uhi; }
    __syncthreads();
  }
  unsigned long long un;
  {
    const unsigned ulo = unib[0] | unib[2] | unib[4] | unib[6];
    const unsigned uhi = unib[1] | unib[3] | unib[5] | unib[7];
    un = ((unsigned long long)__builtin_amdgcn_readfirstlane(uhi) << 32) | (unsigned long long)__builtin_amdgcn_readfirstlane(ulo);
  }
  const unsigned long long rowmask = ((unsigned long long)mhi << 32) | mlo;

#pragma unroll 1
  for (int pass = 0; pass < 2; ++pass) {
    REDERIVE();
#pragma unroll
    for (int m = 0; m < 4; ++m) {
      mrow[m] = -INFINITY; lrow[m] = 0.f;
#pragma unroll
      for (int dt = 0; dt < 4; ++dt) o[m][dt] = (f32x4){0.f, 0.f, 0.f, 0.f};
    }
    const unsigned short* kb = p.kvb + (size_t)(((2 + 2 * pass) * NB + b) * 2 + g) * S * 64;
    const unsigned short* vb = p.kvb + (size_t)(((3 + 2 * pass) * NB + b) * 2 + g) * S * 64;
    const unsigned long long upto = (ci == 63) ? ~0ull : ((1ull << (ci + 1)) - 1ull);
    const int jlo = max(0, ci - 8);
    unsigned long long rem = pass ? (upto & ~((1ull << jlo) - 1ull)) : (un & upto);
    const int jwin0 = pass ? ci - 8 : -100;
    int j = __ffsll((long long)rem) - 1;
    tile_fetch(rk, kb + (size_t)j * 4096, t);
    tile_fetch(rv, vb + (size_t)j * 4096, t);
    while (rem) {
      rem &= rem - 1;
      stage_k(rk, ldsK, t);
      stage_v(rv, ldsV, t);
      __syncthreads();
      const int jn = rem ? (__ffsll((long long)rem) - 1) : -1;
      if (jn >= 0) {
        tile_fetch(rk, kb + (size_t)jn * 4096, t);
        tile_fetch(rv, vb + (size_t)jn * 4096, t);
      }
      const bool rowok = pass ? true : (bool)((rowmask >> j) & 1ull);
      int hi = (j == ci) ? rloc : 63;
      const int lo = ((j == jwin0) ? rloc : -1) - 4 * fq;
      hi = (rowok ? hi : -1000) - 4 * fq;
      attn_tile<true>(o, mrow, lrow, qf, ldsK, ldsV, true, lo, hi, lane);
      __syncthreads();
      j = jn;
    }
#pragma unroll
    for (int m = 0; m < 4; ++m) {
      float l = lrow[m];
      l += __shfl_xor(l, 16);
      l += __shfl_xor(l, 32);
      const float sc = grow[m * 3 + 1 + pass] / l;
#pragma unroll
      for (int dt = 0; dt < 4; ++dt) {
        f32x4* dst = (f32x4*)(orow + m * 64 + dt * 16 + 4 * fq);
        *dst = *dst + o[m][dt] * sc;
      }
    }
  }
}

constexpr int SMEM_FLOATS = 10240;

__global__ void __launch_bounds__(256, 2) mega(Params p) {
  cg::grid_group grid = cg::this_grid();
  __shared__ __attribute__((aligned(16))) float smem[SMEM_FLOATS];
  LAS unsigned char* lds = (LAS unsigned char*)smem;
  const int tid = threadIdx.x;
  const int lane = tid & 63;
  const int wib = tid >> 6;
  const int gthreads = gridDim.x * 256;
  const int gtid = blockIdx.x * 256 + tid;
  const int gwaves = gridDim.x * 4;
  const int gwave = blockIdx.x * 4 + wib;

  {
    for (int i = tid; i < NB * D; i += 256) smem[i] = siluf_(p.c[i]);
    __syncthreads();
    for (int idx = gtid; idx < NB * 6 * D; idx += gthreads) {
      const int b = idx / (6 * D), j = idx % (6 * D);
      float acc = p.b_ada[j];
      const float* sc = smem + b * D;
      for (int k = 0; k < D; ++k) acc = fmaf(sc[k], p.w_ada[(size_t)k * (6 * D) + j], acc);
      p.mod[idx] = acc;
    }
    for (int idx = gtid; idx < 32 * 64; idx += gthreads) {
      const int g = idx / 64;
      const double dt = exp((double)p.log_dt[g]);
      const double lr = p.a_re[idx], li = p.a_im[idx];
      const double mag = exp(lr * dt);
      const double br = mag * cos(li * dt), bi = mag * sin(li * dt);
      p.lamb[idx * 2] = (float)br;
      p.lamb[idx * 2 + 1] = (float)bi;
      const double mag64 = exp(lr * dt * 64.0);
      p.lam64[idx * 2] = (float)(mag64 * cos(li * dt * 64.0));
      p.lam64[idx * 2 + 1] = (float)(mag64 * sin(li * dt * 64.0));
      const double nr = br - 1.0, ni = bi;
      const double den = lr * lr + li * li;
      const double cr = (nr * lr + ni * li) / den, ci = (ni * lr - nr * li) / den;
      for (int q = 0; q < 16; ++q) {
        const double wr = p.b_re[idx * 16 + q], wi = p.b_im[idx * 16 + q];
        p.bbar[(idx * 16 + q) * 2] = (float)(cr * wr - ci * wi);
        p.bbar[(idx * 16 + q) * 2 + 1] = (float)(cr * wi + ci * wr);
      }
    }
    for (int idx = gtid; idx < NE; idx += gthreads) { p.cnt[idx] = 0; p.cursor[idx] = 0; }
    for (int idx = gtid; idx < 512; idx += gthreads) {
      const int kv = idx >> 8, j = idx & 255;
      const float* pe = kv ? p.pe_v : p.pe_k;
      const float* w1 = kv ? p.w_cmp_v1 : p.w_cmp_k1;
      float acc = 0.f;
      for (int k = 0; k < 2048; ++k) acc = fmaf(pe[k], w1[(size_t)k * 256 + j], acc);
      p.cbias[idx] = acc;
    }
  }
  grid.sync();

  for (int row = gwave; row < NT; row += gwaves) {
    const int b = row / S;
    const float* xr = p.x + (size_t)row * D;
    float v[16];
    float ss = 0.f;
#pragma unroll
    for (int i = 0; i < 16; ++i) { v[i] = xr[i * 64 + lane]; ss = fmaf(v[i], v[i], ss); }
    ss = wsum(ss);
    const float r = rsqrtf(ss * (1.0f / D) + EPS);
    const float* md = p.mod + b * 6 * D;
#pragma unroll
    for (int i = 0; i < 16; ++i) {
      const int col = i * 64 + lane;
      p.h[(size_t)row * D + col] = v[i] * r * p.g_norm1[col] * (1.0f + md[D + col]) + md[col];
    }
  }
  grid.sync();

  {
    constexpr int TN = (INC + 127) / 128;
    for (int tile = blockIdx.x; tile < (NT / 128) * TN; tile += gridDim.x) {
      const int m0 = (tile / TN) * 128, n0 = (tile % TN) * 128;
      gemm128<false>(
          D, [&](int r, int k) -> const void* { return p.h + (size_t)(m0 + r) * D + k; },
          [&](int c) -> const float* { return (n0 + c < INC) ? p.w_in + n0 + c : nullptr; }, INC,
          [&](const f32x4 (&acc)[4][4], int wr, int wc, int fr, int fq) {
            const int cw = n0 + wc * 64;
            if (cw < C_GN) {
              const bool isq = cw < C_KC;
              const int slot = isq ? 0 : (cw - C_KC) >> 7, gg = isq ? 0 : ((cw - C_KC) >> 6) & 1;
              const bool norm = isq || slot == 2 || slot == 4;
              const float* gain = isq ? p.q_gain : (slot == 2 ? p.ks_gain : p.kw_gain);
              const float post = isq ? ATT_SCALE * 1.4426950408889634f : 1.0f;
#pragma unroll
              for (int m = 0; m < 4; ++m) {
                const int tok = m0 + wr * 64 + m * 16 + fr;
                float r = 1.0f;
                if (norm) {
                  float ss = 0.f;
#pragma unroll
                  for (int n = 0; n < 4; ++n)
#pragma unroll
                    for (int jj = 0; jj < 4; ++jj) ss = fmaf(acc[m][n][jj], acc[m][n][jj], ss);
                  ss += __shfl_xor(ss, 16);
                  ss += __shfl_xor(ss, 32);
                  r = rsqrtf(ss * (1.0f / 64) + EPS) * post;
                }
                unsigned short* dst = isq ? p.qb + (size_t)tok * 512 + cw
                                          : p.kvb + ((size_t)((slot * NB + (tok >> 12)) * 2 + gg) * S + (tok & (S - 1))) * 64;
#pragma unroll
                for (int n = 0; n < 4; ++n) {
                  f32x4 v = acc[m][n] * r;
                  if (norm) v = v * *(const f32x4*)(gain + n * 16 + 4 * fq);
                  uint2 w;
                  w.x = cvt_pk_bf16(v[0], v[1]); w.y = cvt_pk_bf16(v[2], v[3]);
                  *(uint2*)(dst + n * 16 + 4 * fq) = w;
                }
              }
            } else {
#pragma unroll
              for (int m = 0; m < 4; ++m) {
                const size_t tok = m0 + wr * 64 + m * 16 + fr;
#pragma unroll
                for (int n = 0; n < 4; ++n) {
                  const int c = cw + n * 16 + 4 * fq;
                  if (c < INC) {
                    f32x4 v = acc[m][n];
                    if (c >= C_U && c < C_GA) {
                      *(f32x4*)(p.u + tok * 512 + (c - C_U)) = v;
                    } else {
#pragma unroll
                      for (int j = 0; j < 4; ++j) v[j] = sigmoidf_(v[j]);
                      float* dst = (c < C_U) ? p.gn + tok * 24 + (c - C_GN)
                                             : (c < C_GS) ? p.ga + tok * D + (c - C_GA) : p.gs + tok * D + (c - C_GS);
                      *(f32x4*)dst = v;
                    }
                  }
                }
              }
            }
          },
          lds);
    }
  }
  grid.sync();

  for (int kv = 0; kv < 2; ++kv) {
    const float* w1 = kv ? p.w_cmp_v1 : p.w_cmp_k1;
    float* hid = kv ? p.hidv : p.hidk;
    const float* cb = p.cbias + kv * 256;
    gemm_phase<true>(
        NB * NCMP * 2, 256, 2048,
        [&](int r, int k) {
          const int b = r / (NCMP * 2), n = (r >> 1) % NCMP, g = r & 1;
          return p.kvb + ((size_t)((kv * NB + b) * 2 + g) * S + 16 * n) * 64 + k;
        },
        [&](int n) { return w1 + n; }, 256,
        [&](int r, int n, f32x4 v) {
#pragma unroll
          for (int j = 0; j < 4; ++j) v[j] = geluf_(v[j] + cb[n + j]);
          *(f32x4*)(hid + (size_t)r * 256 + n) = v;
        },
        lds);
  }
  grid.sync();

  for (int wv = gwave; wv < 2 * NB * NCMP * 2; wv += gwaves) {
    const int kv = wv / (NB * NCMP * 2), r = wv % (NB * NCMP * 2);
    const int b = r / (NCMP * 2), n = (r >> 1) % NCMP, g = r & 1;
    const float* hid = (kv ? p.hidv : p.hidk) + (size_t)r * 256;
    const float* w2 = kv ? p.w_cmp_v2 : p.w_cmp_k2;
    float acc = 0.f;
    for (int j = 0; j < 256; ++j) acc = fmaf(hid[j], w2[j * 64 + lane], acc);
    if (kv == 0) {
      const float ss = wsum(acc * acc);
      acc = acc * rsqrtf(ss * (1.0f / 64) + EPS) * p.kc_gain[lane];
    }
    const float other = __shfl_xor(acc, 1);
    if ((lane & 1) == 0)
      *(unsigned*)(p.cmpb + ((size_t)((kv * NB + b) * 2 + g) * 256 + n) * 64 + lane) = cvt_pk_bf16(acc, other);
  }
  for (int idx = gtid; idx < 2 * NB * 2 * 32; idx += gthreads)
    *(unsigned*)(p.cmpb + ((size_t)(idx >> 5) * 256 + 255) * 64 + (idx & 31) * 2) = 0u;
  grid.sync();

  for (int u = blockIdx.x; u < 256; u += gridDim.x) {
    const int bg = u >> 5, pr = u & 31;
#pragma unroll 1
    for (int half = 0; half < 2; ++half) attn_chunk(p, lds, bg >> 1, bg & 1, half ? pr : 63 - pr);
  }
  grid.sync();

  for (int item = gwave; item < NB * 32 * 64; item += gwaves) {
    const int c = item & 63, g = (item >> 6) & 31, b = item >> 11;
    const int gn = g * 64 + lane;
    float bbr[16], bbi[16];
#pragma unroll
    for (int q = 0; q < 16; ++q) { bbr[q] = p.bbar[(gn * 16 + q) * 2]; bbi[q] = p.bbar[(gn * 16 + q) * 2 + 1]; }
    const float lr = p.lamb[gn * 2], li = p.lamb[gn * 2 + 1];
    float xr = 0.f, xi = 0.f;
    for (int t = 0; t < 64; ++t) {
      const float* up = p.u + (size_t)(b * S + c * 64 + t) * 512 + g * 16;
      float br = 0.f, bi = 0.f;
#pragma unroll
      for (int q = 0; q < 16; ++q) { const float u = up[q]; br = fmaf(bbr[q], u, br); bi = fmaf(bbi[q], u, bi); }
      const float nr = lr * xr - li * xi + br;
      const float ni = lr * xi + li * xr + bi;
      xr = nr; xi = ni;
    }
    p.cstate[(size_t)item * 128 + lane * 2] = xr;
    p.cstate[(size_t)item * 128 + lane * 2 + 1] = xi;
  }
  grid.sync();

  for (int idx = gtid; idx < NB * 32 * 64; idx += gthreads) {
    const int n = idx & 63, g = (idx >> 6) & 31, b = idx >> 11;
    const int gn = g * 64 + n;
    const float lr = p.lam64[gn * 2], li = p.lam64[gn * 2 + 1];
    float hr_ = 0.f, hi_ = 0.f;
    for (int c = 0; c < 64; ++c) {
      const size_t o = ((size_t)((b * 32 + g) * 64 + c)) * 128 + n * 2;
      p.cin[o] = hr_;
      p.cin[o + 1] = hi_;
      const float sr = p.cstate[o], si = p.cstate[o + 1];
      const float nr = lr * hr_ - li * hi_ + sr;
      const float ni = lr * hi_ + li * hr_ + si;
      hr_ = nr; hi_ = ni;
    }
  }
  grid.sync();

  for (int item = gwave; item < NB * 32 * 64; item += gwaves) {
    const int c = item & 63, g = (item >> 6) & 31, b = item >> 11;
    const int gn = g * 64 + lane;
    float bbr[16], bbi[16], ccr[16], cci[16];
#pragma unroll
    for (int q = 0; q < 16; ++q) {
      bbr[q] = p.bbar[(gn * 16 + q) * 2];
      bbi[q] = p.bbar[(gn * 16 + q) * 2 + 1];
      ccr[q] = p.c_re[(g * 16 + q) * 64 + lane];
      cci[q] = p.c_im[(g * 16 + q) * 64 + lane];
    }
    const float lr = p.lamb[gn * 2], li = p.lamb[gn * 2 + 1];
    float xr = p.cin[(size_t)item * 128 + lane * 2], xi = p.cin[(size_t)item * 128 + lane * 2 + 1];
    const float dsk = (lane < 16) ? p.d_skip[g * 16 + lane] : 0.f;
    for (int t = 0; t < 64; ++t) {
      const int tok = b * S + c * 64 + t;
      const float* up = p.u + (size_t)tok * 512 + g * 16;
      float br = 0.f, bi = 0.f;
#pragma unroll
      for (int q = 0; q < 16; ++q) { const float u = up[q]; br = fmaf(bbr[q], u, br); bi = fmaf(bbi[q], u, bi); }
      const float nr = lr * xr - li * xi + br;
      const float ni = lr * xi + li * xr + bi;
      xr = nr; xi = ni;
      float yv = 0.f;
#pragma unroll
      for (int q = 0; q < 16; ++q) {
        const float v = wsum(ccr[q] * xr - cci[q] * xi);
        if (lane == q) yv = v;
      }
      if (lane < 16) {
        const float y = yv + dsk * up[lane];
        p.z[(size_t)tok * 512 + g * 16 + lane] = geluf_(y);
      }
    }
  }
  grid.sync();

  gemm_phase<false>(
      NT, 512, 512, [&](int m, int k) { return p.z + (size_t)m * 512 + k; },
      [&](int n) { return p.w_glu + n; }, 512,
      [&](int m, int n, f32x4 v) {
        const f32x4 zz = *(const f32x4*)(p.z + (size_t)m * 512 + n);
#pragma unroll
        for (int j = 0; j < 4; ++j) v[j] = zz[j] * sigmoidf_(v[j] + p.b_glu[n + j]);
        *(f32x4*)(p.yssm + (size_t)m * 512 + n) = v;
      },
      lds);
  grid.sync();

  gemm_phase<false>(
      NT, D, 512, [&](int m, int k) { return p.onsa + (size_t)m * 512 + k; },
      [&](int n) { return p.w_up_attn + n; }, D,
      [&](int m, int n, f32x4 v) {
        const f32x4 gg = *(const f32x4*)(p.ga + (size_t)m * D + n);
        *(f32x4*)(p.merged + (size_t)m * D + n) = gg * v;
      },
      lds);
  grid.sync();
  gemm_phase<false>(
      NT, D, 512, [&](int m, int k) { return p.yssm + (size_t)m * 512 + k; },
      [&](int n) { return p.w_up_ssm + n; }, D,
      [&](int m, int n, f32x4 v) {
        const f32x4 gg = *(const f32x4*)(p.gs + (size_t)m * D + n);
        f32x4* dst = (f32x4*)(p.merged + (size_t)m * D + n);
        *dst = *dst + gg * v;
      },
      lds);
  grid.sync();
  gemm_phase<false>(
      NT, D, D, [&](int m, int k) { return p.merged + (size_t)m * D + k; },
      [&](int n) { return p.w_out + n; }, D,
      [&](int m, int n, f32x4 v) {
        const int b = m / S;
        const f32x4 xx = *(const f32x4*)(p.x + (size_t)m * D + n);
        const f32x4 gt = *(const f32x4*)(p.mod + b * 6 * D + 2 * D + n);
        *(f32x4*)(p.xmid + (size_t)m * D + n) = xx + gt * v;
      },
      lds);
  grid.sync();

  for (int row = gwave; row < NT; row += gwaves) {
    const int b = row / S;
    const float* xr = p.xmid + (size_t)row * D;
    float v[16];
    float ss = 0.f;
#pragma unroll
    for (int i = 0; i < 16; ++i) { v[i] = xr[i * 64 + lane]; ss = fmaf(v[i], v[i], ss); }
    ss = wsum(ss);
    const float r = rsqrtf(ss * (1.0f / D) + EPS);
    const float* md = p.mod + b * 6 * D;
#pragma unroll
    for (int i = 0; i < 16; ++i) {
      const int col = i * 64 + lane;
      p.h[(size_t)row * D + col] = v[i] * r * p.g_norm2[col] * (1.0f + md[4 * D + col]) + md[3 * D + col];
    }
  }
  grid.sync();

  gemm_phase<false>(
      NT, NE, D, [&](int m, int k) { return p.h + (size_t)m * D + k; },
      [&](int n) { return p.w_router + n; }, NE,
      [&](int m, int n, f32x4 v) {
#pragma unroll
        for (int j = 0; j < 4; ++j) v[j] = sigmoidf_(v[j]);
        *(f32x4*)(p.scores + (size_t)m * NE + n) = v;
      },
      lds);
  grid.sync();

  for (int tok = gwave; tok < NT; tok += gwaves) {
    const float4 sc4 = *reinterpret_cast<const float4*>(p.scores + (size_t)tok * NE + lane * 4);
    const float4 bi4 = *reinterpret_cast<const float4*>(p.router_bias + lane * 4);
    const float sc[4] = {sc4.x, sc4.y, sc4.z, sc4.w};
    float bz[4] = {sc4.x + bi4.x, sc4.y + bi4.y, sc4.z + bi4.z, sc4.w + bi4.w};
    float m1 = -INFINITY, m2 = -INFINITY;
#pragma unroll
    for (int i = 0; i < 4; ++i) {
      const float v = bz[i];
      if (v > m1) { m2 = m1; m1 = v; } else if (v > m2) { m2 = v; }
    }
#pragma unroll
    for (int o = 1; o < 8; o <<= 1) {
      const float o1 = __shfl_xor(m1, o), o2 = __shfl_xor(m2, o);
      const float n1 = fmaxf(m1, o1);
      const float n2 = fmaxf(fminf(m1, o1), fmaxf(m2, o2));
      m1 = n1; m2 = n2;
    }
    const float gs = m1 + m2;
    const int mygrp = lane >> 3;
    int grank = 0;
#pragma unroll
    for (int g2 = 0; g2 < 8; ++g2) {
      const float og = __shfl(gs, g2 * 8);
      grank += (og > gs || (og == gs && g2 < mygrp)) ? 1 : 0;
    }
    const bool gsel = grank < 4;
#pragma unroll
    for (int i = 0; i < 4; ++i) if (!gsel) bz[i] = -INFINITY;
    unsigned taken = 0;
    float wsel = 0.f;
    int esel = 0;
    float wtot = 0.f;
#pragma unroll 1
    for (int k = 0; k < TOPK; ++k) {
      float bv = -INFINITY; int bidx = 1 << 30;
#pragma unroll
      for (int i = 0; i < 4; ++i) {
        if (!((taken >> i) & 1u) && bz[i] > bv) { bv = bz[i]; bidx = lane * 4 + i; }
      }
#pragma unroll
      for (int o = 32; o > 0; o >>= 1) {
        const float ov = __shfl_xor(bv, o);
        const int oi = __shfl_xor(bidx, o);
        if (ov > bv || (ov == bv && oi < bidx)) { bv = ov; bidx = oi; }
      }
      const int owner = bidx >> 2, slot = bidx & 3;
      float sv = 0.f;
      if (lane == owner) {
        taken |= 1u << slot;
        sv = (slot == 0) ? sc[0] : (slot == 1) ? sc[1] : (slot == 2) ? sc[2] : sc[3];
      }
      sv = __shfl(sv, owner);
      wtot += sv;
      if (lane == k) { wsel = sv; esel = bidx; }
    }
    if (lane < TOPK) {
      p.eidx[tok * TOPK + lane] = esel;
      p.ew[tok * TOPK + lane] = wsel / wtot * 2.5f;
      atomicAdd(&p.cnt[esel], 1);
    }
  }
  grid.sync();

  if (blockIdx.x == 0 && tid == 0) {
    int o = 0, r = 0;
    for (int e = 0; e < NE; ++e) {
      p.off[e] = o; p.rts[e] = r;
      const int cc = p.cnt[e];
      o += cc; r += (cc + 127) / 128;
    }
    p.off[NE] = o; p.rts[NE] = r;
  }
  grid.sync();

  for (int idx = gtid; idx < NASSIGN; idx += gthreads) {
    const int e = p.eidx[idx];
    const int pos = p.off[e] + atomicAdd(&p.cursor[e], 1);
    p.stok[pos] = idx / TOPK;
    p.sw[pos] = p.ew[idx];
  }
  grid.sync();

  gemm_phase<false>(
      NT, DE, D, [&](int m, int k) { return p.h + (size_t)m * D + k; },
      [&](int n) { return p.ws_gate + n; }, DE,
      [&](int m, int n, f32x4 v) { *(f32x4*)(p.hs + (size_t)m * DE + n) = v; }, lds);
  grid.sync();
  gemm_phase<false>(
      NT, DE, D, [&](int m, int k) { return p.h + (size_t)m * D + k; },
      [&](int n) { return p.ws_up + n; }, DE,
      [&](int m, int n, f32x4 v) {
        f32x4* dst = (f32x4*)(p.hs + (size_t)m * DE + n);
        const f32x4 gq = *dst;
#pragma unroll
        for (int j = 0; j < 4; ++j) v[j] = siluf_(gq[j]) * v[j];
        *dst = v;
      },
      lds);
  grid.sync();
  gemm_phase<false>(
      NT, D, DE, [&](int m, int k) { return p.hs + (size_t)m * DE + k; },
      [&](int n) { return p.ws_down + n; }, D,
      [&](int m, int n, f32x4 v) {
        const int b = m / S;
        const f32x4 xx = *(const f32x4*)(p.xmid + (size_t)m * D + n);
        const f32x4 gt = *(const f32x4*)(p.mod + b * 6 * D + 5 * D + n);
        *(f32x4*)(p.out + (size_t)m * D + n) = xx + gt * v;
      },
      lds);
  grid.sync();

  {
    const int total_rt = p.rts[NE];
    for (int pass = 0; pass < 2; ++pass) {
      for (int tile = blockIdx.x; tile < total_rt * 2; tile += gridDim.x) {
        const int rt = tile >> 1, ct = tile & 1;
        const int e = find_expert(p.rts, rt);
        const int pos0 = p.off[e] + (rt - p.rts[e]) * 128;
        const int mvalid = min(128, p.off[e] + p.cnt[e] - pos0);
        const float* wmat = (pass ? p.w_up : p.w_gate) + (size_t)e * D * DE + ct * 128;
        gemm128<false>(
            D, [&](int r, int k) -> const void* { return (r < mvalid) ? p.h + (size_t)p.stok[pos0 + r] * D + k : nullptr; },
            [&](int c) -> const float* { return wmat + c; }, DE,
            [&](const f32x4 (&acc)[4][4], int wr, int wc, int fr, int fq) {
#pragma unroll
              for (int m = 0; m < 4; ++m)
#pragma unroll
                for (int n = 0; n < 4; ++n) {
                  const int r = wr * 64 + m * 16 + fr, c = wc * 64 + n * 16 + 4 * fq;
                  if (r < mvalid) {
                    f32x4 v = acc[m][n];
                    f32x4* dst = (f32x4*)(p.hr + (size_t)(pos0 + r) * DE + ct * 128 + c);
                    if (pass == 1) {
                      const f32x4 gq = *dst;
#pragma unroll
                      for (int j = 0; j < 4; ++j) v[j] = siluf_(gq[j]) * v[j];
                    }
                    *dst = v;
                  }
                }
            },
            lds);
      }
      grid.sync();
    }
    for (int tile = blockIdx.x; tile < total_rt * 8; tile += gridDim.x) {
      const int rt = tile >> 3, ct = tile & 7;
      const int e = find_expert(p.rts, rt);
      const int pos0 = p.off[e] + (rt - p.rts[e]) * 128;
      const int mvalid = min(128, p.off[e] + p.cnt[e] - pos0);
      const float* wmat = p.w_down + (size_t)e * DE * D + ct * 128;
      gemm128<false>(
          DE, [&](int r, int k) -> const void* { return (r < mvalid) ? p.hr + (size_t)(pos0 + r) * DE + k : nullptr; },
          [&](int c) -> const float* { return wmat + c; }, D,
          [&](const f32x4 (&acc)[4][4], int wr, int wc, int fr, int fq) {
#pragma unroll
            for (int m = 0; m < 4; ++m) {
              const int r = wr * 64 + m * 16 + fr;
              if (r < mvalid) {
                const int tok = p.stok[pos0 + r];
                const int b = tok / S;
                const float wgt = p.sw[pos0 + r];
#pragma unroll
                for (int n = 0; n < 4; ++n) {
                  const int col = ct * 128 + wc * 64 + n * 16 + 4 * fq;
#pragma unroll
                  for (int j = 0; j < 4; ++j)
                    atomicAdd(&p.out[(size_t)tok * D + col + j], p.mod[b * 6 * D + 5 * D + col + j] * wgt * acc[m][n][j]);
                }
              }
            }
          },
          lds);
    }
  }
}

extern "C" void kernel_launch(void* const* d_in, const int* in_sizes, int n_in, void* d_out, int out_size,
                              void* d_ws, size_t ws_size, hipStream_t stream) {
  (void)in_sizes; (void)n_in; (void)out_size; (void)ws_size;
  Params p{};
  const float* const* in = reinterpret_cast<const float* const*>(d_in);
  p.x = in[0]; p.c = in[1]; p.w_ada = in[2]; p.b_ada = in[3]; p.g_norm1 = in[4]; p.g_norm2 = in[5];
  p.w_in = in[6]; p.q_gain = in[7]; p.kc_gain = in[8]; p.ks_gain = in[9]; p.kw_gain = in[10];
  p.pe_k = in[11]; p.pe_v = in[12]; p.w_cmp_k1 = in[13]; p.w_cmp_k2 = in[14]; p.w_cmp_v1 = in[15];
  p.w_cmp_v2 = in[16]; p.a_re = in[17]; p.a_im = in[18]; p.log_dt = in[19]; p.b_re = in[20];
  p.b_im = in[21]; p.c_re = in[22]; p.c_im = in[23]; p.d_skip = in[24]; p.w_glu = in[25];
  p.b_glu = in[26]; p.w_up_attn = in[27]; p.w_up_ssm = in[28]; p.w_out = in[29]; p.w_router = in[30];
  p.router_bias = in[31]; p.w_gate = in[32]; p.w_up = in[33]; p.w_down = in[34]; p.ws_gate = in[35];
  p.ws_up = in[36]; p.ws_down = in[37];
  p.out = (float*)d_out;

  char* base = (char*)d_ws;
  size_t o = 0;
  auto take = [&](size_t bytes) { void* r = base + o; o += (bytes + 255) & ~(size_t)255; return r; };
  p.mod = (float*)take(sizeof(float) * NB * 6 * D);
  p.cbias = (float*)take(sizeof(float) * 512);
  p.h = (float*)take(sizeof(float) * (size_t)NT * D);
  p.qb = (unsigned short*)take(2 * (size_t)NT * 512);
  p.kvb = (unsigned short*)take(2 * (size_t)6 * NB * 2 * S * 64);
  p.cmpb = (unsigned short*)take(2 * (size_t)2 * NB * 2 * 256 * 64);
  p.gn = (float*)take(sizeof(float) * (size_t)NT * 24);
  p.u = (float*)take(sizeof(float) * (size_t)NT * 512);
  p.ga = (float*)take(sizeof(float) * (size_t)NT * D);
  p.gs = (float*)take(sizeof(float) * (size_t)NT * D);
  p.hidk = (float*)take(sizeof(float) * 2040 * 256);
  p.hidv = (float*)take(sizeof(float) * 2040 * 256);
  p.onsa = (float*)take(sizeof(float) * (size_t)NT * 512);
  p.lamb = (float*)take(sizeof(float) * 2048 * 2);
  p.lam64 = (float*)take(sizeof(float) * 2048 * 2);
  p.bbar = (float*)take(sizeof(float) * 2048 * 32);
  p.cstate = (float*)take(sizeof(float) * NB * 32 * 64 * 128);
  p.cin = (float*)take(sizeof(float) * NB * 32 * 64 * 128);
  p.z = (float*)take(sizeof(float) * (size_t)NT * 512);
  p.yssm = (float*)take(sizeof(float) * (size_t)NT * 512);
  p.merged = (float*)take(sizeof(float) * (size_t)NT * D);
  p.xmid = (float*)take(sizeof(float) * (size_t)NT * D);
  p.scores = (float*)take(sizeof(float) * (size_t)NT * NE);
  p.eidx = (int*)take(sizeof(int) * NASSIGN);
  p.ew = (float*)take(sizeof(float) * NASSIGN);
  p.cnt = (int*)take(sizeof(int) * NE);
  p.cursor = (int*)take(sizeof(int) * NE);
  p.off = (int*)take(sizeof(int) * (NE + 1));
  p.rts = (int*)take(sizeof(int) * (NE + 1));
  p.stok = (int*)take(sizeof(int) * NASSIGN);
  p.sw = (float*)take(sizeof(float) * NASSIGN);
  p.hs = (float*)take(sizeof(float) * (size_t)NT * DE);
  p.hr = (float*)take(sizeof(float) * (size_t)NASSIGN * DE);
  if (o > ws_size) fprintf(stderr, "workspace too small: need %zu have %zu\n", o, ws_size);

  static int grid_blocks = 0;
  if (!grid_blocks) {
    int dev = 0, cus = 0, per_cu = 0;
    hipGetDevice(&dev);
    hipDeviceGetAttribute(&cus, hipDeviceAttributeMultiprocessorCount, dev);
    hipOccupancyMaxActiveBlocksPerMultiprocessor(&per_cu, mega, 256, 0);
    if (per_cu > 2) per_cu = 2;
    if (per_cu < 1) per_cu = 1;
    grid_blocks = cus * per_cu;
  }
  void* args[] = {&p};
  hipError_t e = hipLaunchCooperativeKernel((void*)mega, dim3(grid_blocks), dim3(256), args, 0, stream);
  if (e != hipSuccess) fprintf(stderr, "cooperative launch failed: %s (grid %d)\n", hipGetErrorString(e), grid_blocks);
}
```

```cpp
#include <hip/hip_runtime.h>
#include <cstdio>
#include <cstdint>

constexpr int D = 1024;
constexpr int NB = 4;
constexpr int S = 4096;
constexpr int NT = NB * S;
constexpr int INC = 3864;
constexpr int C_Q = 0, C_KC = 512, C_VC = 640, C_KS = 768, C_VS = 896, C_KW = 1024, C_VW = 1152,
              C_GN = 1280, C_U = 1304, C_GA = 1816, C_GS = 2840;
constexpr int NCMP = 255;
constexpr int NE = 256;
constexpr int TOPK = 8;
constexpr int DE = 256;
constexpr int NASSIGN = NT * TOPK;
constexpr float EPS = 1e-6f;
constexpr float ATT_SCALE = 0.125f;

struct Params {
  const float* x; const float* c; const float* w_ada; const float* b_ada; const float* g_norm1;
  const float* g_norm2; const float* w_in; const float* q_gain; const float* kc_gain;
  const float* ks_gain; const float* kw_gain; const float* pe_k; const float* pe_v;
  const float* w_cmp_k1; const float* w_cmp_k2; const float* w_cmp_v1; const float* w_cmp_v2;
  const float* a_re; const float* a_im; const float* log_dt; const float* b_re; const float* b_im;
  const float* c_re; const float* c_im; const float* d_skip; const float* w_glu; const float* b_glu;
  const float* w_up_attn; const float* w_up_ssm; const float* w_out; const float* w_router;
  const float* router_bias; const float* w_gate; const float* w_up; const float* w_down;
  const float* ws_gate; const float* ws_up; const float* ws_down;
  float* out;
  unsigned* bar;
  float* mod;
  float* cbias;
  unsigned short* h;
  unsigned short* qb;
  unsigned short* kvb;
  unsigned short* cmpb;
  float* gn;
  float* u;
  float* ga;
  float* gs;
  float* hidk;
  float* hidv;
  float* onsa;
  float* lamb;
  float* lam64;
  float* bbar;
  float* cstate;
  float* cin;
  float* z;
  float* yssm;
  float* merged;
  float* xmid;
  float* scores;
  int* eidx;
  float* ew;
  int* cnt;
  int* cursor;
  int* off;
  int* rts;
  int* stok;
  float* sw;
  unsigned short* hs;
  unsigned short* hr;
  unsigned short* yk;
  int* apos;
};

__device__ __forceinline__ float wsum(float v) {
#pragma unroll
  for (int o = 32; o > 0; o >>= 1) v += __shfl_xor(v, o);
  return v;
}
__device__ __forceinline__ float wmax(float v) {
#pragma unroll
  for (int o = 32; o > 0; o >>= 1) v = fmaxf(v, __shfl_xor(v, o));
  return v;
}
#define WSYNC() do { __builtin_amdgcn_fence(__ATOMIC_ACQ_REL, "wavefront"); __builtin_amdgcn_wave_barrier(); } while (0)
__device__ __forceinline__ float sigmoidf_(float x) { return 1.0f / (1.0f + expf(-x)); }
__device__ __forceinline__ float siluf_(float x) { return x / (1.0f + expf(-x)); }
__device__ __forceinline__ float geluf_(float x) {
  return 0.5f * x * (1.0f + tanhf(0.7978845608028654f * (x + 0.044715f * x * x * x)));
}

typedef short bf16x8 __attribute__((ext_vector_type(8)));
typedef float f32x4 __attribute__((ext_vector_type(4)));
typedef unsigned u32x4 __attribute__((ext_vector_type(4)));
#define LAS __attribute__((address_space(3)))

__device__ __forceinline__ unsigned cvt_pk_bf16(float lo, float hi) {
  unsigned r;
  asm("v_cvt_pk_bf16_f32 %0, %1, %2" : "=v"(r) : "v"(lo), "v"(hi));
  return r;
}
__device__ __forceinline__ int lds_byte(int r, int c) {
  const int st = (r >> 4) * 2 + (c >> 5), rr = r & 15, cc = c & 31, ob = rr * 64 + cc * 2;
  return st * 1024 + (ob ^ (((ob >> 9) & 1) << 5));
}

template <bool ABF, class AF, class BF, class EPW>
__device__ __forceinline__ void gemm128(int K, AF arow, BF bcol, size_t ldb, EPW epiw, LAS unsigned char* lds) {
  const int t = threadIdx.x, wid = t >> 6, lane = t & 63, wr = wid >> 1, wc = wid & 1, fr = lane & 15, fq = lane >> 4;
  LAS unsigned char* ldsA = lds;
  LAS unsigned char* ldsB = lds + 16384;
  const int ar0 = t >> 3, ac = (t & 7) * 8;
  const int n4 = t & 31, kg = t >> 5;
  const float* bp = bcol(n4 * 4);
  f32x4 acc[4][4];
#pragma unroll
  for (int m = 0; m < 4; ++m)
#pragma unroll
    for (int n = 0; n < 4; ++n) acc[m][n] = (f32x4){0.f, 0.f, 0.f, 0.f};
  f32x4 ra[4][ABF ? 1 : 2], rb[8];
  auto gload = [&](int k0) {
#pragma unroll
    for (int i = 0; i < 4; ++i) {
      const void* pa = arow(ar0 + 32 * i, k0 + ac);
      if (ABF) {
        if (pa) ra[i][0] = *(const f32x4*)pa; else ra[i][0] = (f32x4){0.f, 0.f, 0.f, 0.f};
      } else {
        if (pa) { ra[i][0] = *(const f32x4*)pa; ra[i][ABF ? 0 : 1] = *((const f32x4*)pa + 1); }
        else { ra[i][0] = (f32x4){0.f, 0.f, 0.f, 0.f}; ra[i][ABF ? 0 : 1] = (f32x4){0.f, 0.f, 0.f, 0.f}; }
      }
    }
#pragma unroll
    for (int j = 0; j < 8; ++j) {
      if (bp) rb[j] = *(const f32x4*)(bp + (size_t)(k0 + kg * 8 + j) * ldb);
      else rb[j] = (f32x4){0.f, 0.f, 0.f, 0.f};
    }
  };
  gload(0);
  const int aoff = lds_byte(wr * 64 + fr, fq * 8), boff = lds_byte(wc * 64 + fr, fq * 8);
  const int nk = K >> 6;
  for (int kt = 0; kt < nk; ++kt) {
#pragma unroll
    for (int i = 0; i < 4; ++i) {
      if (ABF) {
        *(LAS f32x4*)(ldsA + lds_byte(ar0 + 32 * i, ac)) = ra[i][0];
      } else {
        u32x4 w;
        w.x = cvt_pk_bf16(ra[i][0][0], ra[i][0][1]); w.y = cvt_pk_bf16(ra[i][0][2], ra[i][0][3]);
        w.z = cvt_pk_bf16(ra[i][ABF ? 0 : 1][0], ra[i][ABF ? 0 : 1][1]); w.w = cvt_pk_bf16(ra[i][ABF ? 0 : 1][2], ra[i][ABF ? 0 : 1][3]);
        *(LAS u32x4*)(ldsA + lds_byte(ar0 + 32 * i, ac)) = w;
      }
    }
#pragma unroll
    for (int c = 0; c < 4; ++c) {
      u32x4 w;
      w.x = cvt_pk_bf16(rb[0][c], rb[1][c]); w.y = cvt_pk_bf16(rb[2][c], rb[3][c]);
      w.z = cvt_pk_bf16(rb[4][c], rb[5][c]); w.w = cvt_pk_bf16(rb[6][c], rb[7][c]);
      *(LAS u32x4*)(ldsB + lds_byte(n4 * 4 + c, kg * 8)) = w;
    }
    __syncthreads();
    if (kt + 1 < nk) gload((kt + 1) * 64);
#pragma unroll
    for (int ks = 0; ks < 2; ++ks) {
      bf16x8 af[4], bf[4];
#pragma unroll
      for (int m = 0; m < 4; ++m) af[m] = *(const LAS bf16x8*)(ldsA + aoff + m * 2048 + ks * 1024);
#pragma unroll
      for (int n = 0; n < 4; ++n) bf[n] = *(const LAS bf16x8*)(ldsB + boff + n * 2048 + ks * 1024);
#pragma unroll
      for (int m = 0; m < 4; ++m)
#pragma unroll
        for (int n = 0; n < 4; ++n)
          acc[m][n] = __builtin_amdgcn_mfma_f32_16x16x32_bf16(bf[n], af[m], acc[m][n], 0, 0, 0);
    }
    __syncthreads();
  }
  epiw(acc, wr, wc, fr, fq);
}

template <bool ABF, class AL, class BL, class EP>
__device__ __forceinline__ void gemm_phase(int M, int N, int K, AL al, BL bl, size_t ldb, EP ep, LAS unsigned char* lds) {
  const int tn = (N + 127) / 128, tm = (M + 127) / 128;
  for (int tile = blockIdx.x; tile < tm * tn; tile += gridDim.x) {
    const int m0 = (tile / tn) * 128, n0 = (tile % tn) * 128;
    gemm128<ABF>(
        K, [&](int r, int k) -> const void* { return (m0 + r < M) ? (const void*)al(m0 + r, k) : nullptr; },
        [&](int c) -> const float* { return (n0 + c < N) ? bl(n0 + c) : nullptr; }, ldb,
        [&](const f32x4 (&acc)[4][4], int wr, int wc, int fr, int fq) {
#pragma unroll
          for (int m = 0; m < 4; ++m)
#pragma unroll
            for (int n = 0; n < 4; ++n) {
              const int r = m0 + wr * 64 + m * 16 + fr, c = n0 + wc * 64 + n * 16 + 4 * fq;
              if (r < M && c < N) ep(r, c, acc[m][n]);
            }
        },
        lds);
  }
}

__device__ __forceinline__ int find_expert(const int* rts, int rt) {
  int lo = 0, hi = NE;
  while (hi - lo > 1) {
    const int mid = (lo + hi) >> 1;
    if (rts[mid] <= rt) lo = mid; else hi = mid;
  }
  return lo;
}


typedef short s16x4 __attribute__((ext_vector_type(4)));
#define OPAQUE(x) asm volatile("" : "+v"(x))
#define REDERIVE() do { OPAQUE(t); w = t >> 6; lane = t & 63; fr = lane & 15; fq = lane >> 4; rloc = w * 16 + fr; } while (0)
constexpr int VROW = 160;

__device__ __forceinline__ bf16x8 pack8(const f32x4 a, const f32x4 b) {
  u32x4 w;
  w.x = cvt_pk_bf16(a[0], a[1]); w.y = cvt_pk_bf16(a[2], a[3]);
  w.z = cvt_pk_bf16(b[0], b[1]); w.w = cvt_pk_bf16(b[2], b[3]);
  return __builtin_bit_cast(bf16x8, w);
}
__device__ __forceinline__ void tile_fetch(bf16x8 (&r)[2], const unsigned short* base, int t) {
  const bf16x8* q = (const bf16x8*)(base + t * 16);
  r[0] = q[0];
  r[1] = q[1];
}
__device__ __forceinline__ void stage_k(const bf16x8 (&r)[2], LAS unsigned char* ldsK, int t) {
  const int row = t >> 2, c0 = (t & 3) * 16;
  *(LAS bf16x8*)(ldsK + lds_byte(row, c0)) = r[0];
  *(LAS bf16x8*)(ldsK + lds_byte(row, c0 + 8)) = r[1];
}
__device__ __forceinline__ void stage_v(const bf16x8 (&r)[2], LAS unsigned char* ldsV, int t) {
  const int row = t >> 2, c0 = (t & 3) * 16;
  *(LAS bf16x8*)(ldsV + row * VROW + c0 * 2) = r[0];
  *(LAS bf16x8*)(ldsV + row * VROW + c0 * 2 + 16) = r[1];
}
template <int H>
__device__ __forceinline__ void attn_qk_h(f32x4 (&s)[4][2], const bf16x8 (&qf)[4][2], LAS unsigned char* ldsK, int fr, int fq) {
  const int koff = lds_byte(fr, fq * 8);
#pragma unroll
  for (int m = 0; m < 4; ++m)
#pragma unroll
    for (int nn = 0; nn < 2; ++nn) s[m][nn] = (f32x4){0.f, 0.f, 0.f, 0.f};
#pragma unroll
  for (int nn = 0; nn < 2; ++nn)
#pragma unroll
    for (int ks = 0; ks < 2; ++ks) {
      const bf16x8 kf = *(const LAS bf16x8*)(ldsK + koff + (2 * H + nn) * 2048 + ks * 1024);
#pragma unroll
      for (int m = 0; m < 4; ++m) s[m][nn] = __builtin_amdgcn_mfma_f32_16x16x32_bf16(kf, qf[m][ks], s[m][nn], 0, 0, 0);
    }
}
template <int H>
__device__ __forceinline__ void attn_pv_h(f32x4 (&o)[4][4], const bf16x8 (&pf)[4], LAS unsigned char* ldsV, int lane) {
  const int fq = lane >> 4, i = lane & 15;
  const int vbase = (4 * fq + (i >> 2)) * VROW + (i & 3) * 8;
#pragma unroll
  for (int dt = 0; dt < 4; ++dt) {
    LAS unsigned char* a0 = ldsV + vbase + H * 32 * VROW + dt * 32;
    const s16x4 v0 = __builtin_amdgcn_ds_read_tr16_b64_v4i16((LAS s16x4*)a0);
    const s16x4 v1 = __builtin_amdgcn_ds_read_tr16_b64_v4i16((LAS s16x4*)(a0 + 16 * VROW));
    bf16x8 vf;
    vf[0] = v0[0]; vf[1] = v0[1]; vf[2] = v0[2]; vf[3] = v0[3];
    vf[4] = v1[0]; vf[5] = v1[1]; vf[6] = v1[2]; vf[7] = v1[3];
#pragma unroll
    for (int m = 0; m < 4; ++m) o[m][dt] = __builtin_amdgcn_mfma_f32_16x16x32_bf16(vf, pf[m], o[m][dt], 0, 0, 0);
  }
}
template <int H, bool EM>
__device__ __forceinline__ void attn_softmax_h(f32x4 (&s)[4][2], f32x4 (&o)[4][4], float (&mrow)[4], float (&lrow)[4],
                                               bf16x8 (&pf)[4], bool rowok, int lo, int hi, int fq) {
#pragma unroll
  for (int m = 0; m < 4; ++m) {
    float mx = -INFINITY;
#pragma unroll
    for (int nn = 0; nn < 2; ++nn)
#pragma unroll
      for (int jj = 0; jj < 4; ++jj) {
        constexpr int dummy2 = 0; (void)dummy2;
        const int kc = 16 * (2 * H + nn) + jj;
        const bool ok = rowok && (!EM || (lo < kc && hi >= kc));
        const float v = ok ? s[m][nn][jj] : -INFINITY;
        s[m][nn][jj] = v;
        mx = fmaxf(mx, v);
      }
    mx = fmaxf(mx, __shfl_xor(mx, 16));
    mx = fmaxf(mx, __shfl_xor(mx, 32));
    const float mnew = fmaxf(mrow[m], mx);
    const float msafe = (mnew == -INFINITY) ? 0.f : mnew;
    const float alpha = __builtin_amdgcn_exp2f(mrow[m] - msafe);
    mrow[m] = mnew;
    float ls = 0.f;
#pragma unroll
    for (int nn = 0; nn < 2; ++nn)
#pragma unroll
      for (int jj = 0; jj < 4; ++jj) {
        const float pv = __builtin_amdgcn_exp2f(s[m][nn][jj] - msafe);
        s[m][nn][jj] = pv;
        ls += pv;
      }
    lrow[m] = lrow[m] * alpha + ls;
#pragma unroll
    for (int dt = 0; dt < 4; ++dt) o[m][dt] = o[m][dt] * alpha;
    pf[m] = pack8(s[m][0], s[m][1]);
  }
}
template <int H, bool EM>
__device__ __forceinline__ void attn_sub(f32x4 (&o)[4][4], float (&mrow)[4], float (&lrow)[4], const bf16x8 (&qf)[4][2],
                                         LAS unsigned char* ldsK, LAS unsigned char* ldsV, bool rowok, int lo, int hi, int lane) {
  f32x4 s[4][2];
  bf16x8 pf[4];
  __builtin_amdgcn_sched_barrier(0);
  attn_qk_h<H>(s, qf, ldsK, lane & 15, lane >> 4);
  __builtin_amdgcn_sched_barrier(0);
  attn_softmax_h<H, EM>(s, o, mrow, lrow, pf, rowok, lo, hi, lane >> 4);
  __builtin_amdgcn_sched_barrier(0);
  attn_pv_h<H>(o, pf, ldsV, lane);
  __builtin_amdgcn_sched_barrier(0);
}
template <bool EM>
__device__ __forceinline__ void attn_tile(f32x4 (&o)[4][4], float (&mrow)[4], float (&lrow)[4], const bf16x8 (&qf)[4][2],
                                          LAS unsigned char* ldsK, LAS unsigned char* ldsV, bool rowok, int lo, int hi, int lane) {
  attn_sub<0, EM>(o, mrow, lrow, qf, ldsK, ldsV, rowok, lo, hi, lane);
  attn_sub<1, EM>(o, mrow, lrow, qf, ldsK, ldsV, rowok, lo, hi, lane);
}
template <int H>
__device__ __forceinline__ void cmp_stats(float (&mrow)[4], float (&lrow)[4], const bf16x8 (&qf)[4][2], LAS unsigned char* ldsK, int hi, int lane) {
  const int fq = lane >> 4;
  f32x4 s[4][2];
  __builtin_amdgcn_sched_barrier(0);
  attn_qk_h<H>(s, qf, ldsK, lane & 15, fq);
  __builtin_amdgcn_sched_barrier(0);
#pragma unroll
  for (int m = 0; m < 4; ++m) {
    float mx = -INFINITY;
#pragma unroll
    for (int nn = 0; nn < 2; ++nn)
#pragma unroll
      for (int jj = 0; jj < 4; ++jj) {
        const int kc = 16 * (2 * H + nn) + jj;
        const float v = (hi >= kc) ? s[m][nn][jj] : -INFINITY;
        s[m][nn][jj] = v;
        mx = fmaxf(mx, v);
      }
    mx = fmaxf(mx, __shfl_xor(mx, 16));
    mx = fmaxf(mx, __shfl_xor(mx, 32));
    const float mnew = fmaxf(mrow[m], mx);
    const float msafe = (mnew == -INFINITY) ? 0.f : mnew;
    float ls = 0.f;
#pragma unroll
    for (int nn = 0; nn < 2; ++nn)
#pragma unroll
      for (int jj = 0; jj < 4; ++jj) ls += __builtin_amdgcn_exp2f(s[m][nn][jj] - msafe);
    lrow[m] = lrow[m] * __builtin_amdgcn_exp2f(mrow[m] - msafe) + ls;
    mrow[m] = mnew;
  }
  __builtin_amdgcn_sched_barrier(0);
}
template <int H>
__device__ __forceinline__ void cmp_apply(f32x4 (&o)[4][4], const float (&msf)[4], const float (&linv)[4], float& lastprev, LAS float* improw,
                                          const bf16x8 (&qf)[4][2], LAS unsigned char* ldsK, LAS unsigned char* ldsV, int hi, int lane) {
  const int fq = lane >> 4;
  f32x4 s[4][2];
  bf16x8 pf[4];
  __builtin_amdgcn_sched_barrier(0);
  attn_qk_h<H>(s, qf, ldsK, lane & 15, fq);
  __builtin_amdgcn_sched_barrier(0);
#pragma unroll
  for (int m = 0; m < 4; ++m) {
#pragma unroll
    for (int nn = 0; nn < 2; ++nn)
#pragma unroll
      for (int jj = 0; jj < 4; ++jj) {
        const int kc = 16 * (2 * H + nn) + jj;
        s[m][nn][jj] = (hi >= kc) ? __builtin_amdgcn_exp2f(s[m][nn][jj] - msf[m]) * linv[m] : 0.f;
      }
    pf[m] = pack8(s[m][0], s[m][1]);
  }
#pragma unroll
  for (int nn = 0; nn < 2; ++nn) {
    float gs = 0.f, last = 0.f;
#pragma unroll
    for (int m = 0; m < 4; ++m) {
      gs += (s[m][nn][0] + s[m][nn][1]) + (s[m][nn][2] + s[m][nn][3]);
      last += s[m][nn][3];
    }
    const float pa = __shfl(last, (lane + 48) & 63);
    const float pb = __shfl(lastprev, (lane + 48) & 63);
    improw[(2 * H + nn) * 4 + fq] = gs + ((fq > 0) ? pa : pb);
    lastprev = last;
  }
  __builtin_amdgcn_sched_barrier(0);
  attn_pv_h<H>(o, pf, ldsV, lane);
  __builtin_amdgcn_sched_barrier(0);
}

__device__ __forceinline__ void attn_chunk(const Params& p, LAS unsigned char* lds, int b, int g, int ci) {
  int t = threadIdx.x;
  OPAQUE(t);
  int w = t >> 6, lane = t & 63, fr = lane & 15, fq = lane >> 4;
  LAS unsigned char* ldsK = lds;
  LAS unsigned char* ldsV = lds + 8192;
  LAS float* impb = (LAS float*)(lds + 18432) + w * 1024;
  LAS unsigned* unib = (LAS unsigned*)(lds + 18432 + 16384);
  int rloc = w * 16 + fr;
  const int tq = ci * 64 + rloc;
  const size_t tok = (size_t)b * S + tq;
  const float* grow = p.gn + tok * 24 + g * 12;
  float* orow = p.onsa + tok * 512 + g * 256;
  bf16x8 qf[4][2];
#pragma unroll
  for (int m = 0; m < 4; ++m)
#pragma unroll
    for (int ks = 0; ks < 2; ++ks)
      qf[m][ks] = *(const bf16x8*)(p.qb + tok * 512 + (g * 4 + m) * 64 + ks * 32 + fq * 8);
  f32x4 o[4][4];
  float mrow[4], lrow[4];
  bf16x8 rk[2], rv[2];

  const int nvis = (tq >= 31) ? ((tq - 31) / 16 + 1) : 0;
  const int nvmax = 4 * ci + 3;
  const int ntc = (nvmax + 63) >> 6;
  const unsigned short* kcb = p.cmpb + (size_t)((0 * NB + b) * 2 + g) * 256 * 64;
  const unsigned short* vcb = p.cmpb + (size_t)((1 * NB + b) * 2 + g) * 256 * 64;
#pragma unroll
  for (int m = 0; m < 4; ++m) { mrow[m] = -INFINITY; lrow[m] = 0.f; }
  REDERIVE();
  for (int tc = 0; tc < ntc; ++tc) {
    tile_fetch(rk, kcb + (size_t)tc * 4096, t);
    stage_k(rk, ldsK, t);
    __syncthreads();
    const int hi = nvis - 1 - tc * 64 - 4 * fq;
    cmp_stats<0>(mrow, lrow, qf, ldsK, hi, lane);
    cmp_stats<1>(mrow, lrow, qf, ldsK, hi, lane);
    __syncthreads();
  }
  {
    float linv[4], msf[4];
#pragma unroll
    for (int m = 0; m < 4; ++m) {
      float l = lrow[m];
      l += __shfl_xor(l, 16);
      l += __shfl_xor(l, 32);
      linv[m] = (l > 0.f) ? 1.0f / l : 0.f;
      msf[m] = (mrow[m] == -INFINITY) ? 0.f : mrow[m];
    }
    REDERIVE();
#pragma unroll
    for (int m = 0; m < 4; ++m)
#pragma unroll
      for (int dt = 0; dt < 4; ++dt) o[m][dt] = (f32x4){0.f, 0.f, 0.f, 0.f};
    float lastprev = 0.f;
    for (int tc = 0; tc < ntc; ++tc) {
      tile_fetch(rk, kcb + (size_t)tc * 4096, t);
      tile_fetch(rv, vcb + (size_t)tc * 4096, t);
      stage_k(rk, ldsK, t);
      stage_v(rv, ldsV, t);
      __syncthreads();
      const int hi = nvis - 1 - tc * 64 - 4 * fq;
      cmp_apply<0>(o, msf, linv, lastprev, impb + fr * 64 + tc * 16, qf, ldsK, ldsV, hi, lane);
      cmp_apply<1>(o, msf, linv, lastprev, impb + fr * 64 + tc * 16, qf, ldsK, ldsV, hi, lane);
      __syncthreads();
    }
  }
#pragma unroll
  for (int m = 0; m < 4; ++m) {
    const float gate = grow[m * 3 + 0];
#pragma unroll
    for (int dt = 0; dt < 4; ++dt) *(f32x4*)(orow + m * 64 + dt * 16 + 4 * fq) = o[m][dt] * gate;
  }
  unsigned mlo, mhi;
  REDERIVE();
  {
    WSYNC();
    float kv[16];
    const int c0 = -fq * 16, c1 = ci - fq * 16;
#pragma unroll
    for (int i = 0; i < 16; ++i) {
      const bool forced = (c0 == i) || (c1 == i) || (c1 == i + 1);
      float v = (c1 >= i) ? impb[fr * 64 + fq * 16 + i] : -INFINITY;
      if (forced) v = INFINITY;
      kv[i] = v;
    }
    WSYNC();
#pragma unroll
    for (int i = 0; i < 16; ++i) impb[fr * 64 + fq * 16 + i] = kv[i];
    WSYNC();
    int rank[16];
#pragma unroll
    for (int i = 0; i < 16; ++i) rank[i] = 0;
#pragma unroll 2
    for (int k = 0; k < 64; ++k) {
      const float ok = impb[fr * 64 + k];
      const int kq = k - fq * 16;
#pragma unroll
      for (int i = 0; i < 16; ++i) rank[i] += (ok > kv[i] || (ok == kv[i] && kq < i)) ? 1 : 0;
    }
    unsigned piece = 0;
#pragma unroll
    for (int i = 0; i < 16; ++i) piece |= (rank[i] < 16) ? (1u << i) : 0u;
    unsigned lo32 = (fq == 0) ? piece : (fq == 1) ? (piece << 16) : 0u;
    unsigned hi32 = (fq == 2) ? piece : (fq == 3) ? (piece << 16) : 0u;
    lo32 |= __shfl_xor(lo32, 16); lo32 |= __shfl_xor(lo32, 32);
    hi32 |= __shfl_xor(hi32, 16); hi32 |= __shfl_xor(hi32, 32);
    mlo = lo32; mhi = hi32;
    unsigned ulo = lo32, uhi = hi32;
#pragma unroll
    for (int off = 1; off < 16; off <<= 1) { ulo |= __shfl_xor(ulo, off); uhi |= __shfl_xor(uhi, off); }
    if (lane == 0) { unib[w * 2] = ulo; unib[w * 2 + 1] = uhi; }
    __syncthreads();
  }
  unsigned long long un;
  {
    const unsigned ulo = unib[0] | unib[2] | unib[4] | unib[6];
    const unsigned uhi = unib[1] | unib[3] | unib[5] | unib[7];
    un = ((unsigned long long)__builtin_amdgcn_readfirstlane(uhi) << 32) | (unsigned long long)__builtin_amdgcn_readfirstlane(ulo);
  }
  const unsigned long long rowmask = ((unsigned long long)mhi << 32) | mlo;

#pragma unroll 1
  for (int pass = 0; pass < 2; ++pass) {
    REDERIVE();
#pragma unroll
    for (int m = 0; m < 4; ++m) {
      mrow[m] = -INFINITY; lrow[m] = 0.f;
#pragma unroll
      for (int dt = 0; dt < 4; ++dt) o[m][dt] = (f32x4){0.f, 0.f, 0.f, 0.f};
    }
    const unsigned short* kb = p.kvb + (size_t)(((2 + 2 * pass) * NB + b) * 2 + g) * S * 64;
    const unsigned short* vb = p.kvb + (size_t)(((3 + 2 * pass) * NB + b) * 2 + g) * S * 64;
    const unsigned long long upto = (ci == 63) ? ~0ull : ((1ull << (ci + 1)) - 1ull);
    const int jlo = max(0, ci - 8);
    unsigned long long rem = pass ? (upto & ~((1ull << jlo) - 1ull)) : (un & upto);
    const int jwin0 = pass ? ci - 8 : -100;
    int j = __ffsll((long long)rem) - 1;
    tile_fetch(rk, kb + (size_t)j * 4096, t);
    tile_fetch(rv, vb + (size_t)j * 4096, t);
    while (rem) {
      rem &= rem - 1;
      stage_k(rk, ldsK, t);
      stage_v(rv, ldsV, t);
      __syncthreads();
      const int jn = rem ? (__ffsll((long long)rem) - 1) : -1;
      if (jn >= 0) {
        tile_fetch(rk, kb + (size_t)jn * 4096, t);
        tile_fetch(rv, vb + (size_t)jn * 4096, t);
      }
      const bool rowok = pass ? true : (bool)((rowmask >> j) & 1ull);
      int hi = (j == ci) ? rloc : 63;
      const int lo = ((j == jwin0) ? rloc : -1) - 4 * fq;
      hi = (rowok ? hi : -1000) - 4 * fq;
      attn_tile<true>(o, mrow, lrow, qf, ldsK, ldsV, true, lo, hi, lane);
      __syncthreads();
      j = jn;
    }
#pragma unroll
    for (int m = 0; m < 4; ++m) {
      float l = lrow[m];
      l += __shfl_xor(l, 16);
      l += __shfl_xor(l, 32);
      const float sc = grow[m * 3 + 1 + pass] / l;
#pragma unroll
      for (int dt = 0; dt < 4; ++dt) {
        f32x4* dst = (f32x4*)(orow + m * 64 + dt * 16 + 4 * fq);
        *dst = *dst + o[m][dt] * sc;
      }
    }
  }
}

#define XB_TMO      128
#define XB_XCNT(j)  (256  + 64 * (j))
#define XB_XSUB(j)  (1280 + 64 * (j))
#define XB_XGEN(j)  (2304 + 64 * (j))
#define XB_TOP      3328
#define XB_TOPGEN   3392
#define XCD_BAR_WORDS 3456
#define XB_SPIN_CAP (1u << 18)

__device__ __forceinline__ unsigned xb_ld(unsigned* p)              { return __hip_atomic_load(p, __ATOMIC_RELAXED, __HIP_MEMORY_SCOPE_AGENT); }
__device__ __forceinline__ unsigned xb_add(unsigned* p, unsigned v) { return __hip_atomic_fetch_add(p, v, __ATOMIC_RELAXED, __HIP_MEMORY_SCOPE_AGENT); }
__device__ __forceinline__ unsigned xb_xcc_id() { return (unsigned)__builtin_amdgcn_s_getreg((3 << 11) | 20) & 0xFu; }
#define XB_SPIN(cond, bar) do { unsigned _sp = 0; while (cond) { __builtin_amdgcn_s_sleep(1); \
    if ((++_sp & 255u) == 0u) { if (xb_ld(&(bar)[XB_TMO])) break; if (_sp > XB_SPIN_CAP) { atomicAdd(&(bar)[XB_TMO], 1u); break; } } } } while (0)

struct XcdBarrier {
    unsigned* bar; unsigned x;
    volatile LAS unsigned* st;
};

__device__ __forceinline__ XcdBarrier xcd_barrier_post(unsigned* bar, volatile LAS unsigned* st) {
    XcdBarrier b; b.bar = bar; b.x = xb_xcc_id(); b.st = st;
    if (threadIdx.x == 0) (void)xb_add(&bar[XB_XCNT(b.x)], 1u);
    return b;
}
__device__ __forceinline__ void xcd_barrier_complete(unsigned* bar, unsigned x, unsigned& nloc, unsigned& nx) {
    const unsigned G = gridDim.x * gridDim.y * gridDim.z;
    unsigned sum, cnt, mine, sp = 0u;
    for (;;) {
        sum = 0u; cnt = 0u; mine = 0u;
#pragma unroll
        for (unsigned j = 0; j < 16; ++j) { const unsigned c = xb_ld(&bar[XB_XCNT(j)]); sum += c; cnt += (c > 0u) ? 1u : 0u; mine = (j == x) ? c : mine; }
        if (sum == G) break;
        __builtin_amdgcn_s_sleep(1);
        if ((++sp & 255u) == 0u) { if (xb_ld(&bar[XB_TMO])) break; if (sp > XB_SPIN_CAP) { atomicAdd(&bar[XB_TMO], 1u); break; } }
    }
    nloc = mine > 0u ? mine : 1u; nx = cnt > 0u ? cnt : 1u;
}

__device__ __forceinline__ void xcd_barrier(const XcdBarrier& b) {
    asm volatile("s_waitcnt vmcnt(0)" ::: "memory");
    __syncthreads();
    if (threadIdx.x == 0) {
        unsigned* bar = b.bar;
        __builtin_amdgcn_s_waitcnt(0);
        unsigned nloc = b.st[0], nx = b.st[1];
        if (nloc == 0u) { xcd_barrier_complete(bar, b.x, nloc, nx); b.st[0] = nloc; b.st[1] = nx; }
        const unsigned old = xb_add(&bar[XB_XSUB(b.x)], 1u);
        const unsigned gen = old / nloc;
        if (old + 1u == (gen + 1u) * nloc) {
            __builtin_amdgcn_fence(__ATOMIC_RELEASE, "agent");
            asm volatile("s_waitcnt vmcnt(0)" ::: "memory");
            const unsigned og = xb_add(&bar[XB_TOP], 1u);
            const unsigned tg = og / nx;
            if (og + 1u == (tg + 1u) * nx) xb_add(&bar[XB_TOPGEN], 1u);
            else XB_SPIN(xb_ld(&bar[XB_TOPGEN]) == tg, bar);
            __builtin_amdgcn_fence(__ATOMIC_ACQUIRE, "agent");
            xb_add(&bar[XB_XGEN(b.x)], 1u);
            asm volatile("s_waitcnt vmcnt(0)" ::: "memory");
        } else {
            XB_SPIN(xb_ld(&bar[XB_XGEN(b.x)]) == gen, bar);
            __builtin_amdgcn_fence(__ATOMIC_ACQUIRE, "agent");
            asm volatile("s_waitcnt vmcnt(0)" ::: "memory");
        }
    }
    __syncthreads();
}


#define PHASE_IDX int t_ = threadIdx.x; OPAQUE(t_); const int tid = t_, lane = t_ & 63, wib = t_ >> 6; \
  const int gthreads = gridDim.x * 256, gtid = blockIdx.x * 256 + t_, gwaves = gridDim.x * 4, gwave = blockIdx.x * 4 + wib; \
  (void)tid; (void)lane; (void)wib; (void)gthreads; (void)gtid; (void)gwaves; (void)gwave;
constexpr int SMEM_FLOATS = 10240;

__global__ void __launch_bounds__(256, 2) mega(Params p) {
  __shared__ __attribute__((aligned(16))) float smem[SMEM_FLOATS];
  LAS unsigned char* lds = (LAS unsigned char*)smem;
  __shared__ __attribute__((aligned(16))) unsigned xb_st[4];
  if (threadIdx.x < 4) xb_st[threadIdx.x] = 0u;
  __syncthreads();
  const XcdBarrier gbar = xcd_barrier_post(p.bar, (volatile LAS unsigned*)xb_st);

  {
  PHASE_IDX
  {
    for (int i = tid; i < NB * D; i += 256) smem[i] = siluf_(p.c[i]);
    __syncthreads();
    for (int idx = gtid; idx < NB * 6 * D; idx += gthreads) {
      const int b = idx / (6 * D), j = idx % (6 * D);
      float acc = p.b_ada[j];
      const float* sc = smem + b * D;
      for (int k = 0; k < D; ++k) acc = fmaf(sc[k], p.w_ada[(size_t)k * (6 * D) + j], acc);
      p.mod[idx] = acc;
    }
    for (int idx = gtid; idx < 32 * 64; idx += gthreads) {
      const int g = idx / 64;
      const double dt = exp((double)p.log_dt[g]);
      const double lr = p.a_re[idx], li = p.a_im[idx];
      const double mag = exp(lr * dt);
      const double br = mag * cos(li * dt), bi = mag * sin(li * dt);
      p.lamb[idx * 2] = (float)br;
      p.lamb[idx * 2 + 1] = (float)bi;
      const double mag64 = exp(lr * dt * 64.0);
      p.lam64[idx * 2] = (float)(mag64 * cos(li * dt * 64.0));
      p.lam64[idx * 2 + 1] = (float)(mag64 * sin(li * dt * 64.0));
      const double nr = br - 1.0, ni = bi;
      const double den = lr * lr + li * li;
      const double cr = (nr * lr + ni * li) / den, ci = (ni * lr - nr * li) / den;
      for (int q = 0; q < 16; ++q) {
        const double wr = p.b_re[idx * 16 + q], wi = p.b_im[idx * 16 + q];
        p.bbar[(idx * 16 + q) * 2] = (float)(cr * wr - ci * wi);
        p.bbar[(idx * 16 + q) * 2 + 1] = (float)(cr * wi + ci * wr);
      }
    }
    for (int idx = gtid; idx < NE; idx += gthreads) { p.cnt[idx] = 0; p.cursor[idx] = 0; }
    for (int idx = gtid; idx < 512; idx += gthreads) {
      const int kv = idx >> 8, j = idx & 255;
      const float* pe = kv ? p.pe_v : p.pe_k;
      const float* w1 = kv ? p.w_cmp_v1 : p.w_cmp_k1;
      float acc = 0.f;
      for (int k = 0; k < 2048; ++k) acc = fmaf(pe[k], w1[(size_t)k * 256 + j], acc);
      p.cbias[idx] = acc;
    }
  }
  }
  xcd_barrier(gbar);

  {
  PHASE_IDX
  for (int row = gwave; row < NT; row += gwaves) {
    const int b = row / S;
    const float* xr = p.x + (size_t)row * D;
    f32x4 v[4];
    float ss = 0.f;
#pragma unroll
    for (int i = 0; i < 4; ++i) {
      v[i] = *(const f32x4*)(xr + i * 256 + lane * 4);
      ss += (v[i][0] * v[i][0] + v[i][1] * v[i][1]) + (v[i][2] * v[i][2] + v[i][3] * v[i][3]);
    }
    ss = wsum(ss);
    const float r = rsqrtf(ss * (1.0f / D) + EPS);
    const float* md = p.mod + b * 6 * D;
#pragma unroll
    for (int i = 0; i < 4; ++i) {
      const int col = i * 256 + lane * 4;
      const f32x4 gg = *(const f32x4*)(p.g_norm1 + col), sc = *(const f32x4*)(md + D + col), sh = *(const f32x4*)(md + col);
      const f32x4 y = v[i] * r * gg * (sc + 1.0f) + sh;
      uint2 w;
      w.x = cvt_pk_bf16(y[0], y[1]); w.y = cvt_pk_bf16(y[2], y[3]);
      *(uint2*)(p.h + (size_t)row * D + col) = w;
    }
  }
  }
  xcd_barrier(gbar);

  {
  PHASE_IDX
  {
    constexpr int TN = (INC + 127) / 128;
    for (int tile = blockIdx.x; tile < (NT / 128) * TN; tile += gridDim.x) {
      const int m0 = (tile / TN) * 128, n0 = (tile % TN) * 128;
      gemm128<true>(
          D, [&](int r, int k) -> const void* { return p.h + (size_t)(m0 + r) * D + k; },
          [&](int c) -> const float* { return (n0 + c < INC) ? p.w_in + n0 + c : nullptr; }, INC,
          [&](const f32x4 (&acc)[4][4], int wr, int wc, int fr, int fq) {
            const int cw = n0 + wc * 64;
            if (cw < C_GN) {
              const bool isq = cw < C_KC;
              const int slot = isq ? 0 : (cw - C_KC) >> 7, gg = isq ? 0 : ((cw - C_KC) >> 6) & 1;
              const bool norm = isq || slot == 2 || slot == 4;
              const float* gain = isq ? p.q_gain : (slot == 2 ? p.ks_gain : p.kw_gain);
              const float post = isq ? ATT_SCALE * 1.4426950408889634f : 1.0f;
#pragma unroll
              for (int m = 0; m < 4; ++m) {
                const int tok = m0 + wr * 64 + m * 16 + fr;
                float r = 1.0f;
                if (norm) {
                  float ss = 0.f;
#pragma unroll
                  for (int n = 0; n < 4; ++n)
#pragma unroll
                    for (int jj = 0; jj < 4; ++jj) ss = fmaf(acc[m][n][jj], acc[m][n][jj], ss);
                  ss += __shfl_xor(ss, 16);
                  ss += __shfl_xor(ss, 32);
                  r = rsqrtf(ss * (1.0f / 64) + EPS) * post;
                }
                unsigned short* dst = isq ? p.qb + (size_t)tok * 512 + cw
                                          : p.kvb + ((size_t)((slot * NB + (tok >> 12)) * 2 + gg) * S + (tok & (S - 1))) * 64;
#pragma unroll
                for (int n = 0; n < 4; ++n) {
                  f32x4 v = acc[m][n] * r;
                  if (norm) v = v * *(const f32x4*)(gain + n * 16 + 4 * fq);
                  uint2 w;
                  w.x = cvt_pk_bf16(v[0], v[1]); w.y = cvt_pk_bf16(v[2], v[3]);
                  *(uint2*)(dst + n * 16 + 4 * fq) = w;
                }
              }
            } else {
#pragma unroll
              for (int m = 0; m < 4; ++m) {
                const size_t tok = m0 + wr * 64 + m * 16 + fr;
#pragma unroll
                for (int n = 0; n < 4; ++n) {
                  const int c = cw + n * 16 + 4 * fq;
                  if (c < INC) {
                    f32x4 v = acc[m][n];
                    if (c >= C_U && c < C_GA) {
                      *(f32x4*)(p.u + tok * 512 + (c - C_U)) = v;
                    } else {
#pragma unroll
                      for (int j = 0; j < 4; ++j) v[j] = sigmoidf_(v[j]);
                      float* dst = (c < C_U) ? p.gn + tok * 24 + (c - C_GN)
                                             : (c < C_GS) ? p.ga + tok * D + (c - C_GA) : p.gs + tok * D + (c - C_GS);
                      *(f32x4*)dst = v;
                    }
                  }
                }
              }
            }
          },
          lds);
    }
  }
  }
  xcd_barrier(gbar);

  {
  PHASE_IDX
  for (int kv = 0; kv < 2; ++kv) {
    const float* w1 = kv ? p.w_cmp_v1 : p.w_cmp_k1;
    float* hid = kv ? p.hidv : p.hidk;
    const float* cb = p.cbias + kv * 256;
    gemm_phase<true>(
        NB * NCMP * 2, 256, 2048,
        [&](int r, int k) {
          const int b = r / (NCMP * 2), n = (r >> 1) % NCMP, g = r & 1;
          return p.kvb + ((size_t)((kv * NB + b) * 2 + g) * S + 16 * n) * 64 + k;
        },
        [&](int n) { return w1 + n; }, 256,
        [&](int r, int n, f32x4 v) {
#pragma unroll
          for (int j = 0; j < 4; ++j) v[j] = geluf_(v[j] + cb[n + j]);
          *(f32x4*)(hid + (size_t)r * 256 + n) = v;
        },
        lds);
  }
  }
  xcd_barrier(gbar);

  {
  PHASE_IDX
  for (int wv = gwave; wv < 2 * NB * NCMP * 2; wv += gwaves) {
    const int kv = wv / (NB * NCMP * 2), r = wv % (NB * NCMP * 2);
    const int b = r / (NCMP * 2), n = (r >> 1) % NCMP, g = r & 1;
    const float* hid = (kv ? p.hidv : p.hidk) + (size_t)r * 256;
    const float* w2 = kv ? p.w_cmp_v2 : p.w_cmp_k2;
    float acc = 0.f;
    for (int j = 0; j < 256; ++j) acc = fmaf(hid[j], w2[j * 64 + lane], acc);
    if (kv == 0) {
      const float ss = wsum(acc * acc);
      acc = acc * rsqrtf(ss * (1.0f / 64) + EPS) * p.kc_gain[lane];
    }
    const float other = __shfl_xor(acc, 1);
    if ((lane & 1) == 0)
      *(unsigned*)(p.cmpb + ((size_t)((kv * NB + b) * 2 + g) * 256 + n) * 64 + lane) = cvt_pk_bf16(acc, other);
  }
  for (int idx = gtid; idx < 2 * NB * 2 * 32; idx += gthreads)
    *(unsigned*)(p.cmpb + ((size_t)(idx >> 5) * 256 + 255) * 64 + (idx & 31) * 2) = 0u;
  }
  xcd_barrier(gbar);

  {
  PHASE_IDX
  for (int u = blockIdx.x; u < 256; u += gridDim.x) {
    const int bg = u >> 5, pr = u & 31;
#pragma unroll 1
    for (int half = 0; half < 2; ++half) attn_chunk(p, lds, bg >> 1, bg & 1, half ? pr : 63 - pr);
  }
  }
  xcd_barrier(gbar);

  {
  PHASE_IDX
  for (int item = gwave; item < NB * 32 * 64; item += gwaves) {
    const int c = item & 63, g = (item >> 6) & 31, b = item >> 11;
    const int gn = g * 64 + lane;
    float bbr[16], bbi[16];
#pragma unroll
    for (int q = 0; q < 16; ++q) { bbr[q] = p.bbar[(gn * 16 + q) * 2]; bbi[q] = p.bbar[(gn * 16 + q) * 2 + 1]; }
    const float lr = p.lamb[gn * 2], li = p.lamb[gn * 2 + 1];
    float xr = 0.f, xi = 0.f;
    for (int t = 0; t < 64; ++t) {
      const float* up = p.u + (size_t)(b * S + c * 64 + t) * 512 + g * 16;
      float br = 0.f, bi = 0.f;
#pragma unroll
      for (int q = 0; q < 16; ++q) { const float u = up[q]; br = fmaf(bbr[q], u, br); bi = fmaf(bbi[q], u, bi); }
      const float nr = lr * xr - li * xi + br;
      const float ni = lr * xi + li * xr + bi;
      xr = nr; xi = ni;
    }
    p.cstate[(size_t)item * 128 + lane * 2] = xr;
    p.cstate[(size_t)item * 128 + lane * 2 + 1] = xi;
  }
  }
  xcd_barrier(gbar);

  {
  PHASE_IDX
  for (int idx = gtid; idx < NB * 32 * 64; idx += gthreads) {
    const int n = idx & 63, g = (idx >> 6) & 31, b = idx >> 11;
    const int gn = g * 64 + n;
    const float lr = p.lam64[gn * 2], li = p.lam64[gn * 2 + 1];
    float hr_ = 0.f, hi_ = 0.f;
    for (int c = 0; c < 64; ++c) {
      const size_t o = ((size_t)((b * 32 + g) * 64 + c)) * 128 + n * 2;
      p.cin[o] = hr_;
      p.cin[o + 1] = hi_;
      const float sr = p.cstate[o], si = p.cstate[o + 1];
      const float nr = lr * hr_ - li * hi_ + sr;
      const float ni = lr * hi_ + li * hr_ + si;
      hr_ = nr; hi_ = ni;
    }
  }
  }
  xcd_barrier(gbar);

  {
  PHASE_IDX
  for (int item = gwave; item < NB * 32 * 64; item += gwaves) {
    const int c = item & 63, g = (item >> 6) & 31, b = item >> 11;
    const int gn = g * 64 + lane;
    float bbr[16], bbi[16], ccr[16], cci[16];
#pragma unroll
    for (int q = 0; q < 16; ++q) {
      bbr[q] = p.bbar[(gn * 16 + q) * 2];
      bbi[q] = p.bbar[(gn * 16 + q) * 2 + 1];
      ccr[q] = p.c_re[(g * 16 + q) * 64 + lane];
      cci[q] = p.c_im[(g * 16 + q) * 64 + lane];
    }
    const float lr = p.lamb[gn * 2], li = p.lamb[gn * 2 + 1];
    float xr = p.cin[(size_t)item * 128 + lane * 2], xi = p.cin[(size_t)item * 128 + lane * 2 + 1];
    const float dsk = (lane < 16) ? p.d_skip[g * 16 + lane] : 0.f;
    for (int t = 0; t < 64; ++t) {
      const int tok = b * S + c * 64 + t;
      const float* up = p.u + (size_t)tok * 512 + g * 16;
      float br = 0.f, bi = 0.f;
#pragma unroll
      for (int q = 0; q < 16; ++q) { const float u = up[q]; br = fmaf(bbr[q], u, br); bi = fmaf(bbi[q], u, bi); }
      const float nr = lr * xr - li * xi + br;
      const float ni = lr * xi + li * xr + bi;
      xr = nr; xi = ni;
      float yv = 0.f;
#pragma unroll
      for (int q = 0; q < 16; ++q) {
        const float v = wsum(ccr[q] * xr - cci[q] * xi);
        if (lane == q) yv = v;
      }
      if (lane < 16) {
        const float y = yv + dsk * up[lane];
        p.z[(size_t)tok * 512 + g * 16 + lane] = geluf_(y);
      }
    }
  }
  }
  xcd_barrier(gbar);

  {
  PHASE_IDX
  gemm_phase<false>(
      NT, 512, 512, [&](int m, int k) { return p.z + (size_t)m * 512 + k; },
      [&](int n) { return p.w_glu + n; }, 512,
      [&](int m, int n, f32x4 v) {
        const f32x4 zz = *(const f32x4*)(p.z + (size_t)m * 512 + n);
#pragma unroll
        for (int j = 0; j < 4; ++j) v[j] = zz[j] * sigmoidf_(v[j] + p.b_glu[n + j]);
        *(f32x4*)(p.yssm + (size_t)m * 512 + n) = v;
      },
      lds);
  }
  xcd_barrier(gbar);

  {
  PHASE_IDX
  gemm_phase<false>(
      NT, D, 512, [&](int m, int k) { return p.onsa + (size_t)m * 512 + k; },
      [&](int n) { return p.w_up_attn + n; }, D,
      [&](int m, int n, f32x4 v) {
        const f32x4 gg = *(const f32x4*)(p.ga + (size_t)m * D + n);
        *(f32x4*)(p.merged + (size_t)m * D + n) = gg * v;
      },
      lds);
  }
  xcd_barrier(gbar);
  {
  PHASE_IDX
  gemm_phase<false>(
      NT, D, 512, [&](int m, int k) { return p.yssm + (size_t)m * 512 + k; },
      [&](int n) { return p.w_up_ssm + n; }, D,
      [&](int m, int n, f32x4 v) {
        const f32x4 gg = *(const f32x4*)(p.gs + (size_t)m * D + n);
        f32x4* dst = (f32x4*)(p.merged + (size_t)m * D + n);
        *dst = *dst + gg * v;
      },
      lds);
  }
  xcd_barrier(gbar);
  {
  PHASE_IDX
  gemm_phase<false>(
      NT, D, D, [&](int m, int k) { return p.merged + (size_t)m * D + k; },
      [&](int n) { return p.w_out + n; }, D,
      [&](int m, int n, f32x4 v) {
        const int b = m / S;
        const f32x4 xx = *(const f32x4*)(p.x + (size_t)m * D + n);
        const f32x4 gt = *(const f32x4*)(p.mod + b * 6 * D + 2 * D + n);
        *(f32x4*)(p.xmid + (size_t)m * D + n) = xx + gt * v;
      },
      lds);
  }
  xcd_barrier(gbar);

  {
  PHASE_IDX
  for (int row = gwave; row < NT; row += gwaves) {
    const int b = row / S;
    const float* xr = p.xmid + (size_t)row * D;
    f32x4 v[4];
    float ss = 0.f;
#pragma unroll
    for (int i = 0; i < 4; ++i) {
      v[i] = *(const f32x4*)(xr + i * 256 + lane * 4);
      ss += (v[i][0] * v[i][0] + v[i][1] * v[i][1]) + (v[i][2] * v[i][2] + v[i][3] * v[i][3]);
    }
    ss = wsum(ss);
    const float r = rsqrtf(ss * (1.0f / D) + EPS);
    const float* md = p.mod + b * 6 * D;
#pragma unroll
    for (int i = 0; i < 4; ++i) {
      const int col = i * 256 + lane * 4;
      const f32x4 gg = *(const f32x4*)(p.g_norm2 + col), sc = *(const f32x4*)(md + 4 * D + col), sh = *(const f32x4*)(md + 3 * D + col);
      const f32x4 y = v[i] * r * gg * (sc + 1.0f) + sh;
      uint2 w;
      w.x = cvt_pk_bf16(y[0], y[1]); w.y = cvt_pk_bf16(y[2], y[3]);
      *(uint2*)(p.h + (size_t)row * D + col) = w;
    }
  }
  }
  xcd_barrier(gbar);

  {
  PHASE_IDX
  for (int tile = blockIdx.x; tile < 128 * 2 + 128 * 4; tile += gridDim.x) {
    if (tile < 256) {
      const int m0 = (tile >> 1) * 128, n0 = (tile & 1) * 128;
      gemm128<true>(
          D, [&](int r, int k) -> const void* { return p.h + (size_t)(m0 + r) * D + k; },
          [&](int c) -> const float* { return p.w_router + n0 + c; }, NE,
          [&](const f32x4 (&acc)[4][4], int wr, int wc, int fr, int fq) {
#pragma unroll
            for (int m = 0; m < 4; ++m)
#pragma unroll
              for (int n = 0; n < 4; ++n) {
                f32x4 v = acc[m][n];
#pragma unroll
                for (int j = 0; j < 4; ++j) v[j] = sigmoidf_(v[j]);
                *(f32x4*)(p.scores + (size_t)(m0 + wr * 64 + m * 16 + fr) * NE + n0 + wc * 64 + n * 16 + 4 * fq) = v;
              }
          },
          lds);
    } else {
      const int tt = tile - 256;
      const int m0 = (tt >> 2) * 128, ct = tt & 3;
      gemm128<true>(
          D, [&](int r, int k) -> const void* { return p.h + (size_t)(m0 + r) * D + k; },
          [&](int c) -> const float* {
            const int hid = ct * 64 + (c >> 6) * 32 + ((c >> 4) & 1) * 16 + (c & 15);
            return (((c >> 5) & 1) ? p.ws_up : p.ws_gate) + hid;
          },
          DE,
          [&](const f32x4 (&acc)[4][4], int wr, int wc, int fr, int fq) {
#pragma unroll
            for (int m = 0; m < 4; ++m)
#pragma unroll
              for (int n = 0; n < 2; ++n) {
                f32x4 v;
#pragma unroll
                for (int j = 0; j < 4; ++j) v[j] = siluf_(acc[m][n][j]) * acc[m][n + 2][j];
                uint2 w;
                w.x = cvt_pk_bf16(v[0], v[1]); w.y = cvt_pk_bf16(v[2], v[3]);
                *(uint2*)(p.hs + (size_t)(m0 + wr * 64 + m * 16 + fr) * DE + ct * 64 + wc * 32 + n * 16 + 4 * fq) = w;
              }
          },
          lds);
    }
  }
  }
  xcd_barrier(gbar);

  {
  PHASE_IDX
  for (int tok = gwave; tok < NT; tok += gwaves) {
    const float4 sc4 = *reinterpret_cast<const float4*>(p.scores + (size_t)tok * NE + lane * 4);
    const float4 bi4 = *reinterpret_cast<const float4*>(p.router_bias + lane * 4);
    const float sc[4] = {sc4.x, sc4.y, sc4.z, sc4.w};
    float bz[4] = {sc4.x + bi4.x, sc4.y + bi4.y, sc4.z + bi4.z, sc4.w + bi4.w};
    float m1 = -INFINITY, m2 = -INFINITY;
#pragma unroll
    for (int i = 0; i < 4; ++i) {
      const float v = bz[i];
      if (v > m1) { m2 = m1; m1 = v; } else if (v > m2) { m2 = v; }
    }
#pragma unroll
    for (int o = 1; o < 8; o <<= 1) {
      const float o1 = __shfl_xor(m1, o), o2 = __shfl_xor(m2, o);
      const float n1 = fmaxf(m1, o1);
      const float n2 = fmaxf(fminf(m1, o1), fmaxf(m2, o2));
      m1 = n1; m2 = n2;
    }
    const float gs = m1 + m2;
    const int mygrp = lane >> 3;
    int grank = 0;
#pragma unroll
    for (int g2 = 0; g2 < 8; ++g2) {
      const float og = __shfl(gs, g2 * 8);
      grank += (og > gs || (og == gs && g2 < mygrp)) ? 1 : 0;
    }
    const bool gsel = grank < 4;
#pragma unroll
    for (int i = 0; i < 4; ++i) if (!gsel) bz[i] = -INFINITY;
    unsigned taken = 0;
    float wsel = 0.f;
    int esel = 0;
    float wtot = 0.f;
#pragma unroll 1
    for (int k = 0; k < TOPK; ++k) {
      float bv = -INFINITY; int bidx = 1 << 30;
#pragma unroll
      for (int i = 0; i < 4; ++i) {
        if (!((taken >> i) & 1u) && bz[i] > bv) { bv = bz[i]; bidx = lane * 4 + i; }
      }
#pragma unroll
      for (int o = 32; o > 0; o >>= 1) {
        const float ov = __shfl_xor(bv, o);
        const int oi = __shfl_xor(bidx, o);
        if (ov > bv || (ov == bv && oi < bidx)) { bv = ov; bidx = oi; }
      }
      const int owner = bidx >> 2, slot = bidx & 3;
      float sv = 0.f;
      if (lane == owner) {
        taken |= 1u << slot;
        sv = (slot == 0) ? sc[0] : (slot == 1) ? sc[1] : (slot == 2) ? sc[2] : sc[3];
      }
      sv = __shfl(sv, owner);
      wtot += sv;
      if (lane == k) { wsel = sv; esel = bidx; }
    }
    if (lane < TOPK) {
      p.eidx[tok * TOPK + lane] = esel;
      p.ew[tok * TOPK + lane] = wsel / wtot * 2.5f;
      atomicAdd(&p.cnt[esel], 1);
    }
  }
  gemm_phase<true>(
      NT, D, DE, [&](int m, int k) { return p.hs + (size_t)m * DE + k; },
      [&](int n) { return p.ws_down + n; }, D,
      [&](int m, int n, f32x4 v) {
        const int b = m / S;
        const f32x4 xx = *(const f32x4*)(p.xmid + (size_t)m * D + n);
        const f32x4 gt = *(const f32x4*)(p.mod + b * 6 * D + 5 * D + n);
        *(f32x4*)(p.out + (size_t)m * D + n) = xx + gt * v;
      },
      lds);
  }
  xcd_barrier(gbar);

  {
  PHASE_IDX
  {
    int* soff = (int*)smem;
    int* srt = soff + 320;
    const int myc = p.cnt[tid];
    soff[tid] = myc;
    srt[tid] = (myc + 127) >> 7;
    __syncthreads();
    for (int st = 1; st < 256; st <<= 1) {
      const int a0 = (tid >= st) ? soff[tid - st] : 0, a1 = (tid >= st) ? srt[tid - st] : 0;
      __syncthreads();
      soff[tid] += a0; srt[tid] += a1;
      __syncthreads();
    }
    const int exo = soff[tid] - myc, exr = srt[tid] - ((myc + 127) >> 7);
    __syncthreads();
    soff[tid] = exo;
    if (blockIdx.x == 0) {
      p.off[tid] = exo; p.rts[tid] = exr;
      if (tid == 255) { p.off[NE] = exo + myc; p.rts[NE] = exr + ((myc + 127) >> 7); }
    }
    __syncthreads();
    for (int idx = gtid; idx < NASSIGN; idx += gthreads) {
      const int e = p.eidx[idx];
      const int pos = soff[e] + atomicAdd(&p.cursor[e], 1);
      p.stok[pos] = idx / TOPK;
      p.sw[pos] = p.ew[idx];
      p.apos[idx] = pos;
    }
  }
  }
  xcd_barrier(gbar);

  {
  PHASE_IDX
  {
    const int total_rt = p.rts[NE];
    for (int tile = blockIdx.x; tile < total_rt * 4; tile += gridDim.x) {
      const int rt = tile >> 2, ct = tile & 3;
      const int e = find_expert(p.rts, rt);
      const int pos0 = p.off[e] + (rt - p.rts[e]) * 128;
      const int mvalid = min(128, p.off[e] + p.cnt[e] - pos0);
      const float* wg = p.w_gate + (size_t)e * D * DE;
      const float* wu = p.w_up + (size_t)e * D * DE;
      gemm128<true>(
          D, [&](int r, int k) -> const void* { return (r < mvalid) ? p.h + (size_t)p.stok[pos0 + r] * D + k : nullptr; },
          [&](int c) -> const float* {
            const int hid = ct * 64 + (c >> 6) * 32 + ((c >> 4) & 1) * 16 + (c & 15);
            return (((c >> 5) & 1) ? wu : wg) + hid;
          },
          DE,
          [&](const f32x4 (&acc)[4][4], int wr, int wc, int fr, int fq) {
#pragma unroll
            for (int m = 0; m < 4; ++m) {
              const int r = wr * 64 + m * 16 + fr;
              if (r < mvalid) {
#pragma unroll
                for (int n = 0; n < 2; ++n) {
                  f32x4 v;
#pragma unroll
                  for (int j = 0; j < 4; ++j) v[j] = siluf_(acc[m][n][j]) * acc[m][n + 2][j];
                  uint2 w;
                  w.x = cvt_pk_bf16(v[0], v[1]); w.y = cvt_pk_bf16(v[2], v[3]);
                  *(uint2*)(p.hr + (size_t)(pos0 + r) * DE + ct * 64 + wc * 32 + n * 16 + 4 * fq) = w;
                }
              }
            }
          },
          lds);
    }
  }
  }
  xcd_barrier(gbar);
  {
  PHASE_IDX
  {
    const int total_rt = p.rts[NE];
    for (int tile = blockIdx.x; tile < total_rt * 8; tile += gridDim.x) {
      const int rt = tile >> 3, ct = tile & 7;
      const int e = find_expert(p.rts, rt);
      const int pos0 = p.off[e] + (rt - p.rts[e]) * 128;
      const int mvalid = min(128, p.off[e] + p.cnt[e] - pos0);
      const float* wmat = p.w_down + (size_t)e * DE * D + ct * 128;
      gemm128<true>(
          DE, [&](int r, int k) -> const void* { return (r < mvalid) ? p.hr + (size_t)(pos0 + r) * DE + k : nullptr; },
          [&](int c) -> const float* { return wmat + c; }, D,
          [&](const f32x4 (&acc)[4][4], int wr, int wc, int fr, int fq) {
#pragma unroll
            for (int m = 0; m < 4; ++m) {
              const int r = wr * 64 + m * 16 + fr;
              if (r < mvalid) {
                const float wgt = p.sw[pos0 + r];
#pragma unroll
                for (int n = 0; n < 4; ++n) {
                  const f32x4 v = acc[m][n] * wgt;
                  uint2 w;
                  w.x = cvt_pk_bf16(v[0], v[1]); w.y = cvt_pk_bf16(v[2], v[3]);
                  *(uint2*)(p.yk + (size_t)(pos0 + r) * D + ct * 128 + wc * 64 + n * 16 + 4 * fq) = w;
                }
              }
            }
          },
          lds);
    }
  }
  }
  xcd_barrier(gbar);
  {
  PHASE_IDX
  for (int tok = gwave; tok < NT; tok += gwaves) {
    const int b = tok / S;
    float acc[16];
#pragma unroll
    for (int i = 0; i < 16; ++i) acc[i] = 0.f;
#pragma unroll 1
    for (int k = 0; k < TOPK; ++k) {
      const int pos = p.apos[tok * TOPK + k];
      const u32x4* src = (const u32x4*)(p.yk + (size_t)pos * D + lane * 16);
      const u32x4 a = src[0], c = src[1];
      const unsigned wv[8] = {a.x, a.y, a.z, a.w, c.x, c.y, c.z, c.w};
#pragma unroll
      for (int i = 0; i < 8; ++i) {
        acc[2 * i] += __uint_as_float(wv[i] << 16);
        acc[2 * i + 1] += __uint_as_float(wv[i] & 0xffff0000u);
      }
    }
    float* dst = p.out + (size_t)tok * D + lane * 16;
    const float* gt = p.mod + b * 6 * D + 5 * D + lane * 16;
#pragma unroll
    for (int i = 0; i < 4; ++i) {
      f32x4 o4 = *(f32x4*)(dst + 4 * i);
      const f32x4 g4 = *(const f32x4*)(gt + 4 * i);
#pragma unroll
      for (int j = 0; j < 4; ++j) o4[j] += g4[j] * acc[4 * i + j];
      *(f32x4*)(dst + 4 * i) = o4;
    }
  }
  }
}

extern "C" void kernel_launch(void* const* d_in, const int* in_sizes, int n_in, void* d_out, int out_size,
                              void* d_ws, size_t ws_size, hipStream_t stream) {
  (void)in_sizes; (void)n_in; (void)out_size; (void)ws_size;
  Params p{};
  const float* const* in = reinterpret_cast<const float* const*>(d_in);
  p.x = in[0]; p.c = in[1]; p.w_ada = in[2]; p.b_ada = in[3]; p.g_norm1 = in[4]; p.g_norm2 = in[5];
  p.w_in = in[6]; p.q_gain = in[7]; p.kc_gain = in[8]; p.ks_gain = in[9]; p.kw_gain = in[10];
  p.pe_k = in[11]; p.pe_v = in[12]; p.w_cmp_k1 = in[13]; p.w_cmp_k2 = in[14]; p.w_cmp_v1 = in[15];
  p.w_cmp_v2 = in[16]; p.a_re = in[17]; p.a_im = in[18]; p.log_dt = in[19]; p.b_re = in[20];
  p.b_im = in[21]; p.c_re = in[22]; p.c_im = in[23]; p.d_skip = in[24]; p.w_glu = in[25];
  p.b_glu = in[26]; p.w_up_attn = in[27]; p.w_up_ssm = in[28]; p.w_out = in[29]; p.w_router = in[30];
  p.router_bias = in[31]; p.w_gate = in[32]; p.w_up = in[33]; p.w_down = in[34]; p.ws_gate = in[35];
  p.ws_up = in[36]; p.ws_down = in[37];
  p.out = (float*)d_out;

  char* base = (char*)d_ws;
  size_t o = 0;
  auto take = [&](size_t bytes) { void* r = base + o; o += (bytes + 255) & ~(size_t)255; return r; };
  p.bar = (unsigned*)take(sizeof(unsigned) * XCD_BAR_WORDS);
  p.mod = (float*)take(sizeof(float) * NB * 6 * D);
  p.cbias = (float*)take(sizeof(float) * 512);
  p.h = (unsigned short*)take(2 * (size_t)NT * D);
  p.qb = (unsigned short*)take(2 * (size_t)NT * 512);
  p.kvb = (unsigned short*)take(2 * (size_t)6 * NB * 2 * S * 64);
  p.cmpb = (unsigned short*)take(2 * (size_t)2 * NB * 2 * 256 * 64);
  p.gn = (float*)take(sizeof(float) * (size_t)NT * 24);
  p.u = (float*)take(sizeof(float) * (size_t)NT * 512);
  p.ga = (float*)take(sizeof(float) * (size_t)NT * D);
  p.gs = (float*)take(sizeof(float) * (size_t)NT * D);
  p.hidk = (float*)take(sizeof(float) * 2040 * 256);
  p.hidv = (float*)take(sizeof(float) * 2040 * 256);
  p.onsa = (float*)take(sizeof(float) * (size_t)NT * 512);
  p.lamb = (float*)take(sizeof(float) * 2048 * 2);
  p.lam64 = (float*)take(sizeof(float) * 2048 * 2);
  p.bbar = (float*)take(sizeof(float) * 2048 * 32);
  p.cstate = (float*)take(sizeof(float) * NB * 32 * 64 * 128);
  p.cin = (float*)take(sizeof(float) * NB * 32 * 64 * 128);
  p.z = (float*)take(sizeof(float) * (size_t)NT * 512);
  p.yssm = (float*)take(sizeof(float) * (size_t)NT * 512);
  p.merged = (float*)take(sizeof(float) * (size_t)NT * D);
  p.xmid = (float*)take(sizeof(float) * (size_t)NT * D);
  p.scores = (float*)take(sizeof(float) * (size_t)NT * NE);
  p.eidx = (int*)take(sizeof(int) * NASSIGN);
  p.ew = (float*)take(sizeof(float) * NASSIGN);
  p.cnt = (int*)take(sizeof(int) * NE);
  p.cursor = (int*)take(sizeof(int) * NE);
  p.off = (int*)take(sizeof(int) * (NE + 1));
  p.rts = (int*)take(sizeof(int) * (NE + 1));
  p.stok = (int*)take(sizeof(int) * NASSIGN);
  p.sw = (float*)take(sizeof(float) * NASSIGN);
  p.hs = (unsigned short*)take(2 * (size_t)NT * DE);
  p.hr = (unsigned short*)take(2 * (size_t)NASSIGN * DE);
  p.yk = (unsigned short*)take(2 * (size_t)NASSIGN * D);
  p.apos = (int*)take(sizeof(int) * NASSIGN);
  if (o > ws_size) fprintf(stderr, "workspace too small: need %zu have %zu\n", o, ws_size);

  static int grid_blocks = 0;
  if (!grid_blocks) {
    int dev = 0, cus = 0, per_cu = 0;
    hipGetDevice(&dev);
    hipDeviceGetAttribute(&cus, hipDeviceAttributeMultiprocessorCount, dev);
    hipOccupancyMaxActiveBlocksPerMultiprocessor(&per_cu, mega, 256, 0);
    if (per_cu > 2) per_cu = 2;
    if (per_cu < 1) per_cu = 1;
    grid_blocks = cus * per_cu;
  }
  (void)hipMemsetAsync(p.bar, 0, sizeof(unsigned) * XCD_BAR_WORDS, stream);
  hipLaunchKernelGGL(mega, dim3(grid_blocks), dim3(256), 0, stream, p);
  hipError_t e = hipPeekAtLastError();
  if (e != hipSuccess) fprintf(stderr, "launch failed: %s (grid %d)\n", hipGetErrorString(e), grid_blocks);
}
```

```cpp
#include <hip/hip_runtime.h>
#include <cstdio>
#include <cstdint>

constexpr int D = 1024;
constexpr int NB = 4;
constexpr int S = 4096;
constexpr int NT = NB * S;
constexpr int INC = 3864;
constexpr int C_Q = 0, C_KC = 512, C_VC = 640, C_KS = 768, C_VS = 896, C_KW = 1024, C_VW = 1152,
              C_GN = 1280, C_U = 1304, C_GA = 1816, C_GS = 2840;
constexpr int NCMP = 255;
constexpr int NE = 256;
constexpr int TOPK = 8;
constexpr int DE = 256;
constexpr int NASSIGN = NT * TOPK;
constexpr float EPS = 1e-6f;
constexpr float ATT_SCALE = 0.125f;

struct Params {
  const float* x; const float* c; const float* w_ada; const float* b_ada; const float* g_norm1;
  const float* g_norm2; const float* w_in; const float* q_gain; const float* kc_gain;
  const float* ks_gain; const float* kw_gain; const float* pe_k; const float* pe_v;
  const float* w_cmp_k1; const float* w_cmp_k2; const float* w_cmp_v1; const float* w_cmp_v2;
  const float* a_re; const float* a_im; const float* log_dt; const float* b_re; const float* b_im;
  const float* c_re; const float* c_im; const float* d_skip; const float* w_glu; const float* b_glu;
  const float* w_up_attn; const float* w_up_ssm; const float* w_out; const float* w_router;
  const float* router_bias; const float* w_gate; const float* w_up; const float* w_down;
  const float* ws_gate; const float* ws_up; const float* ws_down;
  float* out;
  unsigned* bar;
  float* mod;
  float* cbias;
  unsigned short* h;
  unsigned short* qb;
  unsigned short* kvb;
  unsigned short* cmpb;
  float* gn;
  float* u;
  float* ga;
  float* gs;
  float* hidk;
  float* hidv;
  float* onsa;
  float* pw;
  float* bbar;
  float* w1s;
  float* kd;
  float* wy;
  float* lbuf;
  float* hbuf;
  unsigned short* z;
  float* yssm;
  float* merged;
  float* xmid;
  float* scores;
  int* eidx;
  float* ew;
  int* cnt;
  int* cursor;
  int* off;
  int* rts;
  int* stok;
  float* sw;
  unsigned short* hs;
  unsigned short* hr;
  unsigned short* yk;
  int* apos;
};

__device__ __forceinline__ float wsum(float v) {
#pragma unroll
  for (int o = 32; o > 0; o >>= 1) v += __shfl_xor(v, o);
  return v;
}
__device__ __forceinline__ float wmax(float v) {
#pragma unroll
  for (int o = 32; o > 0; o >>= 1) v = fmaxf(v, __shfl_xor(v, o));
  return v;
}
#define WSYNC() do { __builtin_amdgcn_fence(__ATOMIC_ACQ_REL, "wavefront"); __builtin_amdgcn_wave_barrier(); } while (0)
__device__ __forceinline__ float sigmoidf_(float x) { return 1.0f / (1.0f + expf(-x)); }
__device__ __forceinline__ float siluf_(float x) { return x / (1.0f + expf(-x)); }
__device__ __forceinline__ float geluf_(float x) {
  return 0.5f * x * (1.0f + tanhf(0.7978845608028654f * (x + 0.044715f * x * x * x)));
}

#define OPAQUE(x) asm volatile("" : "+v"(x))
typedef short bf16x8 __attribute__((ext_vector_type(8)));
typedef float f32x4 __attribute__((ext_vector_type(4)));
typedef unsigned u32x4 __attribute__((ext_vector_type(4)));
#define LAS __attribute__((address_space(3)))

__device__ __forceinline__ unsigned cvt_pk_bf16(float lo, float hi) {
  unsigned r;
  asm("v_cvt_pk_bf16_f32 %0, %1, %2" : "=v"(r) : "v"(lo), "v"(hi));
  return r;
}
__device__ __forceinline__ int lds_byte(int r, int c) {
  const int st = (r >> 4) * 2 + (c >> 5), rr = r & 15, cc = c & 31, ob = rr * 64 + cc * 2;
  return st * 1024 + (ob ^ (((ob >> 9) & 1) << 5));
}

template <bool ABF, class AF, class BF, class EPW>
__device__ __forceinline__ void gemm128(int K, AF arow, BF bcol, size_t ldb, EPW epiw, LAS unsigned char* lds) {
  int t = threadIdx.x;
  OPAQUE(t);
  const int wid = t >> 6, lane = t & 63, wr = wid >> 1, wc = wid & 1, fr = lane & 15, fq = lane >> 4;
  LAS unsigned char* ldsA = lds;
  LAS unsigned char* ldsB = lds + 16384;
  const int ar0 = t >> 3, ac = (t & 7) * 8;
  const int n4 = t & 31, kg = t >> 5;
  const float* bp = bcol(n4 * 4);
  f32x4 acc[4][4];
#pragma unroll
  for (int m = 0; m < 4; ++m)
#pragma unroll
    for (int n = 0; n < 4; ++n) acc[m][n] = (f32x4){0.f, 0.f, 0.f, 0.f};
  f32x4 ra[4][ABF ? 1 : 2], rb[8];
  auto gload = [&](int k0) {
#pragma unroll
    for (int i = 0; i < 4; ++i) {
      const void* pa = arow(ar0 + 32 * i, k0 + ac);
      if (ABF) {
        if (pa) ra[i][0] = *(const f32x4*)pa; else ra[i][0] = (f32x4){0.f, 0.f, 0.f, 0.f};
      } else {
        if (pa) { ra[i][0] = *(const f32x4*)pa; ra[i][ABF ? 0 : 1] = *((const f32x4*)pa + 1); }
        else { ra[i][0] = (f32x4){0.f, 0.f, 0.f, 0.f}; ra[i][ABF ? 0 : 1] = (f32x4){0.f, 0.f, 0.f, 0.f}; }
      }
    }
#pragma unroll
    for (int j = 0; j < 8; ++j) {
      if (bp) rb[j] = *(const f32x4*)(bp + (size_t)(k0 + kg * 8 + j) * ldb);
      else rb[j] = (f32x4){0.f, 0.f, 0.f, 0.f};
    }
  };
  gload(0);
  const int aoff = lds_byte(wr * 64 + fr, fq * 8), boff = lds_byte(wc * 64 + fr, fq * 8);
  const int nk = K >> 6;
  for (int kt = 0; kt < nk; ++kt) {
#pragma unroll
    for (int i = 0; i < 4; ++i) {
      if (ABF) {
        *(LAS f32x4*)(ldsA + lds_byte(ar0 + 32 * i, ac)) = ra[i][0];
      } else {
        u32x4 w;
        w.x = cvt_pk_bf16(ra[i][0][0], ra[i][0][1]); w.y = cvt_pk_bf16(ra[i][0][2], ra[i][0][3]);
        w.z = cvt_pk_bf16(ra[i][ABF ? 0 : 1][0], ra[i][ABF ? 0 : 1][1]); w.w = cvt_pk_bf16(ra[i][ABF ? 0 : 1][2], ra[i][ABF ? 0 : 1][3]);
        *(LAS u32x4*)(ldsA + lds_byte(ar0 + 32 * i, ac)) = w;
      }
    }
#pragma unroll
    for (int c = 0; c < 4; ++c) {
      u32x4 w;
      w.x = cvt_pk_bf16(rb[0][c], rb[1][c]); w.y = cvt_pk_bf16(rb[2][c], rb[3][c]);
      w.z = cvt_pk_bf16(rb[4][c], rb[5][c]); w.w = cvt_pk_bf16(rb[6][c], rb[7][c]);
      *(LAS u32x4*)(ldsB + lds_byte(n4 * 4 + c, kg * 8)) = w;
    }
    __syncthreads();
    if (kt + 1 < nk) gload((kt + 1) * 64);
#pragma unroll
    for (int ks = 0; ks < 2; ++ks) {
      bf16x8 af[4], bf[4];
#pragma unroll
      for (int m = 0; m < 4; ++m) af[m] = *(const LAS bf16x8*)(ldsA + aoff + m * 2048 + ks * 1024);
#pragma unroll
      for (int n = 0; n < 4; ++n) bf[n] = *(const LAS bf16x8*)(ldsB + boff + n * 2048 + ks * 1024);
#pragma unroll
      for (int m = 0; m < 4; ++m)
#pragma unroll
        for (int n = 0; n < 4; ++n)
          acc[m][n] = __builtin_amdgcn_mfma_f32_16x16x32_bf16(bf[n], af[m], acc[m][n], 0, 0, 0);
    }
    __syncthreads();
  }
  epiw(acc, wr, wc, fr, fq);
}

template <bool ABF, class AL, class BL, class EP>
__device__ __forceinline__ void gemm_phase(int M, int N, int K, AL al, BL bl, size_t ldb, EP ep, LAS unsigned char* lds) {
  const int tn = (N + 127) / 128, tm = (M + 127) / 128;
  for (int tile = blockIdx.x; tile < tm * tn; tile += gridDim.x) {
    const int m0 = (tile / tn) * 128, n0 = (tile % tn) * 128;
    gemm128<ABF>(
        K, [&](int r, int k) -> const void* { return (m0 + r < M) ? (const void*)al(m0 + r, k) : nullptr; },
        [&](int c) -> const float* { return (n0 + c < N) ? bl(n0 + c) : nullptr; }, ldb,
        [&](const f32x4 (&acc)[4][4], int wr, int wc, int fr, int fq) {
#pragma unroll
          for (int m = 0; m < 4; ++m)
#pragma unroll
            for (int n = 0; n < 4; ++n) {
              const int r = m0 + wr * 64 + m * 16 + fr, c = n0 + wc * 64 + n * 16 + 4 * fq;
              if (r < M && c < N) ep(r, c, acc[m][n]);
            }
        },
        lds);
  }
}

__device__ __forceinline__ int find_expert(const int* rts, int rt) {
  int lo = 0, hi = NE;
  while (hi - lo > 1) {
    const int mid = (lo + hi) >> 1;
    if (rts[mid] <= rt) lo = mid; else hi = mid;
  }
  return lo;
}


typedef short s16x4 __attribute__((ext_vector_type(4)));
#define REDERIVE() do { OPAQUE(t); w = t >> 6; lane = t & 63; fr = lane & 15; fq = lane >> 4; rloc = w * 16 + fr; } while (0)
constexpr int VROW = 160;

__device__ __forceinline__ bf16x8 pack8(const f32x4 a, const f32x4 b) {
  u32x4 w;
  w.x = cvt_pk_bf16(a[0], a[1]); w.y = cvt_pk_bf16(a[2], a[3]);
  w.z = cvt_pk_bf16(b[0], b[1]); w.w = cvt_pk_bf16(b[2], b[3]);
  return __builtin_bit_cast(bf16x8, w);
}
__device__ __forceinline__ void tile_fetch(bf16x8 (&r)[2], const unsigned short* base, int t) {
  const bf16x8* q = (const bf16x8*)(base + t * 16);
  r[0] = q[0];
  r[1] = q[1];
}
__device__ __forceinline__ void stage_k(const bf16x8 (&r)[2], LAS unsigned char* ldsK, int t) {
  const int row = t >> 2, c0 = (t & 3) * 16;
  *(LAS bf16x8*)(ldsK + lds_byte(row, c0)) = r[0];
  *(LAS bf16x8*)(ldsK + lds_byte(row, c0 + 8)) = r[1];
}
__device__ __forceinline__ void stage_v(const bf16x8 (&r)[2], LAS unsigned char* ldsV, int t) {
  const int row = t >> 2, c0 = (t & 3) * 16;
  *(LAS bf16x8*)(ldsV + row * VROW + c0 * 2) = r[0];
  *(LAS bf16x8*)(ldsV + row * VROW + c0 * 2 + 16) = r[1];
}
template <int H>
__device__ __forceinline__ void attn_qk_h(f32x4 (&s)[4][2], const bf16x8 (&qf)[4][2], LAS unsigned char* ldsK, int fr, int fq) {
  const int koff = lds_byte(fr, fq * 8);
#pragma unroll
  for (int m = 0; m < 4; ++m)
#pragma unroll
    for (int nn = 0; nn < 2; ++nn) s[m][nn] = (f32x4){0.f, 0.f, 0.f, 0.f};
#pragma unroll
  for (int nn = 0; nn < 2; ++nn)
#pragma unroll
    for (int ks = 0; ks < 2; ++ks) {
      const bf16x8 kf = *(const LAS bf16x8*)(ldsK + koff + (2 * H + nn) * 2048 + ks * 1024);
#pragma unroll
      for (int m = 0; m < 4; ++m) s[m][nn] = __builtin_amdgcn_mfma_f32_16x16x32_bf16(kf, qf[m][ks], s[m][nn], 0, 0, 0);
    }
}
template <int H>
__device__ __forceinline__ void attn_pv_h(f32x4 (&o)[4][4], const bf16x8 (&pf)[4], LAS unsigned char* ldsV, int lane) {
  const int fq = lane >> 4, i = lane & 15;
  const int vbase = (4 * fq + (i >> 2)) * VROW + (i & 3) * 8;
#pragma unroll
  for (int dt = 0; dt < 4; ++dt) {
    LAS unsigned char* a0 = ldsV + vbase + H * 32 * VROW + dt * 32;
    const s16x4 v0 = __builtin_amdgcn_ds_read_tr16_b64_v4i16((LAS s16x4*)a0);
    const s16x4 v1 = __builtin_amdgcn_ds_read_tr16_b64_v4i16((LAS s16x4*)(a0 + 16 * VROW));
    bf16x8 vf;
    vf[0] = v0[0]; vf[1] = v0[1]; vf[2] = v0[2]; vf[3] = v0[3];
    vf[4] = v1[0]; vf[5] = v1[1]; vf[6] = v1[2]; vf[7] = v1[3];
#pragma unroll
    for (int m = 0; m < 4; ++m) o[m][dt] = __builtin_amdgcn_mfma_f32_16x16x32_bf16(vf, pf[m], o[m][dt], 0, 0, 0);
  }
}
template <int H, bool EM>
__device__ __forceinline__ void attn_softmax_h(f32x4 (&s)[4][2], f32x4 (&o)[4][4], float (&mrow)[4], float (&lrow)[4],
                                               bf16x8 (&pf)[4], bool rowok, int lo, int hi, int fq) {
#pragma unroll
  for (int m = 0; m < 4; ++m) {
    float mx = -INFINITY;
#pragma unroll
    for (int nn = 0; nn < 2; ++nn)
#pragma unroll
      for (int jj = 0; jj < 4; ++jj) {
        constexpr int dummy2 = 0; (void)dummy2;
        const int kc = 16 * (2 * H + nn) + jj;
        const bool ok = rowok && (!EM || (lo < kc && hi >= kc));
        const float v = ok ? s[m][nn][jj] : -INFINITY;
        s[m][nn][jj] = v;
        mx = fmaxf(mx, v);
      }
    mx = fmaxf(mx, __shfl_xor(mx, 16));
    mx = fmaxf(mx, __shfl_xor(mx, 32));
    const float mnew = fmaxf(mrow[m], mx);
    const float msafe = (mnew == -INFINITY) ? 0.f : mnew;
    const float alpha = __builtin_amdgcn_exp2f(mrow[m] - msafe);
    mrow[m] = mnew;
    float ls = 0.f;
#pragma unroll
    for (int nn = 0; nn < 2; ++nn)
#pragma unroll
      for (int jj = 0; jj < 4; ++jj) {
        const float pv = __builtin_amdgcn_exp2f(s[m][nn][jj] - msafe);
        s[m][nn][jj] = pv;
        ls += pv;
      }
    lrow[m] = lrow[m] * alpha + ls;
#pragma unroll
    for (int dt = 0; dt < 4; ++dt) o[m][dt] = o[m][dt] * alpha;
    pf[m] = pack8(s[m][0], s[m][1]);
  }
}
template <int H, bool EM>
__device__ __forceinline__ void attn_sub(f32x4 (&o)[4][4], float (&mrow)[4], float (&lrow)[4], const bf16x8 (&qf)[4][2],
                                         LAS unsigned char* ldsK, LAS unsigned char* ldsV, bool rowok, int lo, int hi, int lane) {
  f32x4 s[4][2];
  bf16x8 pf[4];
  __builtin_amdgcn_sched_barrier(0);
  attn_qk_h<H>(s, qf, ldsK, lane & 15, lane >> 4);
  __builtin_amdgcn_sched_barrier(0);
  attn_softmax_h<H, EM>(s, o, mrow, lrow, pf, rowok, lo, hi, lane >> 4);
  __builtin_amdgcn_sched_barrier(0);
  attn_pv_h<H>(o, pf, ldsV, lane);
  __builtin_amdgcn_sched_barrier(0);
}
template <bool EM>
__device__ __forceinline__ void attn_tile(f32x4 (&o)[4][4], float (&mrow)[4], float (&lrow)[4], const bf16x8 (&qf)[4][2],
                                          LAS unsigned char* ldsK, LAS unsigned char* ldsV, bool rowok, int lo, int hi, int lane) {
  attn_sub<0, EM>(o, mrow, lrow, qf, ldsK, ldsV, rowok, lo, hi, lane);
  attn_sub<1, EM>(o, mrow, lrow, qf, ldsK, ldsV, rowok, lo, hi, lane);
}
template <int H>
__device__ __forceinline__ void cmp_stats(float (&mrow)[4], float (&lrow)[4], const bf16x8 (&qf)[4][2], LAS unsigned char* ldsK, int hi, int lane) {
  const int fq = lane >> 4;
  f32x4 s[4][2];
  __builtin_amdgcn_sched_barrier(0);
  attn_qk_h<H>(s, qf, ldsK, lane & 15, fq);
  __builtin_amdgcn_sched_barrier(0);
#pragma unroll
  for (int m = 0; m < 4; ++m) {
    float mx = -INFINITY;
#pragma unroll
    for (int nn = 0; nn < 2; ++nn)
#pragma unroll
      for (int jj = 0; jj < 4; ++jj) {
        const int kc = 16 * (2 * H + nn) + jj;
        const float v = (hi >= kc) ? s[m][nn][jj] : -INFINITY;
        s[m][nn][jj] = v;
        mx = fmaxf(mx, v);
      }
    mx = fmaxf(mx, __shfl_xor(mx, 16));
    mx = fmaxf(mx, __shfl_xor(mx, 32));
    const float mnew = fmaxf(mrow[m], mx);
    const float msafe = (mnew == -INFINITY) ? 0.f : mnew;
    float ls = 0.f;
#pragma unroll
    for (int nn = 0; nn < 2; ++nn)
#pragma unroll
      for (int jj = 0; jj < 4; ++jj) ls += __builtin_amdgcn_exp2f(s[m][nn][jj] - msafe);
    lrow[m] = lrow[m] * __builtin_amdgcn_exp2f(mrow[m] - msafe) + ls;
    mrow[m] = mnew;
  }
  __builtin_amdgcn_sched_barrier(0);
}
template <int H>
__device__ __forceinline__ void cmp_apply(f32x4 (&o)[4][4], const float (&msf)[4], const float (&linv)[4], float& lastprev, LAS float* improw,
                                          const bf16x8 (&qf)[4][2], LAS unsigned char* ldsK, LAS unsigned char* ldsV, int hi, int lane) {
  const int fq = lane >> 4;
  f32x4 s[4][2];
  bf16x8 pf[4];
  __builtin_amdgcn_sched_barrier(0);
  attn_qk_h<H>(s, qf, ldsK, lane & 15, fq);
  __builtin_amdgcn_sched_barrier(0);
#pragma unroll
  for (int m = 0; m < 4; ++m) {
#pragma unroll
    for (int nn = 0; nn < 2; ++nn)
#pragma unroll
      for (int jj = 0; jj < 4; ++jj) {
        const int kc = 16 * (2 * H + nn) + jj;
        s[m][nn][jj] = (hi >= kc) ? __builtin_amdgcn_exp2f(s[m][nn][jj] - msf[m]) * linv[m] : 0.f;
      }
    pf[m] = pack8(s[m][0], s[m][1]);
  }
#pragma unroll
  for (int nn = 0; nn < 2; ++nn) {
    float gs = 0.f, last = 0.f;
#pragma unroll
    for (int m = 0; m < 4; ++m) {
      gs += (s[m][nn][0] + s[m][nn][1]) + (s[m][nn][2] + s[m][nn][3]);
      last += s[m][nn][3];
    }
    const float pa = __shfl(last, (lane + 48) & 63);
    const float pb = __shfl(lastprev, (lane + 48) & 63);
    improw[(2 * H + nn) * 4 + fq] = gs + ((fq > 0) ? pa : pb);
    lastprev = last;
  }
  __builtin_amdgcn_sched_barrier(0);
  attn_pv_h<H>(o, pf, ldsV, lane);
  __builtin_amdgcn_sched_barrier(0);
}

__device__ __forceinline__ void attn_chunk(const Params& p, LAS unsigned char* lds, int b, int g, int ci) {
  int t = threadIdx.x;
  OPAQUE(t);
  int w = t >> 6, lane = t & 63, fr = lane & 15, fq = lane >> 4;
  LAS unsigned char* ldsK = lds;
  LAS unsigned char* ldsV = lds + 8192;
  LAS float* impb = (LAS float*)(lds + 18432) + w * 1024;
  LAS unsigned* unib = (LAS unsigned*)(lds + 18432 + 16384);
  int rloc = w * 16 + fr;
  const int tq = ci * 64 + rloc;
  const size_t tok = (size_t)b * S + tq;
  const float* grow = p.gn + tok * 24 + g * 12;
  float* orow = p.onsa + tok * 512 + g * 256;
  bf16x8 qf[4][2];
#pragma unroll
  for (int m = 0; m < 4; ++m)
#pragma unroll
    for (int ks = 0; ks < 2; ++ks)
      qf[m][ks] = *(const bf16x8*)(p.qb + tok * 512 + (g * 4 + m) * 64 + ks * 32 + fq * 8);
  f32x4 o[4][4];
  float mrow[4], lrow[4];
  bf16x8 rk[2], rv[2];

  const int nvis = (tq >= 31) ? ((tq - 31) / 16 + 1) : 0;
  const int nvmax = 4 * ci + 3;
  const int ntc = (nvmax + 63) >> 6;
  const unsigned short* kcb = p.cmpb + (size_t)((0 * NB + b) * 2 + g) * 256 * 64;
  const unsigned short* vcb = p.cmpb + (size_t)((1 * NB + b) * 2 + g) * 256 * 64;
#pragma unroll
  for (int m = 0; m < 4; ++m) { mrow[m] = -INFINITY; lrow[m] = 0.f; }
  REDERIVE();
  for (int tc = 0; tc < ntc; ++tc) {
    tile_fetch(rk, kcb + (size_t)tc * 4096, t);
    stage_k(rk, ldsK, t);
    __syncthreads();
    const int hi = nvis - 1 - tc * 64 - 4 * fq;
    cmp_stats<0>(mrow, lrow, qf, ldsK, hi, lane);
    cmp_stats<1>(mrow, lrow, qf, ldsK, hi, lane);
    __syncthreads();
  }
  {
    float linv[4], msf[4];
#pragma unroll
    for (int m = 0; m < 4; ++m) {
      float l = lrow[m];
      l += __shfl_xor(l, 16);
      l += __shfl_xor(l, 32);
      linv[m] = (l > 0.f) ? 1.0f / l : 0.f;
      msf[m] = (mrow[m] == -INFINITY) ? 0.f : mrow[m];
    }
    REDERIVE();
#pragma unroll
    for (int m = 0; m < 4; ++m)
#pragma unroll
      for (int dt = 0; dt < 4; ++dt) o[m][dt] = (f32x4){0.f, 0.f, 0.f, 0.f};
    float lastprev = 0.f;
    for (int tc = 0; tc < ntc; ++tc) {
      tile_fetch(rk, kcb + (size_t)tc * 4096, t);
      tile_fetch(rv, vcb + (size_t)tc * 4096, t);
      stage_k(rk, ldsK, t);
      stage_v(rv, ldsV, t);
      __syncthreads();
      const int hi = nvis - 1 - tc * 64 - 4 * fq;
      cmp_apply<0>(o, msf, linv, lastprev, impb + fr * 64 + tc * 16, qf, ldsK, ldsV, hi, lane);
      cmp_apply<1>(o, msf, linv, lastprev, impb + fr * 64 + tc * 16, qf, ldsK, ldsV, hi, lane);
      __syncthreads();
    }
  }
#pragma unroll
  for (int m = 0; m < 4; ++m) {
    const float gate = grow[m * 3 + 0];
#pragma unroll
    for (int dt = 0; dt < 4; ++dt) *(f32x4*)(orow + m * 64 + dt * 16 + 4 * fq) = o[m][dt] * gate;
  }
  unsigned mlo, mhi;
  REDERIVE();
  {
    WSYNC();
    float kv[16];
    const int c0 = -fq * 16, c1 = ci - fq * 16;
#pragma unroll
    for (int i = 0; i < 16; ++i) {
      const bool forced = (c0 == i) || (c1 == i) || (c1 == i + 1);
      float v = (c1 >= i) ? impb[fr * 64 + fq * 16 + i] : -INFINITY;
      if (forced) v = INFINITY;
      kv[i] = v;
    }
    WSYNC();
#pragma unroll
    for (int i = 0; i < 16; ++i) impb[fr * 64 + fq * 16 + i] = kv[i];
    WSYNC();
    int rank[16];
#pragma unroll
    for (int i = 0; i < 16; ++i) rank[i] = 0;
#pragma unroll 2
    for (int k = 0; k < 64; ++k) {
      const float ok = impb[fr * 64 + k];
      const int kq = k - fq * 16;
#pragma unroll
      for (int i = 0; i < 16; ++i) rank[i] += (ok > kv[i] || (ok == kv[i] && kq < i)) ? 1 : 0;
    }
    unsigned piece = 0;
#pragma unroll
    for (int i = 0; i < 16; ++i) piece |= (rank[i] < 16) ? (1u << i) : 0u;
    unsigned lo32 = (fq == 0) ? piece : (fq == 1) ? (piece << 16) : 0u;
    unsigned hi32 = (fq == 2) ? piece : (fq == 3) ? (piece << 16) : 0u;
    lo32 |= __shfl_xor(lo32, 16); lo32 |= __shfl_xor(lo32, 32);
    hi32 |= __shfl_xor(hi32, 16); hi32 |= __shfl_xor(hi32, 32);
    mlo = lo32; mhi = hi32;
    unsigned ulo = lo32, uhi = hi32;
#pragma unroll
    for (int off = 1; off < 16; off <<= 1) { ulo |= __shfl_xor(ulo, off); uhi |= __shfl_xor(uhi, off); }
    if (lane == 0) { unib[w * 2] = ulo; unib[w * 2 + 1] = uhi; }
    __syncthreads();
  }
  unsigned long long un;
  {
    const unsigned ulo = unib[0] | unib[2] | unib[4] | unib[6];
    const unsigned uhi = unib[1] | unib[3] | unib[5] | unib[7];
    un = ((unsigned long long)__builtin_amdgcn_readfirstlane(uhi) << 32) | (unsigned long long)__builtin_amdgcn_readfirstlane(ulo);
  }
  const unsigned long long rowmask = ((unsigned long long)mhi << 32) | mlo;

#pragma unroll 1
  for (int pass = 0; pass < 2; ++pass) {
    REDERIVE();
#pragma unroll
    for (int m = 0; m < 4; ++m) {
      mrow[m] = -INFINITY; lrow[m] = 0.f;
#pragma unroll
      for (int dt = 0; dt < 4; ++dt) o[m][dt] = (f32x4){0.f, 0.f, 0.f, 0.f};
    }
    const unsigned short* kb = p.kvb + (size_t)(((2 + 2 * pass) * NB + b) * 2 + g) * S * 64;
    const unsigned short* vb = p.kvb + (size_t)(((3 + 2 * pass) * NB + b) * 2 + g) * S * 64;
    const unsigned long long upto = (ci == 63) ? ~0ull : ((1ull << (ci + 1)) - 1ull);
    const int jlo = max(0, ci - 8);
    unsigned long long rem = pass ? (upto & ~((1ull << jlo) - 1ull)) : (un & upto);
    const int jwin0 = pass ? ci - 8 : -100;
    int j = __ffsll((long long)rem) - 1;
    tile_fetch(rk, kb + (size_t)j * 4096, t);
    tile_fetch(rv, vb + (size_t)j * 4096, t);
    while (rem) {
      rem &= rem - 1;
      stage_k(rk, ldsK, t);
      stage_v(rv, ldsV, t);
      __syncthreads();
      const int jn = rem ? (__ffsll((long long)rem) - 1) : -1;
      if (jn >= 0) {
        tile_fetch(rk, kb + (size_t)jn * 4096, t);
        tile_fetch(rv, vb + (size_t)jn * 4096, t);
      }
      const bool rowok = pass ? true : (bool)((rowmask >> j) & 1ull);
      int hi = (j == ci) ? rloc : 63;
      const int lo = ((j == jwin0) ? rloc : -1) - 4 * fq;
      hi = (rowok ? hi : -1000) - 4 * fq;
      attn_tile<true>(o, mrow, lrow, qf, ldsK, ldsV, true, lo, hi, lane);
      __syncthreads();
      j = jn;
    }
#pragma unroll
    for (int m = 0; m < 4; ++m) {
      float l = lrow[m];
      l += __shfl_xor(l, 16);
      l += __shfl_xor(l, 32);
      const float sc = grow[m * 3 + 1 + pass] / l;
#pragma unroll
      for (int dt = 0; dt < 4; ++dt) {
        f32x4* dst = (f32x4*)(orow + m * 64 + dt * 16 + 4 * fq);
        *dst = *dst + o[m][dt] * sc;
      }
    }
  }
}

#define XB_TMO      128
#define XB_XCNT(j)  (256  + 64 * (j))
#define XB_XSUB(j)  (1280 + 64 * (j))
#define XB_XGEN(j)  (2304 + 64 * (j))
#define XB_TOP      3328
#define XB_TOPGEN   3392
#define XCD_BAR_WORDS 3456
#define XB_SPIN_CAP (1u << 18)

__device__ __forceinline__ unsigned xb_ld(unsigned* p)              { return __hip_atomic_load(p, __ATOMIC_RELAXED, __HIP_MEMORY_SCOPE_AGENT); }
__device__ __forceinline__ unsigned xb_add(unsigned* p, unsigned v) { return __hip_atomic_fetch_add(p, v, __ATOMIC_RELAXED, __HIP_MEMORY_SCOPE_AGENT); }
__device__ __forceinline__ unsigned xb_xcc_id() { return (unsigned)__builtin_amdgcn_s_getreg((3 << 11) | 20) & 0xFu; }
#define XB_SPIN(cond, bar) do { unsigned _sp = 0; while (cond) { __builtin_amdgcn_s_sleep(1); \
    if ((++_sp & 255u) == 0u) { if (xb_ld(&(bar)[XB_TMO])) break; if (_sp > XB_SPIN_CAP) { atomicAdd(&(bar)[XB_TMO], 1u); break; } } } } while (0)

struct XcdBarrier {
    unsigned* bar; unsigned x;
    volatile LAS unsigned* st;
};

__device__ __forceinline__ XcdBarrier xcd_barrier_post(unsigned* bar, volatile LAS unsigned* st) {
    XcdBarrier b; b.bar = bar; b.x = xb_xcc_id(); b.st = st;
    if (threadIdx.x == 0) (void)xb_add(&bar[XB_XCNT(b.x)], 1u);
    return b;
}
__device__ __forceinline__ void xcd_barrier_complete(unsigned* bar, unsigned x, unsigned& nloc, unsigned& nx) {
    const unsigned G = gridDim.x * gridDim.y * gridDim.z;
    unsigned sum, cnt, mine, sp = 0u;
    for (;;) {
        sum = 0u; cnt = 0u; mine = 0u;
#pragma unroll
        for (unsigned j = 0; j < 16; ++j) { const unsigned c = xb_ld(&bar[XB_XCNT(j)]); sum += c; cnt += (c > 0u) ? 1u : 0u; mine = (j == x) ? c : mine; }
        if (sum == G) break;
        __builtin_amdgcn_s_sleep(1);
        if ((++sp & 255u) == 0u) { if (xb_ld(&bar[XB_TMO])) break; if (sp > XB_SPIN_CAP) { atomicAdd(&bar[XB_TMO], 1u); break; } }
    }
    nloc = mine > 0u ? mine : 1u; nx = cnt > 0u ? cnt : 1u;
}

__device__ __forceinline__ void xcd_barrier(const XcdBarrier& b) {
    asm volatile("s_waitcnt vmcnt(0)" ::: "memory");
    __syncthreads();
    if (threadIdx.x == 0) {
        unsigned* bar = b.bar;
        __builtin_amdgcn_s_waitcnt(0);
        unsigned nloc = b.st[0], nx = b.st[1];
        if (nloc == 0u) { xcd_barrier_complete(bar, b.x, nloc, nx); b.st[0] = nloc; b.st[1] = nx; }
        const unsigned old = xb_add(&bar[XB_XSUB(b.x)], 1u);
        const unsigned gen = old / nloc;
        if (old + 1u == (gen + 1u) * nloc) {
            __builtin_amdgcn_fence(__ATOMIC_RELEASE, "agent");
            asm volatile("s_waitcnt vmcnt(0)" ::: "memory");
            const unsigned og = xb_add(&bar[XB_TOP], 1u);
            const unsigned tg = og / nx;
            if (og + 1u == (tg + 1u) * nx) xb_add(&bar[XB_TOPGEN], 1u);
            else XB_SPIN(xb_ld(&bar[XB_TOPGEN]) == tg, bar);
            __builtin_amdgcn_fence(__ATOMIC_ACQUIRE, "agent");
            xb_add(&bar[XB_XGEN(b.x)], 1u);
            asm volatile("s_waitcnt vmcnt(0)" ::: "memory");
        } else {
            XB_SPIN(xb_ld(&bar[XB_XGEN(b.x)]) == gen, bar);
            __builtin_amdgcn_fence(__ATOMIC_ACQUIRE, "agent");
            asm volatile("s_waitcnt vmcnt(0)" ::: "memory");
        }
    }
    __syncthreads();
}


#define PHASE_IDX int t_ = threadIdx.x; OPAQUE(t_); const int tid = t_, lane = t_ & 63, wib = t_ >> 6; \
  const int gthreads = gridDim.x * 256, gtid = blockIdx.x * 256 + t_, gwaves = gridDim.x * 4, gwave = blockIdx.x * 4 + wib; \
  (void)tid; (void)lane; (void)wib; (void)gthreads; (void)gtid; (void)gwaves; (void)gwave;
constexpr int SMEM_FLOATS = 10240;

__global__ void __launch_bounds__(256, 2) mega(Params p) {
  __shared__ __attribute__((aligned(16))) float smem[SMEM_FLOATS];
  LAS unsigned char* lds = (LAS unsigned char*)smem;
  __shared__ __attribute__((aligned(16))) unsigned xb_st[4];
  if (threadIdx.x < 4) xb_st[threadIdx.x] = 0u;
  __syncthreads();
  const XcdBarrier gbar = xcd_barrier_post(p.bar, (volatile LAS unsigned*)xb_st);

  {
  PHASE_IDX
  {
    for (int i = tid; i < NB * D; i += 256) smem[i] = siluf_(p.c[i]);
    __syncthreads();
    for (int idx = gtid; idx < NB * 6 * D; idx += gthreads) {
      const int b = idx / (6 * D), j = idx % (6 * D);
      float acc = p.b_ada[j];
      const float* sc = smem + b * D;
      for (int k = 0; k < D; ++k) acc = fmaf(sc[k], p.w_ada[(size_t)k * (6 * D) + j], acc);
      p.mod[idx] = acc;
    }
    for (int idx = gtid; idx < 32 * 64; idx += gthreads) {
      const int g = idx / 64;
      const double dt = exp((double)p.log_dt[g]);
      const double lr = p.a_re[idx], li = p.a_im[idx];
      double br = 1.0, bi = 0.0;
      for (int d = 0; d <= 16; ++d) {
        const double mag = exp(lr * dt * d);
        const double pr_ = mag * cos(li * dt * d), pi_ = mag * sin(li * dt * d);
        p.pw[(idx * 17 + d) * 2] = (float)pr_;
        p.pw[(idx * 17 + d) * 2 + 1] = (float)pi_;
        if (d == 1) { br = pr_; bi = pi_; }
      }
      const double nr = br - 1.0, ni = bi;
      const double den = lr * lr + li * li;
      const double cr = (nr * lr + ni * li) / den, ci = (ni * lr - nr * li) / den;
      for (int q = 0; q < 16; ++q) {
        const double wr = p.b_re[idx * 16 + q], wi = p.b_im[idx * 16 + q];
        p.bbar[(idx * 16 + q) * 2] = (float)(cr * wr - ci * wi);
        p.bbar[(idx * 16 + q) * 2 + 1] = (float)(cr * wi + ci * wr);
      }
    }
    for (int idx = gtid; idx < NE; idx += gthreads) { p.cnt[idx] = 0; p.cursor[idx] = 0; }
    for (int idx = gtid; idx < 512; idx += gthreads) {
      const int kv = idx >> 8, j = idx & 255;
      const float* pe = kv ? p.pe_v : p.pe_k;
      const float* w1 = kv ? p.w_cmp_v1 : p.w_cmp_k1;
      float acc = 0.f;
      for (int k = 0; k < 2048; ++k) acc = fmaf(pe[k], w1[(size_t)k * 256 + j], acc);
      p.cbias[idx] = acc;
    }
  }
  }
  xcd_barrier(gbar);

  {
  PHASE_IDX
  for (int row = gwave; row < NT; row += gwaves) {
    const int b = row / S;
    const float* xr = p.x + (size_t)row * D;
    f32x4 v[4];
    float ss = 0.f;
#pragma unroll
    for (int i = 0; i < 4; ++i) {
      v[i] = *(const f32x4*)(xr + i * 256 + lane * 4);
      ss += (v[i][0] * v[i][0] + v[i][1] * v[i][1]) + (v[i][2] * v[i][2] + v[i][3] * v[i][3]);
    }
    ss = wsum(ss);
    const float r = rsqrtf(ss * (1.0f / D) + EPS);
    const float* md = p.mod + b * 6 * D;
#pragma unroll
    for (int i = 0; i < 4; ++i) {
      const int col = i * 256 + lane * 4;
      const f32x4 gg = *(const f32x4*)(p.g_norm1 + col), sc = *(const f32x4*)(md + D + col), sh = *(const f32x4*)(md + col);
      const f32x4 y = v[i] * r * gg * (sc + 1.0f) + sh;
      uint2 w;
      w.x = cvt_pk_bf16(y[0], y[1]); w.y = cvt_pk_bf16(y[2], y[3]);
      *(uint2*)(p.h + (size_t)row * D + col) = w;
    }
  }
  for (int idx = gtid; idx < 32 * 256 * 128; idx += gthreads) {
    const int col = idx & 127, k = (idx >> 7) & 255, g = idx >> 15;
    const int n = col >> 1, ri = col & 1, sidx = k >> 4, q = k & 15;
    const int gn = g * 64 + n;
    const float pr_ = p.pw[(gn * 17 + 15 - sidx) * 2], pi_ = p.pw[(gn * 17 + 15 - sidx) * 2 + 1];
    const float br = p.bbar[(gn * 16 + q) * 2], bi = p.bbar[(gn * 16 + q) * 2 + 1];
    p.w1s[idx] = ri ? (pr_ * bi + pi_ * br) : (pr_ * br - pi_ * bi);
  }
  for (int idx = gtid; idx < 32 * 16 * 256; idx += gthreads) {
    const int q = idx & 15, pp = (idx >> 4) & 15, d = (idx >> 8) & 15, g = idx >> 12;
    float acc = (d == 0 && pp == q) ? p.d_skip[g * 16 + pp] : 0.f;
    for (int n = 0; n < 64; ++n) {
      const int gn = g * 64 + n;
      const float cr = p.c_re[(g * 16 + pp) * 64 + n], ci = p.c_im[(g * 16 + pp) * 64 + n];
      const float pr_ = p.pw[(gn * 17 + d) * 2], pi_ = p.pw[(gn * 17 + d) * 2 + 1];
      const float br = p.bbar[(gn * 16 + q) * 2], bi = p.bbar[(gn * 16 + q) * 2 + 1];
      const float tr = cr * pr_ - ci * pi_, ti = cr * pi_ + ci * pr_;
      acc += tr * br - ti * bi;
    }
    p.kd[idx] = acc;
  }
  for (int idx = gtid; idx < 32 * 128 * 256; idx += gthreads) {
    const int col = idx & 255, k = (idx >> 8) & 127, g = idx >> 15;
    const int i = col >> 4, pp = col & 15, n = k >> 1, ri = k & 1;
    const int gn = g * 64 + n;
    const float cr = p.c_re[(g * 16 + pp) * 64 + n], ci = p.c_im[(g * 16 + pp) * 64 + n];
    const float pr_ = p.pw[(gn * 17 + i + 1) * 2], pi_ = p.pw[(gn * 17 + i + 1) * 2 + 1];
    p.wy[((size_t)g * 384 + k) * 256 + col] = ri ? -(cr * pi_ + ci * pr_) : (cr * pr_ - ci * pi_);
  }
  }
  xcd_barrier(gbar);

  {
  PHASE_IDX
  {
    constexpr int TN = (INC + 127) / 128;
    for (int tile = blockIdx.x; tile < (NT / 128) * TN; tile += gridDim.x) {
      const int m0 = (tile / TN) * 128, n0 = (tile % TN) * 128;
      gemm128<true>(
          D, [&](int r, int k) -> const void* { return p.h + (size_t)(m0 + r) * D + k; },
          [&](int c) -> const float* { return (n0 + c < INC) ? p.w_in + n0 + c : nullptr; }, INC,
          [&](const f32x4 (&acc)[4][4], int wr, int wc, int fr, int fq) {
            const int cw = n0 + wc * 64;
            if (cw < C_GN) {
              const bool isq = cw < C_KC;
              const int slot = isq ? 0 : (cw - C_KC) >> 7, gg = isq ? 0 : ((cw - C_KC) >> 6) & 1;
              const bool norm = isq || slot == 2 || slot == 4;
              const float* gain = isq ? p.q_gain : (slot == 2 ? p.ks_gain : p.kw_gain);
              const float post = isq ? ATT_SCALE * 1.4426950408889634f : 1.0f;
#pragma unroll
              for (int m = 0; m < 4; ++m) {
                const int tok = m0 + wr * 64 + m * 16 + fr;
                float r = 1.0f;
                if (norm) {
                  float ss = 0.f;
#pragma unroll
                  for (int n = 0; n < 4; ++n)
#pragma unroll
                    for (int jj = 0; jj < 4; ++jj) ss = fmaf(acc[m][n][jj], acc[m][n][jj], ss);
                  ss += __shfl_xor(ss, 16);
                  ss += __shfl_xor(ss, 32);
                  r = rsqrtf(ss * (1.0f / 64) + EPS) * post;
                }
                unsigned short* dst = isq ? p.qb + (size_t)tok * 512 + cw
                                          : p.kvb + ((size_t)((slot * NB + (tok >> 12)) * 2 + gg) * S + (tok & (S - 1))) * 64;
#pragma unroll
                for (int n = 0; n < 4; ++n) {
                  f32x4 v = acc[m][n] * r;
                  if (norm) v = v * *(const f32x4*)(gain + n * 16 + 4 * fq);
                  uint2 w;
                  w.x = cvt_pk_bf16(v[0], v[1]); w.y = cvt_pk_bf16(v[2], v[3]);
                  *(uint2*)(dst + n * 16 + 4 * fq) = w;
                }
              }
            } else {
#pragma unroll
              for (int m = 0; m < 4; ++m) {
                const size_t tok = m0 + wr * 64 + m * 16 + fr;
#pragma unroll
                for (int n = 0; n < 4; ++n) {
                  const int c = cw + n * 16 + 4 * fq;
                  if (c < INC) {
                    f32x4 v = acc[m][n];
                    if (c >= C_U && c < C_GA) {
                      *(f32x4*)(p.u + tok * 512 + (c - C_U)) = v;
                    } else {
#pragma unroll
                      for (int j = 0; j < 4; ++j) v[j] = sigmoidf_(v[j]);
                      float* dst = (c < C_U) ? p.gn + tok * 24 + (c - C_GN)
                                             : (c < C_GS) ? p.ga + tok * D + (c - C_GA) : p.gs + tok * D + (c - C_GS);
                      *(f32x4*)dst = v;
                    }
                  }
                }
              }
            }
          },
          lds);
    }
  }
  for (int idx = gtid; idx < 32 * 256 * 256; idx += gthreads) {
    const int col = idx & 255, k = (idx >> 8) & 255, g = idx >> 16;
    const int i = col >> 4, pp = col & 15, sidx = k >> 4, q = k & 15;
    p.wy[((size_t)g * 384 + 128 + k) * 256 + col] = (i >= sidx) ? p.kd[((g * 16 + (i - sidx)) * 16 + pp) * 16 + q] : 0.f;
  }
  }
  xcd_barrier(gbar);

  {
  PHASE_IDX
  for (int kv = 0; kv < 2; ++kv) {
    const float* w1 = kv ? p.w_cmp_v1 : p.w_cmp_k1;
    float* hid = kv ? p.hidv : p.hidk;
    const float* cb = p.cbias + kv * 256;
    gemm_phase<true>(
        NB * NCMP * 2, 256, 2048,
        [&](int r, int k) {
          const int b = r / (NCMP * 2), n = (r >> 1) % NCMP, g = r & 1;
          return p.kvb + ((size_t)((kv * NB + b) * 2 + g) * S + 16 * n) * 64 + k;
        },
        [&](int n) { return w1 + n; }, 256,
        [&](int r, int n, f32x4 v) {
#pragma unroll
          for (int j = 0; j < 4; ++j) v[j] = geluf_(v[j] + cb[n + j]);
          *(f32x4*)(hid + (size_t)r * 256 + n) = v;
        },
        lds);
  }
  for (int tile = blockIdx.x; tile < 32 * 8; tile += gridDim.x) {
    const int g = tile >> 3, m0 = (tile & 7) * 128;
    gemm128<false>(
        256, [&](int r, int k) -> const void* { return p.u + ((size_t)(m0 + r) * 16 + (k >> 4)) * 512 + g * 16 + (k & 15); },
        [&](int c) -> const float* { return p.w1s + (size_t)g * 256 * 128 + c; }, 128,
        [&](const f32x4 (&acc)[4][4], int wr, int wc, int fr, int fq) {
#pragma unroll
          for (int m = 0; m < 4; ++m)
#pragma unroll
            for (int n = 0; n < 4; ++n)
              *(f32x4*)(p.lbuf + ((size_t)g * 1024 + m0 + wr * 64 + m * 16 + fr) * 128 + wc * 64 + n * 16 + 4 * fq) = acc[m][n];
        },
        lds);
  }
  }
  xcd_barrier(gbar);

  {
  PHASE_IDX
  for (int wv = gwave; wv < 2 * NB * NCMP * 2; wv += gwaves) {
    const int kv = wv / (NB * NCMP * 2), r = wv % (NB * NCMP * 2);
    const int b = r / (NCMP * 2), n = (r >> 1) % NCMP, g = r & 1;
    const float* hid = (kv ? p.hidv : p.hidk) + (size_t)r * 256;
    const float* w2 = kv ? p.w_cmp_v2 : p.w_cmp_k2;
    float acc = 0.f;
    for (int j = 0; j < 256; ++j) acc = fmaf(hid[j], w2[j * 64 + lane], acc);
    if (kv == 0) {
      const float ss = wsum(acc * acc);
      acc = acc * rsqrtf(ss * (1.0f / 64) + EPS) * p.kc_gain[lane];
    }
    const float other = __shfl_xor(acc, 1);
    if ((lane & 1) == 0)
      *(unsigned*)(p.cmpb + ((size_t)((kv * NB + b) * 2 + g) * 256 + n) * 64 + lane) = cvt_pk_bf16(acc, other);
  }
  for (int idx = gtid; idx < 2 * NB * 2 * 32; idx += gthreads)
    *(unsigned*)(p.cmpb + ((size_t)(idx >> 5) * 256 + 255) * 64 + (idx & 31) * 2) = 0u;
  for (int idx = gtid; idx < 32 * NB * 64; idx += gthreads) {
    const int n = idx & 63, b = (idx >> 6) & 3, g = idx >> 8;
    const int gn = g * 64 + n;
    const float lr = p.pw[(gn * 17 + 16) * 2], li = p.pw[(gn * 17 + 16) * 2 + 1];
    float hr_ = 0.f, hi_ = 0.f;
    const size_t base = ((size_t)g * 1024 + b * 256) * 128 + n * 2;
#pragma unroll 8
    for (int c = 0; c < 256; ++c) {
      const float2 l2 = *(const float2*)(p.lbuf + base + (size_t)c * 128);
      *(float2*)(p.hbuf + base + (size_t)c * 128) = make_float2(hr_, hi_);
      const float nr = lr * hr_ - li * hi_ + l2.x;
      const float ni = lr * hi_ + li * hr_ + l2.y;
      hr_ = nr; hi_ = ni;
    }
  }
  }
  xcd_barrier(gbar);

  {
  PHASE_IDX
  const int G = gridDim.x;
  const bool split = G >= 512;
  if (!split || blockIdx.x < 256) {
    for (int u = blockIdx.x; u < 256; u += (split ? 256 : G)) {
      const int bg = u >> 5, pr = u & 31;
#pragma unroll 1
      for (int half = 0; half < 2; ++half) attn_chunk(p, lds, bg >> 1, bg & 1, half ? pr : 63 - pr);
    }
  }
  if (!split || blockIdx.x >= 256) {
    for (int tile = split ? (int)blockIdx.x - 256 : (int)blockIdx.x; tile < 32 * 16; tile += (split ? G - 256 : G)) {
      const int g = tile >> 4, m0 = ((tile >> 1) & 7) * 128, n0 = (tile & 1) * 128;
      gemm128<false>(
          384,
          [&](int r, int k) -> const void* {
            return (k < 128) ? p.hbuf + ((size_t)g * 1024 + m0 + r) * 128 + k
                             : p.u + ((size_t)(m0 + r) * 16 + ((k - 128) >> 4)) * 512 + g * 16 + (k & 15);
          },
          [&](int c) -> const float* { return p.wy + (size_t)g * 384 * 256 + n0 + c; }, 256,
          [&](const f32x4 (&acc)[4][4], int wr, int wc, int fr, int fq) {
#pragma unroll
            for (int m = 0; m < 4; ++m)
#pragma unroll
              for (int n = 0; n < 4; ++n) {
                const int col = n0 + wc * 64 + n * 16 + 4 * fq;
                const size_t tok = (size_t)(m0 + wr * 64 + m * 16 + fr) * 16 + (col >> 4);
                uint2 w;
                w.x = cvt_pk_bf16(geluf_(acc[m][n][0]), geluf_(acc[m][n][1]));
                w.y = cvt_pk_bf16(geluf_(acc[m][n][2]), geluf_(acc[m][n][3]));
                *(uint2*)(p.z + tok * 512 + g * 16 + (col & 15)) = w;
              }
          },
          lds);
    }
  }
  }
  xcd_barrier(gbar);

  {
  PHASE_IDX
  gemm_phase<true>(
      NT, 512, 512, [&](int m, int k) { return p.z + (size_t)m * 512 + k; },
      [&](int n) { return p.w_glu + n; }, 512,
      [&](int m, int n, f32x4 v) {
        const uint2 zw = *(const uint2*)(p.z + (size_t)m * 512 + n);
        const float zz[4] = {__uint_as_float(zw.x << 16), __uint_as_float(zw.x & 0xffff0000u),
                             __uint_as_float(zw.y << 16), __uint_as_float(zw.y & 0xffff0000u)};
#pragma unroll
        for (int j = 0; j < 4; ++j) v[j] = zz[j] * sigmoidf_(v[j] + p.b_glu[n + j]);
        *(f32x4*)(p.yssm + (size_t)m * 512 + n) = v;
      },
      lds);
  }
  xcd_barrier(gbar);

  {
  PHASE_IDX
  gemm_phase<false>(
      NT, D, 512, [&](int m, int k) { return p.onsa + (size_t)m * 512 + k; },
      [&](int n) { return p.w_up_attn + n; }, D,
      [&](int m, int n, f32x4 v) {
        const f32x4 gg = *(const f32x4*)(p.ga + (size_t)m * D + n);
        *(f32x4*)(p.merged + (size_t)m * D + n) = gg * v;
      },
      lds);
  }
  xcd_barrier(gbar);
  {
  PHASE_IDX
  gemm_phase<false>(
      NT, D, 512, [&](int m, int k) { return p.yssm + (size_t)m * 512 + k; },
      [&](int n) { return p.w_up_ssm + n; }, D,
      [&](int m, int n, f32x4 v) {
        const f32x4 gg = *(const f32x4*)(p.gs + (size_t)m * D + n);
        f32x4* dst = (f32x4*)(p.merged + (size_t)m * D + n);
        *dst = *dst + gg * v;
      },
      lds);
  }
  xcd_barrier(gbar);
  {
  PHASE_IDX
  gemm_phase<false>(
      NT, D, D, [&](int m, int k) { return p.merged + (size_t)m * D + k; },
      [&](int n) { return p.w_out + n; }, D,
      [&](int m, int n, f32x4 v) {
        const int b = m / S;
        const f32x4 xx = *(const f32x4*)(p.x + (size_t)m * D + n);
        const f32x4 gt = *(const f32x4*)(p.mod + b * 6 * D + 2 * D + n);
        *(f32x4*)(p.xmid + (size_t)m * D + n) = xx + gt * v;
      },
      lds);
  }
  xcd_barrier(gbar);

  {
  PHASE_IDX
  for (int row = gwave; row < NT; row += gwaves) {
    const int b = row / S;
    const float* xr = p.xmid + (size_t)row * D;
    f32x4 v[4];
    float ss = 0.f;
#pragma unroll
    for (int i = 0; i < 4; ++i) {
      v[i] = *(const f32x4*)(xr + i * 256 + lane * 4);
      ss += (v[i][0] * v[i][0] + v[i][1] * v[i][1]) + (v[i][2] * v[i][2] + v[i][3] * v[i][3]);
    }
    ss = wsum(ss);
    const float r = rsqrtf(ss * (1.0f / D) + EPS);
    const float* md = p.mod + b * 6 * D;
#pragma unroll
    for (int i = 0; i < 4; ++i) {
      const int col = i * 256 + lane * 4;
      const f32x4 gg = *(const f32x4*)(p.g_norm2 + col), sc = *(const f32x4*)(md + 4 * D + col), sh = *(const f32x4*)(md + 3 * D + col);
      const f32x4 y = v[i] * r * gg * (sc + 1.0f) + sh;
      uint2 w;
      w.x = cvt_pk_bf16(y[0], y[1]); w.y = cvt_pk_bf16(y[2], y[3]);
      *(uint2*)(p.h + (size_t)row * D + col) = w;
    }
  }
  }
  xcd_barrier(gbar);

  {
  PHASE_IDX
  for (int tile = blockIdx.x; tile < 128 * 2 + 128 * 4; tile += gridDim.x) {
    if (tile < 256) {
      const int m0 = (tile >> 1) * 128, n0 = (tile & 1) * 128;
      gemm128<true>(
          D, [&](int r, int k) -> const void* { return p.h + (size_t)(m0 + r) * D + k; },
          [&](int c) -> const float* { return p.w_router + n0 + c; }, NE,
          [&](const f32x4 (&acc)[4][4], int wr, int wc, int fr, int fq) {
#pragma unroll
            for (int m = 0; m < 4; ++m)
#pragma unroll
              for (int n = 0; n < 4; ++n) {
                f32x4 v = acc[m][n];
#pragma unroll
                for (int j = 0; j < 4; ++j) v[j] = sigmoidf_(v[j]);
                *(f32x4*)(p.scores + (size_t)(m0 + wr * 64 + m * 16 + fr) * NE + n0 + wc * 64 + n * 16 + 4 * fq) = v;
              }
          },
          lds);
    } else {
      const int tt = tile - 256;
      const int m0 = (tt >> 2) * 128, ct = tt & 3;
      gemm128<true>(
          D, [&](int r, int k) -> const void* { return p.h + (size_t)(m0 + r) * D + k; },
          [&](int c) -> const float* {
            const int hid = ct * 64 + (c >> 6) * 32 + ((c >> 4) & 1) * 16 + (c & 15);
            return (((c >> 5) & 1) ? p.ws_up : p.ws_gate) + hid;
          },
          DE,
          [&](const f32x4 (&acc)[4][4], int wr, int wc, int fr, int fq) {
#pragma unroll
            for (int m = 0; m < 4; ++m)
#pragma unroll
              for (int n = 0; n < 2; ++n) {
                f32x4 v;
#pragma unroll
                for (int j = 0; j < 4; ++j) v[j] = siluf_(acc[m][n][j]) * acc[m][n + 2][j];
                uint2 w;
                w.x = cvt_pk_bf16(v[0], v[1]); w.y = cvt_pk_bf16(v[2], v[3]);
                *(uint2*)(p.hs + (size_t)(m0 + wr * 64 + m * 16 + fr) * DE + ct * 64 + wc * 32 + n * 16 + 4 * fq) = w;
              }
          },
          lds);
    }
  }
  }
  xcd_barrier(gbar);

  {
  PHASE_IDX
  for (int tok = gwave; tok < NT; tok += gwaves) {
    const float4 sc4 = *reinterpret_cast<const float4*>(p.scores + (size_t)tok * NE + lane * 4);
    const float4 bi4 = *reinterpret_cast<const float4*>(p.router_bias + lane * 4);
    const float sc[4] = {sc4.x, sc4.y, sc4.z, sc4.w};
    float bz[4] = {sc4.x + bi4.x, sc4.y + bi4.y, sc4.z + bi4.z, sc4.w + bi4.w};
    float m1 = -INFINITY, m2 = -INFINITY;
#pragma unroll
    for (int i = 0; i < 4; ++i) {
      const float v = bz[i];
      if (v > m1) { m2 = m1; m1 = v; } else if (v > m2) { m2 = v; }
    }
#pragma unroll
    for (int o = 1; o < 8; o <<= 1) {
      const float o1 = __shfl_xor(m1, o), o2 = __shfl_xor(m2, o);
      const float n1 = fmaxf(m1, o1);
      const float n2 = fmaxf(fminf(m1, o1), fmaxf(m2, o2));
      m1 = n1; m2 = n2;
    }
    const float gs = m1 + m2;
    const int mygrp = lane >> 3;
    int grank = 0;
#pragma unroll
    for (int g2 = 0; g2 < 8; ++g2) {
      const float og = __shfl(gs, g2 * 8);
      grank += (og > gs || (og == gs && g2 < mygrp)) ? 1 : 0;
    }
    const bool gsel = grank < 4;
#pragma unroll
    for (int i = 0; i < 4; ++i) if (!gsel) bz[i] = -INFINITY;
    unsigned taken = 0;
    float wsel = 0.f;
    int esel = 0;
    float wtot = 0.f;
#pragma unroll 1
    for (int k = 0; k < TOPK; ++k) {
      float bv = -INFINITY; int bidx = 1 << 30;
#pragma unroll
      for (int i = 0; i < 4; ++i) {
        if (!((taken >> i) & 1u) && bz[i] > bv) { bv = bz[i]; bidx = lane * 4 + i; }
      }
#pragma unroll
      for (int o = 32; o > 0; o >>= 1) {
        const float ov = __shfl_xor(bv, o);
        const int oi = __shfl_xor(bidx, o);
        if (ov > bv || (ov == bv && oi < bidx)) { bv = ov; bidx = oi; }
      }
      const int owner = bidx >> 2, slot = bidx & 3;
      float sv = 0.f;
      if (lane == owner) {
        taken |= 1u << slot;
        sv = (slot == 0) ? sc[0] : (slot == 1) ? sc[1] : (slot == 2) ? sc[2] : sc[3];
      }
      sv = __shfl(sv, owner);
      wtot += sv;
      if (lane == k) { wsel = sv; esel = bidx; }
    }
    if (lane < TOPK) {
      p.eidx[tok * TOPK + lane] = esel;
      p.ew[tok * TOPK + lane] = wsel / wtot * 2.5f;
      atomicAdd(&p.cnt[esel], 1);
    }
  }
  gemm_phase<true>(
      NT, D, DE, [&](int m, int k) { return p.hs + (size_t)m * DE + k; },
      [&](int n) { return p.ws_down + n; }, D,
      [&](int m, int n, f32x4 v) {
        const int b = m / S;
        const f32x4 xx = *(const f32x4*)(p.xmid + (size_t)m * D + n);
        const f32x4 gt = *(const f32x4*)(p.mod + b * 6 * D + 5 * D + n);
        *(f32x4*)(p.out + (size_t)m * D + n) = xx + gt * v;
      },
      lds);
  }
  xcd_barrier(gbar);

  {
  PHASE_IDX
  {
    int* soff = (int*)smem;
    int* srt = soff + 320;
    const int myc = p.cnt[tid];
    soff[tid] = myc;
    srt[tid] = (myc + 127) >> 7;
    __syncthreads();
    for (int st = 1; st < 256; st <<= 1) {
      const int a0 = (tid >= st) ? soff[tid - st] : 0, a1 = (tid >= st) ? srt[tid - st] : 0;
      __syncthreads();
      soff[tid] += a0; srt[tid] += a1;
      __syncthreads();
    }
    const int exo = soff[tid] - myc, exr = srt[tid] - ((myc + 127) >> 7);
    __syncthreads();
    soff[tid] = exo;
    if (blockIdx.x == 0) {
      p.off[tid] = exo; p.rts[tid] = exr;
      if (tid == 255) { p.off[NE] = exo + myc; p.rts[NE] = exr + ((myc + 127) >> 7); }
    }
    __syncthreads();
    for (int idx = gtid; idx < NASSIGN; idx += gthreads) {
      const int e = p.eidx[idx];
      const int pos = soff[e] + atomicAdd(&p.cursor[e], 1);
      p.stok[pos] = idx / TOPK;
      p.sw[pos] = p.ew[idx];
      p.apos[idx] = pos;
    }
  }
  }
  xcd_barrier(gbar);

  {
  PHASE_IDX
  {
    const int total_rt = p.rts[NE];
    for (int tile = blockIdx.x; tile < total_rt * 4; tile += gridDim.x) {
      const int rt = tile >> 2, ct = tile & 3;
      const int e = find_expert(p.rts, rt);
      const int pos0 = p.off[e] + (rt - p.rts[e]) * 128;
      const int mvalid = min(128, p.off[e] + p.cnt[e] - pos0);
      const float* wg = p.w_gate + (size_t)e * D * DE;
      const float* wu = p.w_up + (size_t)e * D * DE;
      gemm128<true>(
          D, [&](int r, int k) -> const void* { return (r < mvalid) ? p.h + (size_t)p.stok[pos0 + r] * D + k : nullptr; },
          [&](int c) -> const float* {
            const int hid = ct * 64 + (c >> 6) * 32 + ((c >> 4) & 1) * 16 + (c & 15);
            return (((c >> 5) & 1) ? wu : wg) + hid;
          },
          DE,
          [&](const f32x4 (&acc)[4][4], int wr, int wc, int fr, int fq) {
#pragma unroll
            for (int m = 0; m < 4; ++m) {
              const int r = wr * 64 + m * 16 + fr;
              if (r < mvalid) {
#pragma unroll
                for (int n = 0; n < 2; ++n) {
                  f32x4 v;
#pragma unroll
                  for (int j = 0; j < 4; ++j) v[j] = siluf_(acc[m][n][j]) * acc[m][n + 2][j];
                  uint2 w;
                  w.x = cvt_pk_bf16(v[0], v[1]); w.y = cvt_pk_bf16(v[2], v[3]);
                  *(uint2*)(p.hr + (size_t)(pos0 + r) * DE + ct * 64 + wc * 32 + n * 16 + 4 * fq) = w;
                }
              }
            }
          },
          lds);
    }
  }
  }
  xcd_barrier(gbar);
  {
  PHASE_IDX
  {
    const int total_rt = p.rts[NE];
    for (int tile = blockIdx.x; tile < total_rt * 8; tile += gridDim.x) {
      const int rt = tile >> 3, ct = tile & 7;
      const int e = find_expert(p.rts, rt);
      const int pos0 = p.off[e] + (rt - p.rts[e]) * 128;
      const int mvalid = min(128, p.off[e] + p.cnt[e] - pos0);
      const float* wmat = p.w_down + (size_t)e * DE * D + ct * 128;
      gemm128<true>(
          DE, [&](int r, int k) -> const void* { return (r < mvalid) ? p.hr + (size_t)(pos0 + r) * DE + k : nullptr; },
          [&](int c) -> const float* { return wmat + c; }, D,
          [&](const f32x4 (&acc)[4][4], int wr, int wc, int fr, int fq) {
#pragma unroll
            for (int m = 0; m < 4; ++m) {
              const int r = wr * 64 + m * 16 + fr;
              if (r < mvalid) {
                const float wgt = p.sw[pos0 + r];
#pragma unroll
                for (int n = 0; n < 4; ++n) {
                  const f32x4 v = acc[m][n] * wgt;
                  uint2 w;
                  w.x = cvt_pk_bf16(v[0], v[1]); w.y = cvt_pk_bf16(v[2], v[3]);
                  *(uint2*)(p.yk + (size_t)(pos0 + r) * D + ct * 128 + wc * 64 + n * 16 + 4 * fq) = w;
                }
              }
            }
          },
          lds);
    }
  }
  }
  xcd_barrier(gbar);
  {
  PHASE_IDX
  for (int tok = gwave; tok < NT; tok += gwaves) {
    const int b = tok / S;
    float acc[16];
#pragma unroll
    for (int i = 0; i < 16; ++i) acc[i] = 0.f;
#pragma unroll 1
    for (int k = 0; k < TOPK; ++k) {
      const int pos = p.apos[tok * TOPK + k];
      const u32x4* src = (const u32x4*)(p.yk + (size_t)pos * D + lane * 16);
      const u32x4 a = src[0], c = src[1];
      const unsigned wv[8] = {a.x, a.y, a.z, a.w, c.x, c.y, c.z, c.w};
#pragma unroll
      for (int i = 0; i < 8; ++i) {
        acc[2 * i] += __uint_as_float(wv[i] << 16);
        acc[2 * i + 1] += __uint_as_float(wv[i] & 0xffff0000u);
      }
    }
    float* dst = p.out + (size_t)tok * D + lane * 16;
    const float* gt = p.mod + b * 6 * D + 5 * D + lane * 16;
#pragma unroll
    for (int i = 0; i < 4; ++i) {
      f32x4 o4 = *(f32x4*)(dst + 4 * i);
      const f32x4 g4 = *(const f32x4*)(gt + 4 * i);
#pragma unroll
      for (int j = 0; j < 4; ++j) o4[j] += g4[j] * acc[4 * i + j];
      *(f32x4*)(dst + 4 * i) = o4;
    }
  }
  }
}

extern "C" void kernel_launch(void* const* d_in, const int* in_sizes, int n_in, void* d_out, int out_size,
                              void* d_ws, size_t ws_size, hipStream_t stream) {
  (void)in_sizes; (void)n_in; (void)out_size; (void)ws_size;
  Params p{};
  const float* const* in = reinterpret_cast<const float* const*>(d_in);
  p.x = in[0]; p.c = in[1]; p.w_ada = in[2]; p.b_ada = in[3]; p.g_norm1 = in[4]; p.g_norm2 = in[5];
  p.w_in = in[6]; p.q_gain = in[7]; p.kc_gain = in[8]; p.ks_gain = in[9]; p.kw_gain = in[10];
  p.pe_k = in[11]; p.pe_v = in[12]; p.w_cmp_k1 = in[13]; p.w_cmp_k2 = in[14]; p.w_cmp_v1 = in[15];
  p.w_cmp_v2 = in[16]; p.a_re = in[17]; p.a_im = in[18]; p.log_dt = in[19]; p.b_re = in[20];
  p.b_im = in[21]; p.c_re = in[22]; p.c_im = in[23]; p.d_skip = in[24]; p.w_glu = in[25];
  p.b_glu = in[26]; p.w_up_attn = in[27]; p.w_up_ssm = in[28]; p.w_out = in[29]; p.w_router = in[30];
  p.router_bias = in[31]; p.w_gate = in[32]; p.w_up = in[33]; p.w_down = in[34]; p.ws_gate = in[35];
  p.ws_up = in[36]; p.ws_down = in[37];
  p.out = (float*)d_out;

  char* base = (char*)d_ws;
  size_t o = 0;
  auto take = [&](size_t bytes) { void* r = base + o; o += (bytes + 255) & ~(size_t)255; return r; };
  p.bar = (unsigned*)take(sizeof(unsigned) * XCD_BAR_WORDS);
  p.mod = (float*)take(sizeof(float) * NB * 6 * D);
  p.cbias = (float*)take(sizeof(float) * 512);
  p.h = (unsigned short*)take(2 * (size_t)NT * D);
  p.qb = (unsigned short*)take(2 * (size_t)NT * 512);
  p.kvb = (unsigned short*)take(2 * (size_t)6 * NB * 2 * S * 64);
  p.cmpb = (unsigned short*)take(2 * (size_t)2 * NB * 2 * 256 * 64);
  p.gn = (float*)take(sizeof(float) * (size_t)NT * 24);
  p.u = (float*)take(sizeof(float) * (size_t)NT * 512);
  p.ga = (float*)take(sizeof(float) * (size_t)NT * D);
  p.gs = (float*)take(sizeof(float) * (size_t)NT * D);
  p.hidk = (float*)take(sizeof(float) * 2040 * 256);
  p.hidv = (float*)take(sizeof(float) * 2040 * 256);
  p.onsa = (float*)take(sizeof(float) * (size_t)NT * 512);
  p.pw = (float*)take(sizeof(float) * 2048 * 17 * 2);
  p.bbar = (float*)take(sizeof(float) * 2048 * 32);
  p.w1s = (float*)take(sizeof(float) * 32 * 256 * 128);
  p.kd = (float*)take(sizeof(float) * 32 * 16 * 256);
  p.wy = (float*)take(sizeof(float) * 32 * 384 * 256);
  p.lbuf = (float*)take(sizeof(float) * 32 * 1024 * 128);
  p.hbuf = (float*)take(sizeof(float) * 32 * 1024 * 128);
  p.z = (unsigned short*)take(2 * (size_t)NT * 512);
  p.yssm = (float*)take(sizeof(float) * (size_t)NT * 512);
  p.merged = (float*)take(sizeof(float) * (size_t)NT * D);
  p.xmid = (float*)take(sizeof(float) * (size_t)NT * D);
  p.scores = (float*)take(sizeof(float) * (size_t)NT * NE);
  p.eidx = (int*)take(sizeof(int) * NASSIGN);
  p.ew = (float*)take(sizeof(float) * NASSIGN);
  p.cnt = (int*)take(sizeof(int) * NE);
  p.cursor = (int*)take(sizeof(int) * NE);
  p.off = (int*)take(sizeof(int) * (NE + 1));
  p.rts = (int*)take(sizeof(int) * (NE + 1));
  p.stok = (int*)take(sizeof(int) * NASSIGN);
  p.sw = (float*)take(sizeof(float) * NASSIGN);
  p.hs = (unsigned short*)take(2 * (size_t)NT * DE);
  p.hr = (unsigned short*)take(2 * (size_t)NASSIGN * DE);
  p.yk = (unsigned short*)take(2 * (size_t)NASSIGN * D);
  p.apos = (int*)take(sizeof(int) * NASSIGN);
  if (o > ws_size) fprintf(stderr, "workspace too small: need %zu have %zu\n", o, ws_size);

  static int grid_blocks = 0;
  if (!grid_blocks) {
    int dev = 0, cus = 0, per_cu = 0;
    hipGetDevice(&dev);
    hipDeviceGetAttribute(&cus, hipDeviceAttributeMultiprocessorCount, dev);
    hipOccupancyMaxActiveBlocksPerMultiprocessor(&per_cu, mega, 256, 0);
    if (per_cu > 2) per_cu = 2;
    if (per_cu < 1) per_cu = 1;
    grid_blocks = cus * per_cu;
  }
  (void)hipMemsetAsync(p.bar, 0, sizeof(unsigned) * XCD_BAR_WORDS, stream);
  hipLaunchKernelGGL(mega, dim3(grid_blocks), dim3(256), 0, stream, p);
  hipError_t e = hipPeekAtLastError();
  if (e != hipSuccess) fprintf(stderr, "launch failed: %s (grid %d)\n", hipGetErrorString(e), grid_blocks);
}
```

```cpp
#include <hip/hip_runtime.h>
#include <cstdio>
#include <cstdint>

constexpr int D = 1024;
constexpr int NB = 4;
constexpr int S = 4096;
constexpr int NT = NB * S;
constexpr int INC = 3864;
constexpr int C_Q = 0, C_KC = 512, C_VC = 640, C_KS = 768, C_VS = 896, C_KW = 1024, C_VW = 1152,
              C_GN = 1280, C_U = 1304, C_GA = 1816, C_GS = 2840;
constexpr int NCMP = 255;
constexpr int NE = 256;
constexpr int TOPK = 8;
constexpr int DE = 256;
constexpr int NASSIGN = NT * TOPK;
constexpr float EPS = 1e-6f;
constexpr float ATT_SCALE = 0.125f;
typedef unsigned short bf16_t;

struct Params {
  const float* x; const float* c; const float* w_ada; const float* b_ada; const float* g_norm1;
  const float* g_norm2; const float* w_in; const float* q_gain; const float* kc_gain;
  const float* ks_gain; const float* kw_gain; const float* pe_k; const float* pe_v;
  const float* w_cmp_k1; const float* w_cmp_k2; const float* w_cmp_v1; const float* w_cmp_v2;
  const float* a_re; const float* a_im; const float* log_dt; const float* b_re; const float* b_im;
  const float* c_re; const float* c_im; const float* d_skip; const float* w_glu; const float* b_glu;
  const float* w_up_attn; const float* w_up_ssm; const float* w_out; const float* w_router;
  const float* router_bias; const float* w_gate; const float* w_up; const float* w_down;
  const float* ws_gate; const float* ws_up; const float* ws_down;
  float* out;
  unsigned* bar;
  float* mod;
  float* cbias;
  bf16_t* w_inT;
  bf16_t* wc1T;
  bf16_t* wgluT;
  bf16_t* wuaT;
  bf16_t* wusT;
  bf16_t* woutT;
  bf16_t* wrT;
  bf16_t* wsgT;
  bf16_t* wsuT;
  bf16_t* wsdT;
  bf16_t* w1T;
  bf16_t* wyT;
  bf16_t* wgT;
  bf16_t* wuT;
  bf16_t* wdT;
  bf16_t* h;
  bf16_t* qb;
  bf16_t* kvb;
  bf16_t* cmpb;
  float* gn;
  bf16_t* a3;
  bf16_t* ga;
  bf16_t* gs;
  float* hidk;
  float* hidv;
  float* onsa;
  bf16_t* onsab;
  float* pw;
  float* bbar;
  float* kd;
  float* lbuf;
  bf16_t* z;
  bf16_t* yssm;
  float* mtmp;
  bf16_t* merged;
  float* xmid;
  float* scores;
  int* eidx;
  float* ew;
  int* cnt;
  int* cursor;
  int* off;
  int* xrts;
  int* stok;
  float* sw;
  int* apos;
  bf16_t* hs;
  bf16_t* hr;
  bf16_t* yk;
};

__device__ __forceinline__ float wsum(float v) {
#pragma unroll
  for (int o = 32; o > 0; o >>= 1) v += __shfl_xor(v, o);
  return v;
}
#define WSYNC() do { __builtin_amdgcn_fence(__ATOMIC_ACQ_REL, "wavefront"); __builtin_amdgcn_wave_barrier(); } while (0)
__device__ __forceinline__ float sigmoidf_(float x) { return 1.0f / (1.0f + expf(-x)); }
__device__ __forceinline__ float siluf_(float x) { return x / (1.0f + expf(-x)); }
__device__ __forceinline__ float geluf_(float x) {
  return 0.5f * x * (1.0f + tanhf(0.7978845608028654f * (x + 0.044715f * x * x * x)));
}
#define OPAQUE(x) asm volatile("" : "+v"(x))
typedef short bf16x8 __attribute__((ext_vector_type(8)));
typedef float f32x4 __attribute__((ext_vector_type(4)));
typedef unsigned u32x4 __attribute__((ext_vector_type(4)));
#define LAS __attribute__((address_space(3)))

__device__ __forceinline__ unsigned cvt_pk_bf16(float lo, float hi) {
  unsigned r;
  asm("v_cvt_pk_bf16_f32 %0, %1, %2" : "=v"(r) : "v"(lo), "v"(hi));
  return r;
}
__device__ __forceinline__ uint2 pack4(const f32x4 v) {
  uint2 w;
  w.x = cvt_pk_bf16(v[0], v[1]); w.y = cvt_pk_bf16(v[2], v[3]);
  return w;
}
__device__ __forceinline__ f32x4 unpack4(const uint2 w) {
  return (f32x4){__uint_as_float(w.x << 16), __uint_as_float(w.x & 0xffff0000u), __uint_as_float(w.y << 16), __uint_as_float(w.y & 0xffff0000u)};
}
__device__ __forceinline__ int lds_byte(int r, int c) {
  const int st = (r >> 4) * 2 + (c >> 5), rr = r & 15, cc = c & 31, ob = rr * 64 + cc * 2;
  return st * 1024 + (ob ^ (((ob >> 9) & 1) << 5));
}
__device__ __forceinline__ int t32_byte(int r, int c) {
  const int ob = (r & 15) * 64 + c * 2;
  return (r >> 4) * 1024 + (ob ^ (((ob >> 9) & 1) << 5));
}

#ifndef GEMM_GLDS
#define GEMM_GLDS 1
#endif
constexpr int GEMM_STAGE = 16384;
constexpr int GEMM_RING = 4;
template <bool GL = false, class AF, class BF, class EPW>
__device__ __forceinline__ void gemm128(int K, AF arow, BF brow, EPW epiw, LAS unsigned char* lds) {
  int t = threadIdx.x;
  OPAQUE(t);
  const int wid = t >> 6, lane = t & 63, wr = wid >> 1, wc = wid & 1, fr = lane & 15, fq = lane >> 4;
  const int sbb = lane * 16, obb = sbb ^ (((sbb >> 9) & 1) << 5);
  const int rin = obb >> 6, cel = (obb & 63) >> 1;
  const bf16_t* ga0 = arow(wid * 16 + rin) + cel;
  const bf16_t* ga1 = arow((wid + 4) * 16 + rin) + cel;
  const bf16_t* gb0 = brow(wid * 16 + rin) + cel;
  const bf16_t* gb1 = brow((wid + 4) * 16 + rin) + cel;
  f32x4 acc[4][4];
#pragma unroll
  for (int m = 0; m < 4; ++m)
#pragma unroll
    for (int n = 0; n < 4; ++n) acc[m][n] = (f32x4){0.f, 0.f, 0.f, 0.f};
  const int foff = t32_byte(fr, fq * 8);
  const int nk = K >> 5;
  if constexpr (GL) {
  LAS unsigned char* l0 = lds + t * 16;
#define GEMM_ISSUE(s_) do { LAS unsigned char* d_ = l0 + ((s_) & (GEMM_RING - 1)) * GEMM_STAGE; const int ko_ = (s_) * 32; \
    __builtin_amdgcn_global_load_lds((const unsigned*)(ga0 + ko_), (LAS unsigned*)(d_), 16, 0, 0); \
    __builtin_amdgcn_global_load_lds((const unsigned*)(ga1 + ko_), (LAS unsigned*)(d_ + 4096), 16, 0, 0); \
    __builtin_amdgcn_global_load_lds((const unsigned*)(gb0 + ko_), (LAS unsigned*)(d_ + 8192), 16, 0, 0); \
    __builtin_amdgcn_global_load_lds((const unsigned*)(gb1 + ko_), (LAS unsigned*)(d_ + 12288), 16, 0, 0); } while (0)
  asm volatile("s_waitcnt vmcnt(0)" ::: "memory");
#pragma unroll
  for (int s_ = 0; s_ < GEMM_RING - 1; ++s_)
    if (s_ < nk) GEMM_ISSUE(s_);
  for (int kt = 0; kt < nk; ++kt) {
    if (kt + 2 < nk) asm volatile("s_waitcnt vmcnt(8)" ::: "memory");
    else if (kt + 1 < nk) asm volatile("s_waitcnt vmcnt(4)" ::: "memory");
    else asm volatile("s_waitcnt vmcnt(0)" ::: "memory");
    __builtin_amdgcn_s_barrier();
    asm volatile("" ::: "memory");
    if (kt + GEMM_RING - 1 < nk) GEMM_ISSUE(kt + GEMM_RING - 1);
    const LAS unsigned char* sa = lds + (kt & (GEMM_RING - 1)) * GEMM_STAGE;
    bf16x8 af[4], bf[4];
#pragma unroll
    for (int m = 0; m < 4; ++m) af[m] = *(const LAS bf16x8*)(sa + (wr * 4 + m) * 1024 + foff);
#pragma unroll
    for (int n = 0; n < 4; ++n) bf[n] = *(const LAS bf16x8*)(sa + 8192 + (wc * 4 + n) * 1024 + foff);
#pragma unroll
    for (int m = 0; m < 4; ++m)
#pragma unroll
      for (int n = 0; n < 4; ++n)
        acc[m][n] = __builtin_amdgcn_mfma_f32_16x16x32_bf16(bf[n], af[m], acc[m][n], 0, 0, 0);
  }
  __builtin_amdgcn_s_barrier();
  asm volatile("" ::: "memory");
#undef GEMM_ISSUE
  } else {
  for (int kt = 0; kt < nk; ++kt) {
    const int ko = kt * 32;
    const u32x4 a0 = *(const u32x4*)(ga0 + ko), a1 = *(const u32x4*)(ga1 + ko);
    const u32x4 b0 = *(const u32x4*)(gb0 + ko), b1 = *(const u32x4*)(gb1 + ko);
    *(LAS u32x4*)(lds + t * 16) = a0;
    *(LAS u32x4*)(lds + t * 16 + 4096) = a1;
    *(LAS u32x4*)(lds + t * 16 + 8192) = b0;
    *(LAS u32x4*)(lds + t * 16 + 12288) = b1;
    __syncthreads();
    bf16x8 af[4], bf[4];
#pragma unroll
    for (int m = 0; m < 4; ++m) af[m] = *(const LAS bf16x8*)(lds + (wr * 4 + m) * 1024 + foff);
#pragma unroll
    for (int n = 0; n < 4; ++n) bf[n] = *(const LAS bf16x8*)(lds + 8192 + (wc * 4 + n) * 1024 + foff);
#pragma unroll
    for (int m = 0; m < 4; ++m)
#pragma unroll
      for (int n = 0; n < 4; ++n)
        acc[m][n] = __builtin_amdgcn_mfma_f32_16x16x32_bf16(bf[n], af[m], acc[m][n], 0, 0, 0);
    __syncthreads();
  }
  }
  epiw(acc, wr, wc, fr, fq);
}

__device__ __forceinline__ bool xcd_tile(int it, int tm, int tn, int& mt, int& nt) {
  const int G = gridDim.x, x = blockIdx.x & 7, slot = blockIdx.x >> 3, ns = (G - x + 7) >> 3;
  const int q = slot + it * ns;
  if (tn >= 8) {
    const int cn = (tn - x + 7) >> 3;
    if (q >= cn * tm) return false;
    mt = q / cn; nt = x + 8 * (q % cn);
  } else {
    const int cm = (tm - x + 7) >> 3;
    if (cm <= 0 || q >= cm * tn) return false;
    mt = x + 8 * (q / tn); nt = q % tn;
  }
  return true;
}
__device__ __forceinline__ int find_idx(const int* pre, int n, int v) {
  int lo = 0, hi = n;
  while (hi - lo > 1) {
    const int mid = (lo + hi) >> 1;
    if (pre[mid] <= v) lo = mid; else hi = mid;
  }
  return lo;
}

template <class AL, class BL, class EP>
__device__ __forceinline__ void gemm_phase(int M, int N, int K, AL al, BL bl, EP ep, LAS unsigned char* lds) {
  const int tn = (N + 127) / 128, tm = (M + 127) / 128;
  int mt, nt;
  for (int it = 0; xcd_tile(it, tm, tn, mt, nt); ++it) {
    const int m0 = mt * 128, n0 = nt * 128;
    gemm128<true>(
        K, [&](int r) { return al(min(m0 + r, M - 1)); }, [&](int c) { return bl(min(n0 + c, N - 1)); },
        [&](const f32x4 (&acc)[4][4], int wr, int wc, int fr, int fq) {
#pragma unroll
          for (int m = 0; m < 4; ++m)
#pragma unroll
            for (int n = 0; n < 4; ++n) {
              const int r = m0 + wr * 64 + m * 16 + fr, c = n0 + wc * 64 + n * 16 + 4 * fq;
              if (r < M && c < N) ep(r, c, acc[m][n]);
            }
        },
        lds);
  }
}

__device__ __forceinline__ void convert_tile(const float* W, int ldw, int nvalid, bf16_t* Wt, int ldt, int k0, int n0, LAS unsigned char* lds) {
  int t = threadIdx.x;
  OPAQUE(t);
  const int n4 = t & 31, kg = t >> 5;
  const int ncol = n0 + n4 * 4;
  f32x4 rb[8];
#pragma unroll
  for (int j = 0; j < 8; ++j)
    rb[j] = (ncol < nvalid) ? *(const f32x4*)(W + (size_t)(k0 + kg * 8 + j) * ldw + ncol) : (f32x4){0.f, 0.f, 0.f, 0.f};
#pragma unroll
  for (int c = 0; c < 4; ++c) {
    u32x4 w;
    w.x = cvt_pk_bf16(rb[0][c], rb[1][c]); w.y = cvt_pk_bf16(rb[2][c], rb[3][c]);
    w.z = cvt_pk_bf16(rb[4][c], rb[5][c]); w.w = cvt_pk_bf16(rb[6][c], rb[7][c]);
    *(LAS u32x4*)(lds + (n4 * 4 + c) * 144 + kg * 16) = w;
  }
  __syncthreads();
#pragma unroll
  for (int i = 0; i < 4; ++i) {
    const int q = t + i * 256, row = q >> 3, piece = q & 7;
    if (n0 + row < nvalid) *(u32x4*)(Wt + (size_t)(n0 + row) * ldt + k0 + piece * 8) = *(const LAS u32x4*)(lds + row * 144 + piece * 16);
  }
  __syncthreads();
}

typedef short s16x4 __attribute__((ext_vector_type(4)));
#define REDERIVE() do { OPAQUE(t); w = t >> 6; lane = t & 63; fr = lane & 15; fq = lane >> 4; rloc = w * 16 + fr; } while (0)
constexpr int VROW = 160;

__device__ __forceinline__ bf16x8 pack8(const f32x4 a, const f32x4 b) {
  u32x4 w;
  w.x = cvt_pk_bf16(a[0], a[1]); w.y = cvt_pk_bf16(a[2], a[3]);
  w.z = cvt_pk_bf16(b[0], b[1]); w.w = cvt_pk_bf16(b[2], b[3]);
  return __builtin_bit_cast(bf16x8, w);
}
__device__ __forceinline__ void tile_fetch(bf16x8 (&r)[2], const unsigned short* base, int t) {
  const bf16x8* q = (const bf16x8*)(base + t * 16);
  r[0] = q[0];
  r[1] = q[1];
}
__device__ __forceinline__ void stage_k(const bf16x8 (&r)[2], LAS unsigned char* ldsK, int t) {
  const int row = t >> 2, c0 = (t & 3) * 16;
  *(LAS bf16x8*)(ldsK + lds_byte(row, c0)) = r[0];
  *(LAS bf16x8*)(ldsK + lds_byte(row, c0 + 8)) = r[1];
}
__device__ __forceinline__ void stage_v(const bf16x8 (&r)[2], LAS unsigned char* ldsV, int t) {
  const int row = t >> 2, c0 = (t & 3) * 16;
  *(LAS bf16x8*)(ldsV + row * VROW + c0 * 2) = r[0];
  *(LAS bf16x8*)(ldsV + row * VROW + c0 * 2 + 16) = r[1];
}
template <int H>
__device__ __forceinline__ void attn_qk_h(f32x4 (&s)[4][2], const bf16x8 (&qf)[4][2], LAS unsigned char* ldsK, int fr, int fq) {
  const int koff = lds_byte(fr, fq * 8);
#pragma unroll
  for (int m = 0; m < 4; ++m)
#pragma unroll
    for (int nn = 0; nn < 2; ++nn) s[m][nn] = (f32x4){0.f, 0.f, 0.f, 0.f};
#pragma unroll
  for (int nn = 0; nn < 2; ++nn)
#pragma unroll
    for (int ks = 0; ks < 2; ++ks) {
      const bf16x8 kf = *(const LAS bf16x8*)(ldsK + koff + (2 * H + nn) * 2048 + ks * 1024);
#pragma unroll
      for (int m = 0; m < 4; ++m) s[m][nn] = __builtin_amdgcn_mfma_f32_16x16x32_bf16(kf, qf[m][ks], s[m][nn], 0, 0, 0);
    }
}
template <int H>
__device__ __forceinline__ void attn_pv_h(f32x4 (&o)[4][4], const bf16x8 (&pf)[4], LAS unsigned char* ldsV, int lane) {
  const int fq = lane >> 4, i = lane & 15;
  const int vbase = (4 * fq + (i >> 2)) * VROW + (i & 3) * 8;
#pragma unroll
  for (int dt = 0; dt < 4; ++dt) {
    LAS unsigned char* a0 = ldsV + vbase + H * 32 * VROW + dt * 32;
    const s16x4 v0 = __builtin_amdgcn_ds_read_tr16_b64_v4i16((LAS s16x4*)a0);
    const s16x4 v1 = __builtin_amdgcn_ds_read_tr16_b64_v4i16((LAS s16x4*)(a0 + 16 * VROW));
    bf16x8 vf;
    vf[0] = v0[0]; vf[1] = v0[1]; vf[2] = v0[2]; vf[3] = v0[3];
    vf[4] = v1[0]; vf[5] = v1[1]; vf[6] = v1[2]; vf[7] = v1[3];
#pragma unroll
    for (int m = 0; m < 4; ++m) o[m][dt] = __builtin_amdgcn_mfma_f32_16x16x32_bf16(vf, pf[m], o[m][dt], 0, 0, 0);
  }
}
template <int H, bool EM>
__device__ __forceinline__ void attn_softmax_h(f32x4 (&s)[4][2], f32x4 (&o)[4][4], float (&mrow)[4], float (&lrow)[4],
                                               bf16x8 (&pf)[4], bool rowok, int lo, int hi, int fq) {
#pragma unroll
  for (int m = 0; m < 4; ++m) {
    float mx = -INFINITY;
#pragma unroll
    for (int nn = 0; nn < 2; ++nn)
#pragma unroll
      for (int jj = 0; jj < 4; ++jj) {
        constexpr int dummy2 = 0; (void)dummy2;
        const int kc = 16 * (2 * H + nn) + jj;
        const bool ok = rowok && (!EM || (lo < kc && hi >= kc));
        const float v = ok ? s[m][nn][jj] : -INFINITY;
        s[m][nn][jj] = v;
        mx = fmaxf(mx, v);
      }
    mx = fmaxf(mx, __shfl_xor(mx, 16));
    mx = fmaxf(mx, __shfl_xor(mx, 32));
    const float mnew = fmaxf(mrow[m], mx);
    const float msafe = (mnew == -INFINITY) ? 0.f : mnew;
    const float alpha = __builtin_amdgcn_exp2f(mrow[m] - msafe);
    mrow[m] = mnew;
    float ls = 0.f;
#pragma unroll
    for (int nn = 0; nn < 2; ++nn)
#pragma unroll
      for (int jj = 0; jj < 4; ++jj) {
        const float pv = __builtin_amdgcn_exp2f(s[m][nn][jj] - msafe);
        s[m][nn][jj] = pv;
        ls += pv;
      }
    lrow[m] = lrow[m] * alpha + ls;
#pragma unroll
    for (int dt = 0; dt < 4; ++dt) o[m][dt] = o[m][dt] * alpha;
    pf[m] = pack8(s[m][0], s[m][1]);
  }
}
template <int H, bool EM>
__device__ __forceinline__ void attn_sub(f32x4 (&o)[4][4], float (&mrow)[4], float (&lrow)[4], const bf16x8 (&qf)[4][2],
                                         LAS unsigned char* ldsK, LAS unsigned char* ldsV, bool rowok, int lo, int hi, int lane) {
  f32x4 s[4][2];
  bf16x8 pf[4];
  __builtin_amdgcn_sched_barrier(0);
  attn_qk_h<H>(s, qf, ldsK, lane & 15, lane >> 4);
  __builtin_amdgcn_sched_barrier(0);
  attn_softmax_h<H, EM>(s, o, mrow, lrow, pf, rowok, lo, hi, lane >> 4);
  __builtin_amdgcn_sched_barrier(0);
  attn_pv_h<H>(o, pf, ldsV, lane);
  __builtin_amdgcn_sched_barrier(0);
}
template <bool EM>
__device__ __forceinline__ void attn_tile(f32x4 (&o)[4][4], float (&mrow)[4], float (&lrow)[4], const bf16x8 (&qf)[4][2],
                                          LAS unsigned char* ldsK, LAS unsigned char* ldsV, bool rowok, int lo, int hi, int lane) {
  attn_sub<0, EM>(o, mrow, lrow, qf, ldsK, ldsV, rowok, lo, hi, lane);
  attn_sub<1, EM>(o, mrow, lrow, qf, ldsK, ldsV, rowok, lo, hi, lane);
}
template <int H>
__device__ __forceinline__ void cmp_stats(float (&mrow)[4], float (&lrow)[4], const bf16x8 (&qf)[4][2], LAS unsigned char* ldsK, int hi, int lane) {
  const int fq = lane >> 4;
  f32x4 s[4][2];
  __builtin_amdgcn_sched_barrier(0);
  attn_qk_h<H>(s, qf, ldsK, lane & 15, fq);
  __builtin_amdgcn_sched_barrier(0);
#pragma unroll
  for (int m = 0; m < 4; ++m) {
    float mx = -INFINITY;
#pragma unroll
    for (int nn = 0; nn < 2; ++nn)
#pragma unroll
      for (int jj = 0; jj < 4; ++jj) {
        const int kc = 16 * (2 * H + nn) + jj;
        const float v = (hi >= kc) ? s[m][nn][jj] : -INFINITY;
        s[m][nn][jj] = v;
        mx = fmaxf(mx, v);
      }
    mx = fmaxf(mx, __shfl_xor(mx, 16));
    mx = fmaxf(mx, __shfl_xor(mx, 32));
    const float mnew = fmaxf(mrow[m], mx);
    const float msafe = (mnew == -INFINITY) ? 0.f : mnew;
    float ls = 0.f;
#pragma unroll
    for (int nn = 0; nn < 2; ++nn)
#pragma unroll
      for (int jj = 0; jj < 4; ++jj) ls += __builtin_amdgcn_exp2f(s[m][nn][jj] - msafe);
    lrow[m] = lrow[m] * __builtin_amdgcn_exp2f(mrow[m] - msafe) + ls;
    mrow[m] = mnew;
  }
  __builtin_amdgcn_sched_barrier(0);
}
template <int H>
__device__ __forceinline__ void cmp_apply(f32x4 (&o)[4][4], const float (&msf)[4], const float (&linv)[4], float& lastprev, LAS float* improw,
                                          const bf16x8 (&qf)[4][2], LAS unsigned char* ldsK, LAS unsigned char* ldsV, int hi, int lane) {
  const int fq = lane >> 4;
  f32x4 s[4][2];
  bf16x8 pf[4];
  __builtin_amdgcn_sched_barrier(0);
  attn_qk_h<H>(s, qf, ldsK, lane & 15, fq);
  __builtin_amdgcn_sched_barrier(0);
#pragma unroll
  for (int m = 0; m < 4; ++m) {
#pragma unroll
    for (int nn = 0; nn < 2; ++nn)
#pragma unroll
      for (int jj = 0; jj < 4; ++jj) {
        const int kc = 16 * (2 * H + nn) + jj;
        s[m][nn][jj] = (hi >= kc) ? __builtin_amdgcn_exp2f(s[m][nn][jj] - msf[m]) * linv[m] : 0.f;
      }
    pf[m] = pack8(s[m][0], s[m][1]);
  }
#pragma unroll
  for (int nn = 0; nn < 2; ++nn) {
    float gs = 0.f, last = 0.f;
#pragma unroll
    for (int m = 0; m < 4; ++m) {
      gs += (s[m][nn][0] + s[m][nn][1]) + (s[m][nn][2] + s[m][nn][3]);
      last += s[m][nn][3];
    }
    const float pa = __shfl(last, (lane + 48) & 63);
    const float pb = __shfl(lastprev, (lane + 48) & 63);
    improw[(2 * H + nn) * 4 + fq] = gs + ((fq > 0) ? pa : pb);
    lastprev = last;
  }
  __builtin_amdgcn_sched_barrier(0);
  attn_pv_h<H>(o, pf, ldsV, lane);
  __builtin_amdgcn_sched_barrier(0);
}

__device__ __forceinline__ void attn_chunk(const Params& p, LAS unsigned char* lds, int b, int g, int ci) {
  int t = threadIdx.x;
  OPAQUE(t);
  int w = t >> 6, lane = t & 63, fr = lane & 15, fq = lane >> 4;
  LAS unsigned char* ldsK = lds;
  LAS unsigned char* ldsV = lds + 8192;
  LAS float* impb = (LAS float*)(lds + 18432) + w * 1024;
  LAS unsigned* unib = (LAS unsigned*)(lds + 18432 + 16384);
  int rloc = w * 16 + fr;
  const int tq = ci * 64 + rloc;
  const size_t tok = (size_t)b * S + tq;
  const float* grow = p.gn + tok * 24 + g * 12;
  float* orow = p.onsa + tok * 512 + g * 256;
  bf16x8 qf[4][2];
#pragma unroll
  for (int m = 0; m < 4; ++m)
#pragma unroll
    for (int ks = 0; ks < 2; ++ks)
      qf[m][ks] = *(const bf16x8*)(p.qb + tok * 512 + (g * 4 + m) * 64 + ks * 32 + fq * 8);
  f32x4 o[4][4];
  float mrow[4], lrow[4];
  bf16x8 rk[2], rv[2];

  const int nvis = (tq >= 31) ? ((tq - 31) / 16 + 1) : 0;
  const int nvmax = 4 * ci + 3;
  const int ntc = (nvmax + 63) >> 6;
  const unsigned short* kcb = p.cmpb + (size_t)((0 * NB + b) * 2 + g) * 256 * 64;
  const unsigned short* vcb = p.cmpb + (size_t)((1 * NB + b) * 2 + g) * 256 * 64;
#pragma unroll
  for (int m = 0; m < 4; ++m) { mrow[m] = -INFINITY; lrow[m] = 0.f; }
  REDERIVE();
  for (int tc = 0; tc < ntc; ++tc) {
    tile_fetch(rk, kcb + (size_t)tc * 4096, t);
    stage_k(rk, ldsK, t);
    __syncthreads();
    const int hi = nvis - 1 - tc * 64 - 4 * fq;
    cmp_stats<0>(mrow, lrow, qf, ldsK, hi, lane);
    cmp_stats<1>(mrow, lrow, qf, ldsK, hi, lane);
    __syncthreads();
  }
  {
    float linv[4], msf[4];
#pragma unroll
    for (int m = 0; m < 4; ++m) {
      float l = lrow[m];
      l += __shfl_xor(l, 16);
      l += __shfl_xor(l, 32);
      linv[m] = (l > 0.f) ? 1.0f / l : 0.f;
      msf[m] = (mrow[m] == -INFINITY) ? 0.f : mrow[m];
    }
    REDERIVE();
#pragma unroll
    for (int m = 0; m < 4; ++m)
#pragma unroll
      for (int dt = 0; dt < 4; ++dt) o[m][dt] = (f32x4){0.f, 0.f, 0.f, 0.f};
    float lastprev = 0.f;
    for (int tc = 0; tc < ntc; ++tc) {
      tile_fetch(rk, kcb + (size_t)tc * 4096, t);
      tile_fetch(rv, vcb + (size_t)tc * 4096, t);
      stage_k(rk, ldsK, t);
      stage_v(rv, ldsV, t);
      __syncthreads();
      const int hi = nvis - 1 - tc * 64 - 4 * fq;
      cmp_apply<0>(o, msf, linv, lastprev, impb + fr * 64 + tc * 16, qf, ldsK, ldsV, hi, lane);
      cmp_apply<1>(o, msf, linv, lastprev, impb + fr * 64 + tc * 16, qf, ldsK, ldsV, hi, lane);
      __syncthreads();
    }
  }
#pragma unroll
  for (int m = 0; m < 4; ++m) {
    const float gate = grow[m * 3 + 0];
#pragma unroll
    for (int dt = 0; dt < 4; ++dt) *(f32x4*)(orow + m * 64 + dt * 16 + 4 * fq) = o[m][dt] * gate;
  }
  unsigned mlo, mhi;
  REDERIVE();
  {
    WSYNC();
    float kv[16];
    const int c0 = -fq * 16, c1 = ci - fq * 16;
#pragma unroll
    for (int i = 0; i < 16; ++i) {
      const bool forced = (c0 == i) || (c1 == i) || (c1 == i + 1);
      float v = (c1 >= i) ? impb[fr * 64 + fq * 16 + i] : -INFINITY;
      if (forced) v = INFINITY;
      kv[i] = v;
    }
    WSYNC();
#pragma unroll
    for (int i = 0; i < 16; ++i) impb[fr * 64 + fq * 16 + i] = kv[i];
    WSYNC();
    int rank[16];
#pragma unroll
    for (int i = 0; i < 16; ++i) rank[i] = 0;
#pragma unroll 2
    for (int k = 0; k < 64; ++k) {
      const float ok = impb[fr * 64 + k];
      const int kq = k - fq * 16;
#pragma unroll
      for (int i = 0; i < 16; ++i) rank[i] += (ok > kv[i] || (ok == kv[i] && kq < i)) ? 1 : 0;
    }
    unsigned piece = 0;
#pragma unroll
    for (int i = 0; i < 16; ++i) piece |= (rank[i] < 16) ? (1u << i) : 0u;
    unsigned lo32 = (fq == 0) ? piece : (fq == 1) ? (piece << 16) : 0u;
    unsigned hi32 = (fq == 2) ? piece : (fq == 3) ? (piece << 16) : 0u;
    lo32 |= __shfl_xor(lo32, 16); lo32 |= __shfl_xor(lo32, 32);
    hi32 |= __shfl_xor(hi32, 16); hi32 |= __shfl_xor(hi32, 32);
    mlo = lo32; mhi = hi32;
    unsigned ulo = lo32, uhi = hi32;
#pragma unroll
    for (int off = 1; off < 16; off <<= 1) { ulo |= __shfl_xor(ulo, off); uhi |= __shfl_xor(uhi, off); }
    if (lane == 0) { unib[w * 2] = ulo; unib[w * 2 + 1] = uhi; }
    __syncthreads();
  }
  unsigned long long un;
  {
    const unsigned ulo = unib[0] | unib[2] | unib[4] | unib[6];
    const unsigned uhi = unib[1] | unib[3] | unib[5] | unib[7];
    un = ((unsigned long long)__builtin_amdgcn_readfirstlane(uhi) << 32) | (unsigned long long)__builtin_amdgcn_readfirstlane(ulo);
  }
  const unsigned long long rowmask = ((unsigned long long)mhi << 32) | mlo;

#pragma unroll 1
  for (int pass = 0; pass < 2; ++pass) {
    REDERIVE();
#pragma unroll
    for (int m = 0; m < 4; ++m) {
      mrow[m] = -INFINITY; lrow[m] = 0.f;
#pragma unroll
      for (int dt = 0; dt < 4; ++dt) o[m][dt] = (f32x4){0.f, 0.f, 0.f, 0.f};
    }
    const unsigned short* kb = p.kvb + (size_t)(((2 + 2 * pass) * NB + b) * 2 + g) * S * 64;
    const unsigned short* vb = p.kvb + (size_t)(((3 + 2 * pass) * NB + b) * 2 + g) * S * 64;
    const unsigned long long upto = (ci == 63) ? ~0ull : ((1ull << (ci + 1)) - 1ull);
    const int jlo = max(0, ci - 8);
    unsigned long long rem = pass ? (upto & ~((1ull << jlo) - 1ull)) : (un & upto);
    const int jwin0 = pass ? ci - 8 : -100;
    int j = __ffsll((long long)rem) - 1;
    tile_fetch(rk, kb + (size_t)j * 4096, t);
    tile_fetch(rv, vb + (size_t)j * 4096, t);
    while (rem) {
      rem &= rem - 1;
      stage_k(rk, ldsK, t);
      stage_v(rv, ldsV, t);
      __syncthreads();
      const int jn = rem ? (__ffsll((long long)rem) - 1) : -1;
      if (jn >= 0) {
        tile_fetch(rk, kb + (size_t)jn * 4096, t);
        tile_fetch(rv, vb + (size_t)jn * 4096, t);
      }
      const bool rowok = pass ? true : (bool)((rowmask >> j) & 1ull);
      int hi = (j == ci) ? rloc : 63;
      const int lo = ((j == jwin0) ? rloc : -1) - 4 * fq;
      hi = (rowok ? hi : -1000) - 4 * fq;
      attn_tile<true>(o, mrow, lrow, qf, ldsK, ldsV, true, lo, hi, lane);
      __syncthreads();
      j = jn;
    }
#pragma unroll
    for (int m = 0; m < 4; ++m) {
      float l = lrow[m];
      l += __shfl_xor(l, 16);
      l += __shfl_xor(l, 32);
      const float sc = grow[m * 3 + 1 + pass] / l;
#pragma unroll
      for (int dt = 0; dt < 4; ++dt) {
        f32x4* dst = (f32x4*)(orow + m * 64 + dt * 16 + 4 * fq);
        const f32x4 tot = *dst + o[m][dt] * sc;
        if (pass == 0) *dst = tot;
        else *(uint2*)(p.onsab + tok * 512 + g * 256 + m * 64 + dt * 16 + 4 * fq) = pack4(tot);
      }
    }
  }
}

#define XB_TMO      128
#define XB_XCNT(j)  (256  + 64 * (j))
#define XB_XSUB(j)  (1280 + 64 * (j))
#define XB_XGEN(j)  (2304 + 64 * (j))
#define XB_TOP      3328
#define XB_TOPGEN   3392
#define XCD_BAR_WORDS 3456
#define XB_SPIN_CAP (1u << 18)

__device__ __forceinline__ unsigned xb_ld(unsigned* p)              { return __hip_atomic_load(p, __ATOMIC_RELAXED, __HIP_MEMORY_SCOPE_AGENT); }
__device__ __forceinline__ unsigned xb_add(unsigned* p, unsigned v) { return __hip_atomic_fetch_add(p, v, __ATOMIC_RELAXED, __HIP_MEMORY_SCOPE_AGENT); }
__device__ __forceinline__ unsigned xb_xcc_id() { return (unsigned)__builtin_amdgcn_s_getreg((3 << 11) | 20) & 0xFu; }
#define XB_SPIN(cond, bar) do { unsigned _sp = 0; while (cond) { __builtin_amdgcn_s_sleep(1); \
    if ((++_sp & 255u) == 0u) { if (xb_ld(&(bar)[XB_TMO])) break; if (_sp > XB_SPIN_CAP) { atomicAdd(&(bar)[XB_TMO], 1u); break; } } } } while (0)

struct XcdBarrier {
    unsigned* bar; unsigned x;
    volatile LAS unsigned* st;
};

__device__ __forceinline__ XcdBarrier xcd_barrier_post(unsigned* bar, volatile LAS unsigned* st) {
    XcdBarrier b; b.bar = bar; b.x = xb_xcc_id(); b.st = st;
    if (threadIdx.x == 0) (void)xb_add(&bar[XB_XCNT(b.x)], 1u);
    return b;
}
__device__ __forceinline__ void xcd_barrier_complete(unsigned* bar, unsigned x, unsigned& nloc, unsigned& nx) {
    const unsigned G = gridDim.x * gridDim.y * gridDim.z;
    unsigned sum, cnt, mine, sp = 0u;
    for (;;) {
        sum = 0u; cnt = 0u; mine = 0u;
#pragma unroll
        for (unsigned j = 0; j < 16; ++j) { const unsigned c = xb_ld(&bar[XB_XCNT(j)]); sum += c; cnt += (c > 0u) ? 1u : 0u; mine = (j == x) ? c : mine; }
        if (sum == G) break;
        __builtin_amdgcn_s_sleep(1);
        if ((++sp & 255u) == 0u) { if (xb_ld(&bar[XB_TMO])) break; if (sp > XB_SPIN_CAP) { atomicAdd(&bar[XB_TMO], 1u); break; } }
    }
    nloc = mine > 0u ? mine : 1u; nx = cnt > 0u ? cnt : 1u;
}

__device__ __forceinline__ void xcd_barrier(const XcdBarrier& b) {
    asm volatile("s_waitcnt vmcnt(0)" ::: "memory");
    __syncthreads();
    if (threadIdx.x == 0) {
        unsigned* bar = b.bar;
        __builtin_amdgcn_s_waitcnt(0);
        unsigned nloc = b.st[0], nx = b.st[1];
        if (nloc == 0u) { xcd_barrier_complete(bar, b.x, nloc, nx); b.st[0] = nloc; b.st[1] = nx; }
        const unsigned old = xb_add(&bar[XB_XSUB(b.x)], 1u);
        const unsigned gen = old / nloc;
        if (old + 1u == (gen + 1u) * nloc) {
            __builtin_amdgcn_fence(__ATOMIC_RELEASE, "agent");
            asm volatile("s_waitcnt vmcnt(0)" ::: "memory");
            const unsigned og = xb_add(&bar[XB_TOP], 1u);
            const unsigned tg = og / nx;
            if (og + 1u == (tg + 1u) * nx) xb_add(&bar[XB_TOPGEN], 1u);
            else XB_SPIN(xb_ld(&bar[XB_TOPGEN]) == tg, bar);
            __builtin_amdgcn_fence(__ATOMIC_ACQUIRE, "agent");
            xb_add(&bar[XB_XGEN(b.x)], 1u);
            asm volatile("s_waitcnt vmcnt(0)" ::: "memory");
        } else {
            XB_SPIN(xb_ld(&bar[XB_XGEN(b.x)]) == gen, bar);
            __builtin_amdgcn_fence(__ATOMIC_ACQUIRE, "agent");
            asm volatile("s_waitcnt vmcnt(0)" ::: "memory");
        }
    }
    __syncthreads();
}


#define PHASE_IDX int t_ = threadIdx.x; OPAQUE(t_); const int tid = t_, lane = t_ & 63, wib = t_ >> 6; \
  const int gthreads = gridDim.x * 256, gtid = blockIdx.x * 256 + t_, gwaves = gridDim.x * 4, gwave = blockIdx.x * 4 + wib; \
  (void)tid; (void)lane; (void)wib; (void)gthreads; (void)gtid; (void)gwaves; (void)gwave;

constexpr int SMEM_BYTES = GEMM_RING * GEMM_STAGE;

__device__ __forceinline__ void conv_job(const float* W, int K, int N, bf16_t* Wt, int tile, LAS unsigned char* lds) {
  const int tnn = (N + 127) >> 7;
  convert_tile(W, N, N, Wt, K, (tile / tnn) * 64, (tile % tnn) * 128, lds);
}

__global__ void __launch_bounds__(256, 2) mega(Params p) {
  __shared__ __attribute__((aligned(16))) unsigned char smem_raw[SMEM_BYTES + 16];
  float* smem = (float*)smem_raw;
  LAS unsigned char* lds = (LAS unsigned char*)smem_raw;
  volatile LAS unsigned* xb_st = (volatile LAS unsigned*)(lds + SMEM_BYTES);
  if (threadIdx.x < 4) xb_st[threadIdx.x] = 0u;
  __syncthreads();
  const XcdBarrier gbar = xcd_barrier_post(p.bar, xb_st);

  {
  PHASE_IDX
  if (blockIdx.x < 96) {
    for (int i = tid; i < NB * D; i += 256) smem[i] = siluf_(p.c[i]);
    __syncthreads();
    const int j = blockIdx.x * 64 + lane;
    float a0 = 0.f, a1 = 0.f, a2 = 0.f, a3 = 0.f;
    const float* wp = p.w_ada + (size_t)(wib * 256) * (6 * D) + j;
#pragma unroll 8
    for (int k = 0; k < 256; ++k) {
      const float w = wp[(size_t)k * (6 * D)];
      const int kk = wib * 256 + k;
      a0 = fmaf(smem[kk], w, a0); a1 = fmaf(smem[D + kk], w, a1);
      a2 = fmaf(smem[2 * D + kk], w, a2); a3 = fmaf(smem[3 * D + kk], w, a3);
    }
    __syncthreads();
    smem[(wib * 4 + 0) * 64 + lane] = a0; smem[(wib * 4 + 1) * 64 + lane] = a1;
    smem[(wib * 4 + 2) * 64 + lane] = a2; smem[(wib * 4 + 3) * 64 + lane] = a3;
    __syncthreads();
    {
      const int b = wib;
      const float v = p.b_ada[j] + ((smem[(0 * 4 + b) * 64 + lane] + smem[(1 * 4 + b) * 64 + lane]) +
                                    (smem[(2 * 4 + b) * 64 + lane] + smem[(3 * 4 + b) * 64 + lane]));
      p.mod[b * 6 * D + j] = v;
    }
    __syncthreads();
  }
  for (int idx = gtid; idx < 32 * 64; idx += gthreads) {
    const int g = idx / 64;
    const double dt = exp((double)p.log_dt[g]);
    const double lr = p.a_re[idx], li = p.a_im[idx];
    double br = 1.0, bi = 0.0;
    for (int d = 0; d <= 16; ++d) {
      const double mag = exp(lr * dt * d);
      const double pr_ = mag * cos(li * dt * d), pi_ = mag * sin(li * dt * d);
      p.pw[(idx * 17 + d) * 2] = (float)pr_;
      p.pw[(idx * 17 + d) * 2 + 1] = (float)pi_;
      if (d == 1) { br = pr_; bi = pi_; }
    }
    const double nr = br - 1.0, ni = bi;
    const double den = lr * lr + li * li;
    const double cr = (nr * lr + ni * li) / den, ci = (ni * lr - nr * li) / den;
    for (int q = 0; q < 16; ++q) {
      const double wr = p.b_re[idx * 16 + q], wi = p.b_im[idx * 16 + q];
      p.bbar[(idx * 16 + q) * 2] = (float)(cr * wr - ci * wi);
      p.bbar[(idx * 16 + q) * 2 + 1] = (float)(cr * wi + ci * wr);
    }
  }
  for (int idx = gtid; idx < NE; idx += gthreads) { p.cnt[idx] = 0; p.cursor[idx] = 0; }
  for (int o = gwave; o < 512; o += gwaves) {
    const int kv = o >> 8, j = o & 255;
    const float* pe = kv ? p.pe_v : p.pe_k;
    const float* w1 = kv ? p.w_cmp_v1 : p.w_cmp_k1;
    float acc = 0.f;
    for (int k = lane; k < 2048; k += 64) acc = fmaf(pe[k], w1[(size_t)k * 256 + j], acc);
    acc = wsum(acc);
    if (lane == 0) p.cbias[o] = acc;
  }
  {
    const int G = gridDim.x;
    const int first = (G > 96) ? 96 : 0, nb = G - first;
    if ((int)blockIdx.x >= first) {
      for (int job = blockIdx.x - first; job < 1040; job += nb) {
        if (job < 496) conv_job(p.w_in, D, INC, p.w_inT, job, lds);
        else if (job < 560) conv_job(p.w_cmp_k1, 2048, 256, p.wc1T, job - 496, lds);
        else if (job < 624) conv_job(p.w_cmp_v1, 2048, 256, p.wc1T + 256 * 2048, job - 560, lds);
        else if (job < 656) conv_job(p.w_glu, 512, 512, p.wgluT, job - 624, lds);
        else if (job < 720) conv_job(p.w_up_attn, 512, D, p.wuaT, job - 656, lds);
        else if (job < 784) conv_job(p.w_up_ssm, 512, D, p.wusT, job - 720, lds);
        else if (job < 912) conv_job(p.w_out, D, D, p.woutT, job - 784, lds);
        else if (job < 944) conv_job(p.w_router, D, NE, p.wrT, job - 912, lds);
        else if (job < 976) conv_job(p.ws_gate, D, DE, p.wsgT, job - 944, lds);
        else if (job < 1008) conv_job(p.ws_up, D, DE, p.wsuT, job - 976, lds);
        else conv_job(p.ws_down, DE, D, p.wsdT, job - 1008, lds);
      }
    }
  }
  }
  xcd_barrier(gbar);

  {
  PHASE_IDX
  for (int row = gwave; row < NT; row += gwaves) {
    const int b = row / S;
    const float* xr = p.x + (size_t)row * D;
    f32x4 v[4];
    float ss = 0.f;
#pragma unroll
    for (int i = 0; i < 4; ++i) {
      v[i] = *(const f32x4*)(xr + i * 256 + lane * 4);
      ss += (v[i][0] * v[i][0] + v[i][1] * v[i][1]) + (v[i][2] * v[i][2] + v[i][3] * v[i][3]);
    }
    ss = wsum(ss);
    const float r = rsqrtf(ss * (1.0f / D) + EPS);
    const float* md = p.mod + b * 6 * D;
#pragma unroll
    for (int i = 0; i < 4; ++i) {
      const int col = i * 256 + lane * 4;
      const f32x4 gg = *(const f32x4*)(p.g_norm1 + col), sc = *(const f32x4*)(md + D + col), sh = *(const f32x4*)(md + col);
      *(uint2*)(p.h + (size_t)row * D + col) = pack4(v[i] * r * gg * (sc + 1.0f) + sh);
    }
  }
  for (int idx = gtid; idx < 32 * 128 * 256; idx += gthreads) {
    const int k = idx & 255, col = (idx >> 8) & 127, g = idx >> 15;
    const int n = col >> 1, ri = col & 1, sidx = k >> 4, q = k & 15;
    const int gn = g * 64 + n;
    const float pr_ = p.pw[(gn * 17 + 15 - sidx) * 2], pi_ = p.pw[(gn * 17 + 15 - sidx) * 2 + 1];
    const float br = p.bbar[(gn * 16 + q) * 2], bi = p.bbar[(gn * 16 + q) * 2 + 1];
    const float v = ri ? (pr_ * bi + pi_ * br) : (pr_ * br - pi_ * bi);
    p.w1T[idx] = (bf16_t)(cvt_pk_bf16(v, 0.f) & 0xffffu);
  }
  for (int idx = gtid; idx < 32 * 16 * 256; idx += gthreads) {
    const int q = idx & 15, pp = (idx >> 4) & 15, d = (idx >> 8) & 15, g = idx >> 12;
    float acc = (d == 0 && pp == q) ? p.d_skip[g * 16 + pp] : 0.f;
    for (int n = 0; n < 64; ++n) {
      const int gn = g * 64 + n;
      const float cr = p.c_re[(g * 16 + pp) * 64 + n], ci = p.c_im[(g * 16 + pp) * 64 + n];
      const float pr_ = p.pw[(gn * 17 + d) * 2], pi_ = p.pw[(gn * 17 + d) * 2 + 1];
      const float br = p.bbar[(gn * 16 + q) * 2], bi = p.bbar[(gn * 16 + q) * 2 + 1];
      const float tr = cr * pr_ - ci * pi_, ti = cr * pi_ + ci * pr_;
      acc += tr * br - ti * bi;
    }
    p.kd[idx] = acc;
  }
  for (int idx = gtid; idx < 32 * 256 * 128; idx += gthreads) {
    const int k = idx & 127, col = (idx >> 7) & 255, g = idx >> 15;
    const int i = col >> 4, pp = col & 15, n = k >> 1, ri = k & 1;
    const int gn = g * 64 + n;
    const float cr = p.c_re[(g * 16 + pp) * 64 + n], ci = p.c_im[(g * 16 + pp) * 64 + n];
    const float pr_ = p.pw[(gn * 17 + i + 1) * 2], pi_ = p.pw[(gn * 17 + i + 1) * 2 + 1];
    const float v = ri ? -(cr * pi_ + ci * pr_) : (cr * pr_ - ci * pi_);
    p.wyT[((size_t)g * 256 + col) * 384 + k] = (bf16_t)(cvt_pk_bf16(v, 0.f) & 0xffffu);
  }
  }
  xcd_barrier(gbar);

  {
  PHASE_IDX
  {
    constexpr int TN = (INC + 127) / 128;
    int mt_, nt_;
    for (int it = 0; xcd_tile(it, NT / 128, TN, mt_, nt_); ++it) {
      const int m0 = mt_ * 128, n0 = nt_ * 128;
      gemm128<true>(
          D, [&](int r) { return p.h + (size_t)(m0 + r) * D; },
          [&](int c) { return p.w_inT + (size_t)min(n0 + c, INC - 1) * D; },
          [&](const f32x4 (&acc)[4][4], int wr, int wc, int fr, int fq) {
            const int cw = n0 + wc * 64;
            if (cw < C_GN) {
              const bool isq = cw < C_KC;
              const int slot = isq ? 0 : (cw - C_KC) >> 7, gg = isq ? 0 : ((cw - C_KC) >> 6) & 1;
              const bool norm = isq || slot == 2 || slot == 4;
              const float* gain = isq ? p.q_gain : (slot == 2 ? p.ks_gain : p.kw_gain);
              const float post = isq ? ATT_SCALE * 1.4426950408889634f : 1.0f;
#pragma unroll
              for (int m = 0; m < 4; ++m) {
                const int tok = m0 + wr * 64 + m * 16 + fr;
                float r = 1.0f;
                if (norm) {
                  float ss = 0.f;
#pragma unroll
                  for (int n = 0; n < 4; ++n)
#pragma unroll
                    for (int jj = 0; jj < 4; ++jj) ss = fmaf(acc[m][n][jj], acc[m][n][jj], ss);
                  ss += __shfl_xor(ss, 16);
                  ss += __shfl_xor(ss, 32);
                  r = rsqrtf(ss * (1.0f / 64) + EPS) * post;
                }
                bf16_t* dst = isq ? p.qb + (size_t)tok * 512 + cw
                                  : p.kvb + ((size_t)((slot * NB + (tok >> 12)) * 2 + gg) * S + (tok & (S - 1))) * 64;
#pragma unroll
                for (int n = 0; n < 4; ++n) {
                  f32x4 v = acc[m][n] * r;
                  if (norm) v = v * *(const f32x4*)(gain + n * 16 + 4 * fq);
                  *(uint2*)(dst + n * 16 + 4 * fq) = pack4(v);
                }
              }
            } else {
#pragma unroll
              for (int m = 0; m < 4; ++m) {
                const size_t tok = m0 + wr * 64 + m * 16 + fr;
#pragma unroll
                for (int n = 0; n < 4; ++n) {
                  const int c = cw + n * 16 + 4 * fq;
                  if (c < INC) {
                    f32x4 v = acc[m][n];
                    if (c >= C_U && c < C_GA) {
                      const int ch = c - C_U;
                      *(uint2*)(p.a3 + ((size_t)(ch >> 4) * 1024 + (tok >> 4)) * 384 + 128 + (tok & 15) * 16 + (ch & 15)) = pack4(v);
                    } else {
#pragma unroll
                      for (int j = 0; j < 4; ++j) v[j] = sigmoidf_(v[j]);
                      if (c < C_U) *(f32x4*)(p.gn + tok * 24 + (c - C_GN)) = v;
                      else if (c < C_GS) *(uint2*)(p.ga + tok * D + (c - C_GA)) = pack4(v);
                      else *(uint2*)(p.gs + tok * D + (c - C_GS)) = pack4(v);
                    }
                  }
                }
              }
            }
          },
          lds);
    }
  }
  for (int idx = gtid; idx < 32 * 256 * 256; idx += gthreads) {
    const int k = idx & 255, col = (idx >> 8) & 255, g = idx >> 16;
    const int i = col >> 4, pp = col & 15, sidx = k >> 4, q = k & 15;
    const float v = (i >= sidx) ? p.kd[((g * 16 + (i - sidx)) * 16 + pp) * 16 + q] : 0.f;
    p.wyT[((size_t)g * 256 + col) * 384 + 128 + k] = (bf16_t)(cvt_pk_bf16(v, 0.f) & 0xffffu);
  }
  }
  xcd_barrier(gbar);

  {
  PHASE_IDX
  for (int kv = 0; kv < 2; ++kv) {
    float* hid = kv ? p.hidv : p.hidk;
    const float* cb = p.cbias + kv * 256;
    gemm_phase(
        NB * NCMP * 2, 256, 2048,
        [&](int r) {
          const int b = r / (NCMP * 2), n = (r >> 1) % NCMP, g = r & 1;
          return p.kvb + ((size_t)((kv * NB + b) * 2 + g) * S + 16 * n) * 64;
        },
        [&](int n) { return p.wc1T + (size_t)(kv * 256 + n) * 2048; },
        [&](int r, int n, f32x4 v) {
#pragma unroll
          for (int j = 0; j < 4; ++j) v[j] = geluf_(v[j] + cb[n + j]);
          *(f32x4*)(hid + (size_t)r * 256 + n) = v;
        },
        lds);
  }
  int mt_, g;
  for (int it = 0; xcd_tile(it, 8, 32, mt_, g); ++it) {
    const int m0 = mt_ * 128;
    gemm128<true>(
        256, [&](int r) { return p.a3 + ((size_t)g * 1024 + m0 + r) * 384 + 128; },
        [&](int c) { return p.w1T + ((size_t)g * 128 + c) * 256; },
        [&](const f32x4 (&acc)[4][4], int wr, int wc, int fr, int fq) {
#pragma unroll
          for (int m = 0; m < 4; ++m)
#pragma unroll
            for (int n = 0; n < 4; ++n)
              *(f32x4*)(p.lbuf + ((size_t)g * 1024 + m0 + wr * 64 + m * 16 + fr) * 128 + wc * 64 + n * 16 + 4 * fq) = acc[m][n];
        },
        lds);
  }
  }
  xcd_barrier(gbar);

  {
  PHASE_IDX
  for (int wv = gwave; wv < 2 * NB * NCMP * 2; wv += gwaves) {
    const int kv = wv / (NB * NCMP * 2), r = wv % (NB * NCMP * 2);
    const int b = r / (NCMP * 2), n = (r >> 1) % NCMP, g = r & 1;
    const float* hid = (kv ? p.hidv : p.hidk) + (size_t)r * 256;
    const float* w2 = kv ? p.w_cmp_v2 : p.w_cmp_k2;
    float acc = 0.f;
    for (int j = 0; j < 256; ++j) acc = fmaf(hid[j], w2[j * 64 + lane], acc);
    if (kv == 0) {
      const float ss = wsum(acc * acc);
      acc = acc * rsqrtf(ss * (1.0f / 64) + EPS) * p.kc_gain[lane];
    }
    const float other = __shfl_xor(acc, 1);
    if ((lane & 1) == 0)
      *(unsigned*)(p.cmpb + ((size_t)((kv * NB + b) * 2 + g) * 256 + n) * 64 + lane) = cvt_pk_bf16(acc, other);
  }
  for (int idx = gtid; idx < 2 * NB * 2 * 32; idx += gthreads)
    *(unsigned*)(p.cmpb + ((size_t)(idx >> 5) * 256 + 255) * 64 + (idx & 31) * 2) = 0u;
  for (int idx = gtid; idx < 32 * NB * 64; idx += gthreads) {
    const int n = idx & 63, b = (idx >> 6) & 3, g = idx >> 8;
    const int gn = g * 64 + n;
    const float lr = p.pw[(gn * 17 + 16) * 2], li = p.pw[(gn * 17 + 16) * 2 + 1];
    float hr_ = 0.f, hi_ = 0.f;
    const size_t row0 = (size_t)g * 1024 + b * 256;
#pragma unroll 8
    for (int c = 0; c < 256; ++c) {
      const float2 l2 = *(const float2*)(p.lbuf + (row0 + c) * 128 + n * 2);
      *(unsigned*)(p.a3 + (row0 + c) * 384 + n * 2) = cvt_pk_bf16(hr_, hi_);
      const float nr = lr * hr_ - li * hi_ + l2.x;
      const float ni = lr * hi_ + li * hr_ + l2.y;
      hr_ = nr; hi_ = ni;
    }
  }
  }
  xcd_barrier(gbar);

  {
  PHASE_IDX
  const int G = gridDim.x;
  const bool split = G >= 512;
  if (!split || blockIdx.x < 256) {
    for (int u = blockIdx.x; u < 256; u += (split ? 256 : G)) {
      const int bg = u >> 5, pr = u & 31;
#pragma unroll 1
      for (int half = 0; half < 2; ++half) attn_chunk(p, lds, bg >> 1, bg & 1, half ? pr : 63 - pr);
    }
  }
  if (!split || blockIdx.x >= 256) {
    const int x8 = blockIdx.x & 7, nsl = split ? ((G - 256) >> 3) : 0, sl = split ? (((int)blockIdx.x - 256) >> 3) : 0;
    for (int it = 0;; ++it) {
      int tile;
      if (split && ((G & 7) == 0)) { const int q = sl + it * nsl; if (q >= 64) break; tile = ((x8 + 8 * (q >> 4)) << 4) | (q & 15); }
      else { tile = (split ? (int)blockIdx.x - 256 : (int)blockIdx.x) + it * (split ? G - 256 : G); if (tile >= 512) break; }
      const int g = tile >> 4, m0 = ((tile >> 1) & 7) * 128, n0 = (tile & 1) * 128;
      gemm128(
          384, [&](int r) { return p.a3 + ((size_t)g * 1024 + m0 + r) * 384; },
          [&](int c) { return p.wyT + ((size_t)g * 256 + n0 + c) * 384; },
          [&](const f32x4 (&acc)[4][4], int wr, int wc, int fr, int fq) {
#pragma unroll
            for (int m = 0; m < 4; ++m)
#pragma unroll
              for (int n = 0; n < 4; ++n) {
                const int col = n0 + wc * 64 + n * 16 + 4 * fq;
                const size_t tok = (size_t)(m0 + wr * 64 + m * 16 + fr) * 16 + (col >> 4);
                f32x4 v = acc[m][n];
#pragma unroll
                for (int j = 0; j < 4; ++j) v[j] = geluf_(v[j]);
                *(uint2*)(p.z + tok * 512 + g * 16 + (col & 15)) = pack4(v);
              }
          },
          lds);
    }
    const int cb = split ? (int)blockIdx.x - 256 : (int)blockIdx.x, cn = split ? G - 256 : G;
    for (int job = cb; job < NE * 96; job += cn) {
      const int e = job / 96, rem = job - e * 96, which = rem >> 5, tile = rem & 31;
      if (which == 0) conv_job(p.w_gate + (size_t)e * D * DE, D, DE, p.wgT + (size_t)e * DE * D, tile, lds);
      else if (which == 1) conv_job(p.w_up + (size_t)e * D * DE, D, DE, p.wuT + (size_t)e * DE * D, tile, lds);
      else conv_job(p.w_down + (size_t)e * DE * D, DE, D, p.wdT + (size_t)e * D * DE, tile, lds);
    }
  }
  }
  xcd_barrier(gbar);

  {
  PHASE_IDX
  gemm_phase(
      NT, 512, 512, [&](int m) { return p.z + (size_t)m * 512; }, [&](int n) { return p.wgluT + (size_t)n * 512; },
      [&](int m, int n, f32x4 v) {
        const f32x4 zz = unpack4(*(const uint2*)(p.z + (size_t)m * 512 + n));
#pragma unroll
        for (int j = 0; j < 4; ++j) v[j] = zz[j] * sigmoidf_(v[j] + p.b_glu[n + j]);
        *(uint2*)(p.yssm + (size_t)m * 512 + n) = pack4(v);
      },
      lds);
  }
  xcd_barrier(gbar);

  {
  PHASE_IDX
  gemm_phase(
      NT, D, 512, [&](int m) { return p.onsab + (size_t)m * 512; }, [&](int n) { return p.wuaT + (size_t)n * 512; },
      [&](int m, int n, f32x4 v) {
        const f32x4 gg = unpack4(*(const uint2*)(p.ga + (size_t)m * D + n));
        *(f32x4*)(p.mtmp + (size_t)m * D + n) = gg * v;
      },
      lds);
  }
  xcd_barrier(gbar);
  {
  PHASE_IDX
  gemm_phase(
      NT, D, 512, [&](int m) { return p.yssm + (size_t)m * 512; }, [&](int n) { return p.wusT + (size_t)n * 512; },
      [&](int m, int n, f32x4 v) {
        const f32x4 gg = unpack4(*(const uint2*)(p.gs + (size_t)m * D + n));
        const f32x4 prev = *(const f32x4*)(p.mtmp + (size_t)m * D + n);
        *(uint2*)(p.merged + (size_t)m * D + n) = pack4(prev + gg * v);
      },
      lds);
  }
  xcd_barrier(gbar);
  {
  PHASE_IDX
  gemm_phase(
      NT, D, D, [&](int m) { return p.merged + (size_t)m * D; }, [&](int n) { return p.woutT + (size_t)n * D; },
      [&](int m, int n, f32x4 v) {
        const int b = m / S;
        const f32x4 xx = *(const f32x4*)(p.x + (size_t)m * D + n);
        const f32x4 gt = *(const f32x4*)(p.mod + b * 6 * D + 2 * D + n);
        *(f32x4*)(p.xmid + (size_t)m * D + n) = xx + gt * v;
      },
      lds);
  }
  xcd_barrier(gbar);

  {
  PHASE_IDX
  for (int row = gwave; row < NT; row += gwaves) {
    const int b = row / S;
    const float* xr = p.xmid + (size_t)row * D;
    f32x4 v[4];
    float ss = 0.f;
#pragma unroll
    for (int i = 0; i < 4; ++i) {
      v[i] = *(const f32x4*)(xr + i * 256 + lane * 4);
      ss += (v[i][0] * v[i][0] + v[i][1] * v[i][1]) + (v[i][2] * v[i][2] + v[i][3] * v[i][3]);
    }
    ss = wsum(ss);
    const float r = rsqrtf(ss * (1.0f / D) + EPS);
    const float* md = p.mod + b * 6 * D;
#pragma unroll
    for (int i = 0; i < 4; ++i) {
      const int col = i * 256 + lane * 4;
      const f32x4 gg = *(const f32x4*)(p.g_norm2 + col), sc = *(const f32x4*)(md + 4 * D + col), sh = *(const f32x4*)(md + 3 * D + col);
      *(uint2*)(p.h + (size_t)row * D + col) = pack4(v[i] * r * gg * (sc + 1.0f) + sh);
    }
  }
  }
  xcd_barrier(gbar);

  {
  PHASE_IDX
  int mt_, nt_;
  for (int it = 0; xcd_tile(it, 128, 6, mt_, nt_); ++it) {
    if (nt_ < 2) {
      const int m0 = mt_ * 128, n0 = nt_ * 128;
      gemm128<true>(
          D, [&](int r) { return p.h + (size_t)(m0 + r) * D; }, [&](int c) { return p.wrT + (size_t)(n0 + c) * D; },
          [&](const f32x4 (&acc)[4][4], int wr, int wc, int fr, int fq) {
#pragma unroll
            for (int m = 0; m < 4; ++m)
#pragma unroll
              for (int n = 0; n < 4; ++n) {
                f32x4 v = acc[m][n];
#pragma unroll
                for (int j = 0; j < 4; ++j) v[j] = sigmoidf_(v[j]);
                *(f32x4*)(p.scores + (size_t)(m0 + wr * 64 + m * 16 + fr) * NE + n0 + wc * 64 + n * 16 + 4 * fq) = v;
              }
          },
          lds);
    } else {
      const int m0 = mt_ * 128, ct = nt_ - 2;
      gemm128<true>(
          D, [&](int r) { return p.h + (size_t)(m0 + r) * D; },
          [&](int c) {
            const int hid = ct * 64 + (c >> 6) * 32 + ((c >> 4) & 1) * 16 + (c & 15);
            return (((c >> 5) & 1) ? p.wsuT : p.wsgT) + (size_t)hid * D;
          },
          [&](const f32x4 (&acc)[4][4], int wr, int wc, int fr, int fq) {
#pragma unroll
            for (int m = 0; m < 4; ++m)
#pragma unroll
              for (int n = 0; n < 2; ++n) {
                f32x4 v;
#pragma unroll
                for (int j = 0; j < 4; ++j) v[j] = siluf_(acc[m][n][j]) * acc[m][n + 2][j];
                *(uint2*)(p.hs + (size_t)(m0 + wr * 64 + m * 16 + fr) * DE + ct * 64 + wc * 32 + n * 16 + 4 * fq) = pack4(v);
              }
          },
          lds);
    }
  }
  }
  xcd_barrier(gbar);

  {
  PHASE_IDX
  for (int tok = gwave; tok < NT; tok += gwaves) {
    const float4 sc4 = *reinterpret_cast<const float4*>(p.scores + (size_t)tok * NE + lane * 4);
    const float4 bi4 = *reinterpret_cast<const float4*>(p.router_bias + lane * 4);
    const float sc[4] = {sc4.x, sc4.y, sc4.z, sc4.w};
    float bz[4] = {sc4.x + bi4.x, sc4.y + bi4.y, sc4.z + bi4.z, sc4.w + bi4.w};
    float m1 = -INFINITY, m2 = -INFINITY;
#pragma unroll
    for (int i = 0; i < 4; ++i) {
      const float v = bz[i];
      if (v > m1) { m2 = m1; m1 = v; } else if (v > m2) { m2 = v; }
    }
#pragma unroll
    for (int o = 1; o < 8; o <<= 1) {
      const float o1 = __shfl_xor(m1, o), o2 = __shfl_xor(m2, o);
      const float n1 = fmaxf(m1, o1);
      const float n2 = fmaxf(fminf(m1, o1), fmaxf(m2, o2));
      m1 = n1; m2 = n2;
    }
    const float gs = m1 + m2;
    const int mygrp = lane >> 3;
    int grank = 0;
#pragma unroll
    for (int g2 = 0; g2 < 8; ++g2) {
      const float og = __shfl(gs, g2 * 8);
      grank += (og > gs || (og == gs && g2 < mygrp)) ? 1 : 0;
    }
    const bool gsel = grank < 4;
#pragma unroll
    for (int i = 0; i < 4; ++i) if (!gsel) bz[i] = -INFINITY;
    unsigned taken = 0;
    float wsel = 0.f;
    int esel = 0;
    float wtot = 0.f;
#pragma unroll 1
    for (int k = 0; k < TOPK; ++k) {
      float bv = -INFINITY; int bidx = 1 << 30;
#pragma unroll
      for (int i = 0; i < 4; ++i) {
        if (!((taken >> i) & 1u) && bz[i] > bv) { bv = bz[i]; bidx = lane * 4 + i; }
      }
#pragma unroll
      for (int o = 32; o > 0; o >>= 1) {
        const float ov = __shfl_xor(bv, o);
        const int oi = __shfl_xor(bidx, o);
        if (ov > bv || (ov == bv && oi < bidx)) { bv = ov; bidx = oi; }
      }
      const int owner = bidx >> 2, slot = bidx & 3;
      float sv = 0.f;
      if (lane == owner) {
        taken |= 1u << slot;
        sv = (slot == 0) ? sc[0] : (slot == 1) ? sc[1] : (slot == 2) ? sc[2] : sc[3];
      }
      sv = __shfl(sv, owner);
      wtot += sv;
      if (lane == k) { wsel = sv; esel = bidx; }
    }
    if (lane < TOPK) {
      p.eidx[tok * TOPK + lane] = esel;
      p.ew[tok * TOPK + lane] = wsel / wtot * 2.5f;
      atomicAdd(&p.cnt[esel], 1);
    }
  }
  gemm_phase(
      NT, D, DE, [&](int m) { return p.hs + (size_t)m * DE; }, [&](int n) { return p.wsdT + (size_t)n * DE; },
      [&](int m, int n, f32x4 v) {
        const int b = m / S;
        const f32x4 xx = *(const f32x4*)(p.xmid + (size_t)m * D + n);
        const f32x4 gt = *(const f32x4*)(p.mod + b * 6 * D + 5 * D + n);
        *(f32x4*)(p.out + (size_t)m * D + n) = xx + gt * v;
      },
      lds);
  }
  xcd_barrier(gbar);

  {
  PHASE_IDX
  {
    int* soff = (int*)smem;
    int* srt = soff + 320;
    const int myc = p.cnt[tid];
    soff[tid] = myc;
    srt[tid] = (myc + 127) >> 7;
    __syncthreads();
    for (int st = 1; st < 256; st <<= 1) {
      const int a0 = (tid >= st) ? soff[tid - st] : 0;
      __syncthreads();
      soff[tid] += a0;
      __syncthreads();
    }
    const int exo = soff[tid] - myc;
    __syncthreads();
    soff[tid] = exo;
    if (blockIdx.x == 0) {
      p.off[tid] = exo;
      if (tid == 255) p.off[NE] = exo + myc;
    }
    __syncthreads();
    if (blockIdx.x == 0 && tid < 8) {
      int acc = 0;
      for (int i = 0; i < 32; ++i) { p.xrts[tid * 33 + i] = acc; acc += srt[tid + 8 * i]; }
      p.xrts[tid * 33 + 32] = acc;
    }
    for (int idx = gtid; idx < NASSIGN; idx += gthreads) {
      const int e = p.eidx[idx];
      const int pos = soff[e] + atomicAdd(&p.cursor[e], 1);
      p.stok[pos] = idx / TOPK;
      p.sw[pos] = p.ew[idx];
      p.apos[idx] = pos;
    }
    __syncthreads();
  }
  }
  xcd_barrier(gbar);

  {
  PHASE_IDX
  {
    const int x8 = blockIdx.x & 7, ns8 = ((int)gridDim.x - x8 + 7) >> 3;
    const int* xr = p.xrts + x8 * 33;
    const int total_rt = xr[32];
    for (int tile = blockIdx.x >> 3; tile < total_rt * 4; tile += ns8) {
      const int rt = tile >> 2, ct = tile & 3;
      const int ei = find_idx(xr, 32, rt);
      const int e = x8 + 8 * ei;
      const int pos0 = p.off[e] + (rt - xr[ei]) * 128;
      const int mvalid = min(128, p.off[e] + p.cnt[e] - pos0);
      const bf16_t* wg = p.wgT + (size_t)e * DE * D;
      const bf16_t* wu = p.wuT + (size_t)e * DE * D;
      gemm128<true>(
          D, [&](int r) { return p.h + (size_t)p.stok[pos0 + min(r, mvalid - 1)] * D; },
          [&](int c) {
            const int hid = ct * 64 + (c >> 6) * 32 + ((c >> 4) & 1) * 16 + (c & 15);
            return (((c >> 5) & 1) ? wu : wg) + (size_t)hid * D;
          },
          [&](const f32x4 (&acc)[4][4], int wr, int wc, int fr, int fq) {
#pragma unroll
            for (int m = 0; m < 4; ++m) {
              const int r = wr * 64 + m * 16 + fr;
              if (r < mvalid) {
#pragma unroll
                for (int n = 0; n < 2; ++n) {
                  f32x4 v;
#pragma unroll
                  for (int j = 0; j < 4; ++j) v[j] = siluf_(acc[m][n][j]) * acc[m][n + 2][j];
                  *(uint2*)(p.hr + (size_t)(pos0 + r) * DE + ct * 64 + wc * 32 + n * 16 + 4 * fq) = pack4(v);
                }
              }
            }
          },
          lds);
    }
  }
  }
  xcd_barrier(gbar);
  {
  PHASE_IDX
  {
    const int x8 = blockIdx.x & 7, ns8 = ((int)gridDim.x - x8 + 7) >> 3;
    const int* xr = p.xrts + x8 * 33;
    const int total_rt = xr[32];
    for (int tile = blockIdx.x >> 3; tile < total_rt * 8; tile += ns8) {
      const int rt = tile >> 3, ct = tile & 7;
      const int ei = find_idx(xr, 32, rt);
      const int e = x8 + 8 * ei;
      const int pos0 = p.off[e] + (rt - xr[ei]) * 128;
      const int mvalid = min(128, p.off[e] + p.cnt[e] - pos0);
      const bf16_t* wd = p.wdT + (size_t)e * D * DE + (size_t)(ct * 128) * DE;
      gemm128<true>(
          DE, [&](int r) { return p.hr + (size_t)(pos0 + min(r, mvalid - 1)) * DE; },
          [&](int c) { return wd + (size_t)c * DE; },
          [&](const f32x4 (&acc)[4][4], int wr, int wc, int fr, int fq) {
#pragma unroll
            for (int m = 0; m < 4; ++m) {
              const int r = wr * 64 + m * 16 + fr;
              if (r < mvalid) {
                const float wgt = p.sw[pos0 + r];
#pragma unroll
                for (int n = 0; n < 4; ++n)
                  *(uint2*)(p.yk + (size_t)(pos0 + r) * D + ct * 128 + wc * 64 + n * 16 + 4 * fq) = pack4(acc[m][n] * wgt);
              }
            }
          },
          lds);
    }
  }
  }
  xcd_barrier(gbar);
  {
  PHASE_IDX
  for (int tok = gwave; tok < NT; tok += gwaves) {
    const int b = tok / S;
    float acc[16];
#pragma unroll
    for (int i = 0; i < 16; ++i) acc[i] = 0.f;
#pragma unroll 1
    for (int k = 0; k < TOPK; ++k) {
      const int pos = p.apos[tok * TOPK + k];
      const u32x4* src = (const u32x4*)(p.yk + (size_t)pos * D + lane * 16);
      const u32x4 a = src[0], c = src[1];
      const unsigned wv[8] = {a.x, a.y, a.z, a.w, c.x, c.y, c.z, c.w};
#pragma unroll
      for (int i = 0; i < 8; ++i) {
        acc[2 * i] += __uint_as_float(wv[i] << 16);
        acc[2 * i + 1] += __uint_as_float(wv[i] & 0xffff0000u);
      }
    }
    float* dst = p.out + (size_t)tok * D + lane * 16;
    const float* gt = p.mod + b * 6 * D + 5 * D + lane * 16;
#pragma unroll
    for (int i = 0; i < 4; ++i) {
      f32x4 o4 = *(f32x4*)(dst + 4 * i);
      const f32x4 g4 = *(const f32x4*)(gt + 4 * i);
#pragma unroll
      for (int j = 0; j < 4; ++j) o4[j] += g4[j] * acc[4 * i + j];
      *(f32x4*)(dst + 4 * i) = o4;
    }
  }
  }
}

extern "C" void kernel_launch(void* const* d_in, const int* in_sizes, int n_in, void* d_out, int out_size,
                              void* d_ws, size_t ws_size, hipStream_t stream) {
  (void)in_sizes; (void)n_in; (void)out_size;
  Params p{};
  const float* const* in = reinterpret_cast<const float* const*>(d_in);
  p.x = in[0]; p.c = in[1]; p.w_ada = in[2]; p.b_ada = in[3]; p.g_norm1 = in[4]; p.g_norm2 = in[5];
  p.w_in = in[6]; p.q_gain = in[7]; p.kc_gain = in[8]; p.ks_gain = in[9]; p.kw_gain = in[10];
  p.pe_k = in[11]; p.pe_v = in[12]; p.w_cmp_k1 = in[13]; p.w_cmp_k2 = in[14]; p.w_cmp_v1 = in[15];
  p.w_cmp_v2 = in[16]; p.a_re = in[17]; p.a_im = in[18]; p.log_dt = in[19]; p.b_re = in[20];
  p.b_im = in[21]; p.c_re = in[22]; p.c_im = in[23]; p.d_skip = in[24]; p.w_glu = in[25];
  p.b_glu = in[26]; p.w_up_attn = in[27]; p.w_up_ssm = in[28]; p.w_out = in[29]; p.w_router = in[30];
  p.router_bias = in[31]; p.w_gate = in[32]; p.w_up = in[33]; p.w_down = in[34]; p.ws_gate = in[35];
  p.ws_up = in[36]; p.ws_down = in[37];
  p.out = (float*)d_out;

  char* base = (char*)d_ws;
  size_t o = 0;
  auto take = [&](size_t bytes) { void* r = base + o; o += (bytes + 255) & ~(size_t)255; return r; };
  p.bar = (unsigned*)take(sizeof(unsigned) * XCD_BAR_WORDS);
  p.mod = (float*)take(sizeof(float) * NB * 6 * D);
  p.cbias = (float*)take(sizeof(float) * 512);
  p.w_inT = (bf16_t*)take(2 * (size_t)INC * D);
  p.wc1T = (bf16_t*)take(2 * (size_t)2 * 256 * 2048);
  p.wgluT = (bf16_t*)take(2 * (size_t)512 * 512);
  p.wuaT = (bf16_t*)take(2 * (size_t)D * 512);
  p.wusT = (bf16_t*)take(2 * (size_t)D * 512);
  p.woutT = (bf16_t*)take(2 * (size_t)D * D);
  p.wrT = (bf16_t*)take(2 * (size_t)NE * D);
  p.wsgT = (bf16_t*)take(2 * (size_t)DE * D);
  p.wsuT = (bf16_t*)take(2 * (size_t)DE * D);
  p.wsdT = (bf16_t*)take(2 * (size_t)D * DE);
  p.w1T = (bf16_t*)take(2 * (size_t)32 * 128 * 256);
  p.wyT = (bf16_t*)take(2 * (size_t)32 * 256 * 384);
  p.wgT = (bf16_t*)take(2 * (size_t)NE * DE * D);
  p.wuT = (bf16_t*)take(2 * (size_t)NE * DE * D);
  p.wdT = (bf16_t*)take(2 * (size_t)NE * D * DE);
  p.h = (bf16_t*)take(2 * (size_t)NT * D);
  p.pw = (float*)take(sizeof(float) * 2048 * 17 * 2);
  p.bbar = (float*)take(sizeof(float) * 2048 * 32);
  p.kd = (float*)take(sizeof(float) * 32 * 16 * 256);
  p.xmid = (float*)take(sizeof(float) * (size_t)NT * D);
  p.scores = (float*)take(sizeof(float) * (size_t)NT * NE);
  p.eidx = (int*)take(sizeof(int) * NASSIGN);
  p.ew = (float*)take(sizeof(float) * NASSIGN);
  p.cnt = (int*)take(sizeof(int) * NE);
  p.cursor = (int*)take(sizeof(int) * NE);
  p.off = (int*)take(sizeof(int) * (NE + 1));
  p.xrts = (int*)take(sizeof(int) * 8 * 33);
  p.stok = (int*)take(sizeof(int) * NASSIGN);
  p.sw = (float*)take(sizeof(float) * NASSIGN);
  p.apos = (int*)take(sizeof(int) * NASSIGN);
  p.hs = (bf16_t*)take(2 * (size_t)NT * DE);
  p.hr = (bf16_t*)take(2 * (size_t)NASSIGN * DE);
  const size_t early0 = o;
  p.qb = (bf16_t*)take(2 * (size_t)NT * 512);
  p.kvb = (bf16_t*)take(2 * (size_t)6 * NB * 2 * S * 64);
  p.cmpb = (bf16_t*)take(2 * (size_t)2 * NB * 2 * 256 * 64);
  p.gn = (float*)take(sizeof(float) * (size_t)NT * 24);
  p.a3 = (bf16_t*)take(2 * (size_t)32 * 1024 * 384);
  p.ga = (bf16_t*)take(2 * (size_t)NT * D);
  p.gs = (bf16_t*)take(2 * (size_t)NT * D);
  p.hidk = (float*)take(sizeof(float) * 2040 * 256);
  p.hidv = (float*)take(sizeof(float) * 2040 * 256);
  p.onsa = (float*)take(sizeof(float) * (size_t)NT * 512);
  p.onsab = (bf16_t*)take(2 * (size_t)NT * 512);
  p.lbuf = (float*)take(sizeof(float) * 32 * 1024 * 128);
  p.z = (bf16_t*)take(2 * (size_t)NT * 512);
  p.yssm = (bf16_t*)take(2 * (size_t)NT * 512);
  p.mtmp = (float*)take(sizeof(float) * (size_t)NT * D);
  p.merged = (bf16_t*)take(2 * (size_t)NT * D);
  const size_t early1 = o;
  p.yk = (bf16_t*)(base + early0);
  const size_t yk_bytes = 2 * (size_t)NASSIGN * D;
  if (early0 + yk_bytes > o) o = early0 + yk_bytes;
  (void)early1;
  if (o > ws_size) fprintf(stderr, "workspace too small: need %zu have %zu\n", o, ws_size);

  static int grid_blocks = 0;
  if (!grid_blocks) {
    int dev = 0, cus = 0, per_cu = 0;
    (void)hipGetDevice(&dev);
    (void)hipDeviceGetAttribute(&cus, hipDeviceAttributeMultiprocessorCount, dev);
    (void)hipOccupancyMaxActiveBlocksPerMultiprocessor(&per_cu, mega, 256, 0);
    if (per_cu > 2) per_cu = 2;
    if (per_cu < 1) per_cu = 1;
    grid_blocks = cus * per_cu;
  }
  (void)hipMemsetAsync(p.bar, 0, sizeof(unsigned) * XCD_BAR_WORDS, stream);
  hipLaunchKernelGGL(mega, dim3(grid_blocks), dim3(256), 0, stream, p);
  hipError_t e = hipPeekAtLastError();
  if (e != hipSuccess) fprintf(stderr, "launch failed: %s (grid %d)\n", hipGetErrorString(e), grid_blocks);
}
```

```cpp
#include <hip/hip_runtime.h>
#include <cstdio>
#include <cstdint>

constexpr int D = 1024;
constexpr int NB = 4;
constexpr int S = 4096;
constexpr int NT = NB * S;
constexpr int INC = 3864;
constexpr int C_Q = 0, C_KC = 512, C_VC = 640, C_KS = 768, C_VS = 896, C_KW = 1024, C_VW = 1152,
              C_GN = 1280, C_U = 1304, C_GA = 1816, C_GS = 2840;
constexpr int NCMP = 255;
constexpr int NE = 256;
constexpr int TOPK = 8;
constexpr int DE = 256;
constexpr int NASSIGN = NT * TOPK;
constexpr float EPS = 1e-6f;
constexpr float ATT_SCALE = 0.125f;
typedef unsigned short bf16_t;

struct Params {
  const float* x; const float* c; const float* w_ada; const float* b_ada; const float* g_norm1;
  const float* g_norm2; const float* w_in; const float* q_gain; const float* kc_gain;
  const float* ks_gain; const float* kw_gain; const float* pe_k; const float* pe_v;
  const float* w_cmp_k1; const float* w_cmp_k2; const float* w_cmp_v1; const float* w_cmp_v2;
  const float* a_re; const float* a_im; const float* log_dt; const float* b_re; const float* b_im;
  const float* c_re; const float* c_im; const float* d_skip; const float* w_glu; const float* b_glu;
  const float* w_up_attn; const float* w_up_ssm; const float* w_out; const float* w_router;
  const float* router_bias; const float* w_gate; const float* w_up; const float* w_down;
  const float* ws_gate; const float* ws_up; const float* ws_down;
  float* out;
  unsigned* bar;
  float* mod;
  float* cbias;
  bf16_t* w_inT;
  bf16_t* wc1T;
  bf16_t* wgluT;
  bf16_t* wuaT;
  bf16_t* wusT;
  bf16_t* woutT;
  bf16_t* wrT;
  bf16_t* wsgT;
  bf16_t* wsuT;
  bf16_t* wsdT;
  bf16_t* w1T;
  bf16_t* wyT;
  bf16_t* wgT;
  bf16_t* wuT;
  bf16_t* wdT;
  bf16_t* h;
  bf16_t* qb;
  bf16_t* kvb;
  bf16_t* cmpb;
  float* gn;
  bf16_t* a3;
  bf16_t* ga;
  bf16_t* gs;
  float* hidp;
  float* onsa;
  bf16_t* onsab;
  float* pw;
  float* bbar;
  float* kd;
  float* lbuf;
  bf16_t* z;
  bf16_t* yssm;
  float* mtmp;
  bf16_t* merged;
  float* xmid;
  float* scores;
  int* eidx;
  float* ew;
  int* cnt;
  int* cursor;
  int* off;
  int* xrts;
  int* stok;
  float* sw;
  int* apos;
  bf16_t* hs;
  bf16_t* hr;
  bf16_t* yk;
};

__device__ __forceinline__ float wsum(float v) {
#pragma unroll
  for (int o = 32; o > 0; o >>= 1) v += __shfl_xor(v, o);
  return v;
}
#define WSYNC() do { __builtin_amdgcn_fence(__ATOMIC_ACQ_REL, "wavefront"); __builtin_amdgcn_wave_barrier(); } while (0)
__device__ __forceinline__ float sigmoidf_(float x) { return 1.0f / (1.0f + expf(-x)); }
__device__ __forceinline__ float siluf_(float x) { return x / (1.0f + expf(-x)); }
__device__ __forceinline__ float geluf_(float x) {
  return 0.5f * x * (1.0f + tanhf(0.7978845608028654f * (x + 0.044715f * x * x * x)));
}
#define OPAQUE(x) asm volatile("" : "+v"(x))
typedef short bf16x8 __attribute__((ext_vector_type(8)));
typedef float f32x4 __attribute__((ext_vector_type(4)));
typedef unsigned u32x4 __attribute__((ext_vector_type(4)));
#define LAS __attribute__((address_space(3)))

__device__ __forceinline__ unsigned cvt_pk_bf16(float lo, float hi) {
  unsigned r;
  asm("v_cvt_pk_bf16_f32 %0, %1, %2" : "=v"(r) : "v"(lo), "v"(hi));
  return r;
}
__device__ __forceinline__ uint2 pack4(const f32x4 v) {
  uint2 w;
  w.x = cvt_pk_bf16(v[0], v[1]); w.y = cvt_pk_bf16(v[2], v[3]);
  return w;
}
__device__ __forceinline__ f32x4 unpack4(const uint2 w) {
  return (f32x4){__uint_as_float(w.x << 16), __uint_as_float(w.x & 0xffff0000u), __uint_as_float(w.y << 16), __uint_as_float(w.y & 0xffff0000u)};
}
__device__ __forceinline__ int lds_byte(int r, int c) {
  const int st = (r >> 4) * 2 + (c >> 5), rr = r & 15, cc = c & 31, ob = rr * 64 + cc * 2;
  return st * 1024 + (ob ^ (((ob >> 9) & 1) << 5));
}
__device__ __forceinline__ int t32_byte(int r, int c) {
  const int ob = (r & 15) * 64 + c * 2;
  return (r >> 4) * 1024 + (ob ^ (((ob >> 9) & 1) << 5));
}

constexpr int GEMM_STAGE = 24576;
constexpr int GEMM_RING = 3;
constexpr int TM = 128, TNW = 256;
template <bool GL = false, class AF, class BF, class EPW>
__device__ __forceinline__ void gemm128(int K, AF arow, BF brow, EPW epiw, LAS unsigned char* lds) {
  int t = threadIdx.x;
  OPAQUE(t);
  const int wid = t >> 6, lane = t & 63, wr = wid >> 1, wc = wid & 1, fr = lane & 15, fq = lane >> 4;
  const int sbb = lane * 16, obb = sbb ^ (((sbb >> 9) & 1) << 5);
  const int rin = obb >> 6, cel = (obb & 63) >> 1;
  const bf16_t* ga0 = arow(wid * 16 + rin) + cel;
  const bf16_t* ga1 = arow((wid + 4) * 16 + rin) + cel;
  const bf16_t* gb0 = brow(wid * 16 + rin) + cel;
  const bf16_t* gb1 = brow((wid + 4) * 16 + rin) + cel;
  const bf16_t* gb2 = brow((wid + 8) * 16 + rin) + cel;
  const bf16_t* gb3 = brow((wid + 12) * 16 + rin) + cel;
  f32x4 acc[4][8];
#pragma unroll
  for (int m = 0; m < 4; ++m)
#pragma unroll
    for (int n = 0; n < 8; ++n) acc[m][n] = (f32x4){0.f, 0.f, 0.f, 0.f};
  const int foff = t32_byte(fr, fq * 8);
  const int nk = K >> 5;
#define GEMM_COMPUTE(sa_) do { \
    bf16x8 af[4]; \
    _Pragma("unroll") for (int m = 0; m < 4; ++m) af[m] = *(const LAS bf16x8*)((sa_) + (wr * 4 + m) * 1024 + foff); \
    _Pragma("unroll") for (int nh = 0; nh < 2; ++nh) { \
      bf16x8 bf[4]; \
      _Pragma("unroll") for (int n = 0; n < 4; ++n) bf[n] = *(const LAS bf16x8*)((sa_) + 8192 + (wc * 8 + nh * 4 + n) * 1024 + foff); \
      _Pragma("unroll") for (int m = 0; m < 4; ++m) \
        _Pragma("unroll") for (int n = 0; n < 4; ++n) \
          acc[m][nh * 4 + n] = __builtin_amdgcn_mfma_f32_16x16x32_bf16(bf[n], af[m], acc[m][nh * 4 + n], 0, 0, 0); \
      if (nh == 0) __builtin_amdgcn_sched_barrier(0); } } while (0)
  if constexpr (GL) {
  LAS unsigned char* l0 = lds + t * 16;
#define GEMM_ISSUE(s_) do { LAS unsigned char* d_ = l0 + ((s_) % GEMM_RING) * GEMM_STAGE; const int ko_ = (s_) * 32; \
    __builtin_amdgcn_global_load_lds((const unsigned*)(ga0 + ko_), (LAS unsigned*)(d_), 16, 0, 0); \
    __builtin_amdgcn_global_load_lds((const unsigned*)(ga1 + ko_), (LAS unsigned*)(d_ + 4096), 16, 0, 0); \
    __builtin_amdgcn_global_load_lds((const unsigned*)(gb0 + ko_), (LAS unsigned*)(d_ + 8192), 16, 0, 0); \
    __builtin_amdgcn_global_load_lds((const unsigned*)(gb1 + ko_), (LAS unsigned*)(d_ + 12288), 16, 0, 0); \
    __builtin_amdgcn_global_load_lds((const unsigned*)(gb2 + ko_), (LAS unsigned*)(d_ + 16384), 16, 0, 0); \
    __builtin_amdgcn_global_load_lds((const unsigned*)(gb3 + ko_), (LAS unsigned*)(d_ + 20480), 16, 0, 0); } while (0)
  asm volatile("s_waitcnt vmcnt(0)" ::: "memory");
#pragma unroll
  for (int s_ = 0; s_ < GEMM_RING - 1; ++s_)
    if (s_ < nk) GEMM_ISSUE(s_);
  for (int kt = 0; kt < nk; ++kt) {
    if (kt + 1 < nk) asm volatile("s_waitcnt vmcnt(6)" ::: "memory");
    else asm volatile("s_waitcnt vmcnt(0)" ::: "memory");
    __builtin_amdgcn_s_barrier();
    asm volatile("" ::: "memory");
    if (kt + GEMM_RING - 1 < nk) GEMM_ISSUE(kt + GEMM_RING - 1);
    const LAS unsigned char* sa = lds + (kt % GEMM_RING) * GEMM_STAGE;
    GEMM_COMPUTE(sa);
  }
  __builtin_amdgcn_s_barrier();
  asm volatile("" ::: "memory");
#undef GEMM_ISSUE
  } else {
  for (int kt = 0; kt < nk; ++kt) {
    const int ko = kt * 32;
    const u32x4 a0 = *(const u32x4*)(ga0 + ko), a1 = *(const u32x4*)(ga1 + ko);
    const u32x4 b0 = *(const u32x4*)(gb0 + ko), b1 = *(const u32x4*)(gb1 + ko);
    const u32x4 b2 = *(const u32x4*)(gb2 + ko), b3 = *(const u32x4*)(gb3 + ko);
    *(LAS u32x4*)(lds + t * 16) = a0;
    *(LAS u32x4*)(lds + t * 16 + 4096) = a1;
    *(LAS u32x4*)(lds + t * 16 + 8192) = b0;
    *(LAS u32x4*)(lds + t * 16 + 12288) = b1;
    *(LAS u32x4*)(lds + t * 16 + 16384) = b2;
    *(LAS u32x4*)(lds + t * 16 + 20480) = b3;
    __syncthreads();
    GEMM_COMPUTE(lds);
    __syncthreads();
  }
  }
#undef GEMM_COMPUTE
  epiw(acc, wr, wc, fr, fq);
}

template <int NCT, class AF, class BF, class EPW>
__device__ __forceinline__ void gemm128_stream(int K, AF arow, BF brow, size_t bct, EPW epiw, LAS unsigned char* lds) {
  int t = threadIdx.x;
  OPAQUE(t);
  const int wid = t >> 6, lane = t & 63, wr = wid >> 1, wc = wid & 1, fr = lane & 15, fq = lane >> 4;
  const int sbb = lane * 16, obb = sbb ^ (((sbb >> 9) & 1) << 5);
  const int rin = obb >> 6, cel = (obb & 63) >> 1;
  const bf16_t* ga0 = arow(wid * 16 + rin) + cel;
  const bf16_t* ga1 = arow((wid + 4) * 16 + rin) + cel;
  const bf16_t* gb0 = brow(wid * 16 + rin) + cel;
  const bf16_t* gb1 = brow((wid + 4) * 16 + rin) + cel;
  const bf16_t* gb2 = brow((wid + 8) * 16 + rin) + cel;
  const bf16_t* gb3 = brow((wid + 12) * 16 + rin) + cel;
  f32x4 acc[4][8];
#pragma unroll
  for (int m = 0; m < 4; ++m)
#pragma unroll
    for (int n = 0; n < 8; ++n) acc[m][n] = (f32x4){0.f, 0.f, 0.f, 0.f};
  const int foff = t32_byte(fr, fq * 8);
  const int nk = K >> 5, ns = nk * NCT;
  LAS unsigned char* l0 = lds + t * 16;
  int iss_k = 0;
  size_t iss_b = 0;
#define GEMM_ISSUE2(s_) do { LAS unsigned char* d_ = l0 + ((s_) % GEMM_RING) * GEMM_STAGE; \
    __builtin_amdgcn_global_load_lds((const unsigned*)(ga0 + iss_k), (LAS unsigned*)(d_), 16, 0, 0); \
    __builtin_amdgcn_global_load_lds((const unsigned*)(ga1 + iss_k), (LAS unsigned*)(d_ + 4096), 16, 0, 0); \
    __builtin_amdgcn_global_load_lds((const unsigned*)(gb0 + iss_b + iss_k), (LAS unsigned*)(d_ + 8192), 16, 0, 0); \
    __builtin_amdgcn_global_load_lds((const unsigned*)(gb1 + iss_b + iss_k), (LAS unsigned*)(d_ + 12288), 16, 0, 0); \
    __builtin_amdgcn_global_load_lds((const unsigned*)(gb2 + iss_b + iss_k), (LAS unsigned*)(d_ + 16384), 16, 0, 0); \
    __builtin_amdgcn_global_load_lds((const unsigned*)(gb3 + iss_b + iss_k), (LAS unsigned*)(d_ + 20480), 16, 0, 0); \
    iss_k += 32; if (iss_k == K) { iss_k = 0; iss_b += bct; } } while (0)
  asm volatile("s_waitcnt vmcnt(0)" ::: "memory");
#pragma unroll
  for (int s_ = 0; s_ < GEMM_RING - 1; ++s_)
    if (s_ < ns) GEMM_ISSUE2(s_);
  int kt = 0, ct = 0;
  for (int s_ = 0; s_ < ns; ++s_) {
    if (s_ + 1 < ns) asm volatile("s_waitcnt vmcnt(6)" ::: "memory");
    else asm volatile("s_waitcnt vmcnt(0)" ::: "memory");
    __builtin_amdgcn_s_barrier();
    asm volatile("" ::: "memory");
    if (s_ + GEMM_RING - 1 < ns) GEMM_ISSUE2(s_ + GEMM_RING - 1);
    const LAS unsigned char* sa = lds + (s_ % GEMM_RING) * GEMM_STAGE;
    {
      bf16x8 af[4];
#pragma unroll
      for (int m = 0; m < 4; ++m) af[m] = *(const LAS bf16x8*)(sa + (wr * 4 + m) * 1024 + foff);
#pragma unroll
      for (int nh = 0; nh < 2; ++nh) {
        bf16x8 bf[4];
#pragma unroll
        for (int n = 0; n < 4; ++n) bf[n] = *(const LAS bf16x8*)(sa + 8192 + (wc * 8 + nh * 4 + n) * 1024 + foff);
#pragma unroll
        for (int m = 0; m < 4; ++m)
#pragma unroll
          for (int n = 0; n < 4; ++n)
            acc[m][nh * 4 + n] = __builtin_amdgcn_mfma_f32_16x16x32_bf16(bf[n], af[m], acc[m][nh * 4 + n], 0, 0, 0);
        if (nh == 0) __builtin_amdgcn_sched_barrier(0);
      }
    }
    if (++kt == nk) {
      epiw(ct, acc, wr, wc, fr, fq);
#pragma unroll
      for (int m = 0; m < 4; ++m)
#pragma unroll
        for (int n = 0; n < 8; ++n) acc[m][n] = (f32x4){0.f, 0.f, 0.f, 0.f};
      kt = 0; ++ct;
    }
  }
  __builtin_amdgcn_s_barrier();
  asm volatile("" ::: "memory");
#undef GEMM_ISSUE2
}

__device__ __forceinline__ bool xcd_tile(int it, int tm, int tn, int& mt, int& nt) {
  const int G = gridDim.x, x = blockIdx.x & 7, slot = blockIdx.x >> 3, ns = (G - x + 7) >> 3;
  const int q = slot + it * ns;
  if (tn >= 8) {
    const int cn = (tn - x + 7) >> 3;
    if (q >= cn * tm) return false;
    mt = q / cn; nt = x + 8 * (q % cn);
  } else {
    const int cm = (tm - x + 7) >> 3;
    if (cm <= 0 || q >= cm * tn) return false;
    mt = x + 8 * (q / tn); nt = q % tn;
  }
  return true;
}
__device__ __forceinline__ int find_idx(const int* pre, int n, int v) {
  int lo = 0, hi = n;
  while (hi - lo > 1) {
    const int mid = (lo + hi) >> 1;
    if (pre[mid] <= v) lo = mid; else hi = mid;
  }
  return lo;
}

template <class AL, class BL, class EP>
__device__ __forceinline__ void gemm_phase(int M, int N, int K, AL al, BL bl, EP ep, LAS unsigned char* lds) {
  const int tn = (N + TNW - 1) / TNW, tm = (M + TM - 1) / TM;
  int mt, nt;
  for (int it = 0; xcd_tile(it, tm, tn, mt, nt); ++it) {
    const int m0 = mt * TM, n0 = nt * TNW;
    gemm128<true>(
        K, [&](int r) { return al(min(m0 + r, M - 1)); }, [&](int c) { return bl(min(n0 + c, N - 1)); },
        [&](const f32x4 (&acc)[4][8], int wr, int wc, int fr, int fq) {
#pragma unroll
          for (int m = 0; m < 4; ++m)
#pragma unroll
            for (int n = 0; n < 8; ++n) {
              const int r = m0 + wr * 64 + m * 16 + fr, c = n0 + wc * 128 + n * 16 + 4 * fq;
              if (r < M && c < N) ep(r, c, acc[m][n]);
            }
        },
        lds);
  }
}

__device__ __forceinline__ void convert_tile(const float* W, int ldw, int nvalid, bf16_t* Wt, int ldt, int k0, int n0, LAS unsigned char* lds) {
  int t = threadIdx.x;
  OPAQUE(t);
  const int n4 = t & 31, kg = t >> 5;
  const int ncol = n0 + n4 * 4;
  f32x4 rb[8];
#pragma unroll
  for (int j = 0; j < 8; ++j)
    rb[j] = (ncol < nvalid) ? *(const f32x4*)(W + (size_t)(k0 + kg * 8 + j) * ldw + ncol) : (f32x4){0.f, 0.f, 0.f, 0.f};
#pragma unroll
  for (int c = 0; c < 4; ++c) {
    u32x4 w;
    w.x = cvt_pk_bf16(rb[0][c], rb[1][c]); w.y = cvt_pk_bf16(rb[2][c], rb[3][c]);
    w.z = cvt_pk_bf16(rb[4][c], rb[5][c]); w.w = cvt_pk_bf16(rb[6][c], rb[7][c]);
    *(LAS u32x4*)(lds + (n4 * 4 + c) * 144 + kg * 16) = w;
  }
  __syncthreads();
#pragma unroll
  for (int i = 0; i < 4; ++i) {
    const int q = t + i * 256, row = q >> 3, piece = q & 7;
    if (n0 + row < nvalid) *(u32x4*)(Wt + (size_t)(n0 + row) * ldt + k0 + piece * 8) = *(const LAS u32x4*)(lds + row * 144 + piece * 16);
  }
  __syncthreads();
}

typedef short s16x4 __attribute__((ext_vector_type(4)));
#define REDERIVE() do { OPAQUE(t); w = t >> 6; lane = t & 63; fr = lane & 15; fq = lane >> 4; rloc = w * 16 + fr; } while (0)
constexpr int VROW = 160;

__device__ __forceinline__ bf16x8 pack8(const f32x4 a, const f32x4 b) {
  u32x4 w;
  w.x = cvt_pk_bf16(a[0], a[1]); w.y = cvt_pk_bf16(a[2], a[3]);
  w.z = cvt_pk_bf16(b[0], b[1]); w.w = cvt_pk_bf16(b[2], b[3]);
  return __builtin_bit_cast(bf16x8, w);
}
__device__ __forceinline__ void tile_fetch(bf16x8 (&r)[2], const unsigned short* base, int t) {
  const bf16x8* q = (const bf16x8*)(base + t * 16);
  r[0] = q[0];
  r[1] = q[1];
}
__device__ __forceinline__ void stage_k(const bf16x8 (&r)[2], LAS unsigned char* ldsK, int t) {
  const int row = t >> 2, c0 = (t & 3) * 16;
  *(LAS bf16x8*)(ldsK + lds_byte(row, c0)) = r[0];
  *(LAS bf16x8*)(ldsK + lds_byte(row, c0 + 8)) = r[1];
}
__device__ __forceinline__ void stage_v(const bf16x8 (&r)[2], LAS unsigned char* ldsV, int t) {
  const int row = t >> 2, c0 = (t & 3) * 16;
  *(LAS bf16x8*)(ldsV + row * VROW + c0 * 2) = r[0];
  *(LAS bf16x8*)(ldsV + row * VROW + c0 * 2 + 16) = r[1];
}
template <int H>
__device__ __forceinline__ void attn_qk_h(f32x4 (&s)[4][2], const bf16x8 (&qf)[4][2], LAS unsigned char* ldsK, int fr, int fq) {
  const int koff = lds_byte(fr, fq * 8);
#pragma unroll
  for (int m = 0; m < 4; ++m)
#pragma unroll
    for (int nn = 0; nn < 2; ++nn) s[m][nn] = (f32x4){0.f, 0.f, 0.f, 0.f};
#pragma unroll
  for (int nn = 0; nn < 2; ++nn)
#pragma unroll
    for (int ks = 0; ks < 2; ++ks) {
      const bf16x8 kf = *(const LAS bf16x8*)(ldsK + koff + (2 * H + nn) * 2048 + ks * 1024);
#pragma unroll
      for (int m = 0; m < 4; ++m) s[m][nn] = __builtin_amdgcn_mfma_f32_16x16x32_bf16(kf, qf[m][ks], s[m][nn], 0, 0, 0);
    }
}
template <int H>
__device__ __forceinline__ void attn_pv_h(f32x4 (&o)[4][4], const bf16x8 (&pf)[4], LAS unsigned char* ldsV, int lane) {
  const int fq = lane >> 4, i = lane & 15;
  const int vbase = (4 * fq + (i >> 2)) * VROW + (i & 3) * 8;
#pragma unroll
  for (int dt = 0; dt < 4; ++dt) {
    LAS unsigned char* a0 = ldsV + vbase + H * 32 * VROW + dt * 32;
    const s16x4 v0 = __builtin_amdgcn_ds_read_tr16_b64_v4i16((LAS s16x4*)a0);
    const s16x4 v1 = __builtin_amdgcn_ds_read_tr16_b64_v4i16((LAS s16x4*)(a0 + 16 * VROW));
    bf16x8 vf;
    vf[0] = v0[0]; vf[1] = v0[1]; vf[2] = v0[2]; vf[3] = v0[3];
    vf[4] = v1[0]; vf[5] = v1[1]; vf[6] = v1[2]; vf[7] = v1[3];
#pragma unroll
    for (int m = 0; m < 4; ++m) o[m][dt] = __builtin_amdgcn_mfma_f32_16x16x32_bf16(vf, pf[m], o[m][dt], 0, 0, 0);
  }
}
template <int H, bool EM>
__device__ __forceinline__ void attn_softmax_h(f32x4 (&s)[4][2], f32x4 (&o)[4][4], float (&mrow)[4], float (&lrow)[4],
                                               bf16x8 (&pf)[4], bool rowok, int lo, int hi, int fq) {
#pragma unroll
  for (int m = 0; m < 4; ++m) {
    float mx = -INFINITY;
#pragma unroll
    for (int nn = 0; nn < 2; ++nn)
#pragma unroll
      for (int jj = 0; jj < 4; ++jj) {
        constexpr int dummy2 = 0; (void)dummy2;
        const int kc = 16 * (2 * H + nn) + jj;
        const bool ok = rowok && (!EM || (lo < kc && hi >= kc));
        const float v = ok ? s[m][nn][jj] : -INFINITY;
        s[m][nn][jj] = v;
        mx = fmaxf(mx, v);
      }
    mx = fmaxf(mx, __shfl_xor(mx, 16));
    mx = fmaxf(mx, __shfl_xor(mx, 32));
    const float mnew = fmaxf(mrow[m], mx);
    const float msafe = (mnew == -INFINITY) ? 0.f : mnew;
    const float alpha = __builtin_amdgcn_exp2f(mrow[m] - msafe);
    mrow[m] = mnew;
    float ls = 0.f;
#pragma unroll
    for (int nn = 0; nn < 2; ++nn)
#pragma unroll
      for (int jj = 0; jj < 4; ++jj) {
        const float pv = __builtin_amdgcn_exp2f(s[m][nn][jj] - msafe);
        s[m][nn][jj] = pv;
        ls += pv;
      }
    lrow[m] = lrow[m] * alpha + ls;
#pragma unroll
    for (int dt = 0; dt < 4; ++dt) o[m][dt] = o[m][dt] * alpha;
    pf[m] = pack8(s[m][0], s[m][1]);
  }
}
template <int H, bool EM>
__device__ __forceinline__ void attn_sub(f32x4 (&o)[4][4], float (&mrow)[4], float (&lrow)[4], const bf16x8 (&qf)[4][2],
                                         LAS unsigned char* ldsK, LAS unsigned char* ldsV, bool rowok, int lo, int hi, int lane) {
  f32x4 s[4][2];
  bf16x8 pf[4];
  __builtin_amdgcn_sched_barrier(0);
  attn_qk_h<H>(s, qf, ldsK, lane & 15, lane >> 4);
  __builtin_amdgcn_sched_barrier(0);
  attn_softmax_h<H, EM>(s, o, mrow, lrow, pf, rowok, lo, hi, lane >> 4);
  __builtin_amdgcn_sched_barrier(0);
  attn_pv_h<H>(o, pf, ldsV, lane);
  __builtin_amdgcn_sched_barrier(0);
}
template <bool EM>
__device__ __forceinline__ void attn_tile(f32x4 (&o)[4][4], float (&mrow)[4], float (&lrow)[4], const bf16x8 (&qf)[4][2],
                                          LAS unsigned char* ldsK, LAS unsigned char* ldsV, bool rowok, int lo, int hi, int lane) {
  attn_sub<0, EM>(o, mrow, lrow, qf, ldsK, ldsV, rowok, lo, hi, lane);
  attn_sub<1, EM>(o, mrow, lrow, qf, ldsK, ldsV, rowok, lo, hi, lane);
}
template <int H>
__device__ __forceinline__ void cmp_stats(float (&mrow)[4], float (&lrow)[4], const bf16x8 (&qf)[4][2], LAS unsigned char* ldsK, int hi, int lane) {
  const int fq = lane >> 4;
  f32x4 s[4][2];
  __builtin_amdgcn_sched_barrier(0);
  attn_qk_h<H>(s, qf, ldsK, lane & 15, fq);
  __builtin_amdgcn_sched_barrier(0);
#pragma unroll
  for (int m = 0; m < 4; ++m) {
    float mx = -INFINITY;
#pragma unroll
    for (int nn = 0; nn < 2; ++nn)
#pragma unroll
      for (int jj = 0; jj < 4; ++jj) {
        const int kc = 16 * (2 * H + nn) + jj;
        const float v = (hi >= kc) ? s[m][nn][jj] : -INFINITY;
        s[m][nn][jj] = v;
        mx = fmaxf(mx, v);
      }
    mx = fmaxf(mx, __shfl_xor(mx, 16));
    mx = fmaxf(mx, __shfl_xor(mx, 32));
    const float mnew = fmaxf(mrow[m], mx);
    const float msafe = (mnew == -INFINITY) ? 0.f : mnew;
    float ls = 0.f;
#pragma unroll
    for (int nn = 0; nn < 2; ++nn)
#pragma unroll
      for (int jj = 0; jj < 4; ++jj) ls += __builtin_amdgcn_exp2f(s[m][nn][jj] - msafe);
    lrow[m] = lrow[m] * __builtin_amdgcn_exp2f(mrow[m] - msafe) + ls;
    mrow[m] = mnew;
  }
  __builtin_amdgcn_sched_barrier(0);
}
template <int H>
__device__ __forceinline__ void cmp_apply(f32x4 (&o)[4][4], const float (&msf)[4], const float (&linv)[4], float& lastprev, LAS float* improw,
                                          const bf16x8 (&qf)[4][2], LAS unsigned char* ldsK, LAS unsigned char* ldsV, int hi, int lane) {
  const int fq = lane >> 4;
  f32x4 s[4][2];
  bf16x8 pf[4];
  __builtin_amdgcn_sched_barrier(0);
  attn_qk_h<H>(s, qf, ldsK, lane & 15, fq);
  __builtin_amdgcn_sched_barrier(0);
#pragma unroll
  for (int m = 0; m < 4; ++m) {
#pragma unroll
    for (int nn = 0; nn < 2; ++nn)
#pragma unroll
      for (int jj = 0; jj < 4; ++jj) {
        const int kc = 16 * (2 * H + nn) + jj;
        s[m][nn][jj] = (hi >= kc) ? __builtin_amdgcn_exp2f(s[m][nn][jj] - msf[m]) * linv[m] : 0.f;
      }
    pf[m] = pack8(s[m][0], s[m][1]);
  }
#pragma unroll
  for (int nn = 0; nn < 2; ++nn) {
    float gs = 0.f, last = 0.f;
#pragma unroll
    for (int m = 0; m < 4; ++m) {
      gs += (s[m][nn][0] + s[m][nn][1]) + (s[m][nn][2] + s[m][nn][3]);
      last += s[m][nn][3];
    }
    const float pa = __shfl(last, (lane + 48) & 63);
    const float pb = __shfl(lastprev, (lane + 48) & 63);
    improw[(2 * H + nn) * 4 + fq] = gs + ((fq > 0) ? pa : pb);
    lastprev = last;
  }
  __builtin_amdgcn_sched_barrier(0);
  attn_pv_h<H>(o, pf, ldsV, lane);
  __builtin_amdgcn_sched_barrier(0);
}

__device__ __forceinline__ void attn_chunk(const Params& p, LAS unsigned char* lds, int b, int g, int ci) {
  int t = threadIdx.x;
  OPAQUE(t);
  int w = t >> 6, lane = t & 63, fr = lane & 15, fq = lane >> 4;
  LAS unsigned char* ldsK = lds;
  LAS unsigned char* ldsV = lds + 8192;
  LAS float* impb = (LAS float*)(lds + 18432) + w * 1024;
  LAS unsigned* unib = (LAS unsigned*)(lds + 18432 + 16384);
  int rloc = w * 16 + fr;
  const int tq = ci * 64 + rloc;
  const size_t tok = (size_t)b * S + tq;
  const float* grow = p.gn + tok * 24 + g * 12;
  float* orow = p.onsa + tok * 512 + g * 256;
  bf16x8 qf[4][2];
#pragma unroll
  for (int m = 0; m < 4; ++m)
#pragma unroll
    for (int ks = 0; ks < 2; ++ks)
      qf[m][ks] = *(const bf16x8*)(p.qb + tok * 512 + (g * 4 + m) * 64 + ks * 32 + fq * 8);
  f32x4 o[4][4];
  float mrow[4], lrow[4];
  bf16x8 rk[2], rv[2];

  const int nvis = (tq >= 31) ? ((tq - 31) / 16 + 1) : 0;
  const int nvmax = 4 * ci + 3;
  const int ntc = (nvmax + 63) >> 6;
  const unsigned short* kcb = p.cmpb + (size_t)((0 * NB + b) * 2 + g) * 256 * 64;
  const unsigned short* vcb = p.cmpb + (size_t)((1 * NB + b) * 2 + g) * 256 * 64;
#pragma unroll
  for (int m = 0; m < 4; ++m) { mrow[m] = -INFINITY; lrow[m] = 0.f; }
  REDERIVE();
  for (int tc = 0; tc < ntc; ++tc) {
    tile_fetch(rk, kcb + (size_t)tc * 4096, t);
    stage_k(rk, ldsK, t);
    __syncthreads();
    const int hi = nvis - 1 - tc * 64 - 4 * fq;
    cmp_stats<0>(mrow, lrow, qf, ldsK, hi, lane);
    cmp_stats<1>(mrow, lrow, qf, ldsK, hi, lane);
    __syncthreads();
  }
  {
    float linv[4], msf[4];
#pragma unroll
    for (int m = 0; m < 4; ++m) {
      float l = lrow[m];
      l += __shfl_xor(l, 16);
      l += __shfl_xor(l, 32);
      linv[m] = (l > 0.f) ? 1.0f / l : 0.f;
      msf[m] = (mrow[m] == -INFINITY) ? 0.f : mrow[m];
    }
    REDERIVE();
#pragma unroll
    for (int m = 0; m < 4; ++m)
#pragma unroll
      for (int dt = 0; dt < 4; ++dt) o[m][dt] = (f32x4){0.f, 0.f, 0.f, 0.f};
    float lastprev = 0.f;
    for (int tc = 0; tc < ntc; ++tc) {
      tile_fetch(rk, kcb + (size_t)tc * 4096, t);
      tile_fetch(rv, vcb + (size_t)tc * 4096, t);
      stage_k(rk, ldsK, t);
      stage_v(rv, ldsV, t);
      __syncthreads();
      const int hi = nvis - 1 - tc * 64 - 4 * fq;
      cmp_apply<0>(o, msf, linv, lastprev, impb + fr * 64 + tc * 16, qf, ldsK, ldsV, hi, lane);
      cmp_apply<1>(o, msf, linv, lastprev, impb + fr * 64 + tc * 16, qf, ldsK, ldsV, hi, lane);
      __syncthreads();
    }
  }
#pragma unroll
  for (int m = 0; m < 4; ++m) {
    const float gate = grow[m * 3 + 0];
#pragma unroll
    for (int dt = 0; dt < 4; ++dt) *(f32x4*)(orow + m * 64 + dt * 16 + 4 * fq) = o[m][dt] * gate;
  }
  unsigned mlo, mhi;
  REDERIVE();
  {
    WSYNC();
    float kv[16];
    const int c0 = -fq * 16, c1 = ci - fq * 16;
#pragma unroll
    for (int i = 0; i < 16; ++i) {
      const bool forced = (c0 == i) || (c1 == i) || (c1 == i + 1);
      float v = (c1 >= i) ? impb[fr * 64 + fq * 16 + i] : -INFINITY;
      if (forced) v = INFINITY;
      kv[i] = v;
    }
    WSYNC();
#pragma unroll
    for (int i = 0; i < 16; ++i) impb[fr * 64 + fq * 16 + i] = kv[i];
    WSYNC();
    int rank[16];
#pragma unroll
    for (int i = 0; i < 16; ++i) rank[i] = 0;
#pragma unroll 2
    for (int k = 0; k < 64; ++k) {
      const float ok = impb[fr * 64 + k];
      const int kq = k - fq * 16;
#pragma unroll
      for (int i = 0; i < 16; ++i) rank[i] += (ok > kv[i] || (ok == kv[i] && kq < i)) ? 1 : 0;
    }
    unsigned piece = 0;
#pragma unroll
    for (int i = 0; i < 16; ++i) piece |= (rank[i] < 16) ? (1u << i) : 0u;
    unsigned lo32 = (fq == 0) ? piece : (fq == 1) ? (piece << 16) : 0u;
    unsigned hi32 = (fq == 2) ? piece : (fq == 3) ? (piece << 16) : 0u;
    lo32 |= __shfl_xor(lo32, 16); lo32 |= __shfl_xor(lo32, 32);
    hi32 |= __shfl_xor(hi32, 16); hi32 |= __shfl_xor(hi32, 32);
    mlo = lo32; mhi = hi32;
    unsigned ulo = lo32, uhi = hi32;
#pragma unroll
    for (int off = 1; off < 16; off <<= 1) { ulo |= __shfl_xor(ulo, off); uhi |= __shfl_xor(uhi, off); }
    if (lane == 0) { unib[w * 2] = ulo; unib[w * 2 + 1] = uhi; }
    __syncthreads();
  }
  unsigned long long un;
  {
    const unsigned ulo = unib[0] | unib[2] | unib[4] | unib[6];
    const unsigned uhi = unib[1] | unib[3] | unib[5] | unib[7];
    un = ((unsigned long long)__builtin_amdgcn_readfirstlane(uhi) << 32) | (unsigned long long)__builtin_amdgcn_readfirstlane(ulo);
  }
  const unsigned long long rowmask = ((unsigned long long)mhi << 32) | mlo;

#pragma unroll 1
  for (int pass = 0; pass < 2; ++pass) {
    REDERIVE();
#pragma unroll
    for (int m = 0; m < 4; ++m) {
      mrow[m] = -INFINITY; lrow[m] = 0.f;
#pragma unroll
      for (int dt = 0; dt < 4; ++dt) o[m][dt] = (f32x4){0.f, 0.f, 0.f, 0.f};
    }
    const unsigned short* kb = p.kvb + (size_t)(((2 + 2 * pass) * NB + b) * 2 + g) * S * 64;
    const unsigned short* vb = p.kvb + (size_t)(((3 + 2 * pass) * NB + b) * 2 + g) * S * 64;
    const unsigned long long upto = (ci == 63) ? ~0ull : ((1ull << (ci + 1)) - 1ull);
    const int jlo = max(0, ci - 8);
    unsigned long long rem = pass ? (upto & ~((1ull << jlo) - 1ull)) : (un & upto);
    const int jwin0 = pass ? ci - 8 : -100;
    int j = __ffsll((long long)rem) - 1;
    tile_fetch(rk, kb + (size_t)j * 4096, t);
    tile_fetch(rv, vb + (size_t)j * 4096, t);
    while (rem) {
      rem &= rem - 1;
      stage_k(rk, ldsK, t);
      stage_v(rv, ldsV, t);
      __syncthreads();
      const int jn = rem ? (__ffsll((long long)rem) - 1) : -1;
      if (jn >= 0) {
        tile_fetch(rk, kb + (size_t)jn * 4096, t);
        tile_fetch(rv, vb + (size_t)jn * 4096, t);
      }
      const bool rowok = pass ? true : (bool)((rowmask >> j) & 1ull);
      int hi = (j == ci) ? rloc : 63;
      const int lo = ((j == jwin0) ? rloc : -1) - 4 * fq;
      hi = (rowok ? hi : -1000) - 4 * fq;
      attn_tile<true>(o, mrow, lrow, qf, ldsK, ldsV, true, lo, hi, lane);
      __syncthreads();
      j = jn;
    }
#pragma unroll
    for (int m = 0; m < 4; ++m) {
      float l = lrow[m];
      l += __shfl_xor(l, 16);
      l += __shfl_xor(l, 32);
      const float sc = grow[m * 3 + 1 + pass] / l;
#pragma unroll
      for (int dt = 0; dt < 4; ++dt) {
        f32x4* dst = (f32x4*)(orow + m * 64 + dt * 16 + 4 * fq);
        const f32x4 tot = *dst + o[m][dt] * sc;
        if (pass == 0) *dst = tot;
        else *(uint2*)(p.onsab + tok * 512 + g * 256 + m * 64 + dt * 16 + 4 * fq) = pack4(tot);
      }
    }
  }
}

#define XB_TMO      128
#define XB_XCNT(j)  (256  + 64 * (j))
#define XB_XSUB(j)  (1280 + 64 * (j))
#define XB_XGEN(j)  (2304 + 64 * (j))
#define XB_TOP      3328
#define XB_TOPGEN   3392
#define XCD_BAR_WORDS 3456
#define XB_SPIN_CAP (1u << 18)

__device__ __forceinline__ unsigned xb_ld(unsigned* p)              { return __hip_atomic_load(p, __ATOMIC_RELAXED, __HIP_MEMORY_SCOPE_AGENT); }
__device__ __forceinline__ unsigned xb_add(unsigned* p, unsigned v) { return __hip_atomic_fetch_add(p, v, __ATOMIC_RELAXED, __HIP_MEMORY_SCOPE_AGENT); }
__device__ __forceinline__ unsigned xb_xcc_id() { return (unsigned)__builtin_amdgcn_s_getreg((3 << 11) | 20) & 0xFu; }
#define XB_SPIN(cond, bar) do { unsigned _sp = 0; while (cond) { __builtin_amdgcn_s_sleep(1); \
    if ((++_sp & 255u) == 0u) { if (xb_ld(&(bar)[XB_TMO])) break; if (_sp > XB_SPIN_CAP) { atomicAdd(&(bar)[XB_TMO], 1u); break; } } } } while (0)

struct XcdBarrier {
    unsigned* bar; unsigned x;
    volatile LAS unsigned* st;
};

__device__ __forceinline__ XcdBarrier xcd_barrier_post(unsigned* bar, volatile LAS unsigned* st) {
    XcdBarrier b; b.bar = bar; b.x = xb_xcc_id(); b.st = st;
    if (threadIdx.x == 0) (void)xb_add(&bar[XB_XCNT(b.x)], 1u);
    return b;
}
__device__ __forceinline__ void xcd_barrier_complete(unsigned* bar, unsigned x, unsigned& nloc, unsigned& nx) {
    const unsigned G = gridDim.x * gridDim.y * gridDim.z;
    unsigned sum, cnt, mine, sp = 0u;
    for (;;) {
        sum = 0u; cnt = 0u; mine = 0u;
#pragma unroll
        for (unsigned j = 0; j < 16; ++j) { const unsigned c = xb_ld(&bar[XB_XCNT(j)]); sum += c; cnt += (c > 0u) ? 1u : 0u; mine = (j == x) ? c : mine; }
        if (sum == G) break;
        __builtin_amdgcn_s_sleep(1);
        if ((++sp & 255u) == 0u) { if (xb_ld(&bar[XB_TMO])) break; if (sp > XB_SPIN_CAP) { atomicAdd(&bar[XB_TMO], 1u); break; } }
    }
    nloc = mine > 0u ? mine : 1u; nx = cnt > 0u ? cnt : 1u;
}

__device__ __forceinline__ void xcd_barrier(const XcdBarrier& b) {
    asm volatile("s_waitcnt vmcnt(0)" ::: "memory");
    __syncthreads();
    if (threadIdx.x == 0) {
        unsigned* bar = b.bar;
        __builtin_amdgcn_s_waitcnt(0);
        unsigned nloc = b.st[0], nx = b.st[1];
        if (nloc == 0u) { xcd_barrier_complete(bar, b.x, nloc, nx); b.st[0] = nloc; b.st[1] = nx; }
        const unsigned old = xb_add(&bar[XB_XSUB(b.x)], 1u);
        const unsigned gen = old / nloc;
        if (old + 1u == (gen + 1u) * nloc) {
            __builtin_amdgcn_fence(__ATOMIC_RELEASE, "agent");
            asm volatile("s_waitcnt vmcnt(0)" ::: "memory");
            const unsigned og = xb_add(&bar[XB_TOP], 1u);
            const unsigned tg = og / nx;
            if (og + 1u == (tg + 1u) * nx) xb_add(&bar[XB_TOPGEN], 1u);
            else XB_SPIN(xb_ld(&bar[XB_TOPGEN]) == tg, bar);
            __builtin_amdgcn_fence(__ATOMIC_ACQUIRE, "agent");
            xb_add(&bar[XB_XGEN(b.x)], 1u);
            asm volatile("s_waitcnt vmcnt(0)" ::: "memory");
        } else {
            XB_SPIN(xb_ld(&bar[XB_XGEN(b.x)]) == gen, bar);
            __builtin_amdgcn_fence(__ATOMIC_ACQUIRE, "agent");
            asm volatile("s_waitcnt vmcnt(0)" ::: "memory");
        }
    }
    __syncthreads();
}


#define PHASE_IDX int t_ = threadIdx.x; OPAQUE(t_); const int tid = t_, lane = t_ & 63, wib = t_ >> 6; \
  const int gthreads = gridDim.x * 256, gtid = blockIdx.x * 256 + t_, gwaves = gridDim.x * 4, gwave = blockIdx.x * 4 + wib; \
  (void)tid; (void)lane; (void)wib; (void)gthreads; (void)gtid; (void)gwaves; (void)gwave;

constexpr int SMEM_BYTES = GEMM_RING * GEMM_STAGE;

__device__ __forceinline__ void conv_job(const float* W, int K, int N, bf16_t* Wt, int tile, LAS unsigned char* lds) {
  const int tnn = (N + 127) >> 7;
  convert_tile(W, N, N, Wt, K, (tile / tnn) * 64, (tile % tnn) * 128, lds);
}

__global__ void __launch_bounds__(256, 2) mega(Params p) {
  __shared__ __attribute__((aligned(16))) unsigned char smem_raw[SMEM_BYTES + 16];
  float* smem = (float*)smem_raw;
  LAS unsigned char* lds = (LAS unsigned char*)smem_raw;
  volatile LAS unsigned* xb_st = (volatile LAS unsigned*)(lds + SMEM_BYTES);
  if (threadIdx.x < 4) xb_st[threadIdx.x] = 0u;
  __syncthreads();
  const XcdBarrier gbar = xcd_barrier_post(p.bar, xb_st);

  {
  PHASE_IDX
  if (blockIdx.x < 96) {
    for (int i = tid; i < NB * D; i += 256) smem[i] = siluf_(p.c[i]);
    __syncthreads();
    const int j = blockIdx.x * 64 + lane;
    float a0 = 0.f, a1 = 0.f, a2 = 0.f, a3 = 0.f;
    const float* wp = p.w_ada + (size_t)(wib * 256) * (6 * D) + j;
#pragma unroll 8
    for (int k = 0; k < 256; ++k) {
      const float w = wp[(size_t)k * (6 * D)];
      const int kk = wib * 256 + k;
      a0 = fmaf(smem[kk], w, a0); a1 = fmaf(smem[D + kk], w, a1);
      a2 = fmaf(smem[2 * D + kk], w, a2); a3 = fmaf(smem[3 * D + kk], w, a3);
    }
    __syncthreads();
    smem[(wib * 4 + 0) * 64 + lane] = a0; smem[(wib * 4 + 1) * 64 + lane] = a1;
    smem[(wib * 4 + 2) * 64 + lane] = a2; smem[(wib * 4 + 3) * 64 + lane] = a3;
    __syncthreads();
    {
      const int b = wib;
      const float v = p.b_ada[j] + ((smem[(0 * 4 + b) * 64 + lane] + smem[(1 * 4 + b) * 64 + lane]) +
                                    (smem[(2 * 4 + b) * 64 + lane] + smem[(3 * 4 + b) * 64 + lane]));
      p.mod[b * 6 * D + j] = v;
    }
    __syncthreads();
  }
  for (int idx = gtid; idx < 32 * 64; idx += gthreads) {
    const int g = idx / 64;
    const double dt = exp((double)p.log_dt[g]);
    const double lr = p.a_re[idx], li = p.a_im[idx];
    double br = 1.0, bi = 0.0;
    for (int d = 0; d <= 16; ++d) {
      const double mag = exp(lr * dt * d);
      const double pr_ = mag * cos(li * dt * d), pi_ = mag * sin(li * dt * d);
      p.pw[(idx * 17 + d) * 2] = (float)pr_;
      p.pw[(idx * 17 + d) * 2 + 1] = (float)pi_;
      if (d == 1) { br = pr_; bi = pi_; }
    }
    const double nr = br - 1.0, ni = bi;
    const double den = lr * lr + li * li;
    const double cr = (nr * lr + ni * li) / den, ci = (ni * lr - nr * li) / den;
    for (int q = 0; q < 16; ++q) {
      const double wr = p.b_re[idx * 16 + q], wi = p.b_im[idx * 16 + q];
      p.bbar[(idx * 16 + q) * 2] = (float)(cr * wr - ci * wi);
      p.bbar[(idx * 16 + q) * 2 + 1] = (float)(cr * wi + ci * wr);
    }
  }
  for (int idx = gtid; idx < NE; idx += gthreads) { p.cnt[idx] = 0; p.cursor[idx] = 0; }
  for (int o = gwave; o < 512; o += gwaves) {
    const int kv = o >> 8, j = o & 255;
    const float* pe = kv ? p.pe_v : p.pe_k;
    const float* w1 = kv ? p.w_cmp_v1 : p.w_cmp_k1;
    float acc = 0.f;
    for (int k = lane; k < 2048; k += 64) acc = fmaf(pe[k], w1[(size_t)k * 256 + j], acc);
    acc = wsum(acc);
    if (lane == 0) p.cbias[o] = acc;
  }
  {
    const int G = gridDim.x;
    const int first = (G > 96) ? 96 : 0, nb = G - first;
    if ((int)blockIdx.x >= first) {
      for (int job = blockIdx.x - first; job < 1040; job += nb) {
        if (job < 496) conv_job(p.w_in, D, INC, p.w_inT, job, lds);
        else if (job < 560) conv_job(p.w_cmp_k1, 2048, 256, p.wc1T, job - 496, lds);
        else if (job < 624) conv_job(p.w_cmp_v1, 2048, 256, p.wc1T + 256 * 2048, job - 560, lds);
        else if (job < 656) conv_job(p.w_glu, 512, 512, p.wgluT, job - 624, lds);
        else if (job < 720) conv_job(p.w_up_attn, 512, D, p.wuaT, job - 656, lds);
        else if (job < 784) conv_job(p.w_up_ssm, 512, D, p.wusT, job - 720, lds);
        else if (job < 912) conv_job(p.w_out, D, D, p.woutT, job - 784, lds);
        else if (job < 944) conv_job(p.w_router, D, NE, p.wrT, job - 912, lds);
        else if (job < 976) conv_job(p.ws_gate, D, DE, p.wsgT, job - 944, lds);
        else if (job < 1008) conv_job(p.ws_up, D, DE, p.wsuT, job - 976, lds);
        else conv_job(p.ws_down, DE, D, p.wsdT, job - 1008, lds);
      }
    }
  }
  }
  xcd_barrier(gbar);

  {
  PHASE_IDX
  for (int row = gwave; row < NT; row += gwaves) {
    const int b = row / S;
    const float* xr = p.x + (size_t)row * D;
    f32x4 v[4];
    float ss = 0.f;
#pragma unroll
    for (int i = 0; i < 4; ++i) {
      v[i] = *(const f32x4*)(xr + i * 256 + lane * 4);
      ss += (v[i][0] * v[i][0] + v[i][1] * v[i][1]) + (v[i][2] * v[i][2] + v[i][3] * v[i][3]);
    }
    ss = wsum(ss);
    const float r = rsqrtf(ss * (1.0f / D) + EPS);
    const float* md = p.mod + b * 6 * D;
#pragma unroll
    for (int i = 0; i < 4; ++i) {
      const int col = i * 256 + lane * 4;
      const f32x4 gg = *(const f32x4*)(p.g_norm1 + col), sc = *(const f32x4*)(md + D + col), sh = *(const f32x4*)(md + col);
      *(uint2*)(p.h + (size_t)row * D + col) = pack4(v[i] * r * gg * (sc + 1.0f) + sh);
    }
  }
  for (int idx = gtid; idx < 32 * 128 * 256; idx += gthreads) {
    const int k = idx & 255, col = (idx >> 8) & 127, g = idx >> 15;
    const int n = col >> 1, ri = col & 1, sidx = k >> 4, q = k & 15;
    const int gn = g * 64 + n;
    const float pr_ = p.pw[(gn * 17 + 15 - sidx) * 2], pi_ = p.pw[(gn * 17 + 15 - sidx) * 2 + 1];
    const float br = p.bbar[(gn * 16 + q) * 2], bi = p.bbar[(gn * 16 + q) * 2 + 1];
    const float v = ri ? (pr_ * bi + pi_ * br) : (pr_ * br - pi_ * bi);
    p.w1T[idx] = (bf16_t)(cvt_pk_bf16(v, 0.f) & 0xffffu);
  }
  for (int idx = gtid; idx < 32 * 16 * 256; idx += gthreads) {
    const int q = idx & 15, pp = (idx >> 4) & 15, d = (idx >> 8) & 15, g = idx >> 12;
    float acc = (d == 0 && pp == q) ? p.d_skip[g * 16 + pp] : 0.f;
    for (int n = 0; n < 64; ++n) {
      const int gn = g * 64 + n;
      const float cr = p.c_re[(g * 16 + pp) * 64 + n], ci = p.c_im[(g * 16 + pp) * 64 + n];
      const float pr_ = p.pw[(gn * 17 + d) * 2], pi_ = p.pw[(gn * 17 + d) * 2 + 1];
      const float br = p.bbar[(gn * 16 + q) * 2], bi = p.bbar[(gn * 16 + q) * 2 + 1];
      const float tr = cr * pr_ - ci * pi_, ti = cr * pi_ + ci * pr_;
      acc += tr * br - ti * bi;
    }
    p.kd[idx] = acc;
  }
  for (int idx = gtid; idx < 32 * 256 * 128; idx += gthreads) {
    const int k = idx & 127, col = (idx >> 7) & 255, g = idx >> 15;
    const int i = col >> 4, pp = col & 15, n = k >> 1, ri = k & 1;
    const int gn = g * 64 + n;
    const float cr = p.c_re[(g * 16 + pp) * 64 + n], ci = p.c_im[(g * 16 + pp) * 64 + n];
    const float pr_ = p.pw[(gn * 17 + i + 1) * 2], pi_ = p.pw[(gn * 17 + i + 1) * 2 + 1];
    const float v = ri ? -(cr * pi_ + ci * pr_) : (cr * pr_ - ci * pi_);
    p.wyT[((size_t)g * 256 + col) * 384 + k] = (bf16_t)(cvt_pk_bf16(v, 0.f) & 0xffffu);
  }
  }
  xcd_barrier(gbar);

  {
  PHASE_IDX
  {
    constexpr int TN = (INC + TNW - 1) / TNW;
    int mt_, nt_;
    for (int it = 0; xcd_tile(it, NT / TM, TN, mt_, nt_); ++it) {
      const int m0 = mt_ * TM, n0 = nt_ * TNW;
      gemm128<true>(
          D, [&](int r) { return p.h + (size_t)(m0 + r) * D; },
          [&](int c) { return p.w_inT + (size_t)min(n0 + c, INC - 1) * D; },
          [&](const f32x4 (&acc)[4][8], int wr, int wc, int fr, int fq) {
#pragma unroll
            for (int sg = 0; sg < 2; ++sg) {
              const int cw = n0 + wc * 128 + sg * 64;
              if (cw < C_GN) {
                const bool isq = cw < C_KC;
                const int slot = isq ? 0 : (cw - C_KC) >> 7, gg = isq ? 0 : ((cw - C_KC) >> 6) & 1;
                const bool norm = isq || slot == 2 || slot == 4;
                const float* gain = isq ? p.q_gain : (slot == 2 ? p.ks_gain : p.kw_gain);
                const float post = isq ? ATT_SCALE * 1.4426950408889634f : 1.0f;
#pragma unroll
                for (int m = 0; m < 4; ++m) {
                  const int tok = m0 + wr * 64 + m * 16 + fr;
                  float r = 1.0f;
                  if (norm) {
                    float ss = 0.f;
#pragma unroll
                    for (int n = 0; n < 4; ++n)
#pragma unroll
                      for (int jj = 0; jj < 4; ++jj) ss = fmaf(acc[m][sg * 4 + n][jj], acc[m][sg * 4 + n][jj], ss);
                    ss += __shfl_xor(ss, 16);
                    ss += __shfl_xor(ss, 32);
                    r = rsqrtf(ss * (1.0f / 64) + EPS) * post;
                  }
                  bf16_t* dst = isq ? p.qb + (size_t)tok * 512 + cw
                                    : p.kvb + ((size_t)((slot * NB + (tok >> 12)) * 2 + gg) * S + (tok & (S - 1))) * 64;
#pragma unroll
                  for (int n = 0; n < 4; ++n) {
                    f32x4 v = acc[m][sg * 4 + n] * r;
                    if (norm) v = v * *(const f32x4*)(gain + n * 16 + 4 * fq);
                    *(uint2*)(dst + n * 16 + 4 * fq) = pack4(v);
                  }
                }
              } else {
#pragma unroll
                for (int m = 0; m < 4; ++m) {
                  const size_t tok = m0 + wr * 64 + m * 16 + fr;
#pragma unroll
                  for (int n = 0; n < 4; ++n) {
                    const int c = cw + n * 16 + 4 * fq;
                    if (c < INC) {
                      f32x4 v = acc[m][sg * 4 + n];
                      if (c >= C_U && c < C_GA) {
                        const int ch = c - C_U;
                        *(uint2*)(p.a3 + ((size_t)(ch >> 4) * 1024 + (tok >> 4)) * 384 + 128 + (tok & 15) * 16 + (ch & 15)) = pack4(v);
                      } else {
#pragma unroll
                        for (int j = 0; j < 4; ++j) v[j] = sigmoidf_(v[j]);
                        if (c < C_U) *(f32x4*)(p.gn + tok * 24 + (c - C_GN)) = v;
                        else if (c < C_GS) *(uint2*)(p.ga + tok * D + (c - C_GA)) = pack4(v);
                        else *(uint2*)(p.gs + tok * D + (c - C_GS)) = pack4(v);
                      }
                    }
                  }
                }
              }
            }
          },
          lds);
    }
  }
  for (int idx = gtid; idx < 32 * 256 * 256; idx += gthreads) {
    const int k = idx & 255, col = (idx >> 8) & 255, g = idx >> 16;
    const int i = col >> 4, pp = col & 15, sidx = k >> 4, q = k & 15;
    const float v = (i >= sidx) ? p.kd[((g * 16 + (i - sidx)) * 16 + pp) * 16 + q] : 0.f;
    p.wyT[((size_t)g * 256 + col) * 384 + 128 + k] = (bf16_t)(cvt_pk_bf16(v, 0.f) & 0xffffu);
  }
  }
  xcd_barrier(gbar);

  {
  PHASE_IDX
  for (int job = blockIdx.x; job < 2 * 8 * 16; job += gridDim.x) {
    const int kv = job >> 7, ks = (job >> 4) & 7, m0 = (job & 15) * 128;
    float* hp = p.hidp + (size_t)(ks * 2 + kv) * 2040 * 256;
    gemm128<true>(
        256,
        [&](int r) {
          const int rr = min(m0 + r, NB * NCMP * 2 - 1);
          const int b = rr / (NCMP * 2), n = (rr >> 1) % NCMP, g = rr & 1;
          return p.kvb + ((size_t)((kv * NB + b) * 2 + g) * S + 16 * n) * 64 + ks * 256;
        },
        [&](int c) { return p.wc1T + (size_t)(kv * 256 + c) * 2048 + ks * 256; },
        [&](const f32x4 (&acc)[4][8], int wr, int wc, int fr, int fq) {
#pragma unroll
          for (int m = 0; m < 4; ++m) {
            const int r = m0 + wr * 64 + m * 16 + fr;
            if (r < NB * NCMP * 2) {
#pragma unroll
              for (int n = 0; n < 8; ++n) *(f32x4*)(hp + (size_t)r * 256 + wc * 128 + n * 16 + 4 * fq) = acc[m][n];
            }
          }
        },
        lds);
  }
  int mt_, g;
  for (int it = 0; xcd_tile(it, 8, 32, mt_, g); ++it) {
    const int m0 = mt_ * 128;
    gemm128<true>(
        256, [&](int r) { return p.a3 + ((size_t)g * 1024 + m0 + r) * 384 + 128; },
        [&](int c) { return p.w1T + ((size_t)g * 128 + (c & 127)) * 256; },
        [&](const f32x4 (&acc)[4][8], int wr, int wc, int fr, int fq) {
          if (wc == 0) {
#pragma unroll
            for (int m = 0; m < 4; ++m)
#pragma unroll
              for (int n = 0; n < 8; ++n)
                *(f32x4*)(p.lbuf + ((size_t)g * 1024 + m0 + wr * 64 + m * 16 + fr) * 128 + n * 16 + 4 * fq) = acc[m][n];
          }
        },
        lds);
  }
  }
  xcd_barrier(gbar);

  {
  PHASE_IDX
  for (int wv = gwave; wv < 2 * NB * NCMP * 2; wv += gwaves) {
    const int kv = wv / (NB * NCMP * 2), r = wv % (NB * NCMP * 2);
    const int b = r / (NCMP * 2), n = (r >> 1) % NCMP, g = r & 1;
    const float* w2 = kv ? p.w_cmp_v2 : p.w_cmp_k2;
    {
      f32x4 hsum = *(const f32x4*)(p.cbias + kv * 256 + lane * 4);
#pragma unroll
      for (int ks = 0; ks < 8; ++ks) hsum = hsum + *(const f32x4*)(p.hidp + ((size_t)(ks * 2 + kv) * 2040 + r) * 256 + lane * 4);
#pragma unroll
      for (int j = 0; j < 4; ++j) hsum[j] = geluf_(hsum[j]);
      WSYNC();
      *(f32x4*)(smem + wib * 256 + lane * 4) = hsum;
      WSYNC();
    }
    const float* hid = smem + wib * 256;
    float acc = 0.f;
    for (int j = 0; j < 256; ++j) acc = fmaf(hid[j], w2[j * 64 + lane], acc);
    if (kv == 0) {
      const float ss = wsum(acc * acc);
      acc = acc * rsqrtf(ss * (1.0f / 64) + EPS) * p.kc_gain[lane];
    }
    const float other = __shfl_xor(acc, 1);
    if ((lane & 1) == 0)
      *(unsigned*)(p.cmpb + ((size_t)((kv * NB + b) * 2 + g) * 256 + n) * 64 + lane) = cvt_pk_bf16(acc, other);
  }
  for (int idx = gtid; idx < 2 * NB * 2 * 32; idx += gthreads)
    *(unsigned*)(p.cmpb + ((size_t)(idx >> 5) * 256 + 255) * 64 + (idx & 31) * 2) = 0u;
  for (int idx = gtid; idx < 32 * NB * 64; idx += gthreads) {
    const int n = idx & 63, b = (idx >> 6) & 3, g = idx >> 8;
    const int gn = g * 64 + n;
    const float lr = p.pw[(gn * 17 + 16) * 2], li = p.pw[(gn * 17 + 16) * 2 + 1];
    float hr_ = 0.f, hi_ = 0.f;
    const size_t row0 = (size_t)g * 1024 + b * 256;
#pragma unroll 32
    for (int c = 0; c < 256; ++c) {
      const float2 l2 = *(const float2*)(p.lbuf + (row0 + c) * 128 + n * 2);
      *(unsigned*)(p.a3 + (row0 + c) * 384 + n * 2) = cvt_pk_bf16(hr_, hi_);
      const float nr = lr * hr_ - li * hi_ + l2.x;
      const float ni = lr * hi_ + li * hr_ + l2.y;
      hr_ = nr; hi_ = ni;
    }
  }
  }
  xcd_barrier(gbar);

  {
  PHASE_IDX
  const int G = gridDim.x;
  const bool split = G >= 512;
  if (!split || blockIdx.x < 256) {
    for (int u = blockIdx.x; u < 256; u += (split ? 256 : G)) {
      const int bg = u >> 5, pr = u & 31;
#pragma unroll 1
      for (int half = 0; half < 2; ++half) attn_chunk(p, lds, bg >> 1, bg & 1, half ? pr : 63 - pr);
    }
  }
  if (!split || blockIdx.x >= 256) {
    const int x8 = blockIdx.x & 7, nsl = split ? ((G - 256) >> 3) : 0, sl = split ? (((int)blockIdx.x - 256) >> 3) : 0;
    for (int it = 0;; ++it) {
      int tile;
      if (split && ((G & 7) == 0)) { const int q = sl + it * nsl; if (q >= 32) break; tile = ((x8 + 8 * (q >> 3)) << 3) | (q & 7); }
      else { tile = (split ? (int)blockIdx.x - 256 : (int)blockIdx.x) + it * (split ? G - 256 : G); if (tile >= 256) break; }
      const int g = tile >> 3, m0 = (tile & 7) * 128, n0 = 0;
      gemm128(
          384, [&](int r) { return p.a3 + ((size_t)g * 1024 + m0 + r) * 384; },
          [&](int c) { return p.wyT + ((size_t)g * 256 + n0 + c) * 384; },
          [&](const f32x4 (&acc)[4][8], int wr, int wc, int fr, int fq) {
#pragma unroll
            for (int m = 0; m < 4; ++m)
#pragma unroll
              for (int n = 0; n < 8; ++n) {
                const int col = n0 + wc * 128 + n * 16 + 4 * fq;
                const size_t tok = (size_t)(m0 + wr * 64 + m * 16 + fr) * 16 + (col >> 4);
                f32x4 v = acc[m][n];
#pragma unroll
                for (int j = 0; j < 4; ++j) v[j] = geluf_(v[j]);
                *(uint2*)(p.z + tok * 512 + g * 16 + (col & 15)) = pack4(v);
              }
          },
          lds);
    }
    const int cb = split ? (int)blockIdx.x - 256 : (int)blockIdx.x, cn = split ? G - 256 : G;
    for (int job = cb; job < NE * 96; job += cn) {
      const int e = job / 96, rem = job - e * 96, which = rem >> 5, tile = rem & 31;
      if (which == 0) conv_job(p.w_gate + (size_t)e * D * DE, D, DE, p.wgT + (size_t)e * DE * D, tile, lds);
      else if (which == 1) conv_job(p.w_up + (size_t)e * D * DE, D, DE, p.wuT + (size_t)e * DE * D, tile, lds);
      else conv_job(p.w_down + (size_t)e * DE * D, DE, D, p.wdT + (size_t)e * D * DE, tile, lds);
    }
  }
  }
  xcd_barrier(gbar);

  {
  PHASE_IDX
  gemm_phase(
      NT, 512, 512, [&](int m) { return p.z + (size_t)m * 512; }, [&](int n) { return p.wgluT + (size_t)n * 512; },
      [&](int m, int n, f32x4 v) {
        const f32x4 zz = unpack4(*(const uint2*)(p.z + (size_t)m * 512 + n));
#pragma unroll
        for (int j = 0; j < 4; ++j) v[j] = zz[j] * sigmoidf_(v[j] + p.b_glu[n + j]);
        *(uint2*)(p.yssm + (size_t)m * 512 + n) = pack4(v);
      },
      lds);
  gemm_phase(
      NT, D, 512, [&](int m) { return p.onsab + (size_t)m * 512; }, [&](int n) { return p.wuaT + (size_t)n * 512; },
      [&](int m, int n, f32x4 v) {
        const f32x4 gg = unpack4(*(const uint2*)(p.ga + (size_t)m * D + n));
        *(f32x4*)(p.mtmp + (size_t)m * D + n) = gg * v;
      },
      lds);
  }
  xcd_barrier(gbar);
  {
  PHASE_IDX
  gemm_phase(
      NT, D, 512, [&](int m) { return p.yssm + (size_t)m * 512; }, [&](int n) { return p.wusT + (size_t)n * 512; },
      [&](int m, int n, f32x4 v) {
        const f32x4 gg = unpack4(*(const uint2*)(p.gs + (size_t)m * D + n));
        const f32x4 prev = *(const f32x4*)(p.mtmp + (size_t)m * D + n);
        *(uint2*)(p.merged + (size_t)m * D + n) = pack4(prev + gg * v);
      },
      lds);
  }
  xcd_barrier(gbar);
  {
  PHASE_IDX
  gemm_phase(
      NT, D, D, [&](int m) { return p.merged + (size_t)m * D; }, [&](int n) { return p.woutT + (size_t)n * D; },
      [&](int m, int n, f32x4 v) {
        const int b = m / S;
        const f32x4 xx = *(const f32x4*)(p.x + (size_t)m * D + n);
        const f32x4 gt = *(const f32x4*)(p.mod + b * 6 * D + 2 * D + n);
        *(f32x4*)(p.xmid + (size_t)m * D + n) = xx + gt * v;
      },
      lds);
  }
  xcd_barrier(gbar);

  {
  PHASE_IDX
  for (int row = gwave; row < NT; row += gwaves) {
    const int b = row / S;
    const float* xr = p.xmid + (size_t)row * D;
    f32x4 v[4];
    float ss = 0.f;
#pragma unroll
    for (int i = 0; i < 4; ++i) {
      v[i] = *(const f32x4*)(xr + i * 256 + lane * 4);
      ss += (v[i][0] * v[i][0] + v[i][1] * v[i][1]) + (v[i][2] * v[i][2] + v[i][3] * v[i][3]);
    }
    ss = wsum(ss);
    const float r = rsqrtf(ss * (1.0f / D) + EPS);
    const float* md = p.mod + b * 6 * D;
#pragma unroll
    for (int i = 0; i < 4; ++i) {
      const int col = i * 256 + lane * 4;
      const f32x4 gg = *(const f32x4*)(p.g_norm2 + col), sc = *(const f32x4*)(md + 4 * D + col), sh = *(const f32x4*)(md + 3 * D + col);
      *(uint2*)(p.h + (size_t)row * D + col) = pack4(v[i] * r * gg * (sc + 1.0f) + sh);
    }
  }
  }
  xcd_barrier(gbar);

  {
  PHASE_IDX
  int mt_, nt_;
  for (int it = 0; xcd_tile(it, NT / TM, 3, mt_, nt_); ++it) {
    const int m0 = mt_ * TM;
    if (nt_ == 0) {
      gemm128<true>(
          D, [&](int r) { return p.h + (size_t)(m0 + r) * D; }, [&](int c) { return p.wrT + (size_t)c * D; },
          [&](const f32x4 (&acc)[4][8], int wr, int wc, int fr, int fq) {
#pragma unroll
            for (int m = 0; m < 4; ++m)
#pragma unroll
              for (int n = 0; n < 8; ++n) {
                f32x4 v = acc[m][n];
#pragma unroll
                for (int j = 0; j < 4; ++j) v[j] = sigmoidf_(v[j]);
                *(f32x4*)(p.scores + (size_t)(m0 + wr * 64 + m * 16 + fr) * NE + wc * 128 + n * 16 + 4 * fq) = v;
              }
          },
          lds);
    } else {
      const int ct = nt_ - 1;
      gemm128<true>(
          D, [&](int r) { return p.h + (size_t)(m0 + r) * D; },
          [&](int c) {
            const int hid = ct * 128 + (c >> 7) * 64 + ((c >> 4) & 3) * 16 + (c & 15);
            return (((c >> 6) & 1) ? p.wsuT : p.wsgT) + (size_t)hid * D;
          },
          [&](const f32x4 (&acc)[4][8], int wr, int wc, int fr, int fq) {
#pragma unroll
            for (int m = 0; m < 4; ++m)
#pragma unroll
              for (int n = 0; n < 4; ++n) {
                f32x4 v;
#pragma unroll
                for (int j = 0; j < 4; ++j) v[j] = siluf_(acc[m][n][j]) * acc[m][n + 4][j];
                *(uint2*)(p.hs + (size_t)(m0 + wr * 64 + m * 16 + fr) * DE + ct * 128 + wc * 64 + n * 16 + 4 * fq) = pack4(v);
              }
          },
          lds);
    }
  }
  }
  xcd_barrier(gbar);

  {
  PHASE_IDX
  for (int tok = gwave; tok < NT; tok += gwaves) {
    const float4 sc4 = *reinterpret_cast<const float4*>(p.scores + (size_t)tok * NE + lane * 4);
    const float4 bi4 = *reinterpret_cast<const float4*>(p.router_bias + lane * 4);
    const float sc[4] = {sc4.x, sc4.y, sc4.z, sc4.w};
    float bz[4] = {sc4.x + bi4.x, sc4.y + bi4.y, sc4.z + bi4.z, sc4.w + bi4.w};
    float m1 = -INFINITY, m2 = -INFINITY;
#pragma unroll
    for (int i = 0; i < 4; ++i) {
      const float v = bz[i];
      if (v > m1) { m2 = m1; m1 = v; } else if (v > m2) { m2 = v; }
    }
#pragma unroll
    for (int o = 1; o < 8; o <<= 1) {
      const float o1 = __shfl_xor(m1, o), o2 = __shfl_xor(m2, o);
      const float n1 = fmaxf(m1, o1);
      const float n2 = fmaxf(fminf(m1, o1), fmaxf(m2, o2));
      m1 = n1; m2 = n2;
    }
    const float gs = m1 + m2;
    const int mygrp = lane >> 3;
    int grank = 0;
#pragma unroll
    for (int g2 = 0; g2 < 8; ++g2) {
      const float og = __shfl(gs, g2 * 8);
      grank += (og > gs || (og == gs && g2 < mygrp)) ? 1 : 0;
    }
    const bool gsel = grank < 4;
#pragma unroll
    for (int i = 0; i < 4; ++i) if (!gsel) bz[i] = -INFINITY;
    unsigned taken = 0;
    float wsel = 0.f;
    int esel = 0;
    float wtot = 0.f;
#pragma unroll 1
    for (int k = 0; k < TOPK; ++k) {
      float bv = -INFINITY; int bidx = 1 << 30;
#pragma unroll
      for (int i = 0; i < 4; ++i) {
        if (!((taken >> i) & 1u) && bz[i] > bv) { bv = bz[i]; bidx = lane * 4 + i; }
      }
#pragma unroll
      for (int o = 32; o > 0; o >>= 1) {
        const float ov = __shfl_xor(bv, o);
        const int oi = __shfl_xor(bidx, o);
        if (ov > bv || (ov == bv && oi < bidx)) { bv = ov; bidx = oi; }
      }
      const int owner = bidx >> 2, slot = bidx & 3;
      float sv = 0.f;
      if (lane == owner) {
        taken |= 1u << slot;
        sv = (slot == 0) ? sc[0] : (slot == 1) ? sc[1] : (slot == 2) ? sc[2] : sc[3];
      }
      sv = __shfl(sv, owner);
      wtot += sv;
      if (lane == k) { wsel = sv; esel = bidx; }
    }
    if (lane < TOPK) {
      p.eidx[tok * TOPK + lane] = esel;
      p.ew[tok * TOPK + lane] = wsel / wtot * 2.5f;
      atomicAdd(&p.cnt[esel], 1);
    }
  }
  gemm_phase(
      NT, D, DE, [&](int m) { return p.hs + (size_t)m * DE; }, [&](int n) { return p.wsdT + (size_t)n * DE; },
      [&](int m, int n, f32x4 v) {
        const int b = m / S;
        const f32x4 xx = *(const f32x4*)(p.xmid + (size_t)m * D + n);
        const f32x4 gt = *(const f32x4*)(p.mod + b * 6 * D + 5 * D + n);
        *(f32x4*)(p.out + (size_t)m * D + n) = xx + gt * v;
      },
      lds);
  }
  xcd_barrier(gbar);

  {
  PHASE_IDX
  {
    int* soff = (int*)smem;
    int* srt = soff + 320;
    const int myc = p.cnt[tid];
    soff[tid] = myc;
    srt[tid] = (myc + 127) >> 7;
    __syncthreads();
    for (int st = 1; st < 256; st <<= 1) {
      const int a0 = (tid >= st) ? soff[tid - st] : 0;
      __syncthreads();
      soff[tid] += a0;
      __syncthreads();
    }
    const int exo = soff[tid] - myc;
    __syncthreads();
    soff[tid] = exo;
    if (blockIdx.x == 0) {
      p.off[tid] = exo;
      if (tid == 255) p.off[NE] = exo + myc;
    }
    __syncthreads();
    if (blockIdx.x == 0 && tid < 8) {
      int acc = 0;
      for (int i = 0; i < 32; ++i) { p.xrts[tid * 33 + i] = acc; acc += srt[tid + 8 * i]; }
      p.xrts[tid * 33 + 32] = acc;
    }
    for (int idx = gtid; idx < NASSIGN; idx += gthreads) {
      const int e = p.eidx[idx];
      const int pos = soff[e] + atomicAdd(&p.cursor[e], 1);
      p.stok[pos] = idx / TOPK;
      p.sw[pos] = p.ew[idx];
      p.apos[idx] = pos;
    }
    __syncthreads();
  }
  }
  xcd_barrier(gbar);

  {
  PHASE_IDX
  {
    const int x8 = blockIdx.x & 7, ns8 = ((int)gridDim.x - x8 + 7) >> 3;
    const int* xr = p.xrts + x8 * 33;
    const int total_rt = xr[32];
    for (int tile = blockIdx.x >> 3; tile < total_rt * 2; tile += ns8) {
      const int rt = tile >> 1, ct = tile & 1;
      const int ei = find_idx(xr, 32, rt);
      const int e = x8 + 8 * ei;
      const int pos0 = p.off[e] + (rt - xr[ei]) * 128;
      const int mvalid = min(128, p.off[e] + p.cnt[e] - pos0);
      const bf16_t* wg = p.wgT + (size_t)e * DE * D;
      const bf16_t* wu = p.wuT + (size_t)e * DE * D;
      gemm128<true>(
          D, [&](int r) { return p.h + (size_t)p.stok[pos0 + min(r, mvalid - 1)] * D; },
          [&](int c) {
            const int hid = ct * 128 + (c >> 7) * 64 + ((c >> 4) & 3) * 16 + (c & 15);
            return (((c >> 6) & 1) ? wu : wg) + (size_t)hid * D;
          },
          [&](const f32x4 (&acc)[4][8], int wr, int wc, int fr, int fq) {
#pragma unroll
            for (int m = 0; m < 4; ++m) {
              const int r = wr * 64 + m * 16 + fr;
              if (r < mvalid) {
#pragma unroll
                for (int n = 0; n < 4; ++n) {
                  f32x4 v;
#pragma unroll
                  for (int j = 0; j < 4; ++j) v[j] = siluf_(acc[m][n][j]) * acc[m][n + 4][j];
                  *(uint2*)(p.hr + (size_t)(pos0 + r) * DE + ct * 128 + wc * 64 + n * 16 + 4 * fq) = pack4(v);
                }
              }
            }
          },
          lds);
    }
  }
  }
  xcd_barrier(gbar);
  {
  PHASE_IDX
  {
    const int x8 = blockIdx.x & 7, ns8 = ((int)gridDim.x - x8 + 7) >> 3;
    const int* xr = p.xrts + x8 * 33;
    const int total_rt = xr[32];
    for (int rt = blockIdx.x >> 3; rt < total_rt; rt += ns8) {
      const int ei = find_idx(xr, 32, rt);
      const int e = x8 + 8 * ei;
      const int pos0 = p.off[e] + (rt - xr[ei]) * 128;
      const int mvalid = min(128, p.off[e] + p.cnt[e] - pos0);
      const bf16_t* wd = p.wdT + (size_t)e * D * DE;
      float wgt4[4];
      {
        int tq = threadIdx.x;
        OPAQUE(tq);
        const int wr_ = tq >> 7, fr_ = tq & 15;
#pragma unroll
        for (int m = 0; m < 4; ++m) wgt4[m] = p.sw[pos0 + min(wr_ * 64 + m * 16 + fr_, mvalid - 1)];
      }
      gemm128_stream<4>(
          DE, [&](int r) { return p.hr + (size_t)(pos0 + min(r, mvalid - 1)) * DE; },
          [&](int c) { return wd + (size_t)c * DE; }, (size_t)256 * DE,
          [&](int ct, const f32x4 (&acc)[4][8], int wr, int wc, int fr, int fq) {
#pragma unroll
            for (int m = 0; m < 4; ++m) {
              const int r = wr * 64 + m * 16 + fr;
              if (r < mvalid) {
#pragma unroll
                for (int n = 0; n < 8; ++n)
                  *(uint2*)(p.yk + (size_t)(pos0 + r) * D + ct * 256 + wc * 128 + n * 16 + 4 * fq) = pack4(acc[m][n] * wgt4[m]);
              }
            }
          },
          lds);
    }
  }
  }
  xcd_barrier(gbar);
  {
  PHASE_IDX
  for (int tok = gwave; tok < NT; tok += gwaves) {
    const int b = tok / S;
    float acc[16];
#pragma unroll
    for (int i = 0; i < 16; ++i) acc[i] = 0.f;
#pragma unroll 1
    for (int k = 0; k < TOPK; ++k) {
      const int pos = p.apos[tok * TOPK + k];
      const u32x4* src = (const u32x4*)(p.yk + (size_t)pos * D + lane * 16);
      const u32x4 a = src[0], c = src[1];
      const unsigned wv[8] = {a.x, a.y, a.z, a.w, c.x, c.y, c.z, c.w};
#pragma unroll
      for (int i = 0; i < 8; ++i) {
        acc[2 * i] += __uint_as_float(wv[i] << 16);
        acc[2 * i + 1] += __uint_as_float(wv[i] & 0xffff0000u);
      }
    }
    float* dst = p.out + (size_t)tok * D + lane * 16;
    const float* gt = p.mod + b * 6 * D + 5 * D + lane * 16;
#pragma unroll
    for (int i = 0; i < 4; ++i) {
      f32x4 o4 = *(f32x4*)(dst + 4 * i);
      const f32x4 g4 = *(const f32x4*)(gt + 4 * i);
#pragma unroll
      for (int j = 0; j < 4; ++j) o4[j] += g4[j] * acc[4 * i + j];
      *(f32x4*)(dst + 4 * i) = o4;
    }
  }
  }
}

extern "C" void kernel_launch(void* const* d_in, const int* in_sizes, int n_in, void* d_out, int out_size,
                              void* d_ws, size_t ws_size, hipStream_t stream) {
  (void)in_sizes; (void)n_in; (void)out_size;
  Params p{};
  const float* const* in = reinterpret_cast<const float* const*>(d_in);
  p.x = in[0]; p.c = in[1]; p.w_ada = in[2]; p.b_ada = in[3]; p.g_norm1 = in[4]; p.g_norm2 = in[5];
  p.w_in = in[6]; p.q_gain = in[7]; p.kc_gain = in[8]; p.ks_gain = in[9]; p.kw_gain = in[10];
  p.pe_k = in[11]; p.pe_v = in[12]; p.w_cmp_k1 = in[13]; p.w_cmp_k2 = in[14]; p.w_cmp_v1 = in[15];
  p.w_cmp_v2 = in[16]; p.a_re = in[17]; p.a_im = in[18]; p.log_dt = in[19]; p.b_re = in[20];
  p.b_im = in[21]; p.c_re = in[22]; p.c_im = in[23]; p.d_skip = in[24]; p.w_glu = in[25];
  p.b_glu = in[26]; p.w_up_attn = in[27]; p.w_up_ssm = in[28]; p.w_out = in[29]; p.w_router = in[30];
  p.router_bias = in[31]; p.w_gate = in[32]; p.w_up = in[33]; p.w_down = in[34]; p.ws_gate = in[35];
  p.ws_up = in[36]; p.ws_down = in[37];
  p.out = (float*)d_out;

  char* base = (char*)d_ws;
  size_t o = 0;
  auto take = [&](size_t bytes) { void* r = base + o; o += (bytes + 255) & ~(size_t)255; return r; };
  p.bar = (unsigned*)take(sizeof(unsigned) * XCD_BAR_WORDS);
  p.mod = (float*)take(sizeof(float) * NB * 6 * D);
  p.cbias = (float*)take(sizeof(float) * 512);
  p.w_inT = (bf16_t*)take(2 * (size_t)INC * D);
  p.wc1T = (bf16_t*)take(2 * (size_t)2 * 256 * 2048);
  p.wgluT = (bf16_t*)take(2 * (size_t)512 * 512);
  p.wuaT = (bf16_t*)take(2 * (size_t)D * 512);
  p.wusT = (bf16_t*)take(2 * (size_t)D * 512);
  p.woutT = (bf16_t*)take(2 * (size_t)D * D);
  p.wrT = (bf16_t*)take(2 * (size_t)NE * D);
  p.wsgT = (bf16_t*)take(2 * (size_t)DE * D);
  p.wsuT = (bf16_t*)take(2 * (size_t)DE * D);
  p.wsdT = (bf16_t*)take(2 * (size_t)D * DE);
  p.w1T = (bf16_t*)take(2 * (size_t)32 * 128 * 256);
  p.wyT = (bf16_t*)take(2 * (size_t)32 * 256 * 384);
  p.wgT = (bf16_t*)take(2 * (size_t)NE * DE * D);
  p.wuT = (bf16_t*)take(2 * (size_t)NE * DE * D);
  p.wdT = (bf16_t*)take(2 * (size_t)NE * D * DE);
  p.h = (bf16_t*)take(2 * (size_t)NT * D);
  p.pw = (float*)take(sizeof(float) * 2048 * 17 * 2);
  p.bbar = (float*)take(sizeof(float) * 2048 * 32);
  p.kd = (float*)take(sizeof(float) * 32 * 16 * 256);
  p.xmid = (float*)take(sizeof(float) * (size_t)NT * D);
  p.scores = (float*)take(sizeof(float) * (size_t)NT * NE);
  p.eidx = (int*)take(sizeof(int) * NASSIGN);
  p.ew = (float*)take(sizeof(float) * NASSIGN);
  p.cnt = (int*)take(sizeof(int) * NE);
  p.cursor = (int*)take(sizeof(int) * NE);
  p.off = (int*)take(sizeof(int) * (NE + 1));
  p.xrts = (int*)take(sizeof(int) * 8 * 33);
  p.stok = (int*)take(sizeof(int) * NASSIGN);
  p.sw = (float*)take(sizeof(float) * NASSIGN);
  p.apos = (int*)take(sizeof(int) * NASSIGN);
  p.hs = (bf16_t*)take(2 * (size_t)NT * DE);
  p.hr = (bf16_t*)take(2 * (size_t)NASSIGN * DE);
  const size_t early0 = o;
  p.qb = (bf16_t*)take(2 * (size_t)NT * 512);
  p.kvb = (bf16_t*)take(2 * (size_t)6 * NB * 2 * S * 64);
  p.cmpb = (bf16_t*)take(2 * (size_t)2 * NB * 2 * 256 * 64);
  p.gn = (float*)take(sizeof(float) * (size_t)NT * 24);
  p.a3 = (bf16_t*)take(2 * (size_t)32 * 1024 * 384);
  p.ga = (bf16_t*)take(2 * (size_t)NT * D);
  p.gs = (bf16_t*)take(2 * (size_t)NT * D);
  p.hidp = (float*)take(sizeof(float) * 16 * 2040 * 256);
  p.onsa = (float*)take(sizeof(float) * (size_t)NT * 512);
  p.onsab = (bf16_t*)take(2 * (size_t)NT * 512);
  p.lbuf = (float*)take(sizeof(float) * 32 * 1024 * 128);
  p.z = (bf16_t*)take(2 * (size_t)NT * 512);
  p.yssm = (bf16_t*)take(2 * (size_t)NT * 512);
  p.mtmp = (float*)take(sizeof(float) * (size_t)NT * D);
  p.merged = (bf16_t*)take(2 * (size_t)NT * D);
  const size_t early1 = o;
  p.yk = (bf16_t*)(base + early0);
  const size_t yk_bytes = 2 * (size_t)NASSIGN * D;
  if (early0 + yk_bytes > o) o = early0 + yk_bytes;
  (void)early1;
  if (o > ws_size) fprintf(stderr, "workspace too small: need %zu have %zu\n", o, ws_size);

  static int grid_blocks = 0;
  if (!grid_blocks) {
    int dev = 0, cus = 0, per_cu = 0;
    (void)hipGetDevice(&dev);
    (void)hipDeviceGetAttribute(&cus, hipDeviceAttributeMultiprocessorCount, dev);
    (void)hipOccupancyMaxActiveBlocksPerMultiprocessor(&per_cu, mega, 256, 0);
    if (per_cu > 2) per_cu = 2;
    if (per_cu < 1) per_cu = 1;
    grid_blocks = cus * per_cu;
  }
  (void)hipMemsetAsync(p.bar, 0, sizeof(unsigned) * XCD_BAR_WORDS, stream);
  hipLaunchKernelGGL(mega, dim3(grid_blocks), dim3(256), 0, stream, p);
  hipError_t e = hipPeekAtLastError();
  if (e != hipSuccess) fprintf(stderr, "launch failed: %s (grid %d)\n", hipGetErrorString(e), grid_blocks);
}
```

```cpp
#include <hip/hip_runtime.h>
#include <cstdio>
#include <cstdint>

constexpr int D = 1024;
constexpr int NB = 4;
constexpr int S = 4096;
constexpr int NT = NB * S;
constexpr int INC = 3864;
constexpr int C_Q = 0, C_KC = 512, C_VC = 640, C_KS = 768, C_VS = 896, C_KW = 1024, C_VW = 1152,
              C_GN = 1280, C_U = 1304, C_GA = 1816, C_GS = 2840;
constexpr int NCMP = 255;
constexpr int NE = 256;
constexpr int TOPK = 8;
constexpr int DE = 256;
constexpr int NASSIGN = NT * TOPK;
constexpr float EPS = 1e-6f;
constexpr float ATT_SCALE = 0.125f;
typedef unsigned short bf16_t;

struct Params {
  const float* x; const float* c; const float* w_ada; const float* b_ada; const float* g_norm1;
  const float* g_norm2; const float* w_in; const float* q_gain; const float* kc_gain;
  const float* ks_gain; const float* kw_gain; const float* pe_k; const float* pe_v;
  const float* w_cmp_k1; const float* w_cmp_k2; const float* w_cmp_v1; const float* w_cmp_v2;
  const float* a_re; const float* a_im; const float* log_dt; const float* b_re; const float* b_im;
  const float* c_re; const float* c_im; const float* d_skip; const float* w_glu; const float* b_glu;
  const float* w_up_attn; const float* w_up_ssm; const float* w_out; const float* w_router;
  const float* router_bias; const float* w_gate; const float* w_up; const float* w_down;
  const float* ws_gate; const float* ws_up; const float* ws_down;
  float* out;
  unsigned* bar;
  float* mod;
  float* cbias;
  bf16_t* w_inT;
  bf16_t* wc1T;
  bf16_t* wgluT;
  bf16_t* wuaT;
  bf16_t* wusT;
  bf16_t* woutT;
  bf16_t* wrT;
  bf16_t* wsgT;
  bf16_t* wsuT;
  bf16_t* wsdT;
  bf16_t* w1T;
  bf16_t* wyT;
  bf16_t* wgT;
  bf16_t* wuT;
  bf16_t* wdT;
  bf16_t* h;
  bf16_t* qb;
  bf16_t* kvb;
  bf16_t* cmpb;
  float* gn;
  bf16_t* a3;
  bf16_t* ga;
  bf16_t* gs;
  float* hidp;
  float* onsa;
  bf16_t* onsab;
  float* pw;
  float* bbar;
  float* kd;
  float* lbuf;
  bf16_t* z;
  bf16_t* yssm;
  float* mtmp;
  bf16_t* merged;
  float* xmid;
  float* scores;
  int* eidx;
  float* ew;
  int* cnt;
  int* cursor;
  int* off;
  int* xrts;
  int* stok;
  float* sw;
  int* apos;
  bf16_t* hs;
  bf16_t* hr;
  bf16_t* yk;
};

__device__ __forceinline__ float bpx(float v, int lane, int off) {
  return __int_as_float(__builtin_amdgcn_ds_bpermute((lane ^ off) << 2, __float_as_int(v)));
}
__device__ __forceinline__ int bpxi(int v, int lane, int off) { return __builtin_amdgcn_ds_bpermute((lane ^ off) << 2, v); }
__device__ __forceinline__ unsigned bpxu(unsigned v, int lane, int off) { return (unsigned)__builtin_amdgcn_ds_bpermute((lane ^ off) << 2, (int)v); }
__device__ __forceinline__ float bpl(float v, int src) {
  return __int_as_float(__builtin_amdgcn_ds_bpermute(src << 2, __float_as_int(v)));
}
__device__ __forceinline__ float wsum(float v, int lane) {
#pragma unroll
  for (int o = 32; o > 0; o >>= 1) v += bpx(v, lane, o);
  return v;
}
#define WSYNC() do { __builtin_amdgcn_fence(__ATOMIC_ACQ_REL, "wavefront"); __builtin_amdgcn_wave_barrier(); } while (0)
__device__ __forceinline__ float sigmoidf_(float x) { return 1.0f / (1.0f + expf(-x)); }
__device__ __forceinline__ float siluf_(float x) { return x / (1.0f + expf(-x)); }
__device__ __forceinline__ float geluf_(float x) {
  return 0.5f * x * (1.0f + tanhf(0.7978845608028654f * (x + 0.044715f * x * x * x)));
}
#define OPAQUE(x) asm volatile("" : "+v"(x))
typedef short bf16x8 __attribute__((ext_vector_type(8)));
typedef float f32x4 __attribute__((ext_vector_type(4)));
typedef unsigned u32x4 __attribute__((ext_vector_type(4)));
#define LAS __attribute__((address_space(3)))

__device__ __forceinline__ unsigned cvt_pk_bf16(float lo, float hi) {
  unsigned r;
  asm("v_cvt_pk_bf16_f32 %0, %1, %2" : "=v"(r) : "v"(lo), "v"(hi));
  return r;
}
__device__ __forceinline__ uint2 pack4(const f32x4 v) {
  uint2 w;
  w.x = cvt_pk_bf16(v[0], v[1]); w.y = cvt_pk_bf16(v[2], v[3]);
  return w;
}
__device__ __forceinline__ f32x4 unpack4(const uint2 w) {
  return (f32x4){__uint_as_float(w.x << 16), __uint_as_float(w.x & 0xffff0000u), __uint_as_float(w.y << 16), __uint_as_float(w.y & 0xffff0000u)};
}
__device__ __forceinline__ int lds_byte(int r, int c) {
  const int st = (r >> 4) * 2 + (c >> 5), rr = r & 15, cc = c & 31, ob = rr * 64 + cc * 2;
  return st * 1024 + (ob ^ (((ob >> 9) & 1) << 5));
}
__device__ __forceinline__ int t32_byte(int r, int c) {
  const int ob = (r & 15) * 64 + c * 2;
  return (r >> 4) * 1024 + (ob ^ (((ob >> 9) & 1) << 5));
}

constexpr int GEMM_STAGE = 24576;
constexpr int GEMM_RING = 3;
constexpr int TM = 128, TNW = 256;
template <bool GL = false, class AF, class BF, class EPW>
__device__ __forceinline__ void gemm128(int K, AF arow, BF brow, EPW epiw, LAS unsigned char* lds) {
  int t = threadIdx.x;
  OPAQUE(t);
  const int wid = t >> 6, lane = t & 63, wr = wid >> 1, wc = wid & 1, fr = lane & 15, fq = lane >> 4;
  const int sbb = lane * 16, obb = sbb ^ (((sbb >> 9) & 1) << 5);
  const int rin = obb >> 6, cel = (obb & 63) >> 1;
  const bf16_t* ga0 = arow(wid * 16 + rin) + cel;
  const bf16_t* ga1 = arow((wid + 4) * 16 + rin) + cel;
  const bf16_t* gb0 = brow(wid * 16 + rin) + cel;
  const bf16_t* gb1 = brow((wid + 4) * 16 + rin) + cel;
  const bf16_t* gb2 = brow((wid + 8) * 16 + rin) + cel;
  const bf16_t* gb3 = brow((wid + 12) * 16 + rin) + cel;
  f32x4 acc[4][8];
#pragma unroll
  for (int m = 0; m < 4; ++m)
#pragma unroll
    for (int n = 0; n < 8; ++n) acc[m][n] = (f32x4){0.f, 0.f, 0.f, 0.f};
  const int foff = t32_byte(fr, fq * 8);
  const int nk = K >> 5;
#define GEMM_COMPUTE(sa_) do { \
    bf16x8 af[4]; \
    _Pragma("unroll") for (int m = 0; m < 4; ++m) af[m] = *(const LAS bf16x8*)((sa_) + (wr * 4 + m) * 1024 + foff); \
    _Pragma("unroll") for (int nh = 0; nh < 2; ++nh) { \
      bf16x8 bf[4]; \
      _Pragma("unroll") for (int n = 0; n < 4; ++n) bf[n] = *(const LAS bf16x8*)((sa_) + 8192 + (wc * 8 + nh * 4 + n) * 1024 + foff); \
      __builtin_amdgcn_s_setprio(1); \
      _Pragma("unroll") for (int m = 0; m < 4; ++m) \
        _Pragma("unroll") for (int n = 0; n < 4; ++n) \
          acc[m][nh * 4 + n] = __builtin_amdgcn_mfma_f32_16x16x32_bf16(bf[n], af[m], acc[m][nh * 4 + n], 0, 0, 0); \
      __builtin_amdgcn_s_setprio(0); \
      if (nh == 0) __builtin_amdgcn_sched_barrier(0); } } while (0)
  if constexpr (GL) {
  LAS unsigned char* l0 = lds + t * 16;
#define GEMM_ISSUE(s_) do { LAS unsigned char* d_ = l0 + ((s_) % GEMM_RING) * GEMM_STAGE; const int ko_ = (s_) * 32; \
    __builtin_amdgcn_global_load_lds((const unsigned*)(ga0 + ko_), (LAS unsigned*)(d_), 16, 0, 0); \
    __builtin_amdgcn_global_load_lds((const unsigned*)(ga1 + ko_), (LAS unsigned*)(d_ + 4096), 16, 0, 0); \
    __builtin_amdgcn_global_load_lds((const unsigned*)(gb0 + ko_), (LAS unsigned*)(d_ + 8192), 16, 0, 0); \
    __builtin_amdgcn_global_load_lds((const unsigned*)(gb1 + ko_), (LAS unsigned*)(d_ + 12288), 16, 0, 0); \
    __builtin_amdgcn_global_load_lds((const unsigned*)(gb2 + ko_), (LAS unsigned*)(d_ + 16384), 16, 0, 0); \
    __builtin_amdgcn_global_load_lds((const unsigned*)(gb3 + ko_), (LAS unsigned*)(d_ + 20480), 16, 0, 0); } while (0)
  asm volatile("s_waitcnt vmcnt(0)" ::: "memory");
#pragma unroll
  for (int s_ = 0; s_ < GEMM_RING - 1; ++s_)
    if (s_ < nk) GEMM_ISSUE(s_);
  for (int kt = 0; kt < nk; ++kt) {
    if (kt + 1 < nk) asm volatile("s_waitcnt vmcnt(6)" ::: "memory");
    else asm volatile("s_waitcnt vmcnt(0)" ::: "memory");
    __builtin_amdgcn_s_barrier();
    asm volatile("" ::: "memory");
    if (kt + GEMM_RING - 1 < nk) GEMM_ISSUE(kt + GEMM_RING - 1);
    const LAS unsigned char* sa = lds + (kt % GEMM_RING) * GEMM_STAGE;
    GEMM_COMPUTE(sa);
  }
  __builtin_amdgcn_s_barrier();
  asm volatile("" ::: "memory");
#undef GEMM_ISSUE
  } else {
  for (int kt = 0; kt < nk; ++kt) {
    const int ko = kt * 32;
    const u32x4 a0 = *(const u32x4*)(ga0 + ko), a1 = *(const u32x4*)(ga1 + ko);
    const u32x4 b0 = *(const u32x4*)(gb0 + ko), b1 = *(const u32x4*)(gb1 + ko);
    const u32x4 b2 = *(const u32x4*)(gb2 + ko), b3 = *(const u32x4*)(gb3 + ko);
    *(LAS u32x4*)(lds + t * 16) = a0;
    *(LAS u32x4*)(lds + t * 16 + 4096) = a1;
    *(LAS u32x4*)(lds + t * 16 + 8192) = b0;
    *(LAS u32x4*)(lds + t * 16 + 12288) = b1;
    *(LAS u32x4*)(lds + t * 16 + 16384) = b2;
    *(LAS u32x4*)(lds + t * 16 + 20480) = b3;
    __syncthreads();
    GEMM_COMPUTE(lds);
    __syncthreads();
  }
  }
#undef GEMM_COMPUTE
  epiw(acc, wr, wc, fr, fq);
}

template <int NCT, class AF, class BF, class EPW>
__device__ __forceinline__ void gemm128_stream(int K, AF arow, BF brow, size_t bct, EPW epiw, LAS unsigned char* lds) {
  int t = threadIdx.x;
  OPAQUE(t);
  const int wid = t >> 6, lane = t & 63, wr = wid >> 1, wc = wid & 1, fr = lane & 15, fq = lane >> 4;
  const int sbb = lane * 16, obb = sbb ^ (((sbb >> 9) & 1) << 5);
  const int rin = obb >> 6, cel = (obb & 63) >> 1;
  const bf16_t* ga0 = arow(wid * 16 + rin) + cel;
  const bf16_t* ga1 = arow((wid + 4) * 16 + rin) + cel;
  const bf16_t* gb0 = brow(wid * 16 + rin) + cel;
  const bf16_t* gb1 = brow((wid + 4) * 16 + rin) + cel;
  const bf16_t* gb2 = brow((wid + 8) * 16 + rin) + cel;
  const bf16_t* gb3 = brow((wid + 12) * 16 + rin) + cel;
  f32x4 acc[4][8];
#pragma unroll
  for (int m = 0; m < 4; ++m)
#pragma unroll
    for (int n = 0; n < 8; ++n) acc[m][n] = (f32x4){0.f, 0.f, 0.f, 0.f};
  const int foff = t32_byte(fr, fq * 8);
  const int nk = K >> 5, ns = nk * NCT;
  LAS unsigned char* l0 = lds + t * 16;
  int iss_k = 0;
  size_t iss_b = 0;
#define GEMM_ISSUE2(s_) do { LAS unsigned char* d_ = l0 + ((s_) % GEMM_RING) * GEMM_STAGE; \
    __builtin_amdgcn_global_load_lds((const unsigned*)(ga0 + iss_k), (LAS unsigned*)(d_), 16, 0, 0); \
    __builtin_amdgcn_global_load_lds((const unsigned*)(ga1 + iss_k), (LAS unsigned*)(d_ + 4096), 16, 0, 0); \
    __builtin_amdgcn_global_load_lds((const unsigned*)(gb0 + iss_b + iss_k), (LAS unsigned*)(d_ + 8192), 16, 0, 0); \
    __builtin_amdgcn_global_load_lds((const unsigned*)(gb1 + iss_b + iss_k), (LAS unsigned*)(d_ + 12288), 16, 0, 0); \
    __builtin_amdgcn_global_load_lds((const unsigned*)(gb2 + iss_b + iss_k), (LAS unsigned*)(d_ + 16384), 16, 0, 0); \
    __builtin_amdgcn_global_load_lds((const unsigned*)(gb3 + iss_b + iss_k), (LAS unsigned*)(d_ + 20480), 16, 0, 0); \
    iss_k += 32; if (iss_k == K) { iss_k = 0; iss_b += bct; } } while (0)
  asm volatile("s_waitcnt vmcnt(0)" ::: "memory");
#pragma unroll
  for (int s_ = 0; s_ < GEMM_RING - 1; ++s_)
    if (s_ < ns) GEMM_ISSUE2(s_);
  int kt = 0, ct = 0;
  for (int s_ = 0; s_ < ns; ++s_) {
    if (s_ + 1 < ns) asm volatile("s_waitcnt vmcnt(6)" ::: "memory");
    else asm volatile("s_waitcnt vmcnt(0)" ::: "memory");
    __builtin_amdgcn_s_barrier();
    asm volatile("" ::: "memory");
    if (s_ + GEMM_RING - 1 < ns) GEMM_ISSUE2(s_ + GEMM_RING - 1);
    const LAS unsigned char* sa = lds + (s_ % GEMM_RING) * GEMM_STAGE;
    {
      bf16x8 af[4];
#pragma unroll
      for (int m = 0; m < 4; ++m) af[m] = *(const LAS bf16x8*)(sa + (wr * 4 + m) * 1024 + foff);
#pragma unroll
      for (int nh = 0; nh < 2; ++nh) {
        bf16x8 bf[4];
#pragma unroll
        for (int n = 0; n < 4; ++n) bf[n] = *(const LAS bf16x8*)(sa + 8192 + (wc * 8 + nh * 4 + n) * 1024 + foff);
#pragma unroll
        for (int m = 0; m < 4; ++m)
#pragma unroll
          for (int n = 0; n < 4; ++n)
            acc[m][nh * 4 + n] = __builtin_amdgcn_mfma_f32_16x16x32_bf16(bf[n], af[m], acc[m][nh * 4 + n], 0, 0, 0);
        if (nh == 0) __builtin_amdgcn_sched_barrier(0);
      }
    }
    if (++kt == nk) {
      epiw(ct, acc, wr, wc, fr, fq);
#pragma unroll
      for (int m = 0; m < 4; ++m)
#pragma unroll
        for (int n = 0; n < 8; ++n) acc[m][n] = (f32x4){0.f, 0.f, 0.f, 0.f};
      kt = 0; ++ct;
    }
  }
  __builtin_amdgcn_s_barrier();
  asm volatile("" ::: "memory");
#undef GEMM_ISSUE2
}

__device__ __forceinline__ bool xcd_tile(int it, int tm, int tn, int& mt, int& nt) {
  const int G = gridDim.x, x = blockIdx.x & 7, slot = blockIdx.x >> 3, ns = (G - x + 7) >> 3;
  const int q = slot + it * ns;
  if (tn >= 8) {
    const int cn = (tn - x + 7) >> 3;
    if (q >= cn * tm) return false;
    mt = q / cn; nt = x + 8 * (q % cn);
  } else {
    const int cm = (tm - x + 7) >> 3;
    if (cm <= 0 || q >= cm * tn) return false;
    mt = x + 8 * (q / tn); nt = q % tn;
  }
  return true;
}
__device__ __forceinline__ int find_idx(const int* pre, int n, int v) {
  int lo = 0, hi = n;
  while (hi - lo > 1) {
    const int mid = (lo + hi) >> 1;
    if (pre[mid] <= v) lo = mid; else hi = mid;
  }
  return lo;
}

template <class AL, class BL, class EP>
__device__ __forceinline__ void gemm_phase(int M, int N, int K, AL al, BL bl, EP ep, LAS unsigned char* lds) {
  const int tn = (N + TNW - 1) / TNW, tm = (M + TM - 1) / TM;
  int mt, nt;
  for (int it = 0; xcd_tile(it, tm, tn, mt, nt); ++it) {
    const int m0 = mt * TM, n0 = nt * TNW;
    gemm128<true>(
        K, [&](int r) { return al(min(m0 + r, M - 1)); }, [&](int c) { return bl(min(n0 + c, N - 1)); },
        [&](const f32x4 (&acc)[4][8], int wr, int wc, int fr, int fq) {
#pragma unroll
          for (int m = 0; m < 4; ++m)
#pragma unroll
            for (int n = 0; n < 8; ++n) {
              const int r = m0 + wr * 64 + m * 16 + fr, c = n0 + wc * 128 + n * 16 + 4 * fq;
              if (r < M && c < N) ep(r, c, acc[m][n]);
            }
        },
        lds);
  }
}

__device__ __forceinline__ void convert_tile(const float* W, int ldw, int nvalid, bf16_t* Wt, int ldt, int k0, int n0, LAS unsigned char* lds) {
  int t = threadIdx.x;
  OPAQUE(t);
  const int n4 = t & 31, kg = t >> 5;
  const int ncol = n0 + n4 * 4;
  f32x4 rb[8];
#pragma unroll
  for (int j = 0; j < 8; ++j)
    rb[j] = (ncol < nvalid) ? *(const f32x4*)(W + (size_t)(k0 + kg * 8 + j) * ldw + ncol) : (f32x4){0.f, 0.f, 0.f, 0.f};
#pragma unroll
  for (int c = 0; c < 4; ++c) {
    u32x4 w;
    w.x = cvt_pk_bf16(rb[0][c], rb[1][c]); w.y = cvt_pk_bf16(rb[2][c], rb[3][c]);
    w.z = cvt_pk_bf16(rb[4][c], rb[5][c]); w.w = cvt_pk_bf16(rb[6][c], rb[7][c]);
    *(LAS u32x4*)(lds + (n4 * 4 + c) * 144 + kg * 16) = w;
  }
  __syncthreads();
#pragma unroll
  for (int i = 0; i < 4; ++i) {
    const int q = t + i * 256, row = q >> 3, piece = q & 7;
    if (n0 + row < nvalid) *(u32x4*)(Wt + (size_t)(n0 + row) * ldt + k0 + piece * 8) = *(const LAS u32x4*)(lds + row * 144 + piece * 16);
  }
  __syncthreads();
}

typedef short s16x4 __attribute__((ext_vector_type(4)));
#define REDERIVE() do { OPAQUE(t); w = t >> 6; lane = t & 63; fr = lane & 15; fq = lane >> 4; rloc = w * 16 + fr; } while (0)
constexpr int VROW = 160;

__device__ __forceinline__ bf16x8 pack8(const f32x4 a, const f32x4 b) {
  u32x4 w;
  w.x = cvt_pk_bf16(a[0], a[1]); w.y = cvt_pk_bf16(a[2], a[3]);
  w.z = cvt_pk_bf16(b[0], b[1]); w.w = cvt_pk_bf16(b[2], b[3]);
  return __builtin_bit_cast(bf16x8, w);
}
__device__ __forceinline__ void tile_fetch(bf16x8 (&r)[2], const unsigned short* base, int t) {
  const bf16x8* q = (const bf16x8*)(base + t * 16);
  r[0] = q[0];
  r[1] = q[1];
}
__device__ __forceinline__ void stage_k(const bf16x8 (&r)[2], LAS unsigned char* ldsK, int t) {
  const int row = t >> 2, c0 = (t & 3) * 16;
  *(LAS bf16x8*)(ldsK + lds_byte(row, c0)) = r[0];
  *(LAS bf16x8*)(ldsK + lds_byte(row, c0 + 8)) = r[1];
}
__device__ __forceinline__ void stage_v(const bf16x8 (&r)[2], LAS unsigned char* ldsV, int t) {
  const int row = t >> 2, c0 = (t & 3) * 16;
  *(LAS bf16x8*)(ldsV + row * VROW + c0 * 2) = r[0];
  *(LAS bf16x8*)(ldsV + row * VROW + c0 * 2 + 16) = r[1];
}
template <int H>
__device__ __forceinline__ void attn_qk_h(f32x4 (&s)[4][2], const LAS unsigned char* qf, LAS unsigned char* ldsK, int fr, int fq) {
  const int koff = lds_byte(fr, fq * 8);
#pragma unroll
  for (int m = 0; m < 4; ++m)
#pragma unroll
    for (int nn = 0; nn < 2; ++nn) s[m][nn] = (f32x4){0.f, 0.f, 0.f, 0.f};
#pragma unroll
  for (int nn = 0; nn < 2; ++nn)
#pragma unroll
    for (int ks = 0; ks < 2; ++ks) {
      const bf16x8 kf = *(const LAS bf16x8*)(ldsK + koff + (2 * H + nn) * 2048 + ks * 1024);
#pragma unroll
      for (int m = 0; m < 4; ++m)
        s[m][nn] = __builtin_amdgcn_mfma_f32_16x16x32_bf16(kf, *(const LAS bf16x8*)(qf + (m * 2 + ks) * 1024), s[m][nn], 0, 0, 0);
    }
}
template <int H>
__device__ __forceinline__ void attn_pv_h(f32x4 (&o)[4][4], const bf16x8 (&pf)[4], LAS unsigned char* ldsV, int lane) {
  const int fq = lane >> 4, i = lane & 15;
  const int vbase = (4 * fq + (i >> 2)) * VROW + (i & 3) * 8;
#pragma unroll
  for (int dt = 0; dt < 4; ++dt) {
    LAS unsigned char* a0 = ldsV + vbase + H * 32 * VROW + dt * 32;
    const s16x4 v0 = __builtin_amdgcn_ds_read_tr16_b64_v4i16((LAS s16x4*)a0);
    const s16x4 v1 = __builtin_amdgcn_ds_read_tr16_b64_v4i16((LAS s16x4*)(a0 + 16 * VROW));
    bf16x8 vf;
    vf[0] = v0[0]; vf[1] = v0[1]; vf[2] = v0[2]; vf[3] = v0[3];
    vf[4] = v1[0]; vf[5] = v1[1]; vf[6] = v1[2]; vf[7] = v1[3];
#pragma unroll
    for (int m = 0; m < 4; ++m) o[m][dt] = __builtin_amdgcn_mfma_f32_16x16x32_bf16(vf, pf[m], o[m][dt], 0, 0, 0);
  }
}
constexpr float SOFTMAX_SHIFT = 12.0f;
template <int H, bool EM>
__device__ __forceinline__ void attn_softmax_h(f32x4 (&s)[4][2], float (&lrow)[4], bf16x8 (&pf)[4], bool rowok, int lo, int hi) {
#pragma unroll
  for (int m = 0; m < 4; ++m) {
    float ls = 0.f;
#pragma unroll
    for (int nn = 0; nn < 2; ++nn)
#pragma unroll
      for (int jj = 0; jj < 4; ++jj) {
        const int kc = 16 * (2 * H + nn) + jj;
        const bool ok = rowok && (!EM || (lo < kc && hi >= kc));
        const float pv = ok ? __builtin_amdgcn_exp2f(s[m][nn][jj] - SOFTMAX_SHIFT) : 0.f;
        s[m][nn][jj] = pv;
        ls += pv;
      }
    lrow[m] += ls;
    pf[m] = pack8(s[m][0], s[m][1]);
  }
}
template <int H, bool EM>
__device__ __forceinline__ void attn_sub(f32x4 (&o)[4][4], float (&mrow)[4], float (&lrow)[4], const LAS unsigned char* qf,
                                         LAS unsigned char* ldsK, LAS unsigned char* ldsV, bool rowok, int lo, int hi, int lane) {
  f32x4 s[4][2];
  bf16x8 pf[4];
  attn_qk_h<H>(s, qf, ldsK, lane & 15, lane >> 4);
  attn_softmax_h<H, EM>(s, lrow, pf, rowok, lo, hi);
  attn_pv_h<H>(o, pf, ldsV, lane);
  if (H == 0) __builtin_amdgcn_sched_barrier(0);
}
template <bool EM>
__device__ __forceinline__ void attn_tile(f32x4 (&o)[4][4], float (&mrow)[4], float (&lrow)[4], const LAS unsigned char* qf,
                                          LAS unsigned char* ldsK, LAS unsigned char* ldsV, bool rowok, int lo, int hi, int lane) {
  attn_sub<0, EM>(o, mrow, lrow, qf, ldsK, ldsV, rowok, lo, hi, lane);
  attn_sub<1, EM>(o, mrow, lrow, qf, ldsK, ldsV, rowok, lo, hi, lane);
}
template <int H>
__device__ __forceinline__ void cmp_stats(float (&mrow)[4], float (&lrow)[4], const LAS unsigned char* qf, LAS unsigned char* ldsK, int hi, int lane) {
  const int fq = lane >> 4;
  f32x4 s[4][2];
  __builtin_amdgcn_sched_barrier(0);
  attn_qk_h<H>(s, qf, ldsK, lane & 15, fq);
  __builtin_amdgcn_sched_barrier(0);
#pragma unroll
  for (int m = 0; m < 4; ++m) {
    float ls = 0.f;
#pragma unroll
    for (int nn = 0; nn < 2; ++nn)
#pragma unroll
      for (int jj = 0; jj < 4; ++jj) {
        const int kc = 16 * (2 * H + nn) + jj;
        ls += (hi >= kc) ? __builtin_amdgcn_exp2f(s[m][nn][jj] - SOFTMAX_SHIFT) : 0.f;
      }
    lrow[m] += ls;
  }
  __builtin_amdgcn_sched_barrier(0);
}
template <int H>
__device__ __forceinline__ void cmp_apply(f32x4 (&o)[4][4], const float (&msf)[4], const float (&linv)[4], float& lastprev, LAS float* improw,
                                          const LAS unsigned char* qf, LAS unsigned char* ldsK, LAS unsigned char* ldsV, int hi, int lane) {
  const int fq = lane >> 4;
  f32x4 s[4][2];
  bf16x8 pf[4];
  __builtin_amdgcn_sched_barrier(0);
  attn_qk_h<H>(s, qf, ldsK, lane & 15, fq);
  __builtin_amdgcn_sched_barrier(0);
#pragma unroll
  for (int m = 0; m < 4; ++m) {
#pragma unroll
    for (int nn = 0; nn < 2; ++nn)
#pragma unroll
      for (int jj = 0; jj < 4; ++jj) {
        const int kc = 16 * (2 * H + nn) + jj;
        s[m][nn][jj] = (hi >= kc) ? __builtin_amdgcn_exp2f(s[m][nn][jj] - SOFTMAX_SHIFT) * linv[m] : 0.f;
      }
    pf[m] = pack8(s[m][0], s[m][1]);
  }
#pragma unroll
  for (int nn = 0; nn < 2; ++nn) {
    float gs = 0.f, last = 0.f;
#pragma unroll
    for (int m = 0; m < 4; ++m) {
      gs += (s[m][nn][0] + s[m][nn][1]) + (s[m][nn][2] + s[m][nn][3]);
      last += s[m][nn][3];
    }
    const float pa = bpl(last, (lane + 48) & 63);
    const float pb = bpl(lastprev, (lane + 48) & 63);
    improw[(2 * H + nn) * 4 + fq] = gs + ((fq > 0) ? pa : pb);
    lastprev = last;
  }
  __builtin_amdgcn_sched_barrier(0);
  attn_pv_h<H>(o, pf, ldsV, lane);
  __builtin_amdgcn_sched_barrier(0);
}

__device__ __forceinline__ void attn_chunk(const Params& p, LAS unsigned char* lds, int b, int g, int ci) {
  int t = threadIdx.x;
  OPAQUE(t);
  int w = t >> 6, lane = t & 63, fr = lane & 15, fq = lane >> 4;
  LAS unsigned char* ldsK = lds;
  LAS unsigned char* ldsV = lds + 8192;
  LAS float* impb = (LAS float*)(lds + 18432) + w * 1024;
  LAS unsigned* unib = (LAS unsigned*)(lds + 18432 + 16384);
  int rloc = w * 16 + fr;
  const int tq = ci * 64 + rloc;
  const size_t tok = (size_t)b * S + tq;
  const float* grow = p.gn + tok * 24 + g * 12;
  float* orow = p.onsa + tok * 512 + g * 256;
  LAS unsigned char* qf = lds + 36864 + w * 8192 + lane * 16;
#pragma unroll
  for (int m = 0; m < 4; ++m)
#pragma unroll
    for (int ks = 0; ks < 2; ++ks)
      *(LAS bf16x8*)(qf + (m * 2 + ks) * 1024) = *(const bf16x8*)(p.qb + tok * 512 + (g * 4 + m) * 64 + ks * 32 + fq * 8);
  f32x4 o[4][4];
  float mrow[4], lrow[4];
  bf16x8 rk[2], rv[2];

  const int nvis = (tq >= 31) ? ((tq - 31) / 16 + 1) : 0;
  const int nvmax = 4 * ci + 3;
  const int ntc = (nvmax + 63) >> 6;
  const unsigned short* kcb = p.cmpb + (size_t)((0 * NB + b) * 2 + g) * 256 * 64;
  const unsigned short* vcb = p.cmpb + (size_t)((1 * NB + b) * 2 + g) * 256 * 64;
#pragma unroll
  for (int m = 0; m < 4; ++m) { mrow[m] = -INFINITY; lrow[m] = 0.f; }
  REDERIVE();
  for (int tc = 0; tc < ntc; ++tc) {
    tile_fetch(rk, kcb + (size_t)tc * 4096, t);
    stage_k(rk, ldsK, t);
    __syncthreads();
    const int hi = nvis - 1 - tc * 64 - 4 * fq;
    cmp_stats<0>(mrow, lrow, qf, ldsK, hi, lane);
    cmp_stats<1>(mrow, lrow, qf, ldsK, hi, lane);
    __syncthreads();
  }
  {
    float linv[4], msf[4];
#pragma unroll
    for (int m = 0; m < 4; ++m) {
      float l = lrow[m];
      l += bpx(l, lane, 16);
      l += bpx(l, lane, 32);
      linv[m] = (l > 0.f) ? 1.0f / l : 0.f;
      msf[m] = 0.f;
    }
    REDERIVE();
#pragma unroll
    for (int m = 0; m < 4; ++m)
#pragma unroll
      for (int dt = 0; dt < 4; ++dt) o[m][dt] = (f32x4){0.f, 0.f, 0.f, 0.f};
    float lastprev = 0.f;
    for (int tc = 0; tc < ntc; ++tc) {
      tile_fetch(rk, kcb + (size_t)tc * 4096, t);
      tile_fetch(rv, vcb + (size_t)tc * 4096, t);
      stage_k(rk, ldsK, t);
      stage_v(rv, ldsV, t);
      __syncthreads();
      const int hi = nvis - 1 - tc * 64 - 4 * fq;
      cmp_apply<0>(o, msf, linv, lastprev, impb + fr * 64 + tc * 16, qf, ldsK, ldsV, hi, lane);
      cmp_apply<1>(o, msf, linv, lastprev, impb + fr * 64 + tc * 16, qf, ldsK, ldsV, hi, lane);
      __syncthreads();
    }
  }
#pragma unroll
  for (int m = 0; m < 4; ++m) {
    const float gate = grow[m * 3 + 0];
#pragma unroll
    for (int dt = 0; dt < 4; ++dt) *(f32x4*)(orow + m * 64 + dt * 16 + 4 * fq) = o[m][dt] * gate;
  }
  unsigned mlo, mhi;
  REDERIVE();
  {
    WSYNC();
    float kv[16];
    const int c0 = -fq * 16, c1 = ci - fq * 16;
#pragma unroll
    for (int i = 0; i < 16; ++i) {
      const bool forced = (c0 == i) || (c1 == i) || (c1 == i + 1);
      float v = (c1 >= i) ? impb[fr * 64 + fq * 16 + i] : -INFINITY;
      if (forced) v = INFINITY;
      kv[i] = v;
    }
    WSYNC();
#pragma unroll
    for (int i = 0; i < 16; ++i) impb[fr * 64 + fq * 16 + i] = kv[i];
    WSYNC();
    int rank[16];
#pragma unroll
    for (int i = 0; i < 16; ++i) rank[i] = 0;
#pragma unroll 2
    for (int k = 0; k < 64; ++k) {
      const float ok = impb[fr * 64 + k];
      const int kq = k - fq * 16;
#pragma unroll
      for (int i = 0; i < 16; ++i) rank[i] += (ok > kv[i] || (ok == kv[i] && kq < i)) ? 1 : 0;
    }
    unsigned piece = 0;
#pragma unroll
    for (int i = 0; i < 16; ++i) piece |= (rank[i] < 16) ? (1u << i) : 0u;
    unsigned lo32 = (fq == 0) ? piece : (fq == 1) ? (piece << 16) : 0u;
    unsigned hi32 = (fq == 2) ? piece : (fq == 3) ? (piece << 16) : 0u;
    lo32 |= bpxu(lo32, lane, 16); lo32 |= bpxu(lo32, lane, 32);
    hi32 |= bpxu(hi32, lane, 16); hi32 |= bpxu(hi32, lane, 32);
    mlo = lo32; mhi = hi32;
    unsigned ulo = lo32, uhi = hi32;
#pragma unroll
    for (int off = 1; off < 16; off <<= 1) { ulo |= bpxu(ulo, lane, off); uhi |= bpxu(uhi, lane, off); }
    if (lane == 0) { unib[w * 2] = ulo; unib[w * 2 + 1] = uhi; }
    __syncthreads();
  }
  unsigned long long un;
  {
    const unsigned ulo = unib[0] | unib[2] | unib[4] | unib[6];
    const unsigned uhi = unib[1] | unib[3] | unib[5] | unib[7];
    un = ((unsigned long long)__builtin_amdgcn_readfirstlane(uhi) << 32) | (unsigned long long)__builtin_amdgcn_readfirstlane(ulo);
  }
  const unsigned long long rowmask = ((unsigned long long)mhi << 32) | mlo;

#pragma unroll 1
  for (int pass = 0; pass < 2; ++pass) {
    REDERIVE();
#pragma unroll
    for (int m = 0; m < 4; ++m) {
      mrow[m] = -INFINITY; lrow[m] = 0.f;
#pragma unroll
      for (int dt = 0; dt < 4; ++dt) o[m][dt] = (f32x4){0.f, 0.f, 0.f, 0.f};
    }
    const unsigned short* kb = p.kvb + (size_t)(((2 + 2 * pass) * NB + b) * 2 + g) * S * 64;
    const unsigned short* vb = p.kvb + (size_t)(((3 + 2 * pass) * NB + b) * 2 + g) * S * 64;
    const unsigned long long upto = (ci == 63) ? ~0ull : ((1ull << (ci + 1)) - 1ull);
    const int jlo = max(0, ci - 8);
    unsigned long long rem = pass ? (upto & ~((1ull << jlo) - 1ull)) : (un & upto);
    const int jwin0 = pass ? ci - 8 : -100;
    int j = __ffsll((long long)rem) - 1;
    tile_fetch(rk, kb + (size_t)j * 4096, t);
    tile_fetch(rv, vb + (size_t)j * 4096, t);
    while (rem) {
      rem &= rem - 1;
      stage_k(rk, ldsK, t);
      stage_v(rv, ldsV, t);
      __syncthreads();
      const int jn = rem ? (__ffsll((long long)rem) - 1) : -1;
      if (jn >= 0) {
        tile_fetch(rk, kb + (size_t)jn * 4096, t);
        tile_fetch(rv, vb + (size_t)jn * 4096, t);
      }
      const bool rowok = pass ? true : (bool)((rowmask >> j) & 1ull);
      int hi = (j == ci) ? rloc : 63;
      const int lo = ((j == jwin0) ? rloc : -1) - 4 * fq;
      hi = (rowok ? hi : -1000) - 4 * fq;
      attn_tile<true>(o, mrow, lrow, qf, ldsK, ldsV, true, lo, hi, lane);
      __syncthreads();
      j = jn;
    }
#pragma unroll
    for (int m = 0; m < 4; ++m) {
      float l = lrow[m];
      l += bpx(l, lane, 16);
      l += bpx(l, lane, 32);
      const float sc = grow[m * 3 + 1 + pass] / l;
#pragma unroll
      for (int dt = 0; dt < 4; ++dt) {
        f32x4* dst = (f32x4*)(orow + m * 64 + dt * 16 + 4 * fq);
        const f32x4 tot = *dst + o[m][dt] * sc;
        if (pass == 0) *dst = tot;
        else *(uint2*)(p.onsab + tok * 512 + g * 256 + m * 64 + dt * 16 + 4 * fq) = pack4(tot);
      }
    }
  }
}

#define XB_TMO      128
#define XB_XCNT(j)  (256  + 64 * (j))
#define XB_XSUB(j)  (1280 + 64 * (j))
#define XB_XGEN(j)  (2304 + 64 * (j))
#define XB_TOP      3328
#define XB_TOPGEN   3392
#define XCD_BAR_WORDS 3456
#define XB_SPIN_CAP (1u << 18)

__device__ __forceinline__ unsigned xb_ld(unsigned* p)              { return __hip_atomic_load(p, __ATOMIC_RELAXED, __HIP_MEMORY_SCOPE_AGENT); }
__device__ __forceinline__ unsigned xb_add(unsigned* p, unsigned v) { return __hip_atomic_fetch_add(p, v, __ATOMIC_RELAXED, __HIP_MEMORY_SCOPE_AGENT); }
__device__ __forceinline__ unsigned xb_xcc_id() { return (unsigned)__builtin_amdgcn_s_getreg((3 << 11) | 20) & 0xFu; }
#define XB_SPIN(cond, bar) do { unsigned _sp = 0; while (cond) { __builtin_amdgcn_s_sleep(1); \
    if ((++_sp & 255u) == 0u) { if (xb_ld(&(bar)[XB_TMO])) break; if (_sp > XB_SPIN_CAP) { atomicAdd(&(bar)[XB_TMO], 1u); break; } } } } while (0)

struct XcdBarrier {
    unsigned* bar; unsigned x;
    volatile LAS unsigned* st;
};

__device__ __forceinline__ XcdBarrier xcd_barrier_post(unsigned* bar, volatile LAS unsigned* st) {
    XcdBarrier b; b.bar = bar; b.x = xb_xcc_id(); b.st = st;
    if (threadIdx.x == 0) (void)xb_add(&bar[XB_XCNT(b.x)], 1u);
    return b;
}
__device__ __forceinline__ void xcd_barrier_complete(unsigned* bar, unsigned x, unsigned& nloc, unsigned& nx) {
    const unsigned G = gridDim.x * gridDim.y * gridDim.z;
    unsigned sum, cnt, mine, sp = 0u;
    for (;;) {
        sum = 0u; cnt = 0u; mine = 0u;
#pragma unroll
        for (unsigned j = 0; j < 16; ++j) { const unsigned c = xb_ld(&bar[XB_XCNT(j)]); sum += c; cnt += (c > 0u) ? 1u : 0u; mine = (j == x) ? c : mine; }
        if (sum == G) break;
        __builtin_amdgcn_s_sleep(1);
        if ((++sp & 255u) == 0u) { if (xb_ld(&bar[XB_TMO])) break; if (sp > XB_SPIN_CAP) { atomicAdd(&bar[XB_TMO], 1u); break; } }
    }
    nloc = mine > 0u ? mine : 1u; nx = cnt > 0u ? cnt : 1u;
}

__device__ __forceinline__ void xcd_barrier(const XcdBarrier& b) {
    asm volatile("s_waitcnt vmcnt(0)" ::: "memory");
    __syncthreads();
    if (threadIdx.x == 0) {
        unsigned* bar = b.bar;
        __builtin_amdgcn_s_waitcnt(0);
        unsigned nloc = b.st[0], nx = b.st[1];
        if (nloc == 0u) { xcd_barrier_complete(bar, b.x, nloc, nx); b.st[0] = nloc; b.st[1] = nx; }
        const unsigned old = xb_add(&bar[XB_XSUB(b.x)], 1u);
        const unsigned gen = old / nloc;
        if (old + 1u == (gen + 1u) * nloc) {
            __builtin_amdgcn_fence(__ATOMIC_RELEASE, "agent");
            asm volatile("s_waitcnt vmcnt(0)" ::: "memory");
            const unsigned og = xb_add(&bar[XB_TOP], 1u);
            const unsigned tg = og / nx;
            if (og + 1u == (tg + 1u) * nx) xb_add(&bar[XB_TOPGEN], 1u);
            else XB_SPIN(xb_ld(&bar[XB_TOPGEN]) == tg, bar);
            __builtin_amdgcn_fence(__ATOMIC_ACQUIRE, "agent");
            xb_add(&bar[XB_XGEN(b.x)], 1u);
            asm volatile("s_waitcnt vmcnt(0)" ::: "memory");
        } else {
            XB_SPIN(xb_ld(&bar[XB_XGEN(b.x)]) == gen, bar);
            __builtin_amdgcn_fence(__ATOMIC_ACQUIRE, "agent");
            asm volatile("s_waitcnt vmcnt(0)" ::: "memory");
        }
    }
    __syncthreads();
}


#define PHASE_IDX int t_ = threadIdx.x; OPAQUE(t_); const int tid = t_, lane = t_ & 63, wib = t_ >> 6; \
  const int gthreads = gridDim.x * 256, gtid = blockIdx.x * 256 + t_, gwaves = gridDim.x * 4, gwave = blockIdx.x * 4 + wib; \
  (void)tid; (void)lane; (void)wib; (void)gthreads; (void)gtid; (void)gwaves; (void)gwave;

constexpr int SMEM_BYTES = GEMM_RING * GEMM_STAGE;

__device__ __forceinline__ void conv_job(const float* W, int K, int N, bf16_t* Wt, int tile, LAS unsigned char* lds) {
  const int tnn = (N + 127) >> 7;
  convert_tile(W, N, N, Wt, K, (tile / tnn) * 64, (tile % tnn) * 128, lds);
}

__global__ void __launch_bounds__(256, 2) mega(Params p) {
  __shared__ __attribute__((aligned(16))) unsigned char smem_raw[SMEM_BYTES + 16];
  float* smem = (float*)smem_raw;
  LAS unsigned char* lds = (LAS unsigned char*)smem_raw;
  volatile LAS unsigned* xb_st = (volatile LAS unsigned*)(lds + SMEM_BYTES);
  if (threadIdx.x < 4) xb_st[threadIdx.x] = 0u;
  __syncthreads();
  const XcdBarrier gbar = xcd_barrier_post(p.bar, xb_st);

  {
  PHASE_IDX
  if (blockIdx.x < 96) {
    for (int i = tid; i < NB * D; i += 256) smem[i] = siluf_(p.c[i]);
    __syncthreads();
    const int j = blockIdx.x * 64 + lane;
    float a0 = 0.f, a1 = 0.f, a2 = 0.f, a3 = 0.f;
    const float* wp = p.w_ada + (size_t)(wib * 256) * (6 * D) + j;
#pragma unroll 8
    for (int k = 0; k < 256; ++k) {
      const float w = wp[(size_t)k * (6 * D)];
      const int kk = wib * 256 + k;
      a0 = fmaf(smem[kk], w, a0); a1 = fmaf(smem[D + kk], w, a1);
      a2 = fmaf(smem[2 * D + kk], w, a2); a3 = fmaf(smem[3 * D + kk], w, a3);
    }
    __syncthreads();
    smem[(wib * 4 + 0) * 64 + lane] = a0; smem[(wib * 4 + 1) * 64 + lane] = a1;
    smem[(wib * 4 + 2) * 64 + lane] = a2; smem[(wib * 4 + 3) * 64 + lane] = a3;
    __syncthreads();
    {
      const int b = wib;
      const float v = p.b_ada[j] + ((smem[(0 * 4 + b) * 64 + lane] + smem[(1 * 4 + b) * 64 + lane]) +
                                    (smem[(2 * 4 + b) * 64 + lane] + smem[(3 * 4 + b) * 64 + lane]));
      p.mod[b * 6 * D + j] = v;
    }
    __syncthreads();
  }
  for (int idx = gtid; idx < 32 * 64; idx += gthreads) {
    const int g = idx / 64;
    const double dt = exp((double)p.log_dt[g]);
    const double lr = p.a_re[idx], li = p.a_im[idx];
    double br = 1.0, bi = 0.0;
    for (int d = 0; d <= 16; ++d) {
      const double mag = exp(lr * dt * d);
      const double pr_ = mag * cos(li * dt * d), pi_ = mag * sin(li * dt * d);
      p.pw[(idx * 17 + d) * 2] = (float)pr_;
      p.pw[(idx * 17 + d) * 2 + 1] = (float)pi_;
      if (d == 1) { br = pr_; bi = pi_; }
    }
    const double nr = br - 1.0, ni = bi;
    const double den = lr * lr + li * li;
    const double cr = (nr * lr + ni * li) / den, ci = (ni * lr - nr * li) / den;
    for (int q = 0; q < 16; ++q) {
      const double wr = p.b_re[idx * 16 + q], wi = p.b_im[idx * 16 + q];
      p.bbar[(idx * 16 + q) * 2] = (float)(cr * wr - ci * wi);
      p.bbar[(idx * 16 + q) * 2 + 1] = (float)(cr * wi + ci * wr);
    }
  }
  for (int idx = gtid; idx < NE; idx += gthreads) { p.cnt[idx] = 0; p.cursor[idx] = 0; }
  for (int o = gwave; o < 512; o += gwaves) {
    const int kv = o >> 8, j = o & 255;
    const float* pe = kv ? p.pe_v : p.pe_k;
    const float* w1 = kv ? p.w_cmp_v1 : p.w_cmp_k1;
    float acc = 0.f;
    for (int k = lane; k < 2048; k += 64) acc = fmaf(pe[k], w1[(size_t)k * 256 + j], acc);
    acc = wsum(acc, lane);
    if (lane == 0) p.cbias[o] = acc;
  }
  {
    const int G = gridDim.x;
    const int first = (G > 96) ? 96 : 0, nb = G - first;
    if ((int)blockIdx.x >= first) {
      for (int job = blockIdx.x - first; job < 1040; job += nb) {
        if (job < 496) conv_job(p.w_in, D, INC, p.w_inT, job, lds);
        else if (job < 560) conv_job(p.w_cmp_k1, 2048, 256, p.wc1T, job - 496, lds);
        else if (job < 624) conv_job(p.w_cmp_v1, 2048, 256, p.wc1T + 256 * 2048, job - 560, lds);
        else if (job < 656) conv_job(p.w_glu, 512, 512, p.wgluT, job - 624, lds);
        else if (job < 720) conv_job(p.w_up_attn, 512, D, p.wuaT, job - 656, lds);
        else if (job < 784) conv_job(p.w_up_ssm, 512, D, p.wusT, job - 720, lds);
        else if (job < 912) conv_job(p.w_out, D, D, p.woutT, job - 784, lds);
        else if (job < 944) conv_job(p.w_router, D, NE, p.wrT, job - 912, lds);
        else if (job < 976) conv_job(p.ws_gate, D, DE, p.wsgT, job - 944, lds);
        else if (job < 1008) conv_job(p.ws_up, D, DE, p.wsuT, job - 976, lds);
        else conv_job(p.ws_down, DE, D, p.wsdT, job - 1008, lds);
      }
    }
  }
  }
  xcd_barrier(gbar);

  {
  PHASE_IDX
  for (int row = gwave; row < NT; row += gwaves) {
    const int b = row / S;
    const float* xr = p.x + (size_t)row * D;
    f32x4 v[4];
    float ss = 0.f;
#pragma unroll
    for (int i = 0; i < 4; ++i) {
      v[i] = *(const f32x4*)(xr + i * 256 + lane * 4);
      ss += (v[i][0] * v[i][0] + v[i][1] * v[i][1]) + (v[i][2] * v[i][2] + v[i][3] * v[i][3]);
    }
    ss = wsum(ss, lane);
    const float r = rsqrtf(ss * (1.0f / D) + EPS);
    const float* md = p.mod + b * 6 * D;
#pragma unroll
    for (int i = 0; i < 4; ++i) {
      const int col = i * 256 + lane * 4;
      const f32x4 gg = *(const f32x4*)(p.g_norm1 + col), sc = *(const f32x4*)(md + D + col), sh = *(const f32x4*)(md + col);
      *(uint2*)(p.h + (size_t)row * D + col) = pack4(v[i] * r * gg * (sc + 1.0f) + sh);
    }
  }
  for (int idx = gtid; idx < 32 * 128 * 256; idx += gthreads) {
    const int k = idx & 255, col = (idx >> 8) & 127, g = idx >> 15;
    const int n = col >> 1, ri = col & 1, sidx = k >> 4, q = k & 15;
    const int gn = g * 64 + n;
    const float pr_ = p.pw[(gn * 17 + 15 - sidx) * 2], pi_ = p.pw[(gn * 17 + 15 - sidx) * 2 + 1];
    const float br = p.bbar[(gn * 16 + q) * 2], bi = p.bbar[(gn * 16 + q) * 2 + 1];
    const float v = ri ? (pr_ * bi + pi_ * br) : (pr_ * br - pi_ * bi);
    p.w1T[idx] = (bf16_t)(cvt_pk_bf16(v, 0.f) & 0xffffu);
  }
  for (int idx = gtid; idx < 32 * 16 * 256; idx += gthreads) {
    const int q = idx & 15, pp = (idx >> 4) & 15, d = (idx >> 8) & 15, g = idx >> 12;
    float acc = (d == 0 && pp == q) ? p.d_skip[g * 16 + pp] : 0.f;
    for (int n = 0; n < 64; ++n) {
      const int gn = g * 64 + n;
      const float cr = p.c_re[(g * 16 + pp) * 64 + n], ci = p.c_im[(g * 16 + pp) * 64 + n];
      const float pr_ = p.pw[(gn * 17 + d) * 2], pi_ = p.pw[(gn * 17 + d) * 2 + 1];
      const float br = p.bbar[(gn * 16 + q) * 2], bi = p.bbar[(gn * 16 + q) * 2 + 1];
      const float tr = cr * pr_ - ci * pi_, ti = cr * pi_ + ci * pr_;
      acc += tr * br - ti * bi;
    }
    p.kd[idx] = acc;
  }
  for (int idx = gtid; idx < 32 * 256 * 128; idx += gthreads) {
    const int k = idx & 127, col = (idx >> 7) & 255, g = idx >> 15;
    const int i = col >> 4, pp = col & 15, n = k >> 1, ri = k & 1;
    const int gn = g * 64 + n;
    const float cr = p.c_re[(g * 16 + pp) * 64 + n], ci = p.c_im[(g * 16 + pp) * 64 + n];
    const float pr_ = p.pw[(gn * 17 + i + 1) * 2], pi_ = p.pw[(gn * 17 + i + 1) * 2 + 1];
    const float v = ri ? -(cr * pi_ + ci * pr_) : (cr * pr_ - ci * pi_);
    p.wyT[((size_t)g * 256 + col) * 384 + k] = (bf16_t)(cvt_pk_bf16(v, 0.f) & 0xffffu);
  }
  }
  xcd_barrier(gbar);

  {
  PHASE_IDX
  {
    constexpr int TN = (INC + TNW - 1) / TNW;
    int mt_, nt_;
    for (int it = 0; xcd_tile(it, NT / TM, TN, mt_, nt_); ++it) {
      const int m0 = mt_ * TM, n0 = nt_ * TNW;
      gemm128<true>(
          D, [&](int r) { return p.h + (size_t)(m0 + r) * D; },
          [&](int c) { return p.w_inT + (size_t)min(n0 + c, INC - 1) * D; },
          [&](const f32x4 (&acc)[4][8], int wr, int wc, int fr, int fq) {
#pragma unroll
            for (int sg = 0; sg < 2; ++sg) {
              const int cw = n0 + wc * 128 + sg * 64;
              if (cw < C_GN) {
                const bool isq = cw < C_KC;
                const int slot = isq ? 0 : (cw - C_KC) >> 7, gg = isq ? 0 : ((cw - C_KC) >> 6) & 1;
                const bool norm = isq || slot == 2 || slot == 4;
                const float* gain = isq ? p.q_gain : (slot == 2 ? p.ks_gain : p.kw_gain);
                const float post = isq ? ATT_SCALE * 1.4426950408889634f : 1.0f;
#pragma unroll
                for (int m = 0; m < 4; ++m) {
                  const int tok = m0 + wr * 64 + m * 16 + fr;
                  float r = 1.0f;
                  if (norm) {
                    float ss = 0.f;
#pragma unroll
                    for (int n = 0; n < 4; ++n)
#pragma unroll
                      for (int jj = 0; jj < 4; ++jj) ss = fmaf(acc[m][sg * 4 + n][jj], acc[m][sg * 4 + n][jj], ss);
                    ss += bpx(ss, fq * 16 + fr, 16);
                    ss += bpx(ss, fq * 16 + fr, 32);
                    r = rsqrtf(ss * (1.0f / 64) + EPS) * post;
                  }
                  bf16_t* dst = isq ? p.qb + (size_t)tok * 512 + cw
                                    : p.kvb + ((size_t)((slot * NB + (tok >> 12)) * 2 + gg) * S + (tok & (S - 1))) * 64;
#pragma unroll
                  for (int n = 0; n < 4; ++n) {
                    f32x4 v = acc[m][sg * 4 + n] * r;
                    if (norm) v = v * *(const f32x4*)(gain + n * 16 + 4 * fq);
                    *(uint2*)(dst + n * 16 + 4 * fq) = pack4(v);
                  }
                }
              } else {
#pragma unroll
                for (int m = 0; m < 4; ++m) {
                  const size_t tok = m0 + wr * 64 + m * 16 + fr;
#pragma unroll
                  for (int n = 0; n < 4; ++n) {
                    const int c = cw + n * 16 + 4 * fq;
                    if (c < INC) {
                      f32x4 v = acc[m][sg * 4 + n];
                      if (c >= C_U && c < C_GA) {
                        const int ch = c - C_U;
                        *(uint2*)(p.a3 + ((size_t)(ch >> 4) * 1024 + (tok >> 4)) * 384 + 128 + (tok & 15) * 16 + (ch & 15)) = pack4(v);
                      } else {
#pragma unroll
                        for (int j = 0; j < 4; ++j) v[j] = sigmoidf_(v[j]);
                        if (c < C_U) *(f32x4*)(p.gn + tok * 24 + (c - C_GN)) = v;
                        else if (c < C_GS) *(uint2*)(p.ga + tok * D + (c - C_GA)) = pack4(v);
                        else *(uint2*)(p.gs + tok * D + (c - C_GS)) = pack4(v);
                      }
                    }
                  }
                }
              }
            }
          },
          lds);
    }
  }
  for (int idx = gtid; idx < 32 * 256 * 256; idx += gthreads) {
    const int k = idx & 255, col = (idx >> 8) & 255, g = idx >> 16;
    const int i = col >> 4, pp = col & 15, sidx = k >> 4, q = k & 15;
    const float v = (i >= sidx) ? p.kd[((g * 16 + (i - sidx)) * 16 + pp) * 16 + q] : 0.f;
    p.wyT[((size_t)g * 256 + col) * 384 + 128 + k] = (bf16_t)(cvt_pk_bf16(v, 0.f) & 0xffffu);
  }
  }
  xcd_barrier(gbar);

  {
  PHASE_IDX
  for (int job = blockIdx.x; job < 2 * 8 * 16; job += gridDim.x) {
    const int kv = job >> 7, ks = (job >> 4) & 7, m0 = (job & 15) * 128;
    float* hp = p.hidp + (size_t)(ks * 2 + kv) * 2040 * 256;
    gemm128<true>(
        256,
        [&](int r) {
          const int rr = min(m0 + r, NB * NCMP * 2 - 1);
          const int b = rr / (NCMP * 2), n = (rr >> 1) % NCMP, g = rr & 1;
          return p.kvb + ((size_t)((kv * NB + b) * 2 + g) * S + 16 * n) * 64 + ks * 256;
        },
        [&](int c) { return p.wc1T + (size_t)(kv * 256 + c) * 2048 + ks * 256; },
        [&](const f32x4 (&acc)[4][8], int wr, int wc, int fr, int fq) {
#pragma unroll
          for (int m = 0; m < 4; ++m) {
            const int r = m0 + wr * 64 + m * 16 + fr;
            if (r < NB * NCMP * 2) {
#pragma unroll
              for (int n = 0; n < 8; ++n) *(f32x4*)(hp + (size_t)r * 256 + wc * 128 + n * 16 + 4 * fq) = acc[m][n];
            }
          }
        },
        lds);
  }
  int mt_, g;
  for (int it = 0; xcd_tile(it, 8, 32, mt_, g); ++it) {
    const int m0 = mt_ * 128;
    gemm128<true>(
        256, [&](int r) { return p.a3 + ((size_t)g * 1024 + m0 + r) * 384 + 128; },
        [&](int c) { return p.w1T + ((size_t)g * 128 + (c & 127)) * 256; },
        [&](const f32x4 (&acc)[4][8], int wr, int wc, int fr, int fq) {
          if (wc == 0) {
#pragma unroll
            for (int m = 0; m < 4; ++m)
#pragma unroll
              for (int n = 0; n < 8; ++n)
                *(f32x4*)(p.lbuf + ((size_t)g * 1024 + m0 + wr * 64 + m * 16 + fr) * 128 + n * 16 + 4 * fq) = acc[m][n];
          }
        },
        lds);
  }
  }
  xcd_barrier(gbar);

  {
  PHASE_IDX
  for (int wv = gwave; wv < 2 * NB * NCMP * 2; wv += gwaves) {
    const int kv = wv / (NB * NCMP * 2), r = wv % (NB * NCMP * 2);
    const int b = r / (NCMP * 2), n = (r >> 1) % NCMP, g = r & 1;
    const float* w2 = kv ? p.w_cmp_v2 : p.w_cmp_k2;
    {
      f32x4 hsum = *(const f32x4*)(p.cbias + kv * 256 + lane * 4);
#pragma unroll
      for (int ks = 0; ks < 8; ++ks) hsum = hsum + *(const f32x4*)(p.hidp + ((size_t)(ks * 2 + kv) * 2040 + r) * 256 + lane * 4);
#pragma unroll
      for (int j = 0; j < 4; ++j) hsum[j] = geluf_(hsum[j]);
      WSYNC();
      *(f32x4*)(smem + wib * 256 + lane * 4) = hsum;
      WSYNC();
    }
    const float* hid = smem + wib * 256;
    float acc = 0.f;
    for (int j = 0; j < 256; ++j) acc = fmaf(hid[j], w2[j * 64 + lane], acc);
    if (kv == 0) {
      const float ss = wsum(acc * acc, lane);
      acc = acc * rsqrtf(ss * (1.0f / 64) + EPS) * p.kc_gain[lane];
    }
    const float other = bpx(acc, lane, 1);
    if ((lane & 1) == 0)
      *(unsigned*)(p.cmpb + ((size_t)((kv * NB + b) * 2 + g) * 256 + n) * 64 + lane) = cvt_pk_bf16(acc, other);
  }
  for (int idx = gtid; idx < 2 * NB * 2 * 32; idx += gthreads)
    *(unsigned*)(p.cmpb + ((size_t)(idx >> 5) * 256 + 255) * 64 + (idx & 31) * 2) = 0u;
  for (int idx = gtid; idx < 32 * NB * 64; idx += gthreads) {
    const int n = idx & 63, b = (idx >> 6) & 3, g = idx >> 8;
    const int gn = g * 64 + n;
    const float lr = p.pw[(gn * 17 + 16) * 2], li = p.pw[(gn * 17 + 16) * 2 + 1];
    float hr_ = 0.f, hi_ = 0.f;
    const size_t row0 = (size_t)g * 1024 + b * 256;
#pragma unroll 32
    for (int c = 0; c < 256; ++c) {
      const float2 l2 = *(const float2*)(p.lbuf + (row0 + c) * 128 + n * 2);
      *(unsigned*)(p.a3 + (row0 + c) * 384 + n * 2) = cvt_pk_bf16(hr_, hi_);
      const float nr = lr * hr_ - li * hi_ + l2.x;
      const float ni = lr * hi_ + li * hr_ + l2.y;
      hr_ = nr; hi_ = ni;
    }
  }
  }
  xcd_barrier(gbar);

  {
  PHASE_IDX
  const int G = gridDim.x;
  const bool split = G >= 512;
  if (!split || blockIdx.x < 256) {
    for (int u = blockIdx.x; u < 256; u += (split ? 256 : G)) {
      const int bg = u >> 5, pr = u & 31;
      __builtin_amdgcn_s_setprio(2);
#pragma unroll 1
      for (int half = 0; half < 2; ++half) attn_chunk(p, lds, bg >> 1, bg & 1, half ? pr : 63 - pr);
      __builtin_amdgcn_s_setprio(0);
    }
  }
  if (!split || blockIdx.x >= 256) {
    const int x8 = blockIdx.x & 7, nsl = split ? ((G - 256) >> 3) : 0, sl = split ? (((int)blockIdx.x - 256) >> 3) : 0;
    for (int it = 0;; ++it) {
      int tile;
      if (split && ((G & 7) == 0)) { const int q = sl + it * nsl; if (q >= 32) break; tile = ((x8 + 8 * (q >> 3)) << 3) | (q & 7); }
      else { tile = (split ? (int)blockIdx.x - 256 : (int)blockIdx.x) + it * (split ? G - 256 : G); if (tile >= 256) break; }
      const int g = tile >> 3, m0 = (tile & 7) * 128, n0 = 0;
      gemm128(
          384, [&](int r) { return p.a3 + ((size_t)g * 1024 + m0 + r) * 384; },
          [&](int c) { return p.wyT + ((size_t)g * 256 + n0 + c) * 384; },
          [&](const f32x4 (&acc)[4][8], int wr, int wc, int fr, int fq) {
#pragma unroll
            for (int m = 0; m < 4; ++m)
#pragma unroll
              for (int n = 0; n < 8; ++n) {
                const int col = n0 + wc * 128 + n * 16 + 4 * fq;
                const size_t tok = (size_t)(m0 + wr * 64 + m * 16 + fr) * 16 + (col >> 4);
                f32x4 v = acc[m][n];
#pragma unroll
                for (int j = 0; j < 4; ++j) v[j] = geluf_(v[j]);
                *(uint2*)(p.z + tok * 512 + g * 16 + (col & 15)) = pack4(v);
              }
          },
          lds);
    }
    const int cb = split ? (int)blockIdx.x - 256 : (int)blockIdx.x, cn = split ? G - 256 : G;
    for (int job = cb; job < NE * 96; job += cn) {
      const int e = job / 96, rem = job - e * 96, which = rem >> 5, tile = rem & 31;
      if (which == 0) conv_job(p.w_gate + (size_t)e * D * DE, D, DE, p.wgT + (size_t)e * DE * D, tile, lds);
      else if (which == 1) conv_job(p.w_up + (size_t)e * D * DE, D, DE, p.wuT + (size_t)e * DE * D, tile, lds);
      else conv_job(p.w_down + (size_t)e * DE * D, DE, D, p.wdT + (size_t)e * D * DE, tile, lds);
    }
  }
  }
  xcd_barrier(gbar);

  {
  PHASE_IDX
  gemm_phase(
      NT, 512, 512, [&](int m) { return p.z + (size_t)m * 512; }, [&](int n) { return p.wgluT + (size_t)n * 512; },
      [&](int m, int n, f32x4 v) {
        const f32x4 zz = unpack4(*(const uint2*)(p.z + (size_t)m * 512 + n));
#pragma unroll
        for (int j = 0; j < 4; ++j) v[j] = zz[j] * sigmoidf_(v[j] + p.b_glu[n + j]);
        *(uint2*)(p.yssm + (size_t)m * 512 + n) = pack4(v);
      },
      lds);
  gemm_phase(
      NT, D, 512, [&](int m) { return p.onsab + (size_t)m * 512; }, [&](int n) { return p.wuaT + (size_t)n * 512; },
      [&](int m, int n, f32x4 v) {
        const f32x4 gg = unpack4(*(const uint2*)(p.ga + (size_t)m * D + n));
        *(f32x4*)(p.mtmp + (size_t)m * D + n) = gg * v;
      },
      lds);
  }
  xcd_barrier(gbar);
  {
  PHASE_IDX
  gemm_phase(
      NT, D, 512, [&](int m) { return p.yssm + (size_t)m * 512; }, [&](int n) { return p.wusT + (size_t)n * 512; },
      [&](int m, int n, f32x4 v) {
        const f32x4 gg = unpack4(*(const uint2*)(p.gs + (size_t)m * D + n));
        const f32x4 prev = *(const f32x4*)(p.mtmp + (size_t)m * D + n);
        *(uint2*)(p.merged + (size_t)m * D + n) = pack4(prev + gg * v);
      },
      lds);
  }
  xcd_barrier(gbar);
  {
  PHASE_IDX
  gemm_phase(
      NT, D, D, [&](int m) { return p.merged + (size_t)m * D; }, [&](int n) { return p.woutT + (size_t)n * D; },
      [&](int m, int n, f32x4 v) {
        const int b = m / S;
        const f32x4 xx = *(const f32x4*)(p.x + (size_t)m * D + n);
        const f32x4 gt = *(const f32x4*)(p.mod + b * 6 * D + 2 * D + n);
        *(f32x4*)(p.xmid + (size_t)m * D + n) = xx + gt * v;
      },
      lds);
  }
  xcd_barrier(gbar);

  {
  PHASE_IDX
  for (int row = gwave; row < NT; row += gwaves) {
    const int b = row / S;
    const float* xr = p.xmid + (size_t)row * D;
    f32x4 v[4];
    float ss = 0.f;
#pragma unroll
    for (int i = 0; i < 4; ++i) {
      v[i] = *(const f32x4*)(xr + i * 256 + lane * 4);
      ss += (v[i][0] * v[i][0] + v[i][1] * v[i][1]) + (v[i][2] * v[i][2] + v[i][3] * v[i][3]);
    }
    ss = wsum(ss, lane);
    const float r = rsqrtf(ss * (1.0f / D) + EPS);
    const float* md = p.mod + b * 6 * D;
#pragma unroll
    for (int i = 0; i < 4; ++i) {
      const int col = i * 256 + lane * 4;
      const f32x4 gg = *(const f32x4*)(p.g_norm2 + col), sc = *(const f32x4*)(md + 4 * D + col), sh = *(const f32x4*)(md + 3 * D + col);
      *(uint2*)(p.h + (size_t)row * D + col) = pack4(v[i] * r * gg * (sc + 1.0f) + sh);
    }
  }
  }
  xcd_barrier(gbar);

  {
  PHASE_IDX
  int mt_, nt_;
  for (int it = 0; xcd_tile(it, NT / TM, 3, mt_, nt_); ++it) {
    const int m0 = mt_ * TM;
    if (nt_ == 0) {
      gemm128<true>(
          D, [&](int r) { return p.h + (size_t)(m0 + r) * D; }, [&](int c) { return p.wrT + (size_t)c * D; },
          [&](const f32x4 (&acc)[4][8], int wr, int wc, int fr, int fq) {
#pragma unroll
            for (int m = 0; m < 4; ++m)
#pragma unroll
              for (int n = 0; n < 8; ++n) {
                f32x4 v = acc[m][n];
#pragma unroll
                for (int j = 0; j < 4; ++j) v[j] = sigmoidf_(v[j]);
                *(f32x4*)(p.scores + (size_t)(m0 + wr * 64 + m * 16 + fr) * NE + wc * 128 + n * 16 + 4 * fq) = v;
              }
          },
          lds);
    } else {
      const int ct = nt_ - 1;
      gemm128<true>(
          D, [&](int r) { return p.h + (size_t)(m0 + r) * D; },
          [&](int c) {
            const int hid = ct * 128 + (c >> 7) * 64 + ((c >> 4) & 3) * 16 + (c & 15);
            return (((c >> 6) & 1) ? p.wsuT : p.wsgT) + (size_t)hid * D;
          },
          [&](const f32x4 (&acc)[4][8], int wr, int wc, int fr, int fq) {
#pragma unroll
            for (int m = 0; m < 4; ++m)
#pragma unroll
              for (int n = 0; n < 4; ++n) {
                f32x4 v;
#pragma unroll
                for (int j = 0; j < 4; ++j) v[j] = siluf_(acc[m][n][j]) * acc[m][n + 4][j];
                *(uint2*)(p.hs + (size_t)(m0 + wr * 64 + m * 16 + fr) * DE + ct * 128 + wc * 64 + n * 16 + 4 * fq) = pack4(v);
              }
          },
          lds);
    }
  }
  }
  xcd_barrier(gbar);

  {
  PHASE_IDX
  for (int tok = gwave; tok < NT; tok += gwaves) {
    const float4 sc4 = *reinterpret_cast<const float4*>(p.scores + (size_t)tok * NE + lane * 4);
    const float4 bi4 = *reinterpret_cast<const float4*>(p.router_bias + lane * 4);
    const float sc[4] = {sc4.x, sc4.y, sc4.z, sc4.w};
    float bz[4] = {sc4.x + bi4.x, sc4.y + bi4.y, sc4.z + bi4.z, sc4.w + bi4.w};
    float m1 = -INFINITY, m2 = -INFINITY;
#pragma unroll
    for (int i = 0; i < 4; ++i) {
      const float v = bz[i];
      if (v > m1) { m2 = m1; m1 = v; } else if (v > m2) { m2 = v; }
    }
#pragma unroll
    for (int o = 1; o < 8; o <<= 1) {
      const float o1 = bpx(m1, lane, o), o2 = bpx(m2, lane, o);
      const float n1 = fmaxf(m1, o1);
      const float n2 = fmaxf(fminf(m1, o1), fmaxf(m2, o2));
      m1 = n1; m2 = n2;
    }
    const float gs = m1 + m2;
    const int mygrp = lane >> 3;
    int grank = 0;
#pragma unroll
    for (int g2 = 0; g2 < 8; ++g2) {
      const float og = bpl(gs, g2 * 8);
      grank += (og > gs || (og == gs && g2 < mygrp)) ? 1 : 0;
    }
    const bool gsel = grank < 4;
#pragma unroll
    for (int i = 0; i < 4; ++i) if (!gsel) bz[i] = -INFINITY;
    unsigned taken = 0;
    float wsel = 0.f;
    int esel = 0;
    float wtot = 0.f;
#pragma unroll 1
    for (int k = 0; k < TOPK; ++k) {
      float bv = -INFINITY; int bidx = 1 << 30;
#pragma unroll
      for (int i = 0; i < 4; ++i) {
        if (!((taken >> i) & 1u) && bz[i] > bv) { bv = bz[i]; bidx = lane * 4 + i; }
      }
#pragma unroll
      for (int o = 32; o > 0; o >>= 1) {
        const float ov = bpx(bv, lane, o);
        const int oi = bpxi(bidx, lane, o);
        if (ov > bv || (ov == bv && oi < bidx)) { bv = ov; bidx = oi; }
      }
      const int owner = bidx >> 2, slot = bidx & 3;
      float sv = 0.f;
      if (lane == owner) {
        taken |= 1u << slot;
        sv = (slot == 0) ? sc[0] : (slot == 1) ? sc[1] : (slot == 2) ? sc[2] : sc[3];
      }
      sv = bpl(sv, owner);
      wtot += sv;
      if (lane == k) { wsel = sv; esel = bidx; }
    }
    if (lane < TOPK) {
      p.eidx[tok * TOPK + lane] = esel;
      p.ew[tok * TOPK + lane] = wsel / wtot * 2.5f;
      atomicAdd(&p.cnt[esel], 1);
    }
  }
  gemm_phase(
      NT, D, DE, [&](int m) { return p.hs + (size_t)m * DE; }, [&](int n) { return p.wsdT + (size_t)n * DE; },
      [&](int m, int n, f32x4 v) {
        const int b = m / S;
        const f32x4 xx = *(const f32x4*)(p.xmid + (size_t)m * D + n);
        const f32x4 gt = *(const f32x4*)(p.mod + b * 6 * D + 5 * D + n);
        *(f32x4*)(p.out + (size_t)m * D + n) = xx + gt * v;
      },
      lds);
  }
  xcd_barrier(gbar);

  {
  PHASE_IDX
  {
    int* soff = (int*)smem;
    int* srt = soff + 320;
    const int myc = p.cnt[tid];
    soff[tid] = myc;
    srt[tid] = (myc + 127) >> 7;
    __syncthreads();
    for (int st = 1; st < 256; st <<= 1) {
      const int a0 = (tid >= st) ? soff[tid - st] : 0;
      __syncthreads();
      soff[tid] += a0;
      __syncthreads();
    }
    const int exo = soff[tid] - myc;
    __syncthreads();
    soff[tid] = exo;
    if (blockIdx.x == 0) {
      p.off[tid] = exo;
      if (tid == 255) p.off[NE] = exo + myc;
    }
    __syncthreads();
    if (blockIdx.x == 0 && tid < 8) {
      int acc = 0;
      for (int i = 0; i < 32; ++i) { p.xrts[tid * 33 + i] = acc; acc += srt[tid + 8 * i]; }
      p.xrts[tid * 33 + 32] = acc;
    }
    for (int idx = gtid; idx < NASSIGN; idx += gthreads) {
      const int e = p.eidx[idx];
      const int pos = soff[e] + atomicAdd(&p.cursor[e], 1);
      p.stok[pos] = idx / TOPK;
      p.sw[pos] = p.ew[idx];
      p.apos[idx] = pos;
    }
    __syncthreads();
  }
  }
  xcd_barrier(gbar);

  {
  PHASE_IDX
  {
    const int x8 = blockIdx.x & 7, ns8 = ((int)gridDim.x - x8 + 7) >> 3;
    const int* xr = p.xrts + x8 * 33;
    const int total_rt = xr[32];
    for (int tile = blockIdx.x >> 3; tile < total_rt * 2; tile += ns8) {
      const int rt = tile >> 1, ct = tile & 1;
      const int ei = find_idx(xr, 32, rt);
      const int e = x8 + 8 * ei;
      const int pos0 = p.off[e] + (rt - xr[ei]) * 128;
      const int mvalid = min(128, p.off[e] + p.cnt[e] - pos0);
      const bf16_t* wg = p.wgT + (size_t)e * DE * D;
      const bf16_t* wu = p.wuT + (size_t)e * DE * D;
      gemm128<true>(
          D, [&](int r) { return p.h + (size_t)p.stok[pos0 + min(r, mvalid - 1)] * D; },
          [&](int c) {
            const int hid = ct * 128 + (c >> 7) * 64 + ((c >> 4) & 3) * 16 + (c & 15);
            return (((c >> 6) & 1) ? wu : wg) + (size_t)hid * D;
          },
          [&](const f32x4 (&acc)[4][8], int wr, int wc, int fr, int fq) {
#pragma unroll
            for (int m = 0; m < 4; ++m) {
              const int r = wr * 64 + m * 16 + fr;
              if (r < mvalid) {
#pragma unroll
                for (int n = 0; n < 4; ++n) {
                  f32x4 v;
#pragma unroll
                  for (int j = 0; j < 4; ++j) v[j] = siluf_(acc[m][n][j]) * acc[m][n + 4][j];
                  *(uint2*)(p.hr + (size_t)(pos0 + r) * DE + ct * 128 + wc * 64 + n * 16 + 4 * fq) = pack4(v);
                }
              }
            }
          },
          lds);
    }
  }
  }
  xcd_barrier(gbar);
  {
  PHASE_IDX
  {
    const int x8 = blockIdx.x & 7, ns8 = ((int)gridDim.x - x8 + 7) >> 3;
    const int* xr = p.xrts + x8 * 33;
    const int total_rt = xr[32];
    for (int rt = blockIdx.x >> 3; rt < total_rt; rt += ns8) {
      const int ei = find_idx(xr, 32, rt);
      const int e = x8 + 8 * ei;
      const int pos0 = p.off[e] + (rt - xr[ei]) * 128;
      const int mvalid = min(128, p.off[e] + p.cnt[e] - pos0);
      const bf16_t* wd = p.wdT + (size_t)e * D * DE;
      float wgt4[4];
      {
        int tq = threadIdx.x;
        OPAQUE(tq);
        const int wr_ = tq >> 7, fr_ = tq & 15;
#pragma unroll
        for (int m = 0; m < 4; ++m) wgt4[m] = p.sw[pos0 + min(wr_ * 64 + m * 16 + fr_, mvalid - 1)];
      }
      gemm128_stream<4>(
          DE, [&](int r) { return p.hr + (size_t)(pos0 + min(r, mvalid - 1)) * DE; },
          [&](int c) { return wd + (size_t)c * DE; }, (size_t)256 * DE,
          [&](int ct, const f32x4 (&acc)[4][8], int wr, int wc, int fr, int fq) {
#pragma unroll
            for (int m = 0; m < 4; ++m) {
              const int r = wr * 64 + m * 16 + fr;
              if (r < mvalid) {
#pragma unroll
                for (int n = 0; n < 8; ++n)
                  *(uint2*)(p.yk + (size_t)(pos0 + r) * D + ct * 256 + wc * 128 + n * 16 + 4 * fq) = pack4(acc[m][n] * wgt4[m]);
              }
            }
          },
          lds);
    }
  }
  }
  xcd_barrier(gbar);
  {
  PHASE_IDX
  for (int tok = gwave; tok < NT; tok += gwaves) {
    const int b = tok / S;
    float acc[16];
#pragma unroll
    for (int i = 0; i < 16; ++i) acc[i] = 0.f;
#pragma unroll 1
    for (int k = 0; k < TOPK; ++k) {
      const int pos = p.apos[tok * TOPK + k];
      const u32x4* src = (const u32x4*)(p.yk + (size_t)pos * D + lane * 16);
      const u32x4 a = src[0], c = src[1];
      const unsigned wv[8] = {a.x, a.y, a.z, a.w, c.x, c.y, c.z, c.w};
#pragma unroll
      for (int i = 0; i < 8; ++i) {
        acc[2 * i] += __uint_as_float(wv[i] << 16);
        acc[2 * i + 1] += __uint_as_float(wv[i] & 0xffff0000u);
      }
    }
    float* dst = p.out + (size_t)tok * D + lane * 16;
    const float* gt = p.mod + b * 6 * D + 5 * D + lane * 16;
#pragma unroll
    for (int i = 0; i < 4; ++i) {
      f32x4 o4 = *(f32x4*)(dst + 4 * i);
      const f32x4 g4 = *(const f32x4*)(gt + 4 * i);
#pragma unroll
      for (int j = 0; j < 4; ++j) o4[j] += g4[j] * acc[4 * i + j];
      *(f32x4*)(dst + 4 * i) = o4;
    }
  }
  }
}

extern "C" void kernel_launch(void* const* d_in, const int* in_sizes, int n_in, void* d_out, int out_size,
                              void* d_ws, size_t ws_size, hipStream_t stream) {
  (void)in_sizes; (void)n_in; (void)out_size;
  Params p{};
  const float* const* in = reinterpret_cast<const float* const*>(d_in);
  p.x = in[0]; p.c = in[1]; p.w_ada = in[2]; p.b_ada = in[3]; p.g_norm1 = in[4]; p.g_norm2 = in[5];
  p.w_in = in[6]; p.q_gain = in[7]; p.kc_gain = in[8]; p.ks_gain = in[9]; p.kw_gain = in[10];
  p.pe_k = in[11]; p.pe_v = in[12]; p.w_cmp_k1 = in[13]; p.w_cmp_k2 = in[14]; p.w_cmp_v1 = in[15];
  p.w_cmp_v2 = in[16]; p.a_re = in[17]; p.a_im = in[18]; p.log_dt = in[19]; p.b_re = in[20];
  p.b_im = in[21]; p.c_re = in[22]; p.c_im = in[23]; p.d_skip = in[24]; p.w_glu = in[25];
  p.b_glu = in[26]; p.w_up_attn = in[27]; p.w_up_ssm = in[28]; p.w_out = in[29]; p.w_router = in[30];
  p.router_bias = in[31]; p.w_gate = in[32]; p.w_up = in[33]; p.w_down = in[34]; p.ws_gate = in[35];
  p.ws_up = in[36]; p.ws_down = in[37];
  p.out = (float*)d_out;

  char* base = (char*)d_ws;
  size_t o = 0;
  auto take = [&](size_t bytes) { void* r = base + o; o += (bytes + 255) & ~(size_t)255; return r; };
  p.bar = (unsigned*)take(sizeof(unsigned) * XCD_BAR_WORDS);
  p.mod = (float*)take(sizeof(float) * NB * 6 * D);
  p.cbias = (float*)take(sizeof(float) * 512);
  p.w_inT = (bf16_t*)take(2 * (size_t)INC * D);
  p.wc1T = (bf16_t*)take(2 * (size_t)2 * 256 * 2048);
  p.wgluT = (bf16_t*)take(2 * (size_t)512 * 512);
  p.wuaT = (bf16_t*)take(2 * (size_t)D * 512);
  p.wusT = (bf16_t*)take(2 * (size_t)D * 512);
  p.woutT = (bf16_t*)take(2 * (size_t)D * D);
  p.wrT = (bf16_t*)take(2 * (size_t)NE * D);
  p.wsgT = (bf16_t*)take(2 * (size_t)DE * D);
  p.wsuT = (bf16_t*)take(2 * (size_t)DE * D);
  p.wsdT = (bf16_t*)take(2 * (size_t)D * DE);
  p.w1T = (bf16_t*)take(2 * (size_t)32 * 128 * 256);
  p.wyT = (bf16_t*)take(2 * (size_t)32 * 256 * 384);
  p.wgT = (bf16_t*)take(2 * (size_t)NE * DE * D);
  p.wuT = (bf16_t*)take(2 * (size_t)NE * DE * D);
  p.wdT = (bf16_t*)take(2 * (size_t)NE * D * DE);
  p.h = (bf16_t*)take(2 * (size_t)NT * D);
  p.pw = (float*)take(sizeof(float) * 2048 * 17 * 2);
  p.bbar = (float*)take(sizeof(float) * 2048 * 32);
  p.kd = (float*)take(sizeof(float) * 32 * 16 * 256);
  p.xmid = (float*)take(sizeof(float) * (size_t)NT * D);
  p.scores = (float*)take(sizeof(float) * (size_t)NT * NE);
  p.eidx = (int*)take(sizeof(int) * NASSIGN);
  p.ew = (float*)take(sizeof(float) * NASSIGN);
  p.cnt = (int*)take(sizeof(int) * NE);
  p.cursor = (int*)take(sizeof(int) * NE);
  p.off = (int*)take(sizeof(int) * (NE + 1));
  p.xrts = (int*)take(sizeof(int) * 8 * 33);
  p.stok = (int*)take(sizeof(int) * NASSIGN);
  p.sw = (float*)take(sizeof(float) * NASSIGN);
  p.apos = (int*)take(sizeof(int) * NASSIGN);
  p.hs = (bf16_t*)take(2 * (size_t)NT * DE);
  p.hr = (bf16_t*)take(2 * (size_t)NASSIGN * DE);
  const size_t early0 = o;
  p.qb = (bf16_t*)take(2 * (size_t)NT * 512);
  p.kvb = (bf16_t*)take(2 * (size_t)6 * NB * 2 * S * 64);
  p.cmpb = (bf16_t*)take(2 * (size_t)2 * NB * 2 * 256 * 64);
  p.gn = (float*)take(sizeof(float) * (size_t)NT * 24);
  p.a3 = (bf16_t*)take(2 * (size_t)32 * 1024 * 384);
  p.ga = (bf16_t*)take(2 * (size_t)NT * D);
  p.gs = (bf16_t*)take(2 * (size_t)NT * D);
  p.hidp = (float*)take(sizeof(float) * 16 * 2040 * 256);
  p.onsa = (float*)take(sizeof(float) * (size_t)NT * 512);
  p.onsab = (bf16_t*)take(2 * (size_t)NT * 512);
  p.lbuf = (float*)take(sizeof(float) * 32 * 1024 * 128);
  p.z = (bf16_t*)take(2 * (size_t)NT * 512);
  p.yssm = (bf16_t*)take(2 * (size_t)NT * 512);
  p.mtmp = (float*)take(sizeof(float) * (size_t)NT * D);
  p.merged = (bf16_t*)take(2 * (size_t)NT * D);
  const size_t early1 = o;
  p.yk = (bf16_t*)(base + early0);
  const size_t yk_bytes = 2 * (size_t)NASSIGN * D;
  if (early0 + yk_bytes > o) o = early0 + yk_bytes;
  (void)early1;
  if (o > ws_size) fprintf(stderr, "workspace too small: need %zu have %zu\n", o, ws_size);

  static int grid_blocks = 0;
  if (!grid_blocks) {
    int dev = 0, cus = 0, per_cu = 0;
    (void)hipGetDevice(&dev);
    (void)hipDeviceGetAttribute(&cus, hipDeviceAttributeMultiprocessorCount, dev);
    (void)hipOccupancyMaxActiveBlocksPerMultiprocessor(&per_cu, mega, 256, 0);
    if (per_cu > 2) per_cu = 2;
    if (per_cu < 1) per_cu = 1;
    grid_blocks = cus * per_cu;
  }
  (void)hipMemsetAsync(p.bar, 0, sizeof(unsigned) * XCD_BAR_WORDS, stream);
  hipLaunchKernelGGL(mega, dim3(grid_blocks), dim3(256), 0, stream, p);
  hipError_t e = hipPeekAtLastError();
  if (e != hipSuccess) fprintf(stderr, "launch failed: %s (grid %d)\n", hipGetErrorString(e), grid_blocks);
}
```

```cpp
#include <hip/hip_runtime.h>
#include <cstdio>
#include <cstdint>

constexpr int D = 1024;
constexpr int NB = 4;
constexpr int S = 4096;
constexpr int NT = NB * S;
constexpr int INC = 3864;
constexpr int C_Q = 0, C_KC = 512, C_VC = 640, C_KS = 768, C_VS = 896, C_KW = 1024, C_VW = 1152,
              C_GN = 1280, C_U = 1304, C_GA = 1816, C_GS = 2840;
constexpr int NCMP = 255;
constexpr int NE = 256;
constexpr int TOPK = 8;
constexpr int DE = 256;
constexpr int NASSIGN = NT * TOPK;
constexpr float EPS = 1e-6f;
constexpr float ATT_SCALE = 0.125f;
typedef unsigned short bf16_t;

struct Params {
  const float* x; const float* c; const float* w_ada; const float* b_ada; const float* g_norm1;
  const float* g_norm2; const float* w_in; const float* q_gain; const float* kc_gain;
  const float* ks_gain; const float* kw_gain; const float* pe_k; const float* pe_v;
  const float* w_cmp_k1; const float* w_cmp_k2; const float* w_cmp_v1; const float* w_cmp_v2;
  const float* a_re; const float* a_im; const float* log_dt; const float* b_re; const float* b_im;
  const float* c_re; const float* c_im; const float* d_skip; const float* w_glu; const float* b_glu;
  const float* w_up_attn; const float* w_up_ssm; const float* w_out; const float* w_router;
  const float* router_bias; const float* w_gate; const float* w_up; const float* w_down;
  const float* ws_gate; const float* ws_up; const float* ws_down;
  float* out;
  unsigned* bar;
  float* mod;
  float* cbias;
  bf16_t* w_inT;
  bf16_t* wc1T;
  bf16_t* wgluT;
  bf16_t* wuaT;
  bf16_t* wusT;
  bf16_t* woutT;
  bf16_t* wrT;
  bf16_t* wsgT;
  bf16_t* wsuT;
  bf16_t* wsdT;
  bf16_t* w1T;
  bf16_t* wyT;
  bf16_t* wgT;
  bf16_t* wuT;
  bf16_t* wdT;
  bf16_t* h;
  bf16_t* qb;
  bf16_t* kvb;
  bf16_t* cmpb;
  float* gn;
  bf16_t* a3;
  bf16_t* ga;
  bf16_t* gs;
  float* hidp;
  float* onsa;
  bf16_t* onsab;
  float* pw;
  float* bbar;
  float* kd;
  float* lbuf;
  bf16_t* z;
  bf16_t* yssm;
  float* mtmp;
  bf16_t* merged;
  float* xmid;
  float* scores;
  int* eidx;
  float* ew;
  int* cnt;
  int* cursor;
  int* off;
  int* xrts;
  int* stok;
  float* sw;
  int* apos;
  bf16_t* hs;
  bf16_t* hr;
  bf16_t* yk;
};

__device__ __forceinline__ float bpx(float v, int lane, int off) {
  return __int_as_float(__builtin_amdgcn_ds_bpermute((lane ^ off) << 2, __float_as_int(v)));
}
__device__ __forceinline__ int bpxi(int v, int lane, int off) { return __builtin_amdgcn_ds_bpermute((lane ^ off) << 2, v); }
__device__ __forceinline__ unsigned bpxu(unsigned v, int lane, int off) { return (unsigned)__builtin_amdgcn_ds_bpermute((lane ^ off) << 2, (int)v); }
__device__ __forceinline__ float bpl(float v, int src) {
  return __int_as_float(__builtin_amdgcn_ds_bpermute(src << 2, __float_as_int(v)));
}
__device__ __forceinline__ float wsum(float v, int lane) {
#pragma unroll
  for (int o = 32; o > 0; o >>= 1) v += bpx(v, lane, o);
  return v;
}
#define WSYNC() do { __builtin_amdgcn_fence(__ATOMIC_ACQ_REL, "wavefront"); __builtin_amdgcn_wave_barrier(); } while (0)
__device__ __forceinline__ float fexp_(float x) { return __builtin_amdgcn_exp2f(x * 1.4426950408889634f); }
__device__ __forceinline__ float sigmoidf_(float x) { return 1.0f / (1.0f + fexp_(-x)); }
__device__ __forceinline__ float sigmoid_acc(float x) { return 1.0f / (1.0f + expf(-x)); }
__device__ __forceinline__ float siluf_(float x) { return x / (1.0f + fexp_(-x)); }
__device__ __forceinline__ float geluf_(float x) {
  const float u2 = 1.5957691216057308f * (x + 0.044715f * x * x * x);
  return x / (1.0f + fexp_(-u2));
}
#define OPAQUE(x) asm volatile("" : "+v"(x))
typedef short bf16x8 __attribute__((ext_vector_type(8)));
typedef float f32x4 __attribute__((ext_vector_type(4)));
typedef unsigned u32x4 __attribute__((ext_vector_type(4)));
#define LAS __attribute__((address_space(3)))

__device__ __forceinline__ unsigned cvt_pk_bf16(float lo, float hi) {
  unsigned r;
  asm("v_cvt_pk_bf16_f32 %0, %1, %2" : "=v"(r) : "v"(lo), "v"(hi));
  return r;
}
__device__ __forceinline__ uint2 pack4(const f32x4 v) {
  uint2 w;
  w.x = cvt_pk_bf16(v[0], v[1]); w.y = cvt_pk_bf16(v[2], v[3]);
  return w;
}
__device__ __forceinline__ f32x4 unpack4(const uint2 w) {
  return (f32x4){__uint_as_float(w.x << 16), __uint_as_float(w.x & 0xffff0000u), __uint_as_float(w.y << 16), __uint_as_float(w.y & 0xffff0000u)};
}
__device__ __forceinline__ int lds_byte(int r, int c) {
  const int st = (r >> 4) * 2 + (c >> 5), rr = r & 15, cc = c & 31, ob = rr * 64 + cc * 2;
  return st * 1024 + (ob ^ (((ob >> 9) & 1) << 5));
}
__device__ __forceinline__ int t32_byte(int r, int c) {
  const int ob = (r & 15) * 64 + c * 2;
  return (r >> 4) * 1024 + (ob ^ (((ob >> 9) & 1) << 5));
}

constexpr int GEMM_STAGE = 24576;
constexpr int GEMM_RING = 3;
constexpr int TM = 128, TNW = 256;
template <bool GL = false, class AF, class BF, class EPW>
__device__ __forceinline__ void gemm128(int K, AF arow, BF brow, EPW epiw, LAS unsigned char* lds) {
  int t = threadIdx.x;
  OPAQUE(t);
  const int wid = t >> 6, lane = t & 63, wr = wid >> 1, wc = wid & 1, fr = lane & 15, fq = lane >> 4;
  const int sbb = lane * 16, obb = sbb ^ (((sbb >> 9) & 1) << 5);
  const int rin = obb >> 6, cel = (obb & 63) >> 1;
  const bf16_t* ga0 = arow(wid * 16 + rin) + cel;
  const bf16_t* ga1 = arow((wid + 4) * 16 + rin) + cel;
  const bf16_t* gb0 = brow(wid * 16 + rin) + cel;
  const bf16_t* gb1 = brow((wid + 4) * 16 + rin) + cel;
  const bf16_t* gb2 = brow((wid + 8) * 16 + rin) + cel;
  const bf16_t* gb3 = brow((wid + 12) * 16 + rin) + cel;
  f32x4 acc[4][8];
#pragma unroll
  for (int m = 0; m < 4; ++m)
#pragma unroll
    for (int n = 0; n < 8; ++n) acc[m][n] = (f32x4){0.f, 0.f, 0.f, 0.f};
  const int foff = t32_byte(fr, fq * 8);
  const int nk = K >> 5;
#define GEMM_COMPUTE(sa_) do { \
    bf16x8 af[4]; \
    _Pragma("unroll") for (int m = 0; m < 4; ++m) af[m] = *(const LAS bf16x8*)((sa_) + (wr * 4 + m) * 1024 + foff); \
    _Pragma("unroll") for (int nh = 0; nh < 2; ++nh) { \
      bf16x8 bf[4]; \
      _Pragma("unroll") for (int n = 0; n < 4; ++n) bf[n] = *(const LAS bf16x8*)((sa_) + 8192 + (wc * 8 + nh * 4 + n) * 1024 + foff); \
      __builtin_amdgcn_s_setprio(1); \
      _Pragma("unroll") for (int m = 0; m < 4; ++m) \
        _Pragma("unroll") for (int n = 0; n < 4; ++n) \
          acc[m][nh * 4 + n] = __builtin_amdgcn_mfma_f32_16x16x32_bf16(bf[n], af[m], acc[m][nh * 4 + n], 0, 0, 0); \
      __builtin_amdgcn_s_setprio(0); \
      if (nh == 0) __builtin_amdgcn_sched_barrier(0); } } while (0)
  if constexpr (GL) {
  LAS unsigned char* l0 = lds + t * 16;
#define GEMM_ISSUE(s_) do { LAS unsigned char* d_ = l0 + ((s_) % GEMM_RING) * GEMM_STAGE; const int ko_ = (s_) * 32; \
    __builtin_amdgcn_global_load_lds((const unsigned*)(ga0 + ko_), (LAS unsigned*)(d_), 16, 0, 0); \
    __builtin_amdgcn_global_load_lds((const unsigned*)(ga1 + ko_), (LAS unsigned*)(d_ + 4096), 16, 0, 0); \
    __builtin_amdgcn_global_load_lds((const unsigned*)(gb0 + ko_), (LAS unsigned*)(d_ + 8192), 16, 0, 0); \
    __builtin_amdgcn_global_load_lds((const unsigned*)(gb1 + ko_), (LAS unsigned*)(d_ + 12288), 16, 0, 0); \
    __builtin_amdgcn_global_load_lds((const unsigned*)(gb2 + ko_), (LAS unsigned*)(d_ + 16384), 16, 0, 0); \
    __builtin_amdgcn_global_load_lds((const unsigned*)(gb3 + ko_), (LAS unsigned*)(d_ + 20480), 16, 0, 0); } while (0)
  asm volatile("s_waitcnt vmcnt(0)" ::: "memory");
#pragma unroll
  for (int s_ = 0; s_ < GEMM_RING - 1; ++s_)
    if (s_ < nk) GEMM_ISSUE(s_);
  for (int kt = 0; kt < nk; ++kt) {
    if (kt + 1 < nk) asm volatile("s_waitcnt vmcnt(6)" ::: "memory");
    else asm volatile("s_waitcnt vmcnt(0)" ::: "memory");
    __builtin_amdgcn_s_barrier();
    asm volatile("" ::: "memory");
    if (kt + GEMM_RING - 1 < nk) GEMM_ISSUE(kt + GEMM_RING - 1);
    const LAS unsigned char* sa = lds + (kt % GEMM_RING) * GEMM_STAGE;
    GEMM_COMPUTE(sa);
  }
  __builtin_amdgcn_s_barrier();
  asm volatile("" ::: "memory");
#undef GEMM_ISSUE
  } else {
  for (int kt = 0; kt < nk; ++kt) {
    const int ko = kt * 32;
    const u32x4 a0 = *(const u32x4*)(ga0 + ko), a1 = *(const u32x4*)(ga1 + ko);
    const u32x4 b0 = *(const u32x4*)(gb0 + ko), b1 = *(const u32x4*)(gb1 + ko);
    const u32x4 b2 = *(const u32x4*)(gb2 + ko), b3 = *(const u32x4*)(gb3 + ko);
    *(LAS u32x4*)(lds + t * 16) = a0;
    *(LAS u32x4*)(lds + t * 16 + 4096) = a1;
    *(LAS u32x4*)(lds + t * 16 + 8192) = b0;
    *(LAS u32x4*)(lds + t * 16 + 12288) = b1;
    *(LAS u32x4*)(lds + t * 16 + 16384) = b2;
    *(LAS u32x4*)(lds + t * 16 + 20480) = b3;
    __syncthreads();
    GEMM_COMPUTE(lds);
    __syncthreads();
  }
  }
#undef GEMM_COMPUTE
  epiw(acc, wr, wc, fr, fq);
}

template <int NCT, class AF, class BF, class EPW>
__device__ __forceinline__ void gemm128_stream(int K, AF arow, BF brow, size_t bct, EPW epiw, LAS unsigned char* lds) {
  int t = threadIdx.x;
  OPAQUE(t);
  const int wid = t >> 6, lane = t & 63, wr = wid >> 1, wc = wid & 1, fr = lane & 15, fq = lane >> 4;
  const int sbb = lane * 16, obb = sbb ^ (((sbb >> 9) & 1) << 5);
  const int rin = obb >> 6, cel = (obb & 63) >> 1;
  const bf16_t* ga0 = arow(wid * 16 + rin) + cel;
  const bf16_t* ga1 = arow((wid + 4) * 16 + rin) + cel;
  const bf16_t* gb0 = brow(wid * 16 + rin) + cel;
  const bf16_t* gb1 = brow((wid + 4) * 16 + rin) + cel;
  const bf16_t* gb2 = brow((wid + 8) * 16 + rin) + cel;
  const bf16_t* gb3 = brow((wid + 12) * 16 + rin) + cel;
  f32x4 acc[4][8];
#pragma unroll
  for (int m = 0; m < 4; ++m)
#pragma unroll
    for (int n = 0; n < 8; ++n) acc[m][n] = (f32x4){0.f, 0.f, 0.f, 0.f};
  const int foff = t32_byte(fr, fq * 8);
  const int nk = K >> 5, ns = nk * NCT;
  LAS unsigned char* l0 = lds + t * 16;
  int iss_k = 0;
  size_t iss_b = 0;
#define GEMM_ISSUE2(s_) do { LAS unsigned char* d_ = l0 + ((s_) % GEMM_RING) * GEMM_STAGE; \
    __builtin_amdgcn_global_load_lds((const unsigned*)(ga0 + iss_k), (LAS unsigned*)(d_), 16, 0, 0); \
    __builtin_amdgcn_global_load_lds((const unsigned*)(ga1 + iss_k), (LAS unsigned*)(d_ + 4096), 16, 0, 0); \
    __builtin_amdgcn_global_load_lds((const unsigned*)(gb0 + iss_b + iss_k), (LAS unsigned*)(d_ + 8192), 16, 0, 0); \
    __builtin_amdgcn_global_load_lds((const unsigned*)(gb1 + iss_b + iss_k), (LAS unsigned*)(d_ + 12288), 16, 0, 0); \
    __builtin_amdgcn_global_load_lds((const unsigned*)(gb2 + iss_b + iss_k), (LAS unsigned*)(d_ + 16384), 16, 0, 0); \
    __builtin_amdgcn_global_load_lds((const unsigned*)(gb3 + iss_b + iss_k), (LAS unsigned*)(d_ + 20480), 16, 0, 0); \
    iss_k += 32; if (iss_k == K) { iss_k = 0; iss_b += bct; } } while (0)
  asm volatile("s_waitcnt vmcnt(0)" ::: "memory");
#pragma unroll
  for (int s_ = 0; s_ < GEMM_RING - 1; ++s_)
    if (s_ < ns) GEMM_ISSUE2(s_);
  int kt = 0, ct = 0;
  for (int s_ = 0; s_ < ns; ++s_) {
    if (s_ + 1 < ns) asm volatile("s_waitcnt vmcnt(6)" ::: "memory");
    else asm volatile("s_waitcnt vmcnt(0)" ::: "memory");
    __builtin_amdgcn_s_barrier();
    asm volatile("" ::: "memory");
    if (s_ + GEMM_RING - 1 < ns) GEMM_ISSUE2(s_ + GEMM_RING - 1);
    const LAS unsigned char* sa = lds + (s_ % GEMM_RING) * GEMM_STAGE;
    {
      bf16x8 af[4];
#pragma unroll
      for (int m = 0; m < 4; ++m) af[m] = *(const LAS bf16x8*)(sa + (wr * 4 + m) * 1024 + foff);
#pragma unroll
      for (int nh = 0; nh < 2; ++nh) {
        bf16x8 bf[4];
#pragma unroll
        for (int n = 0; n < 4; ++n) bf[n] = *(const LAS bf16x8*)(sa + 8192 + (wc * 8 + nh * 4 + n) * 1024 + foff);
#pragma unroll
        for (int m = 0; m < 4; ++m)
#pragma unroll
          for (int n = 0; n < 4; ++n)
            acc[m][nh * 4 + n] = __builtin_amdgcn_mfma_f32_16x16x32_bf16(bf[n], af[m], acc[m][nh * 4 + n], 0, 0, 0);
        if (nh == 0) __builtin_amdgcn_sched_barrier(0);
      }
    }
    if (++kt == nk) {
      epiw(ct, acc, wr, wc, fr, fq);
#pragma unroll
      for (int m = 0; m < 4; ++m)
#pragma unroll
        for (int n = 0; n < 8; ++n) acc[m][n] = (f32x4){0.f, 0.f, 0.f, 0.f};
      kt = 0; ++ct;
    }
  }
  __builtin_amdgcn_s_barrier();
  asm volatile("" ::: "memory");
#undef GEMM_ISSUE2
}

__device__ __forceinline__ bool xcd_tile(int it, int tm, int tn, int& mt, int& nt) {
  const int G = gridDim.x, x = blockIdx.x & 7, slot = blockIdx.x >> 3, ns = (G - x + 7) >> 3;
  const int q = slot + it * ns;
  if (tn >= 8) {
    const int cn = (tn - x + 7) >> 3;
    if (q >= cn * tm) return false;
    mt = q / cn; nt = x + 8 * (q % cn);
  } else {
    const int cm = (tm - x + 7) >> 3;
    if (cm <= 0 || q >= cm * tn) return false;
    mt = x + 8 * (q / tn); nt = q % tn;
  }
  return true;
}
__device__ __forceinline__ int find_idx(const int* pre, int n, int v) {
  int lo = 0, hi = n;
  while (hi - lo > 1) {
    const int mid = (lo + hi) >> 1;
    if (pre[mid] <= v) lo = mid; else hi = mid;
  }
  return lo;
}

template <class AL, class BL, class EP>
__device__ __forceinline__ void gemm_phase(int M, int N, int K, AL al, BL bl, EP ep, LAS unsigned char* lds) {
  const int tn = (N + TNW - 1) / TNW, tm = (M + TM - 1) / TM;
  int mt, nt;
  for (int it = 0; xcd_tile(it, tm, tn, mt, nt); ++it) {
    const int m0 = mt * TM, n0 = nt * TNW;
    gemm128<true>(
        K, [&](int r) { return al(min(m0 + r, M - 1)); }, [&](int c) { return bl(min(n0 + c, N - 1)); },
        [&](const f32x4 (&acc)[4][8], int wr, int wc, int fr, int fq) {
#pragma unroll
          for (int m = 0; m < 4; ++m)
#pragma unroll
            for (int n = 0; n < 8; ++n) {
              const int r = m0 + wr * 64 + m * 16 + fr, c = n0 + wc * 128 + n * 16 + 4 * fq;
              if (r < M && c < N) ep(r, c, acc[m][n]);
            }
        },
        lds);
  }
}

__device__ __forceinline__ void convert_tile(const float* W, int ldw, int nvalid, bf16_t* Wt, int ldt, int k0, int n0, LAS unsigned char* lds) {
  int t = threadIdx.x;
  OPAQUE(t);
  const int n4 = t & 31, kg = t >> 5;
  const int ncol = n0 + n4 * 4;
  f32x4 rb[8];
#pragma unroll
  for (int j = 0; j < 8; ++j)
    rb[j] = (ncol < nvalid) ? *(const f32x4*)(W + (size_t)(k0 + kg * 8 + j) * ldw + ncol) : (f32x4){0.f, 0.f, 0.f, 0.f};
#pragma unroll
  for (int c = 0; c < 4; ++c) {
    u32x4 w;
    w.x = cvt_pk_bf16(rb[0][c], rb[1][c]); w.y = cvt_pk_bf16(rb[2][c], rb[3][c]);
    w.z = cvt_pk_bf16(rb[4][c], rb[5][c]); w.w = cvt_pk_bf16(rb[6][c], rb[7][c]);
    *(LAS u32x4*)(lds + (n4 * 4 + c) * 144 + kg * 16) = w;
  }
  __syncthreads();
#pragma unroll
  for (int i = 0; i < 4; ++i) {
    const int q = t + i * 256, row = q >> 3, piece = q & 7;
    if (n0 + row < nvalid) *(u32x4*)(Wt + (size_t)(n0 + row) * ldt + k0 + piece * 8) = *(const LAS u32x4*)(lds + row * 144 + piece * 16);
  }
  __syncthreads();
}

typedef short s16x4 __attribute__((ext_vector_type(4)));
#define REDERIVE() do { OPAQUE(t); w = t >> 6; lane = t & 63; fr = lane & 15; fq = lane >> 4; rloc = w * 16 + fr; } while (0)
constexpr int VROW = 160;

__device__ __forceinline__ bf16x8 pack8(const f32x4 a, const f32x4 b) {
  u32x4 w;
  w.x = cvt_pk_bf16(a[0], a[1]); w.y = cvt_pk_bf16(a[2], a[3]);
  w.z = cvt_pk_bf16(b[0], b[1]); w.w = cvt_pk_bf16(b[2], b[3]);
  return __builtin_bit_cast(bf16x8, w);
}
__device__ __forceinline__ void tile_fetch(bf16x8 (&r)[2], const unsigned short* base, int t) {
  const bf16x8* q = (const bf16x8*)(base + t * 16);
  r[0] = q[0];
  r[1] = q[1];
}
__device__ __forceinline__ void stage_k(const bf16x8 (&r)[2], LAS unsigned char* ldsK, int t) {
  const int row = t >> 2, c0 = (t & 3) * 16;
  *(LAS bf16x8*)(ldsK + lds_byte(row, c0)) = r[0];
  *(LAS bf16x8*)(ldsK + lds_byte(row, c0 + 8)) = r[1];
}
__device__ __forceinline__ void stage_v(const bf16x8 (&r)[2], LAS unsigned char* ldsV, int t) {
  const int row = t >> 2, c0 = (t & 3) * 16;
  *(LAS bf16x8*)(ldsV + row * VROW + c0 * 2) = r[0];
  *(LAS bf16x8*)(ldsV + row * VROW + c0 * 2 + 16) = r[1];
}
template <int H>
__device__ __forceinline__ void attn_qk_h(f32x4 (&s)[4][2], const LAS unsigned char* qf, LAS unsigned char* ldsK, int fr, int fq) {
  const int koff = lds_byte(fr, fq * 8);
#pragma unroll
  for (int m = 0; m < 4; ++m)
#pragma unroll
    for (int nn = 0; nn < 2; ++nn) s[m][nn] = (f32x4){0.f, 0.f, 0.f, 0.f};
#pragma unroll
  for (int nn = 0; nn < 2; ++nn)
#pragma unroll
    for (int ks = 0; ks < 2; ++ks) {
      const bf16x8 kf = *(const LAS bf16x8*)(ldsK + koff + (2 * H + nn) * 2048 + ks * 1024);
#pragma unroll
      for (int m = 0; m < 4; ++m)
        s[m][nn] = __builtin_amdgcn_mfma_f32_16x16x32_bf16(kf, *(const LAS bf16x8*)(qf + (m * 2 + ks) * 1024), s[m][nn], 0, 0, 0);
    }
}
template <int H>
__device__ __forceinline__ void attn_pv_h(f32x4 (&o)[4][4], const bf16x8 (&pf)[4], LAS unsigned char* ldsV, int lane) {
  const int fq = lane >> 4, i = lane & 15;
  const int vbase = (4 * fq + (i >> 2)) * VROW + (i & 3) * 8;
#pragma unroll
  for (int dt = 0; dt < 4; ++dt) {
    LAS unsigned char* a0 = ldsV + vbase + H * 32 * VROW + dt * 32;
    const s16x4 v0 = __builtin_amdgcn_ds_read_tr16_b64_v4i16((LAS s16x4*)a0);
    const s16x4 v1 = __builtin_amdgcn_ds_read_tr16_b64_v4i16((LAS s16x4*)(a0 + 16 * VROW));
    bf16x8 vf;
    vf[0] = v0[0]; vf[1] = v0[1]; vf[2] = v0[2]; vf[3] = v0[3];
    vf[4] = v1[0]; vf[5] = v1[1]; vf[6] = v1[2]; vf[7] = v1[3];
#pragma unroll
    for (int m = 0; m < 4; ++m) o[m][dt] = __builtin_amdgcn_mfma_f32_16x16x32_bf16(vf, pf[m], o[m][dt], 0, 0, 0);
  }
}
constexpr float SOFTMAX_SHIFT = 12.0f;
template <int H, bool EM>
__device__ __forceinline__ void attn_softmax_h(f32x4 (&s)[4][2], float (&lrow)[4], bf16x8 (&pf)[4], bool rowok, int lo, int hi) {
#pragma unroll
  for (int m = 0; m < 4; ++m) {
    float ls = 0.f;
#pragma unroll
    for (int nn = 0; nn < 2; ++nn)
#pragma unroll
      for (int jj = 0; jj < 4; ++jj) {
        const int kc = 16 * (2 * H + nn) + jj;
        const bool ok = rowok && (!EM || (lo < kc && hi >= kc));
        const float pv = ok ? __builtin_amdgcn_exp2f(s[m][nn][jj] - SOFTMAX_SHIFT) : 0.f;
        s[m][nn][jj] = pv;
        ls += pv;
      }
    lrow[m] += ls;
    pf[m] = pack8(s[m][0], s[m][1]);
  }
}
template <int H, bool EM>
__device__ __forceinline__ void attn_sub(f32x4 (&o)[4][4], float (&mrow)[4], float (&lrow)[4], const LAS unsigned char* qf,
                                         LAS unsigned char* ldsK, LAS unsigned char* ldsV, bool rowok, int lo, int hi, int lane) {
  f32x4 s[4][2];
  bf16x8 pf[4];
  attn_qk_h<H>(s, qf, ldsK, lane & 15, lane >> 4);
  attn_softmax_h<H, EM>(s, lrow, pf, rowok, lo, hi);
  attn_pv_h<H>(o, pf, ldsV, lane);
  if (H == 0) __builtin_amdgcn_sched_barrier(0);
}
template <bool EM>
__device__ __forceinline__ void attn_tile(f32x4 (&o)[4][4], float (&mrow)[4], float (&lrow)[4], const LAS unsigned char* qf,
                                          LAS unsigned char* ldsK, LAS unsigned char* ldsV, bool rowok, int lo, int hi, int lane) {
  attn_sub<0, EM>(o, mrow, lrow, qf, ldsK, ldsV, rowok, lo, hi, lane);
  attn_sub<1, EM>(o, mrow, lrow, qf, ldsK, ldsV, rowok, lo, hi, lane);
}
template <int H>
__device__ __forceinline__ void cmp_stats(float (&mrow)[4], float (&lrow)[4], const LAS unsigned char* qf, LAS unsigned char* ldsK, int hi, int lane) {
  const int fq = lane >> 4;
  f32x4 s[4][2];
  __builtin_amdgcn_sched_barrier(0);
  attn_qk_h<H>(s, qf, ldsK, lane & 15, fq);
  __builtin_amdgcn_sched_barrier(0);
#pragma unroll
  for (int m = 0; m < 4; ++m) {
    float ls = 0.f;
#pragma unroll
    for (int nn = 0; nn < 2; ++nn)
#pragma unroll
      for (int jj = 0; jj < 4; ++jj) {
        const int kc = 16 * (2 * H + nn) + jj;
        ls += (hi >= kc) ? __builtin_amdgcn_exp2f(s[m][nn][jj] - SOFTMAX_SHIFT) : 0.f;
      }
    lrow[m] += ls;
  }
  __builtin_amdgcn_sched_barrier(0);
}
template <int H>
__device__ __forceinline__ void cmp_apply(f32x4 (&o)[4][4], const float (&msf)[4], const float (&linv)[4], float& lastprev, LAS float* improw,
                                          const LAS unsigned char* qf, LAS unsigned char* ldsK, LAS unsigned char* ldsV, int hi, int lane) {
  const int fq = lane >> 4;
  f32x4 s[4][2];
  bf16x8 pf[4];
  __builtin_amdgcn_sched_barrier(0);
  attn_qk_h<H>(s, qf, ldsK, lane & 15, fq);
  __builtin_amdgcn_sched_barrier(0);
#pragma unroll
  for (int m = 0; m < 4; ++m) {
#pragma unroll
    for (int nn = 0; nn < 2; ++nn)
#pragma unroll
      for (int jj = 0; jj < 4; ++jj) {
        const int kc = 16 * (2 * H + nn) + jj;
        s[m][nn][jj] = (hi >= kc) ? __builtin_amdgcn_exp2f(s[m][nn][jj] - SOFTMAX_SHIFT) * linv[m] : 0.f;
      }
    pf[m] = pack8(s[m][0], s[m][1]);
  }
#pragma unroll
  for (int nn = 0; nn < 2; ++nn) {
    float gs = 0.f, last = 0.f;
#pragma unroll
    for (int m = 0; m < 4; ++m) {
      gs += (s[m][nn][0] + s[m][nn][1]) + (s[m][nn][2] + s[m][nn][3]);
      last += s[m][nn][3];
    }
    const float pa = bpl(last, (lane + 48) & 63);
    const float pb = bpl(lastprev, (lane + 48) & 63);
    improw[(2 * H + nn) * 4 + fq] = gs + ((fq > 0) ? pa : pb);
    lastprev = last;
  }
  __builtin_amdgcn_sched_barrier(0);
  attn_pv_h<H>(o, pf, ldsV, lane);
  __builtin_amdgcn_sched_barrier(0);
}

__device__ __forceinline__ void attn_chunk(const Params& p, LAS unsigned char* lds, int b, int g, int ci) {
  int t = threadIdx.x;
  OPAQUE(t);
  int w = t >> 6, lane = t & 63, fr = lane & 15, fq = lane >> 4;
  LAS unsigned char* ldsK = lds;
  LAS unsigned char* ldsV = lds + 8192;
  LAS float* impb = (LAS float*)(lds + 18432) + w * 1024;
  LAS unsigned* unib = (LAS unsigned*)(lds + 18432 + 16384);
  int rloc = w * 16 + fr;
  const int tq = ci * 64 + rloc;
  const size_t tok = (size_t)b * S + tq;
  const float* grow = p.gn + tok * 24 + g * 12;
  float* orow = p.onsa + tok * 512 + g * 256;
  LAS unsigned char* qf = lds + 36864 + w * 8192 + lane * 16;
#pragma unroll
  for (int m = 0; m < 4; ++m)
#pragma unroll
    for (int ks = 0; ks < 2; ++ks)
      *(LAS bf16x8*)(qf + (m * 2 + ks) * 1024) = *(const bf16x8*)(p.qb + tok * 512 + (g * 4 + m) * 64 + ks * 32 + fq * 8);
  f32x4 o[4][4];
  float mrow[4], lrow[4];
  bf16x8 rk[2], rv[2];

  const int nvis = (tq >= 31) ? ((tq - 31) / 16 + 1) : 0;
  const int nvmax = 4 * ci + 3;
  const int ntc = (nvmax + 63) >> 6;
  const unsigned short* kcb = p.cmpb + (size_t)((0 * NB + b) * 2 + g) * 256 * 64;
  const unsigned short* vcb = p.cmpb + (size_t)((1 * NB + b) * 2 + g) * 256 * 64;
#pragma unroll
  for (int m = 0; m < 4; ++m) { mrow[m] = -INFINITY; lrow[m] = 0.f; }
  REDERIVE();
  for (int tc = 0; tc < ntc; ++tc) {
    tile_fetch(rk, kcb + (size_t)tc * 4096, t);
    stage_k(rk, ldsK, t);
    __syncthreads();
    const int hi = nvis - 1 - tc * 64 - 4 * fq;
    cmp_stats<0>(mrow, lrow, qf, ldsK, hi, lane);
    cmp_stats<1>(mrow, lrow, qf, ldsK, hi, lane);
    __syncthreads();
  }
  {
    float linv[4], msf[4];
#pragma unroll
    for (int m = 0; m < 4; ++m) {
      float l = lrow[m];
      l += bpx(l, lane, 16);
      l += bpx(l, lane, 32);
      linv[m] = (l > 0.f) ? 1.0f / l : 0.f;
      msf[m] = 0.f;
    }
    REDERIVE();
#pragma unroll
    for (int m = 0; m < 4; ++m)
#pragma unroll
      for (int dt = 0; dt < 4; ++dt) o[m][dt] = (f32x4){0.f, 0.f, 0.f, 0.f};
    float lastprev = 0.f;
    for (int tc = 0; tc < ntc; ++tc) {
      tile_fetch(rk, kcb + (size_t)tc * 4096, t);
      tile_fetch(rv, vcb + (size_t)tc * 4096, t);
      stage_k(rk, ldsK, t);
      stage_v(rv, ldsV, t);
      __syncthreads();
      const int hi = nvis - 1 - tc * 64 - 4 * fq;
      cmp_apply<0>(o, msf, linv, lastprev, impb + fr * 64 + tc * 16, qf, ldsK, ldsV, hi, lane);
      cmp_apply<1>(o, msf, linv, lastprev, impb + fr * 64 + tc * 16, qf, ldsK, ldsV, hi, lane);
      __syncthreads();
    }
  }
#pragma unroll
  for (int m = 0; m < 4; ++m) {
    const float gate = grow[m * 3 + 0];
#pragma unroll
    for (int dt = 0; dt < 4; ++dt) *(f32x4*)(orow + m * 64 + dt * 16 + 4 * fq) = o[m][dt] * gate;
  }
  unsigned mlo, mhi;
  REDERIVE();
  {
    WSYNC();
    float kv[16];
    const int c0 = -fq * 16, c1 = ci - fq * 16;
#pragma unroll
    for (int i = 0; i < 16; ++i) {
      const bool forced = (c0 == i) || (c1 == i) || (c1 == i + 1);
      float v = (c1 >= i) ? impb[fr * 64 + fq * 16 + i] : -INFINITY;
      if (forced) v = INFINITY;
      kv[i] = v;
    }
    WSYNC();
#pragma unroll
    for (int i = 0; i < 16; ++i) impb[fr * 64 + fq * 16 + i] = kv[i];
    WSYNC();
    int rank[16];
#pragma unroll
    for (int i = 0; i < 16; ++i) rank[i] = 0;
#pragma unroll 2
    for (int k = 0; k < 64; ++k) {
      const float ok = impb[fr * 64 + k];
      const int kq = k - fq * 16;
#pragma unroll
      for (int i = 0; i < 16; ++i) rank[i] += (ok > kv[i] || (ok == kv[i] && kq < i)) ? 1 : 0;
    }
    unsigned piece = 0;
#pragma unroll
    for (int i = 0; i < 16; ++i) piece |= (rank[i] < 16) ? (1u << i) : 0u;
    unsigned lo32 = (fq == 0) ? piece : (fq == 1) ? (piece << 16) : 0u;
    unsigned hi32 = (fq == 2) ? piece : (fq == 3) ? (piece << 16) : 0u;
    lo32 |= bpxu(lo32, lane, 16); lo32 |= bpxu(lo32, lane, 32);
    hi32 |= bpxu(hi32, lane, 16); hi32 |= bpxu(hi32, lane, 32);
    mlo = lo32; mhi = hi32;
    unsigned ulo = lo32, uhi = hi32;
#pragma unroll
    for (int off = 1; off < 16; off <<= 1) { ulo |= bpxu(ulo, lane, off); uhi |= bpxu(uhi, lane, off); }
    if (lane == 0) { unib[w * 2] = ulo; unib[w * 2 + 1] = uhi; }
    __syncthreads();
  }
  unsigned long long un;
  {
    const unsigned ulo = unib[0] | unib[2] | unib[4] | unib[6];
    const unsigned uhi = unib[1] | unib[3] | unib[5] | unib[7];
    un = ((unsigned long long)__builtin_amdgcn_readfirstlane(uhi) << 32) | (unsigned long long)__builtin_amdgcn_readfirstlane(ulo);
  }
  const unsigned long long rowmask = ((unsigned long long)mhi << 32) | mlo;

#pragma unroll 1
  for (int pass = 0; pass < 2; ++pass) {
    REDERIVE();
#pragma unroll
    for (int m = 0; m < 4; ++m) {
      mrow[m] = -INFINITY; lrow[m] = 0.f;
#pragma unroll
      for (int dt = 0; dt < 4; ++dt) o[m][dt] = (f32x4){0.f, 0.f, 0.f, 0.f};
    }
    const unsigned short* kb = p.kvb + (size_t)(((2 + 2 * pass) * NB + b) * 2 + g) * S * 64;
    const unsigned short* vb = p.kvb + (size_t)(((3 + 2 * pass) * NB + b) * 2 + g) * S * 64;
    const unsigned long long upto = (ci == 63) ? ~0ull : ((1ull << (ci + 1)) - 1ull);
    const int jlo = max(0, ci - 8);
    unsigned long long rem = pass ? (upto & ~((1ull << jlo) - 1ull)) : (un & upto);
    const int jwin0 = pass ? ci - 8 : -100;
    int j = __ffsll((long long)rem) - 1;
    tile_fetch(rk, kb + (size_t)j * 4096, t);
    tile_fetch(rv, vb + (size_t)j * 4096, t);
    while (rem) {
      rem &= rem - 1;
      stage_k(rk, ldsK, t);
      stage_v(rv, ldsV, t);
      __syncthreads();
      const int jn = rem ? (__ffsll((long long)rem) - 1) : -1;
      if (jn >= 0) {
        tile_fetch(rk, kb + (size_t)jn * 4096, t);
        tile_fetch(rv, vb + (size_t)jn * 4096, t);
      }
      const bool rowok = pass ? true : (bool)((rowmask >> j) & 1ull);
      int hi = (j == ci) ? rloc : 63;
      const int lo = ((j == jwin0) ? rloc : -1) - 4 * fq;
      hi = (rowok ? hi : -1000) - 4 * fq;
      attn_tile<true>(o, mrow, lrow, qf, ldsK, ldsV, true, lo, hi, lane);
      __syncthreads();
      j = jn;
    }
#pragma unroll
    for (int m = 0; m < 4; ++m) {
      float l = lrow[m];
      l += bpx(l, lane, 16);
      l += bpx(l, lane, 32);
      const float sc = grow[m * 3 + 1 + pass] / l;
#pragma unroll
      for (int dt = 0; dt < 4; ++dt) {
        f32x4* dst = (f32x4*)(orow + m * 64 + dt * 16 + 4 * fq);
        const f32x4 tot = *dst + o[m][dt] * sc;
        if (pass == 0) *dst = tot;
        else *(uint2*)(p.onsab + tok * 512 + g * 256 + m * 64 + dt * 16 + 4 * fq) = pack4(tot);
      }
    }
  }
}

#define XB_TMO      128
#define XB_XCNT(j)  (256  + 64 * (j))
#define XB_XSUB(j)  (1280 + 64 * (j))
#define XB_XGEN(j)  (2304 + 64 * (j))
#define XB_TOP      3328
#define XB_TOPGEN   3392
#define XCD_BAR_WORDS 3456
#define XB_SPIN_CAP (1u << 18)

__device__ __forceinline__ unsigned xb_ld(unsigned* p)              { return __hip_atomic_load(p, __ATOMIC_RELAXED, __HIP_MEMORY_SCOPE_AGENT); }
__device__ __forceinline__ unsigned xb_add(unsigned* p, unsigned v) { return __hip_atomic_fetch_add(p, v, __ATOMIC_RELAXED, __HIP_MEMORY_SCOPE_AGENT); }
__device__ __forceinline__ unsigned xb_xcc_id() { return (unsigned)__builtin_amdgcn_s_getreg((3 << 11) | 20) & 0xFu; }
#define XB_SPIN(cond, bar) do { unsigned _sp = 0; while (cond) { __builtin_amdgcn_s_sleep(1); \
    if ((++_sp & 255u) == 0u) { if (xb_ld(&(bar)[XB_TMO])) break; if (_sp > XB_SPIN_CAP) { atomicAdd(&(bar)[XB_TMO], 1u); break; } } } } while (0)

struct XcdBarrier {
    unsigned* bar; unsigned x;
    volatile LAS unsigned* st;
};

__device__ __forceinline__ XcdBarrier xcd_barrier_post(unsigned* bar, volatile LAS unsigned* st) {
    XcdBarrier b; b.bar = bar; b.x = xb_xcc_id(); b.st = st;
    if (threadIdx.x == 0) (void)xb_add(&bar[XB_XCNT(b.x)], 1u);
    return b;
}
__device__ __forceinline__ void xcd_barrier_complete(unsigned* bar, unsigned x, unsigned& nloc, unsigned& nx) {
    const unsigned G = gridDim.x * gridDim.y * gridDim.z;
    unsigned sum, cnt, mine, sp = 0u;
    for (;;) {
        sum = 0u; cnt = 0u; mine = 0u;
#pragma unroll
        for (unsigned j = 0; j < 16; ++j) { const unsigned c = xb_ld(&bar[XB_XCNT(j)]); sum += c; cnt += (c > 0u) ? 1u : 0u; mine = (j == x) ? c : mine; }
        if (sum == G) break;
        __builtin_amdgcn_s_sleep(1);
        if ((++sp & 255u) == 0u) { if (xb_ld(&bar[XB_TMO])) break; if (sp > XB_SPIN_CAP) { atomicAdd(&bar[XB_TMO], 1u); break; } }
    }
    nloc = mine > 0u ? mine : 1u; nx = cnt > 0u ? cnt : 1u;
}

__device__ __forceinline__ void xcd_barrier(const XcdBarrier& b) {
    asm volatile("s_waitcnt vmcnt(0)" ::: "memory");
    __syncthreads();
    if (threadIdx.x == 0) {
        unsigned* bar = b.bar;
        __builtin_amdgcn_s_waitcnt(0);
        unsigned nloc = b.st[0], nx = b.st[1];
        if (nloc == 0u) { xcd_barrier_complete(bar, b.x, nloc, nx); b.st[0] = nloc; b.st[1] = nx; }
        const unsigned old = xb_add(&bar[XB_XSUB(b.x)], 1u);
        const unsigned gen = old / nloc;
        if (old + 1u == (gen + 1u) * nloc) {
            __builtin_amdgcn_fence(__ATOMIC_RELEASE, "agent");
            asm volatile("s_waitcnt vmcnt(0)" ::: "memory");
            const unsigned og = xb_add(&bar[XB_TOP], 1u);
            const unsigned tg = og / nx;
            if (og + 1u == (tg + 1u) * nx) xb_add(&bar[XB_TOPGEN], 1u);
            else XB_SPIN(xb_ld(&bar[XB_TOPGEN]) == tg, bar);
            __builtin_amdgcn_fence(__ATOMIC_ACQUIRE, "agent");
            xb_add(&bar[XB_XGEN(b.x)], 1u);
            asm volatile("s_waitcnt vmcnt(0)" ::: "memory");
        } else {
            XB_SPIN(xb_ld(&bar[XB_XGEN(b.x)]) == gen, bar);
            __builtin_amdgcn_fence(__ATOMIC_ACQUIRE, "agent");
            asm volatile("s_waitcnt vmcnt(0)" ::: "memory");
        }
    }
    __syncthreads();
}


#define PHASE_IDX int t_ = threadIdx.x; OPAQUE(t_); const int tid = t_, lane = t_ & 63, wib = t_ >> 6; \
  const int gthreads = gridDim.x * 256, gtid = blockIdx.x * 256 + t_, gwaves = gridDim.x * 4, gwave = blockIdx.x * 4 + wib; \
  (void)tid; (void)lane; (void)wib; (void)gthreads; (void)gtid; (void)gwaves; (void)gwave;

constexpr int SMEM_BYTES = GEMM_RING * GEMM_STAGE;

__device__ __forceinline__ void conv_job(const float* W, int K, int N, bf16_t* Wt, int tile, LAS unsigned char* lds) {
  const int tnn = (N + 127) >> 7;
  convert_tile(W, N, N, Wt, K, (tile / tnn) * 64, (tile % tnn) * 128, lds);
}

__global__ void __launch_bounds__(256, 2) mega(Params p) {
  __shared__ __attribute__((aligned(16))) unsigned char smem_raw[SMEM_BYTES + 16];
  float* smem = (float*)smem_raw;
  LAS unsigned char* lds = (LAS unsigned char*)smem_raw;
  volatile LAS unsigned* xb_st = (volatile LAS unsigned*)(lds + SMEM_BYTES);
  if (threadIdx.x < 4) xb_st[threadIdx.x] = 0u;
  __syncthreads();
  const XcdBarrier gbar = xcd_barrier_post(p.bar, xb_st);

  {
  PHASE_IDX
  if (blockIdx.x < 96) {
    for (int i = tid; i < NB * D; i += 256) smem[i] = siluf_(p.c[i]);
    __syncthreads();
    const int j = blockIdx.x * 64 + lane;
    float a0 = 0.f, a1 = 0.f, a2 = 0.f, a3 = 0.f;
    const float* wp = p.w_ada + (size_t)(wib * 256) * (6 * D) + j;
#pragma unroll 32
    for (int k = 0; k < 256; ++k) {
      const float w = wp[(size_t)k * (6 * D)];
      const int kk = wib * 256 + k;
      a0 = fmaf(smem[kk], w, a0); a1 = fmaf(smem[D + kk], w, a1);
      a2 = fmaf(smem[2 * D + kk], w, a2); a3 = fmaf(smem[3 * D + kk], w, a3);
    }
    __syncthreads();
    smem[(wib * 4 + 0) * 64 + lane] = a0; smem[(wib * 4 + 1) * 64 + lane] = a1;
    smem[(wib * 4 + 2) * 64 + lane] = a2; smem[(wib * 4 + 3) * 64 + lane] = a3;
    __syncthreads();
    {
      const int b = wib;
      const float v = p.b_ada[j] + ((smem[(0 * 4 + b) * 64 + lane] + smem[(1 * 4 + b) * 64 + lane]) +
                                    (smem[(2 * 4 + b) * 64 + lane] + smem[(3 * 4 + b) * 64 + lane]));
      p.mod[b * 6 * D + j] = v;
    }
    __syncthreads();
  }
  for (int idx = gtid; idx < 32 * 64; idx += gthreads) {
    const int g = idx / 64;
    const double dt = exp((double)p.log_dt[g]);
    const double lr = p.a_re[idx], li = p.a_im[idx];
    double br = 1.0, bi = 0.0;
    for (int d = 0; d <= 16; ++d) {
      const double mag = exp(lr * dt * d);
      const double pr_ = mag * cos(li * dt * d), pi_ = mag * sin(li * dt * d);
      p.pw[(idx * 17 + d) * 2] = (float)pr_;
      p.pw[(idx * 17 + d) * 2 + 1] = (float)pi_;
      if (d == 1) { br = pr_; bi = pi_; }
    }
    const double nr = br - 1.0, ni = bi;
    const double den = lr * lr + li * li;
    const double cr = (nr * lr + ni * li) / den, ci = (ni * lr - nr * li) / den;
    for (int q = 0; q < 16; ++q) {
      const double wr = p.b_re[idx * 16 + q], wi = p.b_im[idx * 16 + q];
      p.bbar[(idx * 16 + q) * 2] = (float)(cr * wr - ci * wi);
      p.bbar[(idx * 16 + q) * 2 + 1] = (float)(cr * wi + ci * wr);
    }
  }
  for (int idx = gtid; idx < NE; idx += gthreads) { p.cnt[idx] = 0; p.cursor[idx] = 0; }
  for (int o = gwave; o < 512; o += gwaves) {
    const int kv = o >> 8, j = o & 255;
    const float* pe = kv ? p.pe_v : p.pe_k;
    const float* w1 = kv ? p.w_cmp_v1 : p.w_cmp_k1;
    float acc = 0.f;
    for (int k = lane; k < 2048; k += 64) acc = fmaf(pe[k], w1[(size_t)k * 256 + j], acc);
    acc = wsum(acc, lane);
    if (lane == 0) p.cbias[o] = acc;
  }
  {
    const int G = gridDim.x;
    const int first = (G > 96) ? 96 : 0, nb = G - first;
    if ((int)blockIdx.x >= first) {
      for (int job = blockIdx.x - first; job < 1040; job += nb) {
        if (job < 496) conv_job(p.w_in, D, INC, p.w_inT, job, lds);
        else if (job < 560) conv_job(p.w_cmp_k1, 2048, 256, p.wc1T, job - 496, lds);
        else if (job < 624) conv_job(p.w_cmp_v1, 2048, 256, p.wc1T + 256 * 2048, job - 560, lds);
        else if (job < 656) conv_job(p.w_glu, 512, 512, p.wgluT, job - 624, lds);
        else if (job < 720) conv_job(p.w_up_attn, 512, D, p.wuaT, job - 656, lds);
        else if (job < 784) conv_job(p.w_up_ssm, 512, D, p.wusT, job - 720, lds);
        else if (job < 912) conv_job(p.w_out, D, D, p.woutT, job - 784, lds);
        else if (job < 944) conv_job(p.w_router, D, NE, p.wrT, job - 912, lds);
        else if (job < 976) conv_job(p.ws_gate, D, DE, p.wsgT, job - 944, lds);
        else if (job < 1008) conv_job(p.ws_up, D, DE, p.wsuT, job - 976, lds);
        else conv_job(p.ws_down, DE, D, p.wsdT, job - 1008, lds);
      }
    }
  }
  }
  xcd_barrier(gbar);

  {
  PHASE_IDX
  for (int row = gwave; row < NT; row += gwaves) {
    const int b = row / S;
    const float* xr = p.x + (size_t)row * D;
    f32x4 v[4];
    float ss = 0.f;
#pragma unroll
    for (int i = 0; i < 4; ++i) {
      v[i] = *(const f32x4*)(xr + i * 256 + lane * 4);
      ss += (v[i][0] * v[i][0] + v[i][1] * v[i][1]) + (v[i][2] * v[i][2] + v[i][3] * v[i][3]);
    }
    ss = wsum(ss, lane);
    const float r = rsqrtf(ss * (1.0f / D) + EPS);
    const float* md = p.mod + b * 6 * D;
#pragma unroll
    for (int i = 0; i < 4; ++i) {
      const int col = i * 256 + lane * 4;
      const f32x4 gg = *(const f32x4*)(p.g_norm1 + col), sc = *(const f32x4*)(md + D + col), sh = *(const f32x4*)(md + col);
      *(uint2*)(p.h + (size_t)row * D + col) = pack4(v[i] * r * gg * (sc + 1.0f) + sh);
    }
  }
  for (int idx = gtid; idx < 32 * 128 * 256; idx += gthreads) {
    const int k = idx & 255, col = (idx >> 8) & 127, g = idx >> 15;
    const int n = col >> 1, ri = col & 1, sidx = k >> 4, q = k & 15;
    const int gn = g * 64 + n;
    const float pr_ = p.pw[(gn * 17 + 15 - sidx) * 2], pi_ = p.pw[(gn * 17 + 15 - sidx) * 2 + 1];
    const float br = p.bbar[(gn * 16 + q) * 2], bi = p.bbar[(gn * 16 + q) * 2 + 1];
    const float v = ri ? (pr_ * bi + pi_ * br) : (pr_ * br - pi_ * bi);
    p.w1T[idx] = (bf16_t)(cvt_pk_bf16(v, 0.f) & 0xffffu);
  }
  for (int idx = gtid; idx < 32 * 16 * 256; idx += gthreads) {
    const int q = idx & 15, pp = (idx >> 4) & 15, d = (idx >> 8) & 15, g = idx >> 12;
    float acc = (d == 0 && pp == q) ? p.d_skip[g * 16 + pp] : 0.f;
    for (int n = 0; n < 64; ++n) {
      const int gn = g * 64 + n;
      const float cr = p.c_re[(g * 16 + pp) * 64 + n], ci = p.c_im[(g * 16 + pp) * 64 + n];
      const float pr_ = p.pw[(gn * 17 + d) * 2], pi_ = p.pw[(gn * 17 + d) * 2 + 1];
      const float br = p.bbar[(gn * 16 + q) * 2], bi = p.bbar[(gn * 16 + q) * 2 + 1];
      const float tr = cr * pr_ - ci * pi_, ti = cr * pi_ + ci * pr_;
      acc += tr * br - ti * bi;
    }
    p.kd[idx] = acc;
  }
  for (int idx = gtid; idx < 32 * 256 * 128; idx += gthreads) {
    const int k = idx & 127, col = (idx >> 7) & 255, g = idx >> 15;
    const int i = col >> 4, pp = col & 15, n = k >> 1, ri = k & 1;
    const int gn = g * 64 + n;
    const float cr = p.c_re[(g * 16 + pp) * 64 + n], ci = p.c_im[(g * 16 + pp) * 64 + n];
    const float pr_ = p.pw[(gn * 17 + i + 1) * 2], pi_ = p.pw[(gn * 17 + i + 1) * 2 + 1];
    const float v = ri ? -(cr * pi_ + ci * pr_) : (cr * pr_ - ci * pi_);
    p.wyT[((size_t)g * 256 + col) * 384 + k] = (bf16_t)(cvt_pk_bf16(v, 0.f) & 0xffffu);
  }
  }
  xcd_barrier(gbar);

  {
  PHASE_IDX
  {
    constexpr int TN = (INC + TNW - 1) / TNW;
    int mt_, nt_;
    for (int it = 0; xcd_tile(it, NT / TM, TN, mt_, nt_); ++it) {
      const int m0 = mt_ * TM, n0 = nt_ * TNW;
      gemm128<true>(
          D, [&](int r) { return p.h + (size_t)(m0 + r) * D; },
          [&](int c) { return p.w_inT + (size_t)min(n0 + c, INC - 1) * D; },
          [&](const f32x4 (&acc)[4][8], int wr, int wc, int fr, int fq) {
#pragma unroll
            for (int sg = 0; sg < 2; ++sg) {
              const int cw = n0 + wc * 128 + sg * 64;
              if (cw < C_GN) {
                const bool isq = cw < C_KC;
                const int slot = isq ? 0 : (cw - C_KC) >> 7, gg = isq ? 0 : ((cw - C_KC) >> 6) & 1;
                const bool norm = isq || slot == 2 || slot == 4;
                const float* gain = isq ? p.q_gain : (slot == 2 ? p.ks_gain : p.kw_gain);
                const float post = isq ? ATT_SCALE * 1.4426950408889634f : 1.0f;
#pragma unroll
                for (int m = 0; m < 4; ++m) {
                  const int tok = m0 + wr * 64 + m * 16 + fr;
                  float r = 1.0f;
                  if (norm) {
                    float ss = 0.f;
#pragma unroll
                    for (int n = 0; n < 4; ++n)
#pragma unroll
                      for (int jj = 0; jj < 4; ++jj) ss = fmaf(acc[m][sg * 4 + n][jj], acc[m][sg * 4 + n][jj], ss);
                    ss += bpx(ss, fq * 16 + fr, 16);
                    ss += bpx(ss, fq * 16 + fr, 32);
                    r = rsqrtf(ss * (1.0f / 64) + EPS) * post;
                  }
                  bf16_t* dst = isq ? p.qb + (size_t)tok * 512 + cw
                                    : p.kvb + ((size_t)((slot * NB + (tok >> 12)) * 2 + gg) * S + (tok & (S - 1))) * 64;
#pragma unroll
                  for (int n = 0; n < 4; ++n) {
                    f32x4 v = acc[m][sg * 4 + n] * r;
                    if (norm) v = v * *(const f32x4*)(gain + n * 16 + 4 * fq);
                    *(uint2*)(dst + n * 16 + 4 * fq) = pack4(v);
                  }
                }
              } else {
#pragma unroll
                for (int m = 0; m < 4; ++m) {
                  const size_t tok = m0 + wr * 64 + m * 16 + fr;
#pragma unroll
                  for (int n = 0; n < 4; ++n) {
                    const int c = cw + n * 16 + 4 * fq;
                    if (c < INC) {
                      f32x4 v = acc[m][sg * 4 + n];
                      if (c >= C_U && c < C_GA) {
                        const int ch = c - C_U;
                        *(uint2*)(p.a3 + ((size_t)(ch >> 4) * 1024 + (tok >> 4)) * 384 + 128 + (tok & 15) * 16 + (ch & 15)) = pack4(v);
                      } else {
#pragma unroll
                        for (int j = 0; j < 4; ++j) v[j] = sigmoidf_(v[j]);
                        if (c < C_U) *(f32x4*)(p.gn + tok * 24 + (c - C_GN)) = v;
                        else if (c < C_GS) *(uint2*)(p.ga + tok * D + (c - C_GA)) = pack4(v);
                        else *(uint2*)(p.gs + tok * D + (c - C_GS)) = pack4(v);
                      }
                    }
                  }
                }
              }
            }
          },
          lds);
    }
  }
  for (int idx = gtid; idx < 32 * 256 * 256; idx += gthreads) {
    const int k = idx & 255, col = (idx >> 8) & 255, g = idx >> 16;
    const int i = col >> 4, pp = col & 15, sidx = k >> 4, q = k & 15;
    const float v = (i >= sidx) ? p.kd[((g * 16 + (i - sidx)) * 16 + pp) * 16 + q] : 0.f;
    p.wyT[((size_t)g * 256 + col) * 384 + 128 + k] = (bf16_t)(cvt_pk_bf16(v, 0.f) & 0xffffu);
  }
  }
  xcd_barrier(gbar);

  {
  PHASE_IDX
  for (int job = blockIdx.x; job < 2 * 8 * 16; job += gridDim.x) {
    const int kv = job >> 7, ks = (job >> 4) & 7, m0 = (job & 15) * 128;
    float* hp = p.hidp + (size_t)(ks * 2 + kv) * 2040 * 256;
    gemm128<true>(
        256,
        [&](int r) {
          const int rr = min(m0 + r, NB * NCMP * 2 - 1);
          const int b = rr / (NCMP * 2), n = (rr >> 1) % NCMP, g = rr & 1;
          return p.kvb + ((size_t)((kv * NB + b) * 2 + g) * S + 16 * n) * 64 + ks * 256;
        },
        [&](int c) { return p.wc1T + (size_t)(kv * 256 + c) * 2048 + ks * 256; },
        [&](const f32x4 (&acc)[4][8], int wr, int wc, int fr, int fq) {
#pragma unroll
          for (int m = 0; m < 4; ++m) {
            const int r = m0 + wr * 64 + m * 16 + fr;
            if (r < NB * NCMP * 2) {
#pragma unroll
              for (int n = 0; n < 8; ++n) *(f32x4*)(hp + (size_t)r * 256 + wc * 128 + n * 16 + 4 * fq) = acc[m][n];
            }
          }
        },
        lds);
  }
  int mt_, g;
  for (int it = 0; xcd_tile(it, 8, 32, mt_, g); ++it) {
    const int m0 = mt_ * 128;
    gemm128<true>(
        256, [&](int r) { return p.a3 + ((size_t)g * 1024 + m0 + r) * 384 + 128; },
        [&](int c) { return p.w1T + ((size_t)g * 128 + (c & 127)) * 256; },
        [&](const f32x4 (&acc)[4][8], int wr, int wc, int fr, int fq) {
          if (wc == 0) {
#pragma unroll
            for (int m = 0; m < 4; ++m)
#pragma unroll
              for (int n = 0; n < 8; ++n)
                *(f32x4*)(p.lbuf + ((size_t)g * 1024 + m0 + wr * 64 + m * 16 + fr) * 128 + n * 16 + 4 * fq) = acc[m][n];
          }
        },
        lds);
  }
  }
  xcd_barrier(gbar);

  {
  PHASE_IDX
  for (int wv = gwave; wv < 2 * NB * NCMP * 2; wv += gwaves) {
    const int kv = wv / (NB * NCMP * 2), r = wv % (NB * NCMP * 2);
    const int b = r / (NCMP * 2), n = (r >> 1) % NCMP, g = r & 1;
    const float* w2 = kv ? p.w_cmp_v2 : p.w_cmp_k2;
    {
      f32x4 hsum = *(const f32x4*)(p.cbias + kv * 256 + lane * 4);
#pragma unroll
      for (int ks = 0; ks < 8; ++ks) hsum = hsum + *(const f32x4*)(p.hidp + ((size_t)(ks * 2 + kv) * 2040 + r) * 256 + lane * 4);
#pragma unroll
      for (int j = 0; j < 4; ++j) hsum[j] = geluf_(hsum[j]);
      WSYNC();
      *(f32x4*)(smem + wib * 256 + lane * 4) = hsum;
      WSYNC();
    }
    const float* hid = smem + wib * 256;
    float acc = 0.f;
    for (int j = 0; j < 256; ++j) acc = fmaf(hid[j], w2[j * 64 + lane], acc);
    if (kv == 0) {
      const float ss = wsum(acc * acc, lane);
      acc = acc * rsqrtf(ss * (1.0f / 64) + EPS) * p.kc_gain[lane];
    }
    const float other = bpx(acc, lane, 1);
    if ((lane & 1) == 0)
      *(unsigned*)(p.cmpb + ((size_t)((kv * NB + b) * 2 + g) * 256 + n) * 64 + lane) = cvt_pk_bf16(acc, other);
  }
  for (int idx = gtid; idx < 2 * NB * 2 * 32; idx += gthreads)
    *(unsigned*)(p.cmpb + ((size_t)(idx >> 5) * 256 + 255) * 64 + (idx & 31) * 2) = 0u;
  for (int idx = gtid; idx < 32 * NB * 64; idx += gthreads) {
    const int n = idx & 63, b = (idx >> 6) & 3, g = idx >> 8;
    const int gn = g * 64 + n;
    const float lr = p.pw[(gn * 17 + 16) * 2], li = p.pw[(gn * 17 + 16) * 2 + 1];
    float hr_ = 0.f, hi_ = 0.f;
    const size_t row0 = (size_t)g * 1024 + b * 256;
#pragma unroll 32
    for (int c = 0; c < 256; ++c) {
      const float2 l2 = *(const float2*)(p.lbuf + (row0 + c) * 128 + n * 2);
      *(unsigned*)(p.a3 + (row0 + c) * 384 + n * 2) = cvt_pk_bf16(hr_, hi_);
      const float nr = lr * hr_ - li * hi_ + l2.x;
      const float ni = lr * hi_ + li * hr_ + l2.y;
      hr_ = nr; hi_ = ni;
    }
  }
  }
  xcd_barrier(gbar);

  {
  PHASE_IDX
  const int G = gridDim.x;
  const bool split = G >= 512;
  if (!split || blockIdx.x < 256) {
    for (int u = blockIdx.x; u < 256; u += (split ? 256 : G)) {
      const int bg = u >> 5, pr = u & 31;
      __builtin_amdgcn_s_setprio(2);
#pragma unroll 1
      for (int half = 0; half < 2; ++half) attn_chunk(p, lds, bg >> 1, bg & 1, half ? pr : 63 - pr);
      __builtin_amdgcn_s_setprio(0);
    }
  }
  if (!split || blockIdx.x >= 256) {
    const int x8 = blockIdx.x & 7, nsl = split ? ((G - 256) >> 3) : 0, sl = split ? (((int)blockIdx.x - 256) >> 3) : 0;
    for (int it = 0;; ++it) {
      int tile;
      if (split && ((G & 7) == 0)) { const int q = sl + it * nsl; if (q >= 32) break; tile = ((x8 + 8 * (q >> 3)) << 3) | (q & 7); }
      else { tile = (split ? (int)blockIdx.x - 256 : (int)blockIdx.x) + it * (split ? G - 256 : G); if (tile >= 256) break; }
      const int g = tile >> 3, m0 = (tile & 7) * 128, n0 = 0;
      gemm128(
          384, [&](int r) { return p.a3 + ((size_t)g * 1024 + m0 + r) * 384; },
          [&](int c) { return p.wyT + ((size_t)g * 256 + n0 + c) * 384; },
          [&](const f32x4 (&acc)[4][8], int wr, int wc, int fr, int fq) {
#pragma unroll
            for (int m = 0; m < 4; ++m)
#pragma unroll
              for (int n = 0; n < 8; ++n) {
                const int col = n0 + wc * 128 + n * 16 + 4 * fq;
                const size_t tok = (size_t)(m0 + wr * 64 + m * 16 + fr) * 16 + (col >> 4);
                f32x4 v = acc[m][n];
#pragma unroll
                for (int j = 0; j < 4; ++j) v[j] = geluf_(v[j]);
                *(uint2*)(p.z + tok * 512 + g * 16 + (col & 15)) = pack4(v);
              }
          },
          lds);
    }
    const int cb = split ? (int)blockIdx.x - 256 : (int)blockIdx.x, cn = split ? G - 256 : G;
    for (int job = cb; job < NE * 96; job += cn) {
      const int e = job / 96, rem = job - e * 96, which = rem >> 5, tile = rem & 31;
      if (which == 0) conv_job(p.w_gate + (size_t)e * D * DE, D, DE, p.wgT + (size_t)e * DE * D, tile, lds);
      else if (which == 1) conv_job(p.w_up + (size_t)e * D * DE, D, DE, p.wuT + (size_t)e * DE * D, tile, lds);
      else conv_job(p.w_down + (size_t)e * DE * D, DE, D, p.wdT + (size_t)e * D * DE, tile, lds);
    }
  }
  }
  xcd_barrier(gbar);

  {
  PHASE_IDX
  gemm_phase(
      NT, 512, 512, [&](int m) { return p.z + (size_t)m * 512; }, [&](int n) { return p.wgluT + (size_t)n * 512; },
      [&](int m, int n, f32x4 v) {
        const f32x4 zz = unpack4(*(const uint2*)(p.z + (size_t)m * 512 + n));
#pragma unroll
        for (int j = 0; j < 4; ++j) v[j] = zz[j] * sigmoidf_(v[j] + p.b_glu[n + j]);
        *(uint2*)(p.yssm + (size_t)m * 512 + n) = pack4(v);
      },
      lds);
  gemm_phase(
      NT, D, 512, [&](int m) { return p.onsab + (size_t)m * 512; }, [&](int n) { return p.wuaT + (size_t)n * 512; },
      [&](int m, int n, f32x4 v) {
        const f32x4 gg = unpack4(*(const uint2*)(p.ga + (size_t)m * D + n));
        *(f32x4*)(p.mtmp + (size_t)m * D + n) = gg * v;
      },
      lds);
  }
  xcd_barrier(gbar);
  {
  PHASE_IDX
  gemm_phase(
      NT, D, 512, [&](int m) { return p.yssm + (size_t)m * 512; }, [&](int n) { return p.wusT + (size_t)n * 512; },
      [&](int m, int n, f32x4 v) {
        const f32x4 gg = unpack4(*(const uint2*)(p.gs + (size_t)m * D + n));
        const f32x4 prev = *(const f32x4*)(p.mtmp + (size_t)m * D + n);
        *(uint2*)(p.merged + (size_t)m * D + n) = pack4(prev + gg * v);
      },
      lds);
  }
  xcd_barrier(gbar);
  {
  PHASE_IDX
  gemm_phase(
      NT, D, D, [&](int m) { return p.merged + (size_t)m * D; }, [&](int n) { return p.woutT + (size_t)n * D; },
      [&](int m, int n, f32x4 v) {
        const int b = m / S;
        const f32x4 xx = *(const f32x4*)(p.x + (size_t)m * D + n);
        const f32x4 gt = *(const f32x4*)(p.mod + b * 6 * D + 2 * D + n);
        *(f32x4*)(p.xmid + (size_t)m * D + n) = xx + gt * v;
      },
      lds);
  }
  xcd_barrier(gbar);

  {
  PHASE_IDX
  for (int row = gwave; row < NT; row += gwaves) {
    const int b = row / S;
    const float* xr = p.xmid + (size_t)row * D;
    f32x4 v[4];
    float ss = 0.f;
#pragma unroll
    for (int i = 0; i < 4; ++i) {
      v[i] = *(const f32x4*)(xr + i * 256 + lane * 4);
      ss += (v[i][0] * v[i][0] + v[i][1] * v[i][1]) + (v[i][2] * v[i][2] + v[i][3] * v[i][3]);
    }
    ss = wsum(ss, lane);
    const float r = rsqrtf(ss * (1.0f / D) + EPS);
    const float* md = p.mod + b * 6 * D;
#pragma unroll
    for (int i = 0; i < 4; ++i) {
      const int col = i * 256 + lane * 4;
      const f32x4 gg = *(const f32x4*)(p.g_norm2 + col), sc = *(const f32x4*)(md + 4 * D + col), sh = *(const f32x4*)(md + 3 * D + col);
      *(uint2*)(p.h + (size_t)row * D + col) = pack4(v[i] * r * gg * (sc + 1.0f) + sh);
    }
  }
  }
  xcd_barrier(gbar);

  {
  PHASE_IDX
  int mt_, nt_;
  for (int it = 0; xcd_tile(it, NT / TM, 3, mt_, nt_); ++it) {
    const int m0 = mt_ * TM;
    if (nt_ == 0) {
      gemm128<true>(
          D, [&](int r) { return p.h + (size_t)(m0 + r) * D; }, [&](int c) { return p.wrT + (size_t)c * D; },
          [&](const f32x4 (&acc)[4][8], int wr, int wc, int fr, int fq) {
#pragma unroll
            for (int m = 0; m < 4; ++m)
#pragma unroll
              for (int n = 0; n < 8; ++n) {
                f32x4 v = acc[m][n];
#pragma unroll
                for (int j = 0; j < 4; ++j) v[j] = sigmoid_acc(v[j]);
                *(f32x4*)(p.scores + (size_t)(m0 + wr * 64 + m * 16 + fr) * NE + wc * 128 + n * 16 + 4 * fq) = v;
              }
          },
          lds);
    } else {
      const int ct = nt_ - 1;
      gemm128<true>(
          D, [&](int r) { return p.h + (size_t)(m0 + r) * D; },
          [&](int c) {
            const int hid = ct * 128 + (c >> 7) * 64 + ((c >> 4) & 3) * 16 + (c & 15);
            return (((c >> 6) & 1) ? p.wsuT : p.wsgT) + (size_t)hid * D;
          },
          [&](const f32x4 (&acc)[4][8], int wr, int wc, int fr, int fq) {
#pragma unroll
            for (int m = 0; m < 4; ++m)
#pragma unroll
              for (int n = 0; n < 4; ++n) {
                f32x4 v;
#pragma unroll
                for (int j = 0; j < 4; ++j) v[j] = siluf_(acc[m][n][j]) * acc[m][n + 4][j];
                *(uint2*)(p.hs + (size_t)(m0 + wr * 64 + m * 16 + fr) * DE + ct * 128 + wc * 64 + n * 16 + 4 * fq) = pack4(v);
              }
          },
          lds);
    }
  }
  }
  xcd_barrier(gbar);

  {
  PHASE_IDX
  for (int tok = gwave; tok < NT; tok += gwaves) {
    const float4 sc4 = *reinterpret_cast<const float4*>(p.scores + (size_t)tok * NE + lane * 4);
    const float4 bi4 = *reinterpret_cast<const float4*>(p.router_bias + lane * 4);
    const float sc[4] = {sc4.x, sc4.y, sc4.z, sc4.w};
    float bz[4] = {sc4.x + bi4.x, sc4.y + bi4.y, sc4.z + bi4.z, sc4.w + bi4.w};
    float m1 = -INFINITY, m2 = -INFINITY;
#pragma unroll
    for (int i = 0; i < 4; ++i) {
      const float v = bz[i];
      if (v > m1) { m2 = m1; m1 = v; } else if (v > m2) { m2 = v; }
    }
#pragma unroll
    for (int o = 1; o < 8; o <<= 1) {
      const float o1 = bpx(m1, lane, o), o2 = bpx(m2, lane, o);
      const float n1 = fmaxf(m1, o1);
      const float n2 = fmaxf(fminf(m1, o1), fmaxf(m2, o2));
      m1 = n1; m2 = n2;
    }
    const float gs = m1 + m2;
    const int mygrp = lane >> 3;
    int grank = 0;
#pragma unroll
    for (int g2 = 0; g2 < 8; ++g2) {
      const float og = bpl(gs, g2 * 8);
      grank += (og > gs || (og == gs && g2 < mygrp)) ? 1 : 0;
    }
    const bool gsel = grank < 4;
#pragma unroll
    for (int i = 0; i < 4; ++i) if (!gsel) bz[i] = -INFINITY;
    unsigned taken = 0;
    float wsel = 0.f;
    int esel = 0;
    float wtot = 0.f;
#pragma unroll 1
    for (int k = 0; k < TOPK; ++k) {
      float bv = -INFINITY; int bidx = 1 << 30;
#pragma unroll
      for (int i = 0; i < 4; ++i) {
        if (!((taken >> i) & 1u) && bz[i] > bv) { bv = bz[i]; bidx = lane * 4 + i; }
      }
#pragma unroll
      for (int o = 32; o > 0; o >>= 1) {
        const float ov = bpx(bv, lane, o);
        const int oi = bpxi(bidx, lane, o);
        if (ov > bv || (ov == bv && oi < bidx)) { bv = ov; bidx = oi; }
      }
      const int owner = bidx >> 2, slot = bidx & 3;
      float sv = 0.f;
      if (lane == owner) {
        taken |= 1u << slot;
        sv = (slot == 0) ? sc[0] : (slot == 1) ? sc[1] : (slot == 2) ? sc[2] : sc[3];
      }
      sv = bpl(sv, owner);
      wtot += sv;
      if (lane == k) { wsel = sv; esel = bidx; }
    }
    if (lane < TOPK) {
      p.eidx[tok * TOPK + lane] = esel;
      p.ew[tok * TOPK + lane] = wsel / wtot * 2.5f;
      atomicAdd(&p.cnt[esel], 1);
    }
  }
  gemm_phase(
      NT, D, DE, [&](int m) { return p.hs + (size_t)m * DE; }, [&](int n) { return p.wsdT + (size_t)n * DE; },
      [&](int m, int n, f32x4 v) {
        const int b = m / S;
        const f32x4 xx = *(const f32x4*)(p.xmid + (size_t)m * D + n);
        const f32x4 gt = *(const f32x4*)(p.mod + b * 6 * D + 5 * D + n);
        *(f32x4*)(p.out + (size_t)m * D + n) = xx + gt * v;
      },
      lds);
  }
  xcd_barrier(gbar);

  {
  PHASE_IDX
  {
    int* soff = (int*)smem;
    int* srt = soff + 320;
    const int myc = p.cnt[tid];
    soff[tid] = myc;
    srt[tid] = (myc + 127) >> 7;
    __syncthreads();
    for (int st = 1; st < 256; st <<= 1) {
      const int a0 = (tid >= st) ? soff[tid - st] : 0;
      __syncthreads();
      soff[tid] += a0;
      __syncthreads();
    }
    const int exo = soff[tid] - myc;
    __syncthreads();
    soff[tid] = exo;
    if (blockIdx.x == 0) {
      p.off[tid] = exo;
      if (tid == 255) p.off[NE] = exo + myc;
    }
    __syncthreads();
    if (blockIdx.x == 0 && tid < 8) {
      int acc = 0;
      for (int i = 0; i < 32; ++i) { p.xrts[tid * 33 + i] = acc; acc += srt[tid + 8 * i]; }
      p.xrts[tid * 33 + 32] = acc;
    }
    for (int idx = gtid; idx < NASSIGN; idx += gthreads) {
      const int e = p.eidx[idx];
      const int pos = soff[e] + atomicAdd(&p.cursor[e], 1);
      p.stok[pos] = idx / TOPK;
      p.sw[pos] = p.ew[idx];
      p.apos[idx] = pos;
    }
    __syncthreads();
  }
  }
  xcd_barrier(gbar);

  {
  PHASE_IDX
  {
    const int x8 = blockIdx.x & 7, ns8 = ((int)gridDim.x - x8 + 7) >> 3;
    const int* xr = p.xrts + x8 * 33;
    const int total_rt = xr[32];
    for (int tile = blockIdx.x >> 3; tile < total_rt * 2; tile += ns8) {
      const int rt = tile >> 1, ct = tile & 1;
      const int ei = find_idx(xr, 32, rt);
      const int e = x8 + 8 * ei;
      const int pos0 = p.off[e] + (rt - xr[ei]) * 128;
      const int mvalid = min(128, p.off[e] + p.cnt[e] - pos0);
      const bf16_t* wg = p.wgT + (size_t)e * DE * D;
      const bf16_t* wu = p.wuT + (size_t)e * DE * D;
      gemm128<true>(
          D, [&](int r) { return p.h + (size_t)p.stok[pos0 + min(r, mvalid - 1)] * D; },
          [&](int c) {
            const int hid = ct * 128 + (c >> 7) * 64 + ((c >> 4) & 3) * 16 + (c & 15);
            return (((c >> 6) & 1) ? wu : wg) + (size_t)hid * D;
          },
          [&](const f32x4 (&acc)[4][8], int wr, int wc, int fr, int fq) {
#pragma unroll
            for (int m = 0; m < 4; ++m) {
              const int r = wr * 64 + m * 16 + fr;
              if (r < mvalid) {
#pragma unroll
                for (int n = 0; n < 4; ++n) {
                  f32x4 v;
#pragma unroll
                  for (int j = 0; j < 4; ++j) v[j] = siluf_(acc[m][n][j]) * acc[m][n + 4][j];
                  *(uint2*)(p.hr + (size_t)(pos0 + r) * DE + ct * 128 + wc * 64 + n * 16 + 4 * fq) = pack4(v);
                }
              }
            }
          },
          lds);
    }
  }
  }
  xcd_barrier(gbar);
  {
  PHASE_IDX
  {
    const int x8 = blockIdx.x & 7, ns8 = ((int)gridDim.x - x8 + 7) >> 3;
    const int* xr = p.xrts + x8 * 33;
    const int total_rt = xr[32];
    for (int rt = blockIdx.x >> 3; rt < total_rt; rt += ns8) {
      const int ei = find_idx(xr, 32, rt);
      const int e = x8 + 8 * ei;
      const int pos0 = p.off[e] + (rt - xr[ei]) * 128;
      const int mvalid = min(128, p.off[e] + p.cnt[e] - pos0);
      const bf16_t* wd = p.wdT + (size_t)e * D * DE;
      float wgt4[4];
      {
        int tq = threadIdx.x;
        OPAQUE(tq);
        const int wr_ = tq >> 7, fr_ = tq & 15;
#pragma unroll
        for (int m = 0; m < 4; ++m) wgt4[m] = p.sw[pos0 + min(wr_ * 64 + m * 16 + fr_, mvalid - 1)];
      }
      gemm128_stream<4>(
          DE, [&](int r) { return p.hr + (size_t)(pos0 + min(r, mvalid - 1)) * DE; },
          [&](int c) { return wd + (size_t)c * DE; }, (size_t)256 * DE,
          [&](int ct, const f32x4 (&acc)[4][8], int wr, int wc, int fr, int fq) {
#pragma unroll
            for (int m = 0; m < 4; ++m) {
              const int r = wr * 64 + m * 16 + fr;
              if (r < mvalid) {
#pragma unroll
                for (int n = 0; n < 8; ++n)
                  *(uint2*)(p.yk + (size_t)(pos0 + r) * D + ct * 256 + wc * 128 + n * 16 + 4 * fq) = pack4(acc[m][n] * wgt4[m]);
              }
            }
          },
          lds);
    }
  }
  }
  xcd_barrier(gbar);
  {
  PHASE_IDX
  for (int tok = gwave; tok < NT; tok += gwaves) {
    const int b = tok / S;
    float acc[16];
#pragma unroll
    for (int i = 0; i < 16; ++i) acc[i] = 0.f;
#pragma unroll 1
    for (int k = 0; k < TOPK; ++k) {
      const int pos = p.apos[tok * TOPK + k];
      const u32x4* src = (const u32x4*)(p.yk + (size_t)pos * D + lane * 16);
      const u32x4 a = src[0], c = src[1];
      const unsigned wv[8] = {a.x, a.y, a.z, a.w, c.x, c.y, c.z, c.w};
#pragma unroll
      for (int i = 0; i < 8; ++i) {
        acc[2 * i] += __uint_as_float(wv[i] << 16);
        acc[2 * i + 1] += __uint_as_float(wv[i] & 0xffff0000u);
      }
    }
    float* dst = p.out + (size_t)tok * D + lane * 16;
    const float* gt = p.mod + b * 6 * D + 5 * D + lane * 16;
#pragma unroll
    for (int i = 0; i < 4; ++i) {
      f32x4 o4 = *(f32x4*)(dst + 4 * i);
      const f32x4 g4 = *(const f32x4*)(gt + 4 * i);
#pragma unroll
      for (int j = 0; j < 4; ++j) o4[j] += g4[j] * acc[4 * i + j];
      *(f32x4*)(dst + 4 * i) = o4;
    }
  }
  }
}

extern "C" void kernel_launch(void* const* d_in, const int* in_sizes, int n_in, void* d_out, int out_size,
                              void* d_ws, size_t ws_size, hipStream_t stream) {
  (void)in_sizes; (void)n_in; (void)out_size;
  Params p{};
  const float* const* in = reinterpret_cast<const float* const*>(d_in);
  p.x = in[0]; p.c = in[1]; p.w_ada = in[2]; p.b_ada = in[3]; p.g_norm1 = in[4]; p.g_norm2 = in[5];
  p.w_in = in[6]; p.q_gain = in[7]; p.kc_gain = in[8]; p.ks_gain = in[9]; p.kw_gain = in[10];
  p.pe_k = in[11]; p.pe_v = in[12]; p.w_cmp_k1 = in[13]; p.w_cmp_k2 = in[14]; p.w_cmp_v1 = in[15];
  p.w_cmp_v2 = in[16]; p.a_re = in[17]; p.a_im = in[18]; p.log_dt = in[19]; p.b_re = in[20];
  p.b_im = in[21]; p.c_re = in[22]; p.c_im = in[23]; p.d_skip = in[24]; p.w_glu = in[25];
  p.b_glu = in[26]; p.w_up_attn = in[27]; p.w_up_ssm = in[28]; p.w_out = in[29]; p.w_router = in[30];
  p.router_bias = in[31]; p.w_gate = in[32]; p.w_up = in[33]; p.w_down = in[34]; p.ws_gate = in[35];
  p.ws_up = in[36]; p.ws_down = in[37];
  p.out = (float*)d_out;

  char* base = (char*)d_ws;
  size_t o = 0;
  auto take = [&](size_t bytes) { void* r = base + o; o += (bytes + 255) & ~(size_t)255; return r; };
  p.bar = (unsigned*)take(sizeof(unsigned) * XCD_BAR_WORDS);
  p.mod = (float*)take(sizeof(float) * NB * 6 * D);
  p.cbias = (float*)take(sizeof(float) * 512);
  p.w_inT = (bf16_t*)take(2 * (size_t)INC * D);
  p.wc1T = (bf16_t*)take(2 * (size_t)2 * 256 * 2048);
  p.wgluT = (bf16_t*)take(2 * (size_t)512 * 512);
  p.wuaT = (bf16_t*)take(2 * (size_t)D * 512);
  p.wusT = (bf16_t*)take(2 * (size_t)D * 512);
  p.woutT = (bf16_t*)take(2 * (size_t)D * D);
  p.wrT = (bf16_t*)take(2 * (size_t)NE * D);
  p.wsgT = (bf16_t*)take(2 * (size_t)DE * D);
  p.wsuT = (bf16_t*)take(2 * (size_t)DE * D);
  p.wsdT = (bf16_t*)take(2 * (size_t)D * DE);
  p.w1T = (bf16_t*)take(2 * (size_t)32 * 128 * 256);
  p.wyT = (bf16_t*)take(2 * (size_t)32 * 256 * 384);
  p.wgT = (bf16_t*)take(2 * (size_t)NE * DE * D);
  p.wuT = (bf16_t*)take(2 * (size_t)NE * DE * D);
  p.wdT = (bf16_t*)take(2 * (size_t)NE * D * DE);
  p.h = (bf16_t*)take(2 * (size_t)NT * D);
  p.pw = (float*)take(sizeof(float) * 2048 * 17 * 2);
  p.bbar = (float*)take(sizeof(float) * 2048 * 32);
  p.kd = (float*)take(sizeof(float) * 32 * 16 * 256);
  p.xmid = (float*)take(sizeof(float) * (size_t)NT * D);
  p.scores = (float*)take(sizeof(float) * (size_t)NT * NE);
  p.eidx = (int*)take(sizeof(int) * NASSIGN);
  p.ew = (float*)take(sizeof(float) * NASSIGN);
  p.cnt = (int*)take(sizeof(int) * NE);
  p.cursor = (int*)take(sizeof(int) * NE);
  p.off = (int*)take(sizeof(int) * (NE + 1));
  p.xrts = (int*)take(sizeof(int) * 8 * 33);
  p.stok = (int*)take(sizeof(int) * NASSIGN);
  p.sw = (float*)take(sizeof(float) * NASSIGN);
  p.apos = (int*)take(sizeof(int) * NASSIGN);
  p.hs = (bf16_t*)take(2 * (size_t)NT * DE);
  p.hr = (bf16_t*)take(2 * (size_t)NASSIGN * DE);
  const size_t early0 = o;
  p.qb = (bf16_t*)take(2 * (size_t)NT * 512);
  p.kvb = (bf16_t*)take(2 * (size_t)6 * NB * 2 * S * 64);
  p.cmpb = (bf16_t*)take(2 * (size_t)2 * NB * 2 * 256 * 64);
  p.gn = (float*)take(sizeof(float) * (size_t)NT * 24);
  p.a3 = (bf16_t*)take(2 * (size_t)32 * 1024 * 384);
  p.ga = (bf16_t*)take(2 * (size_t)NT * D);
  p.gs = (bf16_t*)take(2 * (size_t)NT * D);
  p.hidp = (float*)take(sizeof(float) * 16 * 2040 * 256);
  p.onsa = (float*)take(sizeof(float) * (size_t)NT * 512);
  p.onsab = (bf16_t*)take(2 * (size_t)NT * 512);
  p.lbuf = (float*)take(sizeof(float) * 32 * 1024 * 128);
  p.z = (bf16_t*)take(2 * (size_t)NT * 512);
  p.yssm = (bf16_t*)take(2 * (size_t)NT * 512);
  p.mtmp = (float*)take(sizeof(float) * (size_t)NT * D);
  p.merged = (bf16_t*)take(2 * (size_t)NT * D);
  const size_t early1 = o;
  p.yk = (bf16_t*)(base + early0);
  const size_t yk_bytes = 2 * (size_t)NASSIGN * D;
  if (early0 + yk_bytes > o) o = early0 + yk_bytes;
  (void)early1;
  if (o > ws_size) fprintf(stderr, "workspace too small: need %zu have %zu\n", o, ws_size);

  static int grid_blocks = 0;
  if (!grid_blocks) {
    int dev = 0, cus = 0, per_cu = 0;
    (void)hipGetDevice(&dev);
    (void)hipDeviceGetAttribute(&cus, hipDeviceAttributeMultiprocessorCount, dev);
    (void)hipOccupancyMaxActiveBlocksPerMultiprocessor(&per_cu, mega, 256, 0);
    if (per_cu > 2) per_cu = 2;
    if (per_cu < 1) per_cu = 1;
    grid_blocks = cus * per_cu;
  }
  (void)hipMemsetAsync(p.bar, 0, sizeof(unsigned) * XCD_BAR_WORDS, stream);
  hipLaunchKernelGGL(mega, dim3(grid_blocks), dim3(256), 0, stream, p);
  hipError_t e = hipPeekAtLastError();
  if (e != hipSuccess) fprintf(stderr, "launch failed: %s (grid %d)\n", hipGetErrorString(e), grid_blocks);
}
```

```cpp
#include <hip/hip_runtime.h>
#include <cstdio>
#include <cstdint>

constexpr int D = 1024;
constexpr int NB = 4;
constexpr int S = 4096;
constexpr int NT = NB * S;
constexpr int INC = 3864;
constexpr int C_Q = 0, C_KC = 512, C_VC = 640, C_KS = 768, C_VS = 896, C_KW = 1024, C_VW = 1152,
              C_GN = 1280, C_U = 1304, C_GA = 1816, C_GS = 2840;
constexpr int NCMP = 255;
constexpr int NE = 256;
constexpr int TOPK = 8;
constexpr int DE = 256;
constexpr int NASSIGN = NT * TOPK;
constexpr float EPS = 1e-6f;
constexpr float ATT_SCALE = 0.125f;
typedef unsigned short bf16_t;

struct Params {
  const float* x; const float* c; const float* w_ada; const float* b_ada; const float* g_norm1;
  const float* g_norm2; const float* w_in; const float* q_gain; const float* kc_gain;
  const float* ks_gain; const float* kw_gain; const float* pe_k; const float* pe_v;
  const float* w_cmp_k1; const float* w_cmp_k2; const float* w_cmp_v1; const float* w_cmp_v2;
  const float* a_re; const float* a_im; const float* log_dt; const float* b_re; const float* b_im;
  const float* c_re; const float* c_im; const float* d_skip; const float* w_glu; const float* b_glu;
  const float* w_up_attn; const float* w_up_ssm; const float* w_out; const float* w_router;
  const float* router_bias; const float* w_gate; const float* w_up; const float* w_down;
  const float* ws_gate; const float* ws_up; const float* ws_down;
  float* out;
  unsigned* bar;
  float* mod;
  float* cbias;
  bf16_t* w_inT;
  bf16_t* wc1T;
  bf16_t* wgluT;
  bf16_t* wuaT;
  bf16_t* wusT;
  bf16_t* woutT;
  bf16_t* wrT;
  bf16_t* wsgT;
  bf16_t* wsuT;
  bf16_t* wsdT;
  bf16_t* w1T;
  bf16_t* wyT;
  bf16_t* wgT;
  bf16_t* wuT;
  bf16_t* wdT;
  bf16_t* h;
  bf16_t* qb;
  bf16_t* kvb;
  bf16_t* cmpb;
  float* gn;
  bf16_t* a3;
  bf16_t* ga;
  bf16_t* gs;
  float* hidp;
  float* onsa;
  bf16_t* onsab;
  float* pw;
  float* bbar;
  float* kd;
  float* lbuf;
  bf16_t* z;
  bf16_t* yssm;
  float* mtmp;
  bf16_t* merged;
  float* xmid;
  float* scores;
  int* eidx;
  float* ew;
  int* cnt;
  int* cursor;
  int* off;
  int* xrts;
  int* stok;
  float* sw;
  int* apos;
  bf16_t* hs;
  bf16_t* hr;
  bf16_t* yk;
};

__device__ __forceinline__ float bpx(float v, int lane, int off) {
  return __int_as_float(__builtin_amdgcn_ds_bpermute((lane ^ off) << 2, __float_as_int(v)));
}
__device__ __forceinline__ int bpxi(int v, int lane, int off) { return __builtin_amdgcn_ds_bpermute((lane ^ off) << 2, v); }
__device__ __forceinline__ unsigned bpxu(unsigned v, int lane, int off) { return (unsigned)__builtin_amdgcn_ds_bpermute((lane ^ off) << 2, (int)v); }
__device__ __forceinline__ float bpl(float v, int src) {
  return __int_as_float(__builtin_amdgcn_ds_bpermute(src << 2, __float_as_int(v)));
}
__device__ __forceinline__ float wsum(float v, int lane) {
#pragma unroll
  for (int o = 32; o > 0; o >>= 1) v += bpx(v, lane, o);
  return v;
}
#define WSYNC() do { __builtin_amdgcn_fence(__ATOMIC_ACQ_REL, "wavefront"); __builtin_amdgcn_wave_barrier(); } while (0)
__device__ __forceinline__ float fexp_(float x) { return __builtin_amdgcn_exp2f(x * 1.4426950408889634f); }
__device__ __forceinline__ float sigmoidf_(float x) { return 1.0f / (1.0f + fexp_(-x)); }
__device__ __forceinline__ float sigmoid_acc(float x) { return 1.0f / (1.0f + expf(-x)); }
__device__ __forceinline__ float siluf_(float x) { return x / (1.0f + fexp_(-x)); }
__device__ __forceinline__ float geluf_(float x) {
  const float u2 = 1.5957691216057308f * (x + 0.044715f * x * x * x);
  return x / (1.0f + fexp_(-u2));
}
#define OPAQUE(x) asm volatile("" : "+v"(x))
typedef short bf16x8 __attribute__((ext_vector_type(8)));
typedef float f32x4 __attribute__((ext_vector_type(4)));
typedef unsigned u32x4 __attribute__((ext_vector_type(4)));
#define LAS __attribute__((address_space(3)))

__device__ __forceinline__ unsigned cvt_pk_bf16(float lo, float hi) {
  unsigned r;
  asm("v_cvt_pk_bf16_f32 %0, %1, %2" : "=v"(r) : "v"(lo), "v"(hi));
  return r;
}
__device__ __forceinline__ uint2 pack4(const f32x4 v) {
  uint2 w;
  w.x = cvt_pk_bf16(v[0], v[1]); w.y = cvt_pk_bf16(v[2], v[3]);
  return w;
}
__device__ __forceinline__ f32x4 unpack4(const uint2 w) {
  return (f32x4){__uint_as_float(w.x << 16), __uint_as_float(w.x & 0xffff0000u), __uint_as_float(w.y << 16), __uint_as_float(w.y & 0xffff0000u)};
}
__device__ __forceinline__ int lds_byte(int r, int c) {
  const int st = (r >> 4) * 2 + (c >> 5), rr = r & 15, cc = c & 31, ob = rr * 64 + cc * 2;
  return st * 1024 + (ob ^ (((ob >> 9) & 1) << 5));
}
__device__ __forceinline__ int t32_byte(int r, int c) {
  const int ob = (r & 15) * 64 + c * 2;
  return (r >> 4) * 1024 + (ob ^ (((ob >> 9) & 1) << 5));
}

constexpr int GEMM_STAGE = 24576;
constexpr int GEMM_RING = 3;
constexpr int TM = 128, TNW = 256;
template <bool GL = false, class AF, class BF, class EPW>
__device__ __forceinline__ void gemm128(int K, AF arow, BF brow, EPW epiw, LAS unsigned char* lds) {
  int t = threadIdx.x;
  OPAQUE(t);
  const int wid = t >> 6, lane = t & 63, wr = wid >> 1, wc = wid & 1, fr = lane & 15, fq = lane >> 4;
  const int sbb = lane * 16, obb = sbb ^ (((sbb >> 9) & 1) << 5);
  const int rin = obb >> 6, cel = (obb & 63) >> 1;
  const bf16_t* ga0 = arow(wid * 16 + rin) + cel;
  const bf16_t* ga1 = arow((wid + 4) * 16 + rin) + cel;
  const bf16_t* gb0 = brow(wid * 16 + rin) + cel;
  const bf16_t* gb1 = brow((wid + 4) * 16 + rin) + cel;
  const bf16_t* gb2 = brow((wid + 8) * 16 + rin) + cel;
  const bf16_t* gb3 = brow((wid + 12) * 16 + rin) + cel;
  f32x4 acc[4][8];
#pragma unroll
  for (int m = 0; m < 4; ++m)
#pragma unroll
    for (int n = 0; n < 8; ++n) acc[m][n] = (f32x4){0.f, 0.f, 0.f, 0.f};
  const int foff = t32_byte(fr, fq * 8);
  const int nk = K >> 5;
#define GEMM_COMPUTE(sa_) do { \
    bf16x8 af[4]; \
    _Pragma("unroll") for (int m = 0; m < 4; ++m) af[m] = *(const LAS bf16x8*)((sa_) + (wr * 4 + m) * 1024 + foff); \
    _Pragma("unroll") for (int nh = 0; nh < 2; ++nh) { \
      bf16x8 bf[4]; \
      _Pragma("unroll") for (int n = 0; n < 4; ++n) bf[n] = *(const LAS bf16x8*)((sa_) + 8192 + (wc * 8 + nh * 4 + n) * 1024 + foff); \
      __builtin_amdgcn_s_setprio(1); \
      _Pragma("unroll") for (int m = 0; m < 4; ++m) \
        _Pragma("unroll") for (int n = 0; n < 4; ++n) \
          acc[m][nh * 4 + n] = __builtin_amdgcn_mfma_f32_16x16x32_bf16(bf[n], af[m], acc[m][nh * 4 + n], 0, 0, 0); \
      __builtin_amdgcn_s_setprio(0); \
      if (nh == 0) __builtin_amdgcn_sched_barrier(0); } } while (0)
  if constexpr (GL) {
  LAS unsigned char* l0 = lds + t * 16;
#define GEMM_ISSUE(s_) do { LAS unsigned char* d_ = l0 + ((s_) % GEMM_RING) * GEMM_STAGE; const int ko_ = (s_) * 32; \
    __builtin_amdgcn_global_load_lds((const unsigned*)(ga0 + ko_), (LAS unsigned*)(d_), 16, 0, 0); \
    __builtin_amdgcn_global_load_lds((const unsigned*)(ga1 + ko_), (LAS unsigned*)(d_ + 4096), 16, 0, 0); \
    __builtin_amdgcn_global_load_lds((const unsigned*)(gb0 + ko_), (LAS unsigned*)(d_ + 8192), 16, 0, 0); \
    __builtin_amdgcn_global_load_lds((const unsigned*)(gb1 + ko_), (LAS unsigned*)(d_ + 12288), 16, 0, 0); \
    __builtin_amdgcn_global_load_lds((const unsigned*)(gb2 + ko_), (LAS unsigned*)(d_ + 16384), 16, 0, 0); \
    __builtin_amdgcn_global_load_lds((const unsigned*)(gb3 + ko_), (LAS unsigned*)(d_ + 20480), 16, 0, 0); } while (0)
  asm volatile("s_waitcnt vmcnt(0)" ::: "memory");
#pragma unroll
  for (int s_ = 0; s_ < GEMM_RING - 1; ++s_)
    if (s_ < nk) GEMM_ISSUE(s_);
  for (int kt = 0; kt < nk; ++kt) {
    if (kt + 1 < nk) asm volatile("s_waitcnt vmcnt(6)" ::: "memory");
    else asm volatile("s_waitcnt vmcnt(0)" ::: "memory");
    __builtin_amdgcn_s_barrier();
    asm volatile("" ::: "memory");
    if (kt + GEMM_RING - 1 < nk) GEMM_ISSUE(kt + GEMM_RING - 1);
    const LAS unsigned char* sa = lds + (kt % GEMM_RING) * GEMM_STAGE;
    GEMM_COMPUTE(sa);
  }
  __builtin_amdgcn_s_barrier();
  asm volatile("" ::: "memory");
#undef GEMM_ISSUE
  } else {
  for (int kt = 0; kt < nk; ++kt) {
    const int ko = kt * 32;
    const u32x4 a0 = *(const u32x4*)(ga0 + ko), a1 = *(const u32x4*)(ga1 + ko);
    const u32x4 b0 = *(const u32x4*)(gb0 + ko), b1 = *(const u32x4*)(gb1 + ko);
    const u32x4 b2 = *(const u32x4*)(gb2 + ko), b3 = *(const u32x4*)(gb3 + ko);
    *(LAS u32x4*)(lds + t * 16) = a0;
    *(LAS u32x4*)(lds + t * 16 + 4096) = a1;
    *(LAS u32x4*)(lds + t * 16 + 8192) = b0;
    *(LAS u32x4*)(lds + t * 16 + 12288) = b1;
    *(LAS u32x4*)(lds + t * 16 + 16384) = b2;
    *(LAS u32x4*)(lds + t * 16 + 20480) = b3;
    __syncthreads();
    GEMM_COMPUTE(lds);
    __syncthreads();
  }
  }
#undef GEMM_COMPUTE
  epiw(acc, wr, wc, fr, fq);
}

template <int NCT, class AF, class BF, class EPW>
__device__ __forceinline__ void gemm128_stream(int K, AF arow, BF brow, size_t bct, EPW epiw, LAS unsigned char* lds) {
  int t = threadIdx.x;
  OPAQUE(t);
  const int wid = t >> 6, lane = t & 63, wr = wid >> 1, wc = wid & 1, fr = lane & 15, fq = lane >> 4;
  const int sbb = lane * 16, obb = sbb ^ (((sbb >> 9) & 1) << 5);
  const int rin = obb >> 6, cel = (obb & 63) >> 1;
  const bf16_t* ga0 = arow(wid * 16 + rin) + cel;
  const bf16_t* ga1 = arow((wid + 4) * 16 + rin) + cel;
  const bf16_t* gb0 = brow(wid * 16 + rin) + cel;
  const bf16_t* gb1 = brow((wid + 4) * 16 + rin) + cel;
  const bf16_t* gb2 = brow((wid + 8) * 16 + rin) + cel;
  const bf16_t* gb3 = brow((wid + 12) * 16 + rin) + cel;
  f32x4 acc[4][8];
#pragma unroll
  for (int m = 0; m < 4; ++m)
#pragma unroll
    for (int n = 0; n < 8; ++n) acc[m][n] = (f32x4){0.f, 0.f, 0.f, 0.f};
  const int foff = t32_byte(fr, fq * 8);
  const int nk = K >> 5, ns = nk * NCT;
  LAS unsigned char* l0 = lds + t * 16;
  int iss_k = 0;
  size_t iss_b = 0;
#define GEMM_ISSUE2(s_) do { LAS unsigned char* d_ = l0 + ((s_) % GEMM_RING) * GEMM_STAGE; \
    __builtin_amdgcn_global_load_lds((const unsigned*)(ga0 + iss_k), (LAS unsigned*)(d_), 16, 0, 0); \
    __builtin_amdgcn_global_load_lds((const unsigned*)(ga1 + iss_k), (LAS unsigned*)(d_ + 4096), 16, 0, 0); \
    __builtin_amdgcn_global_load_lds((const unsigned*)(gb0 + iss_b + iss_k), (LAS unsigned*)(d_ + 8192), 16, 0, 0); \
    __builtin_amdgcn_global_load_lds((const unsigned*)(gb1 + iss_b + iss_k), (LAS unsigned*)(d_ + 12288), 16, 0, 0); \
    __builtin_amdgcn_global_load_lds((const unsigned*)(gb2 + iss_b + iss_k), (LAS unsigned*)(d_ + 16384), 16, 0, 0); \
    __builtin_amdgcn_global_load_lds((const unsigned*)(gb3 + iss_b + iss_k), (LAS unsigned*)(d_ + 20480), 16, 0, 0); \
    iss_k += 32; if (iss_k == K) { iss_k = 0; iss_b += bct; } } while (0)
  asm volatile("s_waitcnt vmcnt(0)" ::: "memory");
#pragma unroll
  for (int s_ = 0; s_ < GEMM_RING - 1; ++s_)
    if (s_ < ns) GEMM_ISSUE2(s_);
  int kt = 0, ct = 0;
  for (int s_ = 0; s_ < ns; ++s_) {
    if (s_ + 1 < ns) asm volatile("s_waitcnt vmcnt(6)" ::: "memory");
    else asm volatile("s_waitcnt vmcnt(0)" ::: "memory");
    __builtin_amdgcn_s_barrier();
    asm volatile("" ::: "memory");
    if (s_ + GEMM_RING - 1 < ns) GEMM_ISSUE2(s_ + GEMM_RING - 1);
    const LAS unsigned char* sa = lds + (s_ % GEMM_RING) * GEMM_STAGE;
    {
      bf16x8 af[4];
#pragma unroll
      for (int m = 0; m < 4; ++m) af[m] = *(const LAS bf16x8*)(sa + (wr * 4 + m) * 1024 + foff);
#pragma unroll
      for (int nh = 0; nh < 2; ++nh) {
        bf16x8 bf[4];
#pragma unroll
        for (int n = 0; n < 4; ++n) bf[n] = *(const LAS bf16x8*)(sa + 8192 + (wc * 8 + nh * 4 + n) * 1024 + foff);
#pragma unroll
        for (int m = 0; m < 4; ++m)
#pragma unroll
          for (int n = 0; n < 4; ++n)
            acc[m][nh * 4 + n] = __builtin_amdgcn_mfma_f32_16x16x32_bf16(bf[n], af[m], acc[m][nh * 4 + n], 0, 0, 0);
        if (nh == 0) __builtin_amdgcn_sched_barrier(0);
      }
    }
    if (++kt == nk) {
      epiw(ct, acc, wr, wc, fr, fq);
#pragma unroll
      for (int m = 0; m < 4; ++m)
#pragma unroll
        for (int n = 0; n < 8; ++n) acc[m][n] = (f32x4){0.f, 0.f, 0.f, 0.f};
      kt = 0; ++ct;
    }
  }
  __builtin_amdgcn_s_barrier();
  asm volatile("" ::: "memory");
#undef GEMM_ISSUE2
}

__device__ __forceinline__ bool xcd_tile(int it, int tm, int tn, int& mt, int& nt) {
  const int G = gridDim.x, x = blockIdx.x & 7, slot = blockIdx.x >> 3, ns = (G - x + 7) >> 3;
  const int q = slot + it * ns;
  if (tn >= 8) {
    const int cn = (tn - x + 7) >> 3;
    if (q >= cn * tm) return false;
    mt = q / cn; nt = x + 8 * (q % cn);
  } else {
    const int cm = (tm - x + 7) >> 3;
    if (cm <= 0 || q >= cm * tn) return false;
    mt = x + 8 * (q / tn); nt = q % tn;
  }
  return true;
}
__device__ __forceinline__ int find_idx(const int* pre, int n, int v) {
  int lo = 0, hi = n;
  while (hi - lo > 1) {
    const int mid = (lo + hi) >> 1;
    if (pre[mid] <= v) lo = mid; else hi = mid;
  }
  return lo;
}

template <class AL, class BL, class EP>
__device__ __forceinline__ void gemm_phase(int M, int N, int K, AL al, BL bl, EP ep, LAS unsigned char* lds) {
  const int tn = (N + TNW - 1) / TNW, tm = (M + TM - 1) / TM;
  int mt, nt;
  for (int it = 0; xcd_tile(it, tm, tn, mt, nt); ++it) {
    const int m0 = mt * TM, n0 = nt * TNW;
    gemm128<true>(
        K, [&](int r) { return al(min(m0 + r, M - 1)); }, [&](int c) { return bl(min(n0 + c, N - 1)); },
        [&](const f32x4 (&acc)[4][8], int wr, int wc, int fr, int fq) {
#pragma unroll
          for (int m = 0; m < 4; ++m)
#pragma unroll
            for (int n = 0; n < 8; ++n) {
              const int r = m0 + wr * 64 + m * 16 + fr, c = n0 + wc * 128 + n * 16 + 4 * fq;
              if (r < M && c < N) ep(r, c, acc[m][n]);
            }
        },
        lds);
  }
}

__device__ __forceinline__ void convert_tile(const float* W, int ldw, int nvalid, bf16_t* Wt, int ldt, int k0, int n0, LAS unsigned char* lds) {
  int t = threadIdx.x;
  OPAQUE(t);
  const int n4 = t & 31, kg = t >> 5;
  const int ncol = n0 + n4 * 4;
  f32x4 rb[8];
#pragma unroll
  for (int j = 0; j < 8; ++j)
    rb[j] = (ncol < nvalid) ? *(const f32x4*)(W + (size_t)(k0 + kg * 8 + j) * ldw + ncol) : (f32x4){0.f, 0.f, 0.f, 0.f};
#pragma unroll
  for (int c = 0; c < 4; ++c) {
    u32x4 w;
    w.x = cvt_pk_bf16(rb[0][c], rb[1][c]); w.y = cvt_pk_bf16(rb[2][c], rb[3][c]);
    w.z = cvt_pk_bf16(rb[4][c], rb[5][c]); w.w = cvt_pk_bf16(rb[6][c], rb[7][c]);
    *(LAS u32x4*)(lds + (n4 * 4 + c) * 144 + kg * 16) = w;
  }
  __syncthreads();
#pragma unroll
  for (int i = 0; i < 4; ++i) {
    const int q = t + i * 256, row = q >> 3, piece = q & 7;
    if (n0 + row < nvalid) *(u32x4*)(Wt + (size_t)(n0 + row) * ldt + k0 + piece * 8) = *(const LAS u32x4*)(lds + row * 144 + piece * 16);
  }
  __syncthreads();
}

typedef short s16x4 __attribute__((ext_vector_type(4)));
#define REDERIVE() do { OPAQUE(t); w = t >> 6; lane = t & 63; fr = lane & 15; fq = lane >> 4; rloc = w * 16 + fr; } while (0)
constexpr int VROW = 160;

__device__ __forceinline__ bf16x8 pack8(const f32x4 a, const f32x4 b) {
  u32x4 w;
  w.x = cvt_pk_bf16(a[0], a[1]); w.y = cvt_pk_bf16(a[2], a[3]);
  w.z = cvt_pk_bf16(b[0], b[1]); w.w = cvt_pk_bf16(b[2], b[3]);
  return __builtin_bit_cast(bf16x8, w);
}
__device__ __forceinline__ void tile_fetch(bf16x8 (&r)[2], const unsigned short* base, int t) {
  const bf16x8* q = (const bf16x8*)(base + t * 16);
  r[0] = q[0];
  r[1] = q[1];
}
__device__ __forceinline__ void stage_k(const bf16x8 (&r)[2], LAS unsigned char* ldsK, int t) {
  const int row = t >> 2, c0 = (t & 3) * 16;
  *(LAS bf16x8*)(ldsK + lds_byte(row, c0)) = r[0];
  *(LAS bf16x8*)(ldsK + lds_byte(row, c0 + 8)) = r[1];
}
__device__ __forceinline__ void stage_v(const bf16x8 (&r)[2], LAS unsigned char* ldsV, int t) {
  const int row = t >> 2, c0 = (t & 3) * 16;
  *(LAS bf16x8*)(ldsV + row * VROW + c0 * 2) = r[0];
  *(LAS bf16x8*)(ldsV + row * VROW + c0 * 2 + 16) = r[1];
}
template <int H>
__device__ __forceinline__ void attn_qk_h(f32x4 (&s)[4][2], const LAS unsigned char* qf, LAS unsigned char* ldsK, int fr, int fq) {
  const int koff = lds_byte(fr, fq * 8);
#pragma unroll
  for (int m = 0; m < 4; ++m)
#pragma unroll
    for (int nn = 0; nn < 2; ++nn) s[m][nn] = (f32x4){0.f, 0.f, 0.f, 0.f};
#pragma unroll
  for (int nn = 0; nn < 2; ++nn)
#pragma unroll
    for (int ks = 0; ks < 2; ++ks) {
      const bf16x8 kf = *(const LAS bf16x8*)(ldsK + koff + (2 * H + nn) * 2048 + ks * 1024);
#pragma unroll
      for (int m = 0; m < 4; ++m)
        s[m][nn] = __builtin_amdgcn_mfma_f32_16x16x32_bf16(kf, *(const LAS bf16x8*)(qf + (m * 2 + ks) * 1024), s[m][nn], 0, 0, 0);
    }
}
template <int H>
__device__ __forceinline__ void attn_pv_h(f32x4 (&o)[4][4], const bf16x8 (&pf)[4], LAS unsigned char* ldsV, int lane) {
  const int fq = lane >> 4, i = lane & 15;
  const int vbase = (4 * fq + (i >> 2)) * VROW + (i & 3) * 8;
#pragma unroll
  for (int dt = 0; dt < 4; ++dt) {
    LAS unsigned char* a0 = ldsV + vbase + H * 32 * VROW + dt * 32;
    const s16x4 v0 = __builtin_amdgcn_ds_read_tr16_b64_v4i16((LAS s16x4*)a0);
    const s16x4 v1 = __builtin_amdgcn_ds_read_tr16_b64_v4i16((LAS s16x4*)(a0 + 16 * VROW));
    bf16x8 vf;
    vf[0] = v0[0]; vf[1] = v0[1]; vf[2] = v0[2]; vf[3] = v0[3];
    vf[4] = v1[0]; vf[5] = v1[1]; vf[6] = v1[2]; vf[7] = v1[3];
#pragma unroll
    for (int m = 0; m < 4; ++m) o[m][dt] = __builtin_amdgcn_mfma_f32_16x16x32_bf16(vf, pf[m], o[m][dt], 0, 0, 0);
  }
}
constexpr float SOFTMAX_SHIFT = 12.0f;
template <int H, bool EM>
__device__ __forceinline__ void attn_softmax_h(f32x4 (&s)[4][2], float (&lrow)[4], bf16x8 (&pf)[4], bool rowok, int lo, int hi) {
#pragma unroll
  for (int m = 0; m < 4; ++m) {
    float ls = 0.f;
#pragma unroll
    for (int nn = 0; nn < 2; ++nn)
#pragma unroll
      for (int jj = 0; jj < 4; ++jj) {
        const int kc = 16 * (2 * H + nn) + jj;
        const bool ok = rowok && (!EM || (lo < kc && hi >= kc));
        const float pv = ok ? __builtin_amdgcn_exp2f(s[m][nn][jj] - SOFTMAX_SHIFT) : 0.f;
        s[m][nn][jj] = pv;
        ls += pv;
      }
    lrow[m] += ls;
    pf[m] = pack8(s[m][0], s[m][1]);
  }
}
template <int H, bool EM>
__device__ __forceinline__ void attn_sub(f32x4 (&o)[4][4], float (&mrow)[4], float (&lrow)[4], const LAS unsigned char* qf,
                                         LAS unsigned char* ldsK, LAS unsigned char* ldsV, bool rowok, int lo, int hi, int lane) {
  f32x4 s[4][2];
  bf16x8 pf[4];
  attn_qk_h<H>(s, qf, ldsK, lane & 15, lane >> 4);
  attn_softmax_h<H, EM>(s, lrow, pf, rowok, lo, hi);
  attn_pv_h<H>(o, pf, ldsV, lane);
  if (H == 0) __builtin_amdgcn_sched_barrier(0);
}
template <bool EM>
__device__ __forceinline__ void attn_tile(f32x4 (&o)[4][4], float (&mrow)[4], float (&lrow)[4], const LAS unsigned char* qf,
                                          LAS unsigned char* ldsK, LAS unsigned char* ldsV, bool rowok, int lo, int hi, int lane) {
  attn_sub<0, EM>(o, mrow, lrow, qf, ldsK, ldsV, rowok, lo, hi, lane);
  attn_sub<1, EM>(o, mrow, lrow, qf, ldsK, ldsV, rowok, lo, hi, lane);
}
template <int H>
__device__ __forceinline__ void cmp_stats(float (&mrow)[4], float (&lrow)[4], const LAS unsigned char* qf, LAS unsigned char* ldsK, int hi, int lane) {
  const int fq = lane >> 4;
  f32x4 s[4][2];
  __builtin_amdgcn_sched_barrier(0);
  attn_qk_h<H>(s, qf, ldsK, lane & 15, fq);
  __builtin_amdgcn_sched_barrier(0);
#pragma unroll
  for (int m = 0; m < 4; ++m) {
    float ls = 0.f;
#pragma unroll
    for (int nn = 0; nn < 2; ++nn)
#pragma unroll
      for (int jj = 0; jj < 4; ++jj) {
        const int kc = 16 * (2 * H + nn) + jj;
        ls += (hi >= kc) ? __builtin_amdgcn_exp2f(s[m][nn][jj] - SOFTMAX_SHIFT) : 0.f;
      }
    lrow[m] += ls;
  }
  __builtin_amdgcn_sched_barrier(0);
}
template <int H>
__device__ __forceinline__ void cmp_apply(f32x4 (&o)[4][4], const float (&msf)[4], const float (&linv)[4], float& lastprev, LAS float* improw,
                                          const LAS unsigned char* qf, LAS unsigned char* ldsK, LAS unsigned char* ldsV, int hi, int lane) {
  const int fq = lane >> 4;
  f32x4 s[4][2];
  bf16x8 pf[4];
  __builtin_amdgcn_sched_barrier(0);
  attn_qk_h<H>(s, qf, ldsK, lane & 15, fq);
  __builtin_amdgcn_sched_barrier(0);
#pragma unroll
  for (int m = 0; m < 4; ++m) {
#pragma unroll
    for (int nn = 0; nn < 2; ++nn)
#pragma unroll
      for (int jj = 0; jj < 4; ++jj) {
        const int kc = 16 * (2 * H + nn) + jj;
        s[m][nn][jj] = (hi >= kc) ? __builtin_amdgcn_exp2f(s[m][nn][jj] - SOFTMAX_SHIFT) * linv[m] : 0.f;
      }
    pf[m] = pack8(s[m][0], s[m][1]);
  }
#pragma unroll
  for (int nn = 0; nn < 2; ++nn) {
    float gs = 0.f, last = 0.f;
#pragma unroll
    for (int m = 0; m < 4; ++m) {
      gs += (s[m][nn][0] + s[m][nn][1]) + (s[m][nn][2] + s[m][nn][3]);
      last += s[m][nn][3];
    }
    const float pa = bpl(last, (lane + 48) & 63);
    const float pb = bpl(lastprev, (lane + 48) & 63);
    improw[(2 * H + nn) * 4 + fq] = gs + ((fq > 0) ? pa : pb);
    lastprev = last;
  }
  __builtin_amdgcn_sched_barrier(0);
  attn_pv_h<H>(o, pf, ldsV, lane);
  __builtin_amdgcn_sched_barrier(0);
}

__device__ __forceinline__ void attn_chunk(const Params& p, LAS unsigned char* lds, int b, int g, int ci) {
  int t = threadIdx.x;
  OPAQUE(t);
  int w = t >> 6, lane = t & 63, fr = lane & 15, fq = lane >> 4;
  LAS unsigned char* ldsK = lds;
  LAS unsigned char* ldsV = lds + 8192;
  LAS float* impb = (LAS float*)(lds + 18432) + w * 1024;
  LAS unsigned* unib = (LAS unsigned*)(lds + 18432 + 16384);
  int rloc = w * 16 + fr;
  const int tq = ci * 64 + rloc;
  const size_t tok = (size_t)b * S + tq;
  const float* grow = p.gn + tok * 24 + g * 12;
  float* orow = p.onsa + tok * 512 + g * 256;
  LAS unsigned char* qf = lds + 36864 + w * 8192 + lane * 16;
#pragma unroll
  for (int m = 0; m < 4; ++m)
#pragma unroll
    for (int ks = 0; ks < 2; ++ks)
      *(LAS bf16x8*)(qf + (m * 2 + ks) * 1024) = *(const bf16x8*)(p.qb + tok * 512 + (g * 4 + m) * 64 + ks * 32 + fq * 8);
  f32x4 o[4][4];
  float mrow[4], lrow[4];
  bf16x8 rk[2], rv[2];

  const int nvis = (tq >= 31) ? ((tq - 31) / 16 + 1) : 0;
  const int nvmax = 4 * ci + 3;
  const int ntc = (nvmax + 63) >> 6;
  const unsigned short* kcb = p.cmpb + (size_t)((0 * NB + b) * 2 + g) * 256 * 64;
  const unsigned short* vcb = p.cmpb + (size_t)((1 * NB + b) * 2 + g) * 256 * 64;
#pragma unroll
  for (int m = 0; m < 4; ++m) { mrow[m] = -INFINITY; lrow[m] = 0.f; }
  REDERIVE();
  for (int tc = 0; tc < ntc; ++tc) {
    tile_fetch(rk, kcb + (size_t)tc * 4096, t);
    stage_k(rk, ldsK, t);
    __syncthreads();
    const int hi = nvis - 1 - tc * 64 - 4 * fq;
    cmp_stats<0>(mrow, lrow, qf, ldsK, hi, lane);
    cmp_stats<1>(mrow, lrow, qf, ldsK, hi, lane);
    __syncthreads();
  }
  {
    float linv[4], msf[4];
#pragma unroll
    for (int m = 0; m < 4; ++m) {
      float l = lrow[m];
      l += bpx(l, lane, 16);
      l += bpx(l, lane, 32);
      linv[m] = (l > 0.f) ? 1.0f / l : 0.f;
      msf[m] = 0.f;
    }
    REDERIVE();
#pragma unroll
    for (int m = 0; m < 4; ++m)
#pragma unroll
      for (int dt = 0; dt < 4; ++dt) o[m][dt] = (f32x4){0.f, 0.f, 0.f, 0.f};
    float lastprev = 0.f;
    for (int tc = 0; tc < ntc; ++tc) {
      tile_fetch(rk, kcb + (size_t)tc * 4096, t);
      tile_fetch(rv, vcb + (size_t)tc * 4096, t);
      stage_k(rk, ldsK, t);
      stage_v(rv, ldsV, t);
      __syncthreads();
      const int hi = nvis - 1 - tc * 64 - 4 * fq;
      cmp_apply<0>(o, msf, linv, lastprev, impb + fr * 64 + tc * 16, qf, ldsK, ldsV, hi, lane);
      cmp_apply<1>(o, msf, linv, lastprev, impb + fr * 64 + tc * 16, qf, ldsK, ldsV, hi, lane);
      __syncthreads();
    }
  }
#pragma unroll
  for (int m = 0; m < 4; ++m) {
    const float gate = grow[m * 3 + 0];
#pragma unroll
    for (int dt = 0; dt < 4; ++dt) *(f32x4*)(orow + m * 64 + dt * 16 + 4 * fq) = o[m][dt] * gate;
  }
  unsigned mlo, mhi;
  REDERIVE();
  {
    WSYNC();
    float kv[16];
    const int c0 = -fq * 16, c1 = ci - fq * 16;
#pragma unroll
    for (int i = 0; i < 16; ++i) {
      const bool forced = (c0 == i) || (c1 == i) || (c1 == i + 1);
      float v = (c1 >= i) ? impb[fr * 64 + fq * 16 + i] : -INFINITY;
      if (forced) v = INFINITY;
      kv[i] = v;
    }
    WSYNC();
#pragma unroll
    for (int i = 0; i < 16; ++i) impb[fr * 64 + fq * 16 + i] = kv[i];
    WSYNC();
    int rank[16];
#pragma unroll
    for (int i = 0; i < 16; ++i) rank[i] = 0;
#pragma unroll 2
    for (int k = 0; k < 64; ++k) {
      const float ok = impb[fr * 64 + k];
      const int kq = k - fq * 16;
#pragma unroll
      for (int i = 0; i < 16; ++i) rank[i] += (ok > kv[i] || (ok == kv[i] && kq < i)) ? 1 : 0;
    }
    unsigned piece = 0;
#pragma unroll
    for (int i = 0; i < 16; ++i) piece |= (rank[i] < 16) ? (1u << i) : 0u;
    unsigned lo32 = (fq == 0) ? piece : (fq == 1) ? (piece << 16) : 0u;
    unsigned hi32 = (fq == 2) ? piece : (fq == 3) ? (piece << 16) : 0u;
    lo32 |= bpxu(lo32, lane, 16); lo32 |= bpxu(lo32, lane, 32);
    hi32 |= bpxu(hi32, lane, 16); hi32 |= bpxu(hi32, lane, 32);
    mlo = lo32; mhi = hi32;
    unsigned ulo = lo32, uhi = hi32;
#pragma unroll
    for (int off = 1; off < 16; off <<= 1) { ulo |= bpxu(ulo, lane, off); uhi |= bpxu(uhi, lane, off); }
    if (lane == 0) { unib[w * 2] = ulo; unib[w * 2 + 1] = uhi; }
    __syncthreads();
  }
  unsigned long long un;
  {
    const unsigned ulo = unib[0] | unib[2] | unib[4] | unib[6];
    const unsigned uhi = unib[1] | unib[3] | unib[5] | unib[7];
    un = ((unsigned long long)__builtin_amdgcn_readfirstlane(uhi) << 32) | (unsigned long long)__builtin_amdgcn_readfirstlane(ulo);
  }
  const unsigned long long rowmask = ((unsigned long long)mhi << 32) | mlo;

#pragma unroll 1
  for (int pass = 0; pass < 2; ++pass) {
    REDERIVE();
#pragma unroll
    for (int m = 0; m < 4; ++m) {
      mrow[m] = -INFINITY; lrow[m] = 0.f;
#pragma unroll
      for (int dt = 0; dt < 4; ++dt) o[m][dt] = (f32x4){0.f, 0.f, 0.f, 0.f};
    }
    const unsigned short* kb = p.kvb + (size_t)(((2 + 2 * pass) * NB + b) * 2 + g) * S * 64;
    const unsigned short* vb = p.kvb + (size_t)(((3 + 2 * pass) * NB + b) * 2 + g) * S * 64;
    const unsigned long long upto = (ci == 63) ? ~0ull : ((1ull << (ci + 1)) - 1ull);
    const int jlo = max(0, ci - 8);
    unsigned long long rem = pass ? (upto & ~((1ull << jlo) - 1ull)) : (un & upto);
    const int jwin0 = pass ? ci - 8 : -100;
    int j = __ffsll((long long)rem) - 1;
    tile_fetch(rk, kb + (size_t)j * 4096, t);
    tile_fetch(rv, vb + (size_t)j * 4096, t);
    while (rem) {
      rem &= rem - 1;
      stage_k(rk, ldsK, t);
      stage_v(rv, ldsV, t);
      __syncthreads();
      const int jn = rem ? (__ffsll((long long)rem) - 1) : -1;
      if (jn >= 0) {
        tile_fetch(rk, kb + (size_t)jn * 4096, t);
        tile_fetch(rv, vb + (size_t)jn * 4096, t);
      }
      const bool rowok = pass ? true : (bool)((rowmask >> j) & 1ull);
      int hi = (j == ci) ? rloc : 63;
      const int lo = ((j == jwin0) ? rloc : -1) - 4 * fq;
      hi = (rowok ? hi : -1000) - 4 * fq;
      attn_tile<true>(o, mrow, lrow, qf, ldsK, ldsV, true, lo, hi, lane);
      __syncthreads();
      j = jn;
    }
#pragma unroll
    for (int m = 0; m < 4; ++m) {
      float l = lrow[m];
      l += bpx(l, lane, 16);
      l += bpx(l, lane, 32);
      const float sc = grow[m * 3 + 1 + pass] / l;
#pragma unroll
      for (int dt = 0; dt < 4; ++dt) {
        f32x4* dst = (f32x4*)(orow + m * 64 + dt * 16 + 4 * fq);
        const f32x4 tot = *dst + o[m][dt] * sc;
        if (pass == 0) *dst = tot;
        else *(uint2*)(p.onsab + tok * 512 + g * 256 + m * 64 + dt * 16 + 4 * fq) = pack4(tot);
      }
    }
  }
}

#define XB_TMO      128
#define XB_XCNT(j)  (256  + 64 * (j))
#define XB_XSUB(j)  (1280 + 64 * (j))
#define XB_XGEN(j)  (2304 + 64 * (j))
#define XB_TOP      3328
#define XB_TOPGEN   3392
#define XCD_BAR_WORDS 3456
#define XB_SPIN_CAP (1u << 18)

__device__ __forceinline__ unsigned xb_ld(unsigned* p)              { return __hip_atomic_load(p, __ATOMIC_RELAXED, __HIP_MEMORY_SCOPE_AGENT); }
__device__ __forceinline__ unsigned xb_add(unsigned* p, unsigned v) { return __hip_atomic_fetch_add(p, v, __ATOMIC_RELAXED, __HIP_MEMORY_SCOPE_AGENT); }
__device__ __forceinline__ unsigned xb_xcc_id() { return (unsigned)__builtin_amdgcn_s_getreg((3 << 11) | 20) & 0xFu; }
#define XB_SPIN(cond, bar) do { unsigned _sp = 0; while (cond) { __builtin_amdgcn_s_sleep(1); \
    if ((++_sp & 255u) == 0u) { if (xb_ld(&(bar)[XB_TMO])) break; if (_sp > XB_SPIN_CAP) { atomicAdd(&(bar)[XB_TMO], 1u); break; } } } } while (0)

struct XcdBarrier {
    unsigned* bar; unsigned x;
    volatile LAS unsigned* st;
};

__device__ __forceinline__ XcdBarrier xcd_barrier_post(unsigned* bar, volatile LAS unsigned* st) {
    XcdBarrier b; b.bar = bar; b.x = xb_xcc_id(); b.st = st;
    if (threadIdx.x == 0) (void)xb_add(&bar[XB_XCNT(b.x)], 1u);
    return b;
}
__device__ __forceinline__ void xcd_barrier_complete(unsigned* bar, unsigned x, unsigned& nloc, unsigned& nx) {
    const unsigned G = gridDim.x * gridDim.y * gridDim.z;
    unsigned sum, cnt, mine, sp = 0u;
    for (;;) {
        sum = 0u; cnt = 0u; mine = 0u;
#pragma unroll
        for (unsigned j = 0; j < 16; ++j) { const unsigned c = xb_ld(&bar[XB_XCNT(j)]); sum += c; cnt += (c > 0u) ? 1u : 0u; mine = (j == x) ? c : mine; }
        if (sum == G) break;
        __builtin_amdgcn_s_sleep(1);
        if ((++sp & 255u) == 0u) { if (xb_ld(&bar[XB_TMO])) break; if (sp > XB_SPIN_CAP) { atomicAdd(&bar[XB_TMO], 1u); break; } }
    }
    nloc = mine > 0u ? mine : 1u; nx = cnt > 0u ? cnt : 1u;
}

__device__ __forceinline__ void xcd_barrier(const XcdBarrier& b) {
    asm volatile("s_waitcnt vmcnt(0)" ::: "memory");
    __syncthreads();
    if (threadIdx.x == 0) {
        unsigned* bar = b.bar;
        __builtin_amdgcn_s_waitcnt(0);
        unsigned nloc = b.st[0], nx = b.st[1];
        if (nloc == 0u) { xcd_barrier_complete(bar, b.x, nloc, nx); b.st[0] = nloc; b.st[1] = nx; }
        const unsigned old = xb_add(&bar[XB_XSUB(b.x)], 1u);
        const unsigned gen = old / nloc;
        if (old + 1u == (gen + 1u) * nloc) {
            __builtin_amdgcn_fence(__ATOMIC_RELEASE, "agent");
            asm volatile("s_waitcnt vmcnt(0)" ::: "memory");
            const unsigned og = xb_add(&bar[XB_TOP], 1u);
            const unsigned tg = og / nx;
            if (og + 1u == (tg + 1u) * nx) xb_add(&bar[XB_TOPGEN], 1u);
            else XB_SPIN(xb_ld(&bar[XB_TOPGEN]) == tg, bar);
            __builtin_amdgcn_fence(__ATOMIC_ACQUIRE, "agent");
            xb_add(&bar[XB_XGEN(b.x)], 1u);
            asm volatile("s_waitcnt vmcnt(0)" ::: "memory");
        } else {
            XB_SPIN(xb_ld(&bar[XB_XGEN(b.x)]) == gen, bar);
            __builtin_amdgcn_fence(__ATOMIC_ACQUIRE, "agent");
            asm volatile("s_waitcnt vmcnt(0)" ::: "memory");
        }
    }
    __syncthreads();
}


#define PHASE_IDX int t_ = threadIdx.x; OPAQUE(t_); const int tid = t_, lane = t_ & 63, wib = t_ >> 6; \
  const int gthreads = gridDim.x * 256, gtid = blockIdx.x * 256 + t_, gwaves = gridDim.x * 4, gwave = blockIdx.x * 4 + wib; \
  (void)tid; (void)lane; (void)wib; (void)gthreads; (void)gtid; (void)gwaves; (void)gwave;

constexpr int SMEM_BYTES = GEMM_RING * GEMM_STAGE;

__device__ __forceinline__ void conv_job(const float* W, int K, int N, bf16_t* Wt, int tile, LAS unsigned char* lds) {
  const int tnn = (N + 127) >> 7;
  convert_tile(W, N, N, Wt, K, (tile / tnn) * 64, (tile % tnn) * 128, lds);
}

__global__ void __launch_bounds__(256, 2) mega(Params p) {
  __shared__ __attribute__((aligned(16))) unsigned char smem_raw[SMEM_BYTES + 16];
  float* smem = (float*)smem_raw;
  LAS unsigned char* lds = (LAS unsigned char*)smem_raw;
  volatile LAS unsigned* xb_st = (volatile LAS unsigned*)(lds + SMEM_BYTES);
  if (threadIdx.x < 4) xb_st[threadIdx.x] = 0u;
  __syncthreads();
  const XcdBarrier gbar = xcd_barrier_post(p.bar, xb_st);

  {
  PHASE_IDX
  if (blockIdx.x < 96) {
    for (int i = tid; i < NB * D; i += 256) smem[i] = siluf_(p.c[i]);
    __syncthreads();
    const int j = blockIdx.x * 64 + lane;
    float a0 = 0.f, a1 = 0.f, a2 = 0.f, a3 = 0.f;
    const float* wp = p.w_ada + (size_t)(wib * 256) * (6 * D) + j;
#pragma unroll 32
    for (int k = 0; k < 256; ++k) {
      const float w = wp[(size_t)k * (6 * D)];
      const int kk = wib * 256 + k;
      a0 = fmaf(smem[kk], w, a0); a1 = fmaf(smem[D + kk], w, a1);
      a2 = fmaf(smem[2 * D + kk], w, a2); a3 = fmaf(smem[3 * D + kk], w, a3);
    }
    __syncthreads();
    smem[(wib * 4 + 0) * 64 + lane] = a0; smem[(wib * 4 + 1) * 64 + lane] = a1;
    smem[(wib * 4 + 2) * 64 + lane] = a2; smem[(wib * 4 + 3) * 64 + lane] = a3;
    __syncthreads();
    {
      const int b = wib;
      const float v = p.b_ada[j] + ((smem[(0 * 4 + b) * 64 + lane] + smem[(1 * 4 + b) * 64 + lane]) +
                                    (smem[(2 * 4 + b) * 64 + lane] + smem[(3 * 4 + b) * 64 + lane]));
      p.mod[b * 6 * D + j] = v;
    }
    __syncthreads();
  }
  for (int idx = gtid; idx < 32 * 64; idx += gthreads) {
    const int g = idx / 64;
    const double dt = exp((double)p.log_dt[g]);
    const double lr = p.a_re[idx], li = p.a_im[idx];
    double br = 1.0, bi = 0.0;
    for (int d = 0; d <= 16; ++d) {
      const double mag = exp(lr * dt * d);
      const double pr_ = mag * cos(li * dt * d), pi_ = mag * sin(li * dt * d);
      p.pw[(idx * 17 + d) * 2] = (float)pr_;
      p.pw[(idx * 17 + d) * 2 + 1] = (float)pi_;
      if (d == 1) { br = pr_; bi = pi_; }
    }
    const double nr = br - 1.0, ni = bi;
    const double den = lr * lr + li * li;
    const double cr = (nr * lr + ni * li) / den, ci = (ni * lr - nr * li) / den;
    for (int q = 0; q < 16; ++q) {
      const double wr = p.b_re[idx * 16 + q], wi = p.b_im[idx * 16 + q];
      p.bbar[(idx * 16 + q) * 2] = (float)(cr * wr - ci * wi);
      p.bbar[(idx * 16 + q) * 2 + 1] = (float)(cr * wi + ci * wr);
    }
  }
  for (int idx = gtid; idx < NE; idx += gthreads) { p.cnt[idx] = 0; p.cursor[idx] = 0; }
  for (int o = gwave; o < 512; o += gwaves) {
    const int kv = o >> 8, j = o & 255;
    const float* pe = kv ? p.pe_v : p.pe_k;
    const float* w1 = kv ? p.w_cmp_v1 : p.w_cmp_k1;
    float acc = 0.f;
    for (int k = lane; k < 2048; k += 64) acc = fmaf(pe[k], w1[(size_t)k * 256 + j], acc);
    acc = wsum(acc, lane);
    if (lane == 0) p.cbias[o] = acc;
  }
  {
    const int G = gridDim.x;
    const int first = (G > 96) ? 96 : 0, nb = G - first;
    if ((int)blockIdx.x >= first) {
      for (int job = blockIdx.x - first; job < 1040; job += nb) {
        if (job < 496) conv_job(p.w_in, D, INC, p.w_inT, job, lds);
        else if (job < 560) conv_job(p.w_cmp_k1, 2048, 256, p.wc1T, job - 496, lds);
        else if (job < 624) conv_job(p.w_cmp_v1, 2048, 256, p.wc1T + 256 * 2048, job - 560, lds);
        else if (job < 656) conv_job(p.w_glu, 512, 512, p.wgluT, job - 624, lds);
        else if (job < 720) conv_job(p.w_up_attn, 512, D, p.wuaT, job - 656, lds);
        else if (job < 784) conv_job(p.w_up_ssm, 512, D, p.wusT, job - 720, lds);
        else if (job < 912) conv_job(p.w_out, D, D, p.woutT, job - 784, lds);
        else if (job < 944) conv_job(p.w_router, D, NE, p.wrT, job - 912, lds);
        else if (job < 976) conv_job(p.ws_gate, D, DE, p.wsgT, job - 944, lds);
        else if (job < 1008) conv_job(p.ws_up, D, DE, p.wsuT, job - 976, lds);
        else conv_job(p.ws_down, DE, D, p.wsdT, job - 1008, lds);
      }
    }
  }
  }
  xcd_barrier(gbar);

  {
  PHASE_IDX
  for (int row = gwave; row < NT; row += gwaves) {
    const int b = row / S;
    const float* xr = p.x + (size_t)row * D;
    f32x4 v[4];
    float ss = 0.f;
#pragma unroll
    for (int i = 0; i < 4; ++i) {
      v[i] = *(const f32x4*)(xr + i * 256 + lane * 4);
      ss += (v[i][0] * v[i][0] + v[i][1] * v[i][1]) + (v[i][2] * v[i][2] + v[i][3] * v[i][3]);
    }
    ss = wsum(ss, lane);
    const float r = rsqrtf(ss * (1.0f / D) + EPS);
    const float* md = p.mod + b * 6 * D;
#pragma unroll
    for (int i = 0; i < 4; ++i) {
      const int col = i * 256 + lane * 4;
      const f32x4 gg = *(const f32x4*)(p.g_norm1 + col), sc = *(const f32x4*)(md + D + col), sh = *(const f32x4*)(md + col);
      *(uint2*)(p.h + (size_t)row * D + col) = pack4(v[i] * r * gg * (sc + 1.0f) + sh);
    }
  }
  for (int idx = gtid; idx < 32 * 128 * 256; idx += gthreads) {
    const int k = idx & 255, col = (idx >> 8) & 127, g = idx >> 15;
    const int n = col >> 1, ri = col & 1, sidx = k >> 4, q = k & 15;
    const int gn = g * 64 + n;
    const float pr_ = p.pw[(gn * 17 + 15 - sidx) * 2], pi_ = p.pw[(gn * 17 + 15 - sidx) * 2 + 1];
    const float br = p.bbar[(gn * 16 + q) * 2], bi = p.bbar[(gn * 16 + q) * 2 + 1];
    const float v = ri ? (pr_ * bi + pi_ * br) : (pr_ * br - pi_ * bi);
    p.w1T[idx] = (bf16_t)(cvt_pk_bf16(v, 0.f) & 0xffffu);
  }
  for (int idx = gtid; idx < 32 * 16 * 256; idx += gthreads) {
    const int q = idx & 15, pp = (idx >> 4) & 15, d = (idx >> 8) & 15, g = idx >> 12;
    float acc = (d == 0 && pp == q) ? p.d_skip[g * 16 + pp] : 0.f;
    for (int n = 0; n < 64; ++n) {
      const int gn = g * 64 + n;
      const float cr = p.c_re[(g * 16 + pp) * 64 + n], ci = p.c_im[(g * 16 + pp) * 64 + n];
      const float pr_ = p.pw[(gn * 17 + d) * 2], pi_ = p.pw[(gn * 17 + d) * 2 + 1];
      const float br = p.bbar[(gn * 16 + q) * 2], bi = p.bbar[(gn * 16 + q) * 2 + 1];
      const float tr = cr * pr_ - ci * pi_, ti = cr * pi_ + ci * pr_;
      acc += tr * br - ti * bi;
    }
    p.kd[idx] = acc;
  }
  for (int idx = gtid; idx < 32 * 256 * 128; idx += gthreads) {
    const int k = idx & 127, col = (idx >> 7) & 255, g = idx >> 15;
    const int i = col >> 4, pp = col & 15, n = k >> 1, ri = k & 1;
    const int gn = g * 64 + n;
    const float cr = p.c_re[(g * 16 + pp) * 64 + n], ci = p.c_im[(g * 16 + pp) * 64 + n];
    const float pr_ = p.pw[(gn * 17 + i + 1) * 2], pi_ = p.pw[(gn * 17 + i + 1) * 2 + 1];
    const float v = ri ? -(cr * pi_ + ci * pr_) : (cr * pr_ - ci * pi_);
    p.wyT[((size_t)g * 256 + col) * 384 + k] = (bf16_t)(cvt_pk_bf16(v, 0.f) & 0xffffu);
  }
  }
  xcd_barrier(gbar);

  {
  PHASE_IDX
  {
    constexpr int TN = (INC + TNW - 1) / TNW;
    int mt_, nt_;
    for (int it = 0; xcd_tile(it, NT / TM, TN, mt_, nt_); ++it) {
      const int m0 = mt_ * TM, n0 = nt_ * TNW;
      gemm128<true>(
          D, [&](int r) { return p.h + (size_t)(m0 + r) * D; },
          [&](int c) { return p.w_inT + (size_t)min(n0 + c, INC - 1) * D; },
          [&](const f32x4 (&acc)[4][8], int wr, int wc, int fr, int fq) {
#pragma unroll
            for (int sg = 0; sg < 2; ++sg) {
              const int cw = n0 + wc * 128 + sg * 64;
              if (cw < C_GN) {
                const bool isq = cw < C_KC;
                const int slot = isq ? 0 : (cw - C_KC) >> 7, gg = isq ? 0 : ((cw - C_KC) >> 6) & 1;
                const bool norm = isq || slot == 2 || slot == 4;
                const float* gain = isq ? p.q_gain : (slot == 2 ? p.ks_gain : p.kw_gain);
                const float post = isq ? ATT_SCALE * 1.4426950408889634f : 1.0f;
#pragma unroll
                for (int m = 0; m < 4; ++m) {
                  const int tok = m0 + wr * 64 + m * 16 + fr;
                  float r = 1.0f;
                  if (norm) {
                    float ss = 0.f;
#pragma unroll
                    for (int n = 0; n < 4; ++n)
#pragma unroll
                      for (int jj = 0; jj < 4; ++jj) ss = fmaf(acc[m][sg * 4 + n][jj], acc[m][sg * 4 + n][jj], ss);
                    ss += bpx(ss, fq * 16 + fr, 16);
                    ss += bpx(ss, fq * 16 + fr, 32);
                    r = rsqrtf(ss * (1.0f / 64) + EPS) * post;
                  }
                  bf16_t* dst = isq ? p.qb + (size_t)tok * 512 + cw
                                    : p.kvb + ((size_t)((slot * NB + (tok >> 12)) * 2 + gg) * S + (tok & (S - 1))) * 64;
#pragma unroll
                  for (int n = 0; n < 4; ++n) {
                    f32x4 v = acc[m][sg * 4 + n] * r;
                    if (norm) v = v * *(const f32x4*)(gain + n * 16 + 4 * fq);
                    *(uint2*)(dst + n * 16 + 4 * fq) = pack4(v);
                  }
                }
              } else {
#pragma unroll
                for (int m = 0; m < 4; ++m) {
                  const size_t tok = m0 + wr * 64 + m * 16 + fr;
#pragma unroll
                  for (int n = 0; n < 4; ++n) {
                    const int c = cw + n * 16 + 4 * fq;
                    if (c < INC) {
                      f32x4 v = acc[m][sg * 4 + n];
                      if (c >= C_U && c < C_GA) {
                        const int ch = c - C_U;
                        *(uint2*)(p.a3 + ((size_t)(ch >> 4) * 1024 + (tok >> 4)) * 384 + 128 + (tok & 15) * 16 + (ch & 15)) = pack4(v);
                      } else {
#pragma unroll
                        for (int j = 0; j < 4; ++j) v[j] = sigmoidf_(v[j]);
                        if (c < C_U) *(f32x4*)(p.gn + tok * 24 + (c - C_GN)) = v;
                        else if (c < C_GS) *(uint2*)(p.ga + tok * D + (c - C_GA)) = pack4(v);
                        else *(uint2*)(p.gs + tok * D + (c - C_GS)) = pack4(v);
                      }
                    }
                  }
                }
              }
            }
          },
          lds);
    }
  }
  for (int idx = gtid; idx < 32 * 256 * 256; idx += gthreads) {
    const int k = idx & 255, col = (idx >> 8) & 255, g = idx >> 16;
    const int i = col >> 4, pp = col & 15, sidx = k >> 4, q = k & 15;
    const float v = (i >= sidx) ? p.kd[((g * 16 + (i - sidx)) * 16 + pp) * 16 + q] : 0.f;
    p.wyT[((size_t)g * 256 + col) * 384 + 128 + k] = (bf16_t)(cvt_pk_bf16(v, 0.f) & 0xffffu);
  }
  }
  xcd_barrier(gbar);

  {
  PHASE_IDX
  for (int job = blockIdx.x; job < 2 * 8 * 16; job += gridDim.x) {
    const int kv = job >> 7, ks = (job >> 4) & 7, m0 = (job & 15) * 128;
    float* hp = p.hidp + (size_t)(ks * 2 + kv) * 2040 * 256;
    gemm128<true>(
        256,
        [&](int r) {
          const int rr = min(m0 + r, NB * NCMP * 2 - 1);
          const int b = rr / (NCMP * 2), n = (rr >> 1) % NCMP, g = rr & 1;
          return p.kvb + ((size_t)((kv * NB + b) * 2 + g) * S + 16 * n) * 64 + ks * 256;
        },
        [&](int c) { return p.wc1T + (size_t)(kv * 256 + c) * 2048 + ks * 256; },
        [&](const f32x4 (&acc)[4][8], int wr, int wc, int fr, int fq) {
#pragma unroll
          for (int m = 0; m < 4; ++m) {
            const int r = m0 + wr * 64 + m * 16 + fr;
            if (r < NB * NCMP * 2) {
#pragma unroll
              for (int n = 0; n < 8; ++n) *(f32x4*)(hp + (size_t)r * 256 + wc * 128 + n * 16 + 4 * fq) = acc[m][n];
            }
          }
        },
        lds);
  }
  int mt_, g;
  for (int it = 0; xcd_tile(it, 8, 32, mt_, g); ++it) {
    const int m0 = mt_ * 128;
    gemm128<true>(
        256, [&](int r) { return p.a3 + ((size_t)g * 1024 + m0 + r) * 384 + 128; },
        [&](int c) { return p.w1T + ((size_t)g * 128 + (c & 127)) * 256; },
        [&](const f32x4 (&acc)[4][8], int wr, int wc, int fr, int fq) {
          if (wc == 0) {
#pragma unroll
            for (int m = 0; m < 4; ++m)
#pragma unroll
              for (int n = 0; n < 8; ++n)
                *(f32x4*)(p.lbuf + ((size_t)g * 1024 + m0 + wr * 64 + m * 16 + fr) * 128 + n * 16 + 4 * fq) = acc[m][n];
          }
        },
        lds);
  }
  }
  xcd_barrier(gbar);

  {
  PHASE_IDX
  for (int wv = gwave; wv < 2 * NB * NCMP * 2; wv += gwaves) {
    const int kv = wv / (NB * NCMP * 2), r = wv % (NB * NCMP * 2);
    const int b = r / (NCMP * 2), n = (r >> 1) % NCMP, g = r & 1;
    const float* w2 = kv ? p.w_cmp_v2 : p.w_cmp_k2;
    {
      f32x4 hsum = *(const f32x4*)(p.cbias + kv * 256 + lane * 4);
#pragma unroll
      for (int ks = 0; ks < 8; ++ks) hsum = hsum + *(const f32x4*)(p.hidp + ((size_t)(ks * 2 + kv) * 2040 + r) * 256 + lane * 4);
#pragma unroll
      for (int j = 0; j < 4; ++j) hsum[j] = geluf_(hsum[j]);
      WSYNC();
      *(f32x4*)(smem + wib * 256 + lane * 4) = hsum;
      WSYNC();
    }
    const float* hid = smem + wib * 256;
    float acc = 0.f;
    for (int j = 0; j < 256; ++j) acc = fmaf(hid[j], w2[j * 64 + lane], acc);
    if (kv == 0) {
      const float ss = wsum(acc * acc, lane);
      acc = acc * rsqrtf(ss * (1.0f / 64) + EPS) * p.kc_gain[lane];
    }
    const float other = bpx(acc, lane, 1);
    if ((lane & 1) == 0)
      *(unsigned*)(p.cmpb + ((size_t)((kv * NB + b) * 2 + g) * 256 + n) * 64 + lane) = cvt_pk_bf16(acc, other);
  }
  for (int idx = gtid; idx < 2 * NB * 2 * 32; idx += gthreads)
    *(unsigned*)(p.cmpb + ((size_t)(idx >> 5) * 256 + 255) * 64 + (idx & 31) * 2) = 0u;
  for (int idx = gtid; idx < 32 * NB * 64; idx += gthreads) {
    const int n = idx & 63, b = (idx >> 6) & 3, g = idx >> 8;
    const int gn = g * 64 + n;
    const float lr = p.pw[(gn * 17 + 16) * 2], li = p.pw[(gn * 17 + 16) * 2 + 1];
    float hr_ = 0.f, hi_ = 0.f;
    const size_t row0 = (size_t)g * 1024 + b * 256;
#pragma unroll 1
    for (int c0 = 0; c0 < 256; c0 += 16) {
      float2 l2[16];
#pragma unroll
      for (int i = 0; i < 16; ++i) l2[i] = *(const float2*)(p.lbuf + (row0 + c0 + i) * 128 + n * 2);
#pragma unroll
      for (int i = 0; i < 16; ++i) {
        *(unsigned*)(p.a3 + (row0 + c0 + i) * 384 + n * 2) = cvt_pk_bf16(hr_, hi_);
        const float nr = lr * hr_ - li * hi_ + l2[i].x;
        const float ni = lr * hi_ + li * hr_ + l2[i].y;
        hr_ = nr; hi_ = ni;
      }
    }
  }
  }
  xcd_barrier(gbar);

  {
  PHASE_IDX
  const int G = gridDim.x;
  const bool split = G >= 512;
  if (!split || blockIdx.x < 256) {
    for (int u = blockIdx.x; u < 256; u += (split ? 256 : G)) {
      const int bg = u >> 5, pr = u & 31;
      __builtin_amdgcn_s_setprio(2);
#pragma unroll 1
      for (int half = 0; half < 2; ++half) attn_chunk(p, lds, bg >> 1, bg & 1, half ? pr : 63 - pr);
      __builtin_amdgcn_s_setprio(0);
    }
  }
  if (!split || blockIdx.x >= 256) {
    const int x8 = blockIdx.x & 7, nsl = split ? ((G - 256) >> 3) : 0, sl = split ? (((int)blockIdx.x - 256) >> 3) : 0;
    for (int it = 0;; ++it) {
      int tile;
      if (split && ((G & 7) == 0)) { const int q = sl + it * nsl; if (q >= 32) break; tile = ((x8 + 8 * (q >> 3)) << 3) | (q & 7); }
      else { tile = (split ? (int)blockIdx.x - 256 : (int)blockIdx.x) + it * (split ? G - 256 : G); if (tile >= 256) break; }
      const int g = tile >> 3, m0 = (tile & 7) * 128, n0 = 0;
      gemm128(
          384, [&](int r) { return p.a3 + ((size_t)g * 1024 + m0 + r) * 384; },
          [&](int c) { return p.wyT + ((size_t)g * 256 + n0 + c) * 384; },
          [&](const f32x4 (&acc)[4][8], int wr, int wc, int fr, int fq) {
#pragma unroll
            for (int m = 0; m < 4; ++m)
#pragma unroll
              for (int n = 0; n < 8; ++n) {
                const int col = n0 + wc * 128 + n * 16 + 4 * fq;
                const size_t tok = (size_t)(m0 + wr * 64 + m * 16 + fr) * 16 + (col >> 4);
                f32x4 v = acc[m][n];
#pragma unroll
                for (int j = 0; j < 4; ++j) v[j] = geluf_(v[j]);
                *(uint2*)(p.z + tok * 512 + g * 16 + (col & 15)) = pack4(v);
              }
          },
          lds);
    }
    const int cb = split ? (int)blockIdx.x - 256 : (int)blockIdx.x, cn = split ? G - 256 : G;
    for (int job = cb; job < NE * 96; job += cn) {
      const int e = job / 96, rem = job - e * 96, which = rem >> 5, tile = rem & 31;
      if (which == 0) conv_job(p.w_gate + (size_t)e * D * DE, D, DE, p.wgT + (size_t)e * DE * D, tile, lds);
      else if (which == 1) conv_job(p.w_up + (size_t)e * D * DE, D, DE, p.wuT + (size_t)e * DE * D, tile, lds);
      else conv_job(p.w_down + (size_t)e * DE * D, DE, D, p.wdT + (size_t)e * D * DE, tile, lds);
    }
  }
  }
  xcd_barrier(gbar);

  {
  PHASE_IDX
  gemm_phase(
      NT, 512, 512, [&](int m) { return p.z + (size_t)m * 512; }, [&](int n) { return p.wgluT + (size_t)n * 512; },
      [&](int m, int n, f32x4 v) {
        const f32x4 zz = unpack4(*(const uint2*)(p.z + (size_t)m * 512 + n));
#pragma unroll
        for (int j = 0; j < 4; ++j) v[j] = zz[j] * sigmoidf_(v[j] + p.b_glu[n + j]);
        *(uint2*)(p.yssm + (size_t)m * 512 + n) = pack4(v);
      },
      lds);
  gemm_phase(
      NT, D, 512, [&](int m) { return p.onsab + (size_t)m * 512; }, [&](int n) { return p.wuaT + (size_t)n * 512; },
      [&](int m, int n, f32x4 v) {
        const f32x4 gg = unpack4(*(const uint2*)(p.ga + (size_t)m * D + n));
        *(f32x4*)(p.mtmp + (size_t)m * D + n) = gg * v;
      },
      lds);
  }
  xcd_barrier(gbar);
  {
  PHASE_IDX
  gemm_phase(
      NT, D, 512, [&](int m) { return p.yssm + (size_t)m * 512; }, [&](int n) { return p.wusT + (size_t)n * 512; },
      [&](int m, int n, f32x4 v) {
        const f32x4 gg = unpack4(*(const uint2*)(p.gs + (size_t)m * D + n));
        const f32x4 prev = *(const f32x4*)(p.mtmp + (size_t)m * D + n);
        *(uint2*)(p.merged + (size_t)m * D + n) = pack4(prev + gg * v);
      },
      lds);
  }
  xcd_barrier(gbar);
  {
  PHASE_IDX
  gemm_phase(
      NT, D, D, [&](int m) { return p.merged + (size_t)m * D; }, [&](int n) { return p.woutT + (size_t)n * D; },
      [&](int m, int n, f32x4 v) {
        const int b = m / S;
        const f32x4 xx = *(const f32x4*)(p.x + (size_t)m * D + n);
        const f32x4 gt = *(const f32x4*)(p.mod + b * 6 * D + 2 * D + n);
        *(f32x4*)(p.xmid + (size_t)m * D + n) = xx + gt * v;
      },
      lds);
  }
  xcd_barrier(gbar);

  {
  PHASE_IDX
  for (int row = gwave; row < NT; row += gwaves) {
    const int b = row / S;
    const float* xr = p.xmid + (size_t)row * D;
    f32x4 v[4];
    float ss = 0.f;
#pragma unroll
    for (int i = 0; i < 4; ++i) {
      v[i] = *(const f32x4*)(xr + i * 256 + lane * 4);
      ss += (v[i][0] * v[i][0] + v[i][1] * v[i][1]) + (v[i][2] * v[i][2] + v[i][3] * v[i][3]);
    }
    ss = wsum(ss, lane);
    const float r = rsqrtf(ss * (1.0f / D) + EPS);
    const float* md = p.mod + b * 6 * D;
#pragma unroll
    for (int i = 0; i < 4; ++i) {
      const int col = i * 256 + lane * 4;
      const f32x4 gg = *(const f32x4*)(p.g_norm2 + col), sc = *(const f32x4*)(md + 4 * D + col), sh = *(const f32x4*)(md + 3 * D + col);
      *(uint2*)(p.h + (size_t)row * D + col) = pack4(v[i] * r * gg * (sc + 1.0f) + sh);
    }
  }
  }
  xcd_barrier(gbar);

  {
  PHASE_IDX
  int mt_, nt_;
  for (int it = 0; xcd_tile(it, NT / TM, 3, mt_, nt_); ++it) {
    const int m0 = mt_ * TM;
    if (nt_ == 0) {
      gemm128<true>(
          D, [&](int r) { return p.h + (size_t)(m0 + r) * D; }, [&](int c) { return p.wrT + (size_t)c * D; },
          [&](const f32x4 (&acc)[4][8], int wr, int wc, int fr, int fq) {
#pragma unroll
            for (int m = 0; m < 4; ++m)
#pragma unroll
              for (int n = 0; n < 8; ++n) {
                f32x4 v = acc[m][n];
#pragma unroll
                for (int j = 0; j < 4; ++j) v[j] = sigmoid_acc(v[j]);
                *(f32x4*)(p.scores + (size_t)(m0 + wr * 64 + m * 16 + fr) * NE + wc * 128 + n * 16 + 4 * fq) = v;
              }
          },
          lds);
    } else {
      const int ct = nt_ - 1;
      gemm128<true>(
          D, [&](int r) { return p.h + (size_t)(m0 + r) * D; },
          [&](int c) {
            const int hid = ct * 128 + (c >> 7) * 64 + ((c >> 4) & 3) * 16 + (c & 15);
            return (((c >> 6) & 1) ? p.wsuT : p.wsgT) + (size_t)hid * D;
          },
          [&](const f32x4 (&acc)[4][8], int wr, int wc, int fr, int fq) {
#pragma unroll
            for (int m = 0; m < 4; ++m)
#pragma unroll
              for (int n = 0; n < 4; ++n) {
                f32x4 v;
#pragma unroll
                for (int j = 0; j < 4; ++j) v[j] = siluf_(acc[m][n][j]) * acc[m][n + 4][j];
                *(uint2*)(p.hs + (size_t)(m0 + wr * 64 + m * 16 + fr) * DE + ct * 128 + wc * 64 + n * 16 + 4 * fq) = pack4(v);
              }
          },
          lds);
    }
  }
  }
  xcd_barrier(gbar);

  {
  PHASE_IDX
  for (int tok = gwave; tok < NT; tok += gwaves) {
    const float4 sc4 = *reinterpret_cast<const float4*>(p.scores + (size_t)tok * NE + lane * 4);
    const float4 bi4 = *reinterpret_cast<const float4*>(p.router_bias + lane * 4);
    const float sc[4] = {sc4.x, sc4.y, sc4.z, sc4.w};
    float bz[4] = {sc4.x + bi4.x, sc4.y + bi4.y, sc4.z + bi4.z, sc4.w + bi4.w};
    float m1 = -INFINITY, m2 = -INFINITY;
#pragma unroll
    for (int i = 0; i < 4; ++i) {
      const float v = bz[i];
      if (v > m1) { m2 = m1; m1 = v; } else if (v > m2) { m2 = v; }
    }
#pragma unroll
    for (int o = 1; o < 8; o <<= 1) {
      const float o1 = bpx(m1, lane, o), o2 = bpx(m2, lane, o);
      const float n1 = fmaxf(m1, o1);
      const float n2 = fmaxf(fminf(m1, o1), fmaxf(m2, o2));
      m1 = n1; m2 = n2;
    }
    const float gs = m1 + m2;
    const int mygrp = lane >> 3;
    int grank = 0;
#pragma unroll
    for (int g2 = 0; g2 < 8; ++g2) {
      const float og = bpl(gs, g2 * 8);
      grank += (og > gs || (og == gs && g2 < mygrp)) ? 1 : 0;
    }
    const bool gsel = grank < 4;
#pragma unroll
    for (int i = 0; i < 4; ++i) if (!gsel) bz[i] = -INFINITY;
    unsigned taken = 0;
    float wsel = 0.f;
    int esel = 0;
    float wtot = 0.f;
#pragma unroll 1
    for (int k = 0; k < TOPK; ++k) {
      float bv = -INFINITY; int bidx = 1 << 30;
#pragma unroll
      for (int i = 0; i < 4; ++i) {
        if (!((taken >> i) & 1u) && bz[i] > bv) { bv = bz[i]; bidx = lane * 4 + i; }
      }
#pragma unroll
      for (int o = 32; o > 0; o >>= 1) {
        const float ov = bpx(bv, lane, o);
        const int oi = bpxi(bidx, lane, o);
        if (ov > bv || (ov == bv && oi < bidx)) { bv = ov; bidx = oi; }
      }
      const int owner = bidx >> 2, slot = bidx & 3;
      float sv = 0.f;
      if (lane == owner) {
        taken |= 1u << slot;
        sv = (slot == 0) ? sc[0] : (slot == 1) ? sc[1] : (slot == 2) ? sc[2] : sc[3];
      }
      sv = bpl(sv, owner);
      wtot += sv;
      if (lane == k) { wsel = sv; esel = bidx; }
    }
    if (lane < TOPK) {
      p.eidx[tok * TOPK + lane] = esel;
      p.ew[tok * TOPK + lane] = wsel / wtot * 2.5f;
      atomicAdd(&p.cnt[esel], 1);
    }
  }
  gemm_phase(
      NT, D, DE, [&](int m) { return p.hs + (size_t)m * DE; }, [&](int n) { return p.wsdT + (size_t)n * DE; },
      [&](int m, int n, f32x4 v) {
        const int b = m / S;
        const f32x4 xx = *(const f32x4*)(p.xmid + (size_t)m * D + n);
        const f32x4 gt = *(const f32x4*)(p.mod + b * 6 * D + 5 * D + n);
        *(f32x4*)(p.out + (size_t)m * D + n) = xx + gt * v;
      },
      lds);
  }
  xcd_barrier(gbar);

  {
  PHASE_IDX
  {
    int* soff = (int*)smem;
    int* srt = soff + 320;
    const int myc = p.cnt[tid];
    soff[tid] = myc;
    srt[tid] = (myc + 127) >> 7;
    __syncthreads();
    for (int st = 1; st < 256; st <<= 1) {
      const int a0 = (tid >= st) ? soff[tid - st] : 0;
      __syncthreads();
      soff[tid] += a0;
      __syncthreads();
    }
    const int exo = soff[tid] - myc;
    __syncthreads();
    soff[tid] = exo;
    if (blockIdx.x == 0) {
      p.off[tid] = exo;
      if (tid == 255) p.off[NE] = exo + myc;
    }
    __syncthreads();
    if (blockIdx.x == 0 && tid < 8) {
      int acc = 0;
      for (int i = 0; i < 32; ++i) { p.xrts[tid * 33 + i] = acc; acc += srt[tid + 8 * i]; }
      p.xrts[tid * 33 + 32] = acc;
    }
    for (int idx = gtid; idx < NASSIGN; idx += gthreads) {
      const int e = p.eidx[idx];
      const int pos = soff[e] + atomicAdd(&p.cursor[e], 1);
      p.stok[pos] = idx / TOPK;
      p.sw[pos] = p.ew[idx];
      p.apos[idx] = pos;
    }
    __syncthreads();
  }
  }
  xcd_barrier(gbar);

  {
  PHASE_IDX
  {
    const int x8 = blockIdx.x & 7, ns8 = ((int)gridDim.x - x8 + 7) >> 3;
    const int* xr = p.xrts + x8 * 33;
    const int total_rt = xr[32];
    for (int tile = blockIdx.x >> 3; tile < total_rt * 2; tile += ns8) {
      const int rt = tile >> 1, ct = tile & 1;
      const int ei = find_idx(xr, 32, rt);
      const int e = x8 + 8 * ei;
      const int pos0 = p.off[e] + (rt - xr[ei]) * 128;
      const int mvalid = min(128, p.off[e] + p.cnt[e] - pos0);
      const bf16_t* wg = p.wgT + (size_t)e * DE * D;
      const bf16_t* wu = p.wuT + (size_t)e * DE * D;
      gemm128<true>(
          D, [&](int r) { return p.h + (size_t)p.stok[pos0 + min(r, mvalid - 1)] * D; },
          [&](int c) {
            const int hid = ct * 128 + (c >> 7) * 64 + ((c >> 4) & 3) * 16 + (c & 15);
            return (((c >> 6) & 1) ? wu : wg) + (size_t)hid * D;
          },
          [&](const f32x4 (&acc)[4][8], int wr, int wc, int fr, int fq) {
#pragma unroll
            for (int m = 0; m < 4; ++m) {
              const int r = wr * 64 + m * 16 + fr;
              if (r < mvalid) {
#pragma unroll
                for (int n = 0; n < 4; ++n) {
                  f32x4 v;
#pragma unroll
                  for (int j = 0; j < 4; ++j) v[j] = siluf_(acc[m][n][j]) * acc[m][n + 4][j];
                  *(uint2*)(p.hr + (size_t)(pos0 + r) * DE + ct * 128 + wc * 64 + n * 16 + 4 * fq) = pack4(v);
                }
              }
            }
          },
          lds);
    }
  }
  }
  xcd_barrier(gbar);
  {
  PHASE_IDX
  {
    const int x8 = blockIdx.x & 7, ns8 = ((int)gridDim.x - x8 + 7) >> 3;
    const int* xr = p.xrts + x8 * 33;
    const int total_rt = xr[32];
    for (int rt = blockIdx.x >> 3; rt < total_rt; rt += ns8) {
      const int ei = find_idx(xr, 32, rt);
      const int e = x8 + 8 * ei;
      const int pos0 = p.off[e] + (rt - xr[ei]) * 128;
      const int mvalid = min(128, p.off[e] + p.cnt[e] - pos0);
      const bf16_t* wd = p.wdT + (size_t)e * D * DE;
      float wgt4[4];
      {
        int tq = threadIdx.x;
        OPAQUE(tq);
        const int wr_ = tq >> 7, fr_ = tq & 15;
#pragma unroll
        for (int m = 0; m < 4; ++m) wgt4[m] = p.sw[pos0 + min(wr_ * 64 + m * 16 + fr_, mvalid - 1)];
      }
      gemm128_stream<4>(
          DE, [&](int r) { return p.hr + (size_t)(pos0 + min(r, mvalid - 1)) * DE; },
          [&](int c) { return wd + (size_t)c * DE; }, (size_t)256 * DE,
          [&](int ct, const f32x4 (&acc)[4][8], int wr, int wc, int fr, int fq) {
#pragma unroll
            for (int m = 0; m < 4; ++m) {
              const int r = wr * 64 + m * 16 + fr;
              if (r < mvalid) {
#pragma unroll
                for (int n = 0; n < 8; ++n)
                  *(uint2*)(p.yk + (size_t)(pos0 + r) * D + ct * 256 + wc * 128 + n * 16 + 4 * fq) = pack4(acc[m][n] * wgt4[m]);
              }
            }
          },
          lds);
    }
  }
  }
  xcd_barrier(gbar);
  {
  PHASE_IDX
  for (int tok = gwave; tok < NT; tok += gwaves) {
    const int b = tok / S;
    const int4 ps0 = *(const int4*)(p.apos + tok * TOPK), ps1 = *(const int4*)(p.apos + tok * TOPK + 4);
    const int pos8[8] = {ps0.x, ps0.y, ps0.z, ps0.w, ps1.x, ps1.y, ps1.z, ps1.w};
    u32x4 ra_[8], rc_[8];
#pragma unroll
    for (int k = 0; k < TOPK; ++k) {
      const u32x4* src = (const u32x4*)(p.yk + (size_t)pos8[k] * D + lane * 16);
      ra_[k] = src[0]; rc_[k] = src[1];
    }
    float acc[16];
#pragma unroll
    for (int i = 0; i < 16; ++i) acc[i] = 0.f;
#pragma unroll
    for (int k = 0; k < TOPK; ++k) {
      const unsigned wv[8] = {ra_[k].x, ra_[k].y, ra_[k].z, ra_[k].w, rc_[k].x, rc_[k].y, rc_[k].z, rc_[k].w};
#pragma unroll
      for (int i = 0; i < 8; ++i) {
        acc[2 * i] += __uint_as_float(wv[i] << 16);
        acc[2 * i + 1] += __uint_as_float(wv[i] & 0xffff0000u);
      }
    }
    float* dst = p.out + (size_t)tok * D + lane * 16;
    const float* gt = p.mod + b * 6 * D + 5 * D + lane * 16;
#pragma unroll
    for (int i = 0; i < 4; ++i) {
      f32x4 o4 = *(f32x4*)(dst + 4 * i);
      const f32x4 g4 = *(const f32x4*)(gt + 4 * i);
#pragma unroll
      for (int j = 0; j < 4; ++j) o4[j] += g4[j] * acc[4 * i + j];
      *(f32x4*)(dst + 4 * i) = o4;
    }
  }
  }
}

extern "C" void kernel_launch(void* const* d_in, const int* in_sizes, int n_in, void* d_out, int out_size,
                              void* d_ws, size_t ws_size, hipStream_t stream) {
  (void)in_sizes; (void)n_in; (void)out_size;
  Params p{};
  const float* const* in = reinterpret_cast<const float* const*>(d_in);
  p.x = in[0]; p.c = in[1]; p.w_ada = in[2]; p.b_ada = in[3]; p.g_norm1 = in[4]; p.g_norm2 = in[5];
  p.w_in = in[6]; p.q_gain = in[7]; p.kc_gain = in[8]; p.ks_gain = in[9]; p.kw_gain = in[10];
  p.pe_k = in[11]; p.pe_v = in[12]; p.w_cmp_k1 = in[13]; p.w_cmp_k2 = in[14]; p.w_cmp_v1 = in[15];
  p.w_cmp_v2 = in[16]; p.a_re = in[17]; p.a_im = in[18]; p.log_dt = in[19]; p.b_re = in[20];
  p.b_im = in[21]; p.c_re = in[22]; p.c_im = in[23]; p.d_skip = in[24]; p.w_glu = in[25];
  p.b_glu = in[26]; p.w_up_attn = in[27]; p.w_up_ssm = in[28]; p.w_out = in[29]; p.w_router = in[30];
  p.router_bias = in[31]; p.w_gate = in[32]; p.w_up = in[33]; p.w_down = in[34]; p.ws_gate = in[35];
  p.ws_up = in[36]; p.ws_down = in[37];
  p.out = (float*)d_out;

  char* base = (char*)d_ws;
  size_t o = 0;
  auto take = [&](size_t bytes) { void* r = base + o; o += (bytes + 255) & ~(size_t)255; return r; };
  p.bar = (unsigned*)take(sizeof(unsigned) * XCD_BAR_WORDS);
  p.mod = (float*)take(sizeof(float) * NB * 6 * D);
  p.cbias = (float*)take(sizeof(float) * 512);
  p.w_inT = (bf16_t*)take(2 * (size_t)INC * D);
  p.wc1T = (bf16_t*)take(2 * (size_t)2 * 256 * 2048);
  p.wgluT = (bf16_t*)take(2 * (size_t)512 * 512);
  p.wuaT = (bf16_t*)take(2 * (size_t)D * 512);
  p.wusT = (bf16_t*)take(2 * (size_t)D * 512);
  p.woutT = (bf16_t*)take(2 * (size_t)D * D);
  p.wrT = (bf16_t*)take(2 * (size_t)NE * D);
  p.wsgT = (bf16_t*)take(2 * (size_t)DE * D);
  p.wsuT = (bf16_t*)take(2 * (size_t)DE * D);
  p.wsdT = (bf16_t*)take(2 * (size_t)D * DE);
  p.w1T = (bf16_t*)take(2 * (size_t)32 * 128 * 256);
  p.wyT = (bf16_t*)take(2 * (size_t)32 * 256 * 384);
  p.wgT = (bf16_t*)take(2 * (size_t)NE * DE * D);
  p.wuT = (bf16_t*)take(2 * (size_t)NE * DE * D);
  p.wdT = (bf16_t*)take(2 * (size_t)NE * D * DE);
  p.h = (bf16_t*)take(2 * (size_t)NT * D);
  p.pw = (float*)take(sizeof(float) * 2048 * 17 * 2);
  p.bbar = (float*)take(sizeof(float) * 2048 * 32);
  p.kd = (float*)take(sizeof(float) * 32 * 16 * 256);
  p.xmid = (float*)take(sizeof(float) * (size_t)NT * D);
  p.scores = (float*)take(sizeof(float) * (size_t)NT * NE);
  p.eidx = (int*)take(sizeof(int) * NASSIGN);
  p.ew = (float*)take(sizeof(float) * NASSIGN);
  p.cnt = (int*)take(sizeof(int) * NE);
  p.cursor = (int*)take(sizeof(int) * NE);
  p.off = (int*)take(sizeof(int) * (NE + 1));
  p.xrts = (int*)take(sizeof(int) * 8 * 33);
  p.stok = (int*)take(sizeof(int) * NASSIGN);
  p.sw = (float*)take(sizeof(float) * NASSIGN);
  p.apos = (int*)take(sizeof(int) * NASSIGN);
  p.hs = (bf16_t*)take(2 * (size_t)NT * DE);
  p.hr = (bf16_t*)take(2 * (size_t)NASSIGN * DE);
  const size_t early0 = o;
  p.qb = (bf16_t*)take(2 * (size_t)NT * 512);
  p.kvb = (bf16_t*)take(2 * (size_t)6 * NB * 2 * S * 64);
  p.cmpb = (bf16_t*)take(2 * (size_t)2 * NB * 2 * 256 * 64);
  p.gn = (float*)take(sizeof(float) * (size_t)NT * 24);
  p.a3 = (bf16_t*)take(2 * (size_t)32 * 1024 * 384);
  p.ga = (bf16_t*)take(2 * (size_t)NT * D);
  p.gs = (bf16_t*)take(2 * (size_t)NT * D);
  p.hidp = (float*)take(sizeof(float) * 16 * 2040 * 256);
  p.onsa = (float*)take(sizeof(float) * (size_t)NT * 512);
  p.onsab = (bf16_t*)take(2 * (size_t)NT * 512);
  p.lbuf = (float*)take(sizeof(float) * 32 * 1024 * 128);
  p.z = (bf16_t*)take(2 * (size_t)NT * 512);
  p.yssm = (bf16_t*)take(2 * (size_t)NT * 512);
  p.mtmp = (float*)take(sizeof(float) * (size_t)NT * D);
  p.merged = (bf16_t*)take(2 * (size_t)NT * D);
  const size_t early1 = o;
  p.yk = (bf16_t*)(base + early0);
  const size_t yk_bytes = 2 * (size_t)NASSIGN * D;
  if (early0 + yk_bytes > o) o = early0 + yk_bytes;
  (void)early1;
  if (o > ws_size) fprintf(stderr, "workspace too small: need %zu have %zu\n", o, ws_size);

  static int grid_blocks = 0;
  if (!grid_blocks) {
    int dev = 0, cus = 0, per_cu = 0;
    (void)hipGetDevice(&dev);
    (void)hipDeviceGetAttribute(&cus, hipDeviceAttributeMultiprocessorCount, dev);
    (void)hipOccupancyMaxActiveBlocksPerMultiprocessor(&per_cu, mega, 256, 0);
    if (per_cu > 2) per_cu = 2;
    if (per_cu < 1) per_cu = 1;
    grid_blocks = cus * per_cu;
  }
  (void)hipMemsetAsync(p.bar, 0, sizeof(unsigned) * XCD_BAR_WORDS, stream);
  hipLaunchKernelGGL(mega, dim3(grid_blocks), dim3(256), 0, stream, p);
  hipError_t e = hipPeekAtLastError();
  if (e != hipSuccess) fprintf(stderr, "launch failed: %s (grid %d)\n", hipGetErrorString(e), grid_blocks);
}
```

```cpp
#include <hip/hip_runtime.h>
#include <cstdio>
#include <cstdint>

constexpr int D = 1024;
constexpr int NB = 4;
constexpr int S = 4096;
constexpr int NT = NB * S;
constexpr int INC = 3864;
constexpr int C_Q = 0, C_KC = 512, C_VC = 640, C_KS = 768, C_VS = 896, C_KW = 1024, C_VW = 1152,
              C_GN = 1280, C_U = 1304, C_GA = 1816, C_GS = 2840;
constexpr int NCMP = 255;
constexpr int NE = 256;
constexpr int TOPK = 8;
constexpr int DE = 256;
constexpr int NASSIGN = NT * TOPK;
constexpr float EPS = 1e-6f;
constexpr float ATT_SCALE = 0.125f;
typedef unsigned short bf16_t;

struct Params {
  const float* x; const float* c; const float* w_ada; const float* b_ada; const float* g_norm1;
  const float* g_norm2; const float* w_in; const float* q_gain; const float* kc_gain;
  const float* ks_gain; const float* kw_gain; const float* pe_k; const float* pe_v;
  const float* w_cmp_k1; const float* w_cmp_k2; const float* w_cmp_v1; const float* w_cmp_v2;
  const float* a_re; const float* a_im; const float* log_dt; const float* b_re; const float* b_im;
  const float* c_re; const float* c_im; const float* d_skip; const float* w_glu; const float* b_glu;
  const float* w_up_attn; const float* w_up_ssm; const float* w_out; const float* w_router;
  const float* router_bias; const float* w_gate; const float* w_up; const float* w_down;
  const float* ws_gate; const float* ws_up; const float* ws_down;
  float* out;
  unsigned* bar;
  float* mod;
  float* cbias;
  bf16_t* w_inT;
  bf16_t* wc1T;
  bf16_t* wgluT;
  bf16_t* wuaT;
  bf16_t* wusT;
  bf16_t* woutT;
  bf16_t* wrT;
  bf16_t* wsgT;
  bf16_t* wsuT;
  bf16_t* wsdT;
  bf16_t* w1T;
  bf16_t* wyT;
  bf16_t* wgT;
  bf16_t* wuT;
  bf16_t* wdT;
  bf16_t* h;
  bf16_t* qb;
  bf16_t* kvb;
  bf16_t* cmpb;
  float* gn;
  bf16_t* a3;
  bf16_t* ga;
  bf16_t* gs;
  float* hidp;
  float* onsa;
  bf16_t* onsab;
  float* pw;
  float* bbar;
  float* kd;
  float* lbuf;
  bf16_t* z;
  bf16_t* yssm;
  float* mtmp;
  bf16_t* merged;
  float* xmid;
  float* scores;
  int* eidx;
  float* ew;
  int* cnt;
  int* cursor;
  int* off;
  int* xrts;
  int* stok;
  float* sw;
  int* apos;
  bf16_t* hs;
  bf16_t* hr;
  bf16_t* yk;
};

__device__ __forceinline__ float bpx(float v, int lane, int off) {
  return __int_as_float(__builtin_amdgcn_ds_bpermute((lane ^ off) << 2, __float_as_int(v)));
}
__device__ __forceinline__ int bpxi(int v, int lane, int off) { return __builtin_amdgcn_ds_bpermute((lane ^ off) << 2, v); }
__device__ __forceinline__ unsigned bpxu(unsigned v, int lane, int off) { return (unsigned)__builtin_amdgcn_ds_bpermute((lane ^ off) << 2, (int)v); }
__device__ __forceinline__ float bpl(float v, int src) {
  return __int_as_float(__builtin_amdgcn_ds_bpermute(src << 2, __float_as_int(v)));
}
__device__ __forceinline__ float wsum(float v, int lane) {
#pragma unroll
  for (int o = 32; o > 0; o >>= 1) v += bpx(v, lane, o);
  return v;
}
#define WSYNC() do { __builtin_amdgcn_fence(__ATOMIC_ACQ_REL, "wavefront"); __builtin_amdgcn_wave_barrier(); } while (0)
__device__ __forceinline__ float fexp_(float x) { return __builtin_amdgcn_exp2f(x * 1.4426950408889634f); }
__device__ __forceinline__ float sigmoidf_(float x) { return 1.0f / (1.0f + fexp_(-x)); }
__device__ __forceinline__ float sigmoid_acc(float x) { return 1.0f / (1.0f + expf(-x)); }
__device__ __forceinline__ float siluf_(float x) { return x / (1.0f + fexp_(-x)); }
__device__ __forceinline__ float geluf_(float x) {
  const float u2 = 1.5957691216057308f * (x + 0.044715f * x * x * x);
  return x / (1.0f + fexp_(-u2));
}
#define OPAQUE(x) asm volatile("" : "+v"(x))
typedef short bf16x8 __attribute__((ext_vector_type(8)));
typedef float f32x4 __attribute__((ext_vector_type(4)));
typedef unsigned u32x4 __attribute__((ext_vector_type(4)));
#define LAS __attribute__((address_space(3)))

__device__ __forceinline__ unsigned cvt_pk_bf16(float lo, float hi) {
  unsigned r;
  asm("v_cvt_pk_bf16_f32 %0, %1, %2" : "=v"(r) : "v"(lo), "v"(hi));
  return r;
}
__device__ __forceinline__ uint2 pack4(const f32x4 v) {
  uint2 w;
  w.x = cvt_pk_bf16(v[0], v[1]); w.y = cvt_pk_bf16(v[2], v[3]);
  return w;
}
__device__ __forceinline__ f32x4 unpack4(const uint2 w) {
  return (f32x4){__uint_as_float(w.x << 16), __uint_as_float(w.x & 0xffff0000u), __uint_as_float(w.y << 16), __uint_as_float(w.y & 0xffff0000u)};
}
__device__ __forceinline__ int lds_byte(int r, int c) {
  const int st = (r >> 4) * 2 + (c >> 5), rr = r & 15, cc = c & 31, ob = rr * 64 + cc * 2;
  return st * 1024 + (ob ^ (((ob >> 9) & 1) << 5));
}
__device__ __forceinline__ int t32_byte(int r, int c) {
  const int ob = (r & 15) * 64 + c * 2;
  return (r >> 4) * 1024 + (ob ^ (((ob >> 9) & 1) << 5));
}

constexpr int GEMM_STAGE = 24576;
constexpr int GEMM_RING = 3;
constexpr int TM = 128, TNW = 256;
template <bool GL = false, class AF, class BF, class EPW>
__device__ __forceinline__ void gemm128(int K, AF arow, BF brow, EPW epiw, LAS unsigned char* lds) {
  int t = threadIdx.x;
  OPAQUE(t);
  const int wid = t >> 6, lane = t & 63, wr = wid >> 1, wc = wid & 1, fr = lane & 15, fq = lane >> 4;
  const int sbb = lane * 16, obb = sbb ^ (((sbb >> 9) & 1) << 5);
  const int rin = obb >> 6, cel = (obb & 63) >> 1;
  const bf16_t* ga0 = arow(wid * 16 + rin) + cel;
  const bf16_t* ga1 = arow((wid + 4) * 16 + rin) + cel;
  const bf16_t* gb0 = brow(wid * 16 + rin) + cel;
  const bf16_t* gb1 = brow((wid + 4) * 16 + rin) + cel;
  const bf16_t* gb2 = brow((wid + 8) * 16 + rin) + cel;
  const bf16_t* gb3 = brow((wid + 12) * 16 + rin) + cel;
  f32x4 acc[4][8];
#pragma unroll
  for (int m = 0; m < 4; ++m)
#pragma unroll
    for (int n = 0; n < 8; ++n) acc[m][n] = (f32x4){0.f, 0.f, 0.f, 0.f};
  const int foff = t32_byte(fr, fq * 8);
  const int nk = K >> 5;
#define GEMM_COMPUTE(sa_) do { \
    bf16x8 af[4]; \
    _Pragma("unroll") for (int m = 0; m < 4; ++m) af[m] = *(const LAS bf16x8*)((sa_) + (wr * 4 + m) * 1024 + foff); \
    _Pragma("unroll") for (int nh = 0; nh < 2; ++nh) { \
      bf16x8 bf[4]; \
      _Pragma("unroll") for (int n = 0; n < 4; ++n) bf[n] = *(const LAS bf16x8*)((sa_) + 8192 + (wc * 8 + nh * 4 + n) * 1024 + foff); \
      __builtin_amdgcn_s_setprio(1); \
      _Pragma("unroll") for (int m = 0; m < 4; ++m) \
        _Pragma("unroll") for (int n = 0; n < 4; ++n) \
          acc[m][nh * 4 + n] = __builtin_amdgcn_mfma_f32_16x16x32_bf16(bf[n], af[m], acc[m][nh * 4 + n], 0, 0, 0); \
      __builtin_amdgcn_s_setprio(0); \
      if (nh == 0) __builtin_amdgcn_sched_barrier(0); } } while (0)
  if constexpr (GL) {
  LAS unsigned char* l0 = lds + t * 16;
#define GEMM_ISSUE(s_) do { LAS unsigned char* d_ = l0 + ((s_) % GEMM_RING) * GEMM_STAGE; const int ko_ = (s_) * 32; \
    __builtin_amdgcn_global_load_lds((const unsigned*)(ga0 + ko_), (LAS unsigned*)(d_), 16, 0, 0); \
    __builtin_amdgcn_global_load_lds((const unsigned*)(ga1 + ko_), (LAS unsigned*)(d_ + 4096), 16, 0, 0); \
    __builtin_amdgcn_global_load_lds((const unsigned*)(gb0 + ko_), (LAS unsigned*)(d_ + 8192), 16, 0, 0); \
    __builtin_amdgcn_global_load_lds((const unsigned*)(gb1 + ko_), (LAS unsigned*)(d_ + 12288), 16, 0, 0); \
    __builtin_amdgcn_global_load_lds((const unsigned*)(gb2 + ko_), (LAS unsigned*)(d_ + 16384), 16, 0, 0); \
    __builtin_amdgcn_global_load_lds((const unsigned*)(gb3 + ko_), (LAS unsigned*)(d_ + 20480), 16, 0, 0); } while (0)
  asm volatile("s_waitcnt vmcnt(0)" ::: "memory");
#pragma unroll
  for (int s_ = 0; s_ < GEMM_RING - 1; ++s_)
    if (s_ < nk) GEMM_ISSUE(s_);
  for (int kt = 0; kt < nk; ++kt) {
    if (kt + 1 < nk) asm volatile("s_waitcnt vmcnt(6)" ::: "memory");
    else asm volatile("s_waitcnt vmcnt(0)" ::: "memory");
    __builtin_amdgcn_s_barrier();
    asm volatile("" ::: "memory");
    if (kt + GEMM_RING - 1 < nk) GEMM_ISSUE(kt + GEMM_RING - 1);
    const LAS unsigned char* sa = lds + (kt % GEMM_RING) * GEMM_STAGE;
    GEMM_COMPUTE(sa);
  }
  __builtin_amdgcn_s_barrier();
  asm volatile("" ::: "memory");
#undef GEMM_ISSUE
  } else {
  for (int kt = 0; kt < nk; ++kt) {
    const int ko = kt * 32;
    const u32x4 a0 = *(const u32x4*)(ga0 + ko), a1 = *(const u32x4*)(ga1 + ko);
    const u32x4 b0 = *(const u32x4*)(gb0 + ko), b1 = *(const u32x4*)(gb1 + ko);
    const u32x4 b2 = *(const u32x4*)(gb2 + ko), b3 = *(const u32x4*)(gb3 + ko);
    *(LAS u32x4*)(lds + t * 16) = a0;
    *(LAS u32x4*)(lds + t * 16 + 4096) = a1;
    *(LAS u32x4*)(lds + t * 16 + 8192) = b0;
    *(LAS u32x4*)(lds + t * 16 + 12288) = b1;
    *(LAS u32x4*)(lds + t * 16 + 16384) = b2;
    *(LAS u32x4*)(lds + t * 16 + 20480) = b3;
    __syncthreads();
    GEMM_COMPUTE(lds);
    __syncthreads();
  }
  }
#undef GEMM_COMPUTE
  epiw(acc, wr, wc, fr, fq);
}

template <int NCT, class AF, class BF, class EPW>
__device__ __forceinline__ void gemm128_stream(int K, AF arow, BF brow, size_t bct, EPW epiw, LAS unsigned char* lds) {
  int t = threadIdx.x;
  OPAQUE(t);
  const int wid = t >> 6, lane = t & 63, wr = wid >> 1, wc = wid & 1, fr = lane & 15, fq = lane >> 4;
  const int sbb = lane * 16, obb = sbb ^ (((sbb >> 9) & 1) << 5);
  const int rin = obb >> 6, cel = (obb & 63) >> 1;
  const bf16_t* ga0 = arow(wid * 16 + rin) + cel;
  const bf16_t* ga1 = arow((wid + 4) * 16 + rin) + cel;
  const bf16_t* gb0 = brow(wid * 16 + rin) + cel;
  const bf16_t* gb1 = brow((wid + 4) * 16 + rin) + cel;
  const bf16_t* gb2 = brow((wid + 8) * 16 + rin) + cel;
  const bf16_t* gb3 = brow((wid + 12) * 16 + rin) + cel;
  f32x4 acc[4][8];
#pragma unroll
  for (int m = 0; m < 4; ++m)
#pragma unroll
    for (int n = 0; n < 8; ++n) acc[m][n] = (f32x4){0.f, 0.f, 0.f, 0.f};
  const int foff = t32_byte(fr, fq * 8);
  const int nk = K >> 5, ns = nk * NCT;
  LAS unsigned char* l0 = lds + t * 16;
  int iss_k = 0;
  size_t iss_b = 0;
#define GEMM_ISSUE2(s_) do { LAS unsigned char* d_ = l0 + ((s_) % GEMM_RING) * GEMM_STAGE; \
    __builtin_amdgcn_global_load_lds((const unsigned*)(ga0 + iss_k), (LAS unsigned*)(d_), 16, 0, 0); \
    __builtin_amdgcn_global_load_lds((const unsigned*)(ga1 + iss_k), (LAS unsigned*)(d_ + 4096), 16, 0, 0); \
    __builtin_amdgcn_global_load_lds((const unsigned*)(gb0 + iss_b + iss_k), (LAS unsigned*)(d_ + 8192), 16, 0, 0); \
    __builtin_amdgcn_global_load_lds((const unsigned*)(gb1 + iss_b + iss_k), (LAS unsigned*)(d_ + 12288), 16, 0, 0); \
    __builtin_amdgcn_global_load_lds((const unsigned*)(gb2 + iss_b + iss_k), (LAS unsigned*)(d_ + 16384), 16, 0, 0); \
    __builtin_amdgcn_global_load_lds((const unsigned*)(gb3 + iss_b + iss_k), (LAS unsigned*)(d_ + 20480), 16, 0, 0); \
    iss_k += 32; if (iss_k == K) { iss_k = 0; iss_b += bct; } } while (0)
  asm volatile("s_waitcnt vmcnt(0)" ::: "memory");
#pragma unroll
  for (int s_ = 0; s_ < GEMM_RING - 1; ++s_)
    if (s_ < ns) GEMM_ISSUE2(s_);
  int kt = 0, ct = 0;
  for (int s_ = 0; s_ < ns; ++s_) {
    if (s_ + 1 < ns) asm volatile("s_waitcnt vmcnt(6)" ::: "memory");
    else asm volatile("s_waitcnt vmcnt(0)" ::: "memory");
    __builtin_amdgcn_s_barrier();
    asm volatile("" ::: "memory");
    if (s_ + GEMM_RING - 1 < ns) GEMM_ISSUE2(s_ + GEMM_RING - 1);
    const LAS unsigned char* sa = lds + (s_ % GEMM_RING) * GEMM_STAGE;
    {
      bf16x8 af[4];
#pragma unroll
      for (int m = 0; m < 4; ++m) af[m] = *(const LAS bf16x8*)(sa + (wr * 4 + m) * 1024 + foff);
#pragma unroll
      for (int nh = 0; nh < 2; ++nh) {
        bf16x8 bf[4];
#pragma unroll
        for (int n = 0; n < 4; ++n) bf[n] = *(const LAS bf16x8*)(sa + 8192 + (wc * 8 + nh * 4 + n) * 1024 + foff);
#pragma unroll
        for (int m = 0; m < 4; ++m)
#pragma unroll
          for (int n = 0; n < 4; ++n)
            acc[m][nh * 4 + n] = __builtin_amdgcn_mfma_f32_16x16x32_bf16(bf[n], af[m], acc[m][nh * 4 + n], 0, 0, 0);
        if (nh == 0) __builtin_amdgcn_sched_barrier(0);
      }
    }
    if (++kt == nk) {
      epiw(ct, acc, wr, wc, fr, fq);
#pragma unroll
      for (int m = 0; m < 4; ++m)
#pragma unroll
        for (int n = 0; n < 8; ++n) acc[m][n] = (f32x4){0.f, 0.f, 0.f, 0.f};
      kt = 0; ++ct;
    }
  }
  __builtin_amdgcn_s_barrier();
  asm volatile("" ::: "memory");
#undef GEMM_ISSUE2
}

__device__ __forceinline__ bool xcd_tile(int it, int tm, int tn, int& mt, int& nt) {
  const int G = gridDim.x, x = blockIdx.x & 7, slot = blockIdx.x >> 3, ns = (G - x + 7) >> 3;
  const int q = slot + it * ns;
  if (tn >= 8) {
    const int cn = (tn - x + 7) >> 3;
    if (q >= cn * tm) return false;
    mt = q / cn; nt = x + 8 * (q % cn);
  } else {
    const int cm = (tm - x + 7) >> 3;
    if (cm <= 0 || q >= cm * tn) return false;
    mt = x + 8 * (q / tn); nt = q % tn;
  }
  return true;
}
__device__ __forceinline__ int find_idx(const int* pre, int n, int v) {
  int lo = 0, hi = n;
  while (hi - lo > 1) {
    const int mid = (lo + hi) >> 1;
    if (pre[mid] <= v) lo = mid; else hi = mid;
  }
  return lo;
}

template <class AL, class BL, class EP>
__device__ __forceinline__ void gemm_phase(int M, int N, int K, AL al, BL bl, EP ep, LAS unsigned char* lds) {
  const int tn = (N + TNW - 1) / TNW, tm = (M + TM - 1) / TM;
  int mt, nt;
  for (int it = 0; xcd_tile(it, tm, tn, mt, nt); ++it) {
    const int m0 = mt * TM, n0 = nt * TNW;
    gemm128<true>(
        K, [&](int r) { return al(min(m0 + r, M - 1)); }, [&](int c) { return bl(min(n0 + c, N - 1)); },
        [&](const f32x4 (&acc)[4][8], int wr, int wc, int fr, int fq) {
#pragma unroll
          for (int m = 0; m < 4; ++m)
#pragma unroll
            for (int n = 0; n < 8; ++n) {
              const int r = m0 + wr * 64 + m * 16 + fr, c = n0 + wc * 128 + n * 16 + 4 * fq;
              if (r < M && c < N) ep(r, c, acc[m][n]);
            }
        },
        lds);
  }
}

__device__ __forceinline__ void convert_tile(const float* W, int ldw, int nvalid, bf16_t* Wt, int ldt, int k0, int n0, LAS unsigned char* lds) {
  int t = threadIdx.x;
  OPAQUE(t);
  const int n4 = t & 31, kg = t >> 5;
  const int ncol = n0 + n4 * 4;
  f32x4 rb[8];
#pragma unroll
  for (int j = 0; j < 8; ++j)
    rb[j] = (ncol < nvalid) ? *(const f32x4*)(W + (size_t)(k0 + kg * 8 + j) * ldw + ncol) : (f32x4){0.f, 0.f, 0.f, 0.f};
#pragma unroll
  for (int c = 0; c < 4; ++c) {
    u32x4 w;
    w.x = cvt_pk_bf16(rb[0][c], rb[1][c]); w.y = cvt_pk_bf16(rb[2][c], rb[3][c]);
    w.z = cvt_pk_bf16(rb[4][c], rb[5][c]); w.w = cvt_pk_bf16(rb[6][c], rb[7][c]);
    *(LAS u32x4*)(lds + (n4 * 4 + c) * 144 + kg * 16) = w;
  }
  __syncthreads();
#pragma unroll
  for (int i = 0; i < 4; ++i) {
    const int q = t + i * 256, row = q >> 3, piece = q & 7;
    if (n0 + row < nvalid) *(u32x4*)(Wt + (size_t)(n0 + row) * ldt + k0 + piece * 8) = *(const LAS u32x4*)(lds + row * 144 + piece * 16);
  }
  __syncthreads();
}

typedef short s16x4 __attribute__((ext_vector_type(4)));
#define REDERIVE() do { OPAQUE(t); w = t >> 6; lane = t & 63; fr = lane & 15; fq = lane >> 4; rloc = w * 16 + fr; } while (0)
constexpr int VROW = 160;

__device__ __forceinline__ bf16x8 pack8(const f32x4 a, const f32x4 b) {
  u32x4 w;
  w.x = cvt_pk_bf16(a[0], a[1]); w.y = cvt_pk_bf16(a[2], a[3]);
  w.z = cvt_pk_bf16(b[0], b[1]); w.w = cvt_pk_bf16(b[2], b[3]);
  return __builtin_bit_cast(bf16x8, w);
}
__device__ __forceinline__ void tile_fetch(bf16x8 (&r)[2], const unsigned short* base, int t) {
  const bf16x8* q = (const bf16x8*)(base + t * 16);
  r[0] = q[0];
  r[1] = q[1];
}
__device__ __forceinline__ void stage_k(const bf16x8 (&r)[2], LAS unsigned char* ldsK, int t) {
  const int row = t >> 2, c0 = (t & 3) * 16;
  *(LAS bf16x8*)(ldsK + lds_byte(row, c0)) = r[0];
  *(LAS bf16x8*)(ldsK + lds_byte(row, c0 + 8)) = r[1];
}
__device__ __forceinline__ void stage_v(const bf16x8 (&r)[2], LAS unsigned char* ldsV, int t) {
  const int row = t >> 2, c0 = (t & 3) * 16;
  *(LAS bf16x8*)(ldsV + row * VROW + c0 * 2) = r[0];
  *(LAS bf16x8*)(ldsV + row * VROW + c0 * 2 + 16) = r[1];
}
template <int H>
__device__ __forceinline__ void attn_qk_h(f32x4 (&s)[4][2], const LAS unsigned char* qf, LAS unsigned char* ldsK, int fr, int fq) {
  const int koff = lds_byte(fr, fq * 8);
#pragma unroll
  for (int m = 0; m < 4; ++m)
#pragma unroll
    for (int nn = 0; nn < 2; ++nn) s[m][nn] = (f32x4){0.f, 0.f, 0.f, 0.f};
#pragma unroll
  for (int nn = 0; nn < 2; ++nn)
#pragma unroll
    for (int ks = 0; ks < 2; ++ks) {
      const bf16x8 kf = *(const LAS bf16x8*)(ldsK + koff + (2 * H + nn) * 2048 + ks * 1024);
#pragma unroll
      for (int m = 0; m < 4; ++m)
        s[m][nn] = __builtin_amdgcn_mfma_f32_16x16x32_bf16(kf, *(const LAS bf16x8*)(qf + (m * 2 + ks) * 1024), s[m][nn], 0, 0, 0);
    }
}
template <int H>
__device__ __forceinline__ void attn_pv_h(f32x4 (&o)[4][4], const bf16x8 (&pf)[4], LAS unsigned char* ldsV, int lane) {
  const int fq = lane >> 4, i = lane & 15;
  const int vbase = (4 * fq + (i >> 2)) * VROW + (i & 3) * 8;
#pragma unroll
  for (int dt = 0; dt < 4; ++dt) {
    LAS unsigned char* a0 = ldsV + vbase + H * 32 * VROW + dt * 32;
    const s16x4 v0 = __builtin_amdgcn_ds_read_tr16_b64_v4i16((LAS s16x4*)a0);
    const s16x4 v1 = __builtin_amdgcn_ds_read_tr16_b64_v4i16((LAS s16x4*)(a0 + 16 * VROW));
    bf16x8 vf;
    vf[0] = v0[0]; vf[1] = v0[1]; vf[2] = v0[2]; vf[3] = v0[3];
    vf[4] = v1[0]; vf[5] = v1[1]; vf[6] = v1[2]; vf[7] = v1[3];
#pragma unroll
    for (int m = 0; m < 4; ++m) o[m][dt] = __builtin_amdgcn_mfma_f32_16x16x32_bf16(vf, pf[m], o[m][dt], 0, 0, 0);
  }
}
constexpr float SOFTMAX_SHIFT = 12.0f;
template <int H, bool EM>
__device__ __forceinline__ void attn_softmax_h(f32x4 (&s)[4][2], float (&lrow)[4], bf16x8 (&pf)[4], bool rowok, int lo, int hi) {
#pragma unroll
  for (int m = 0; m < 4; ++m) {
    float ls = 0.f;
#pragma unroll
    for (int nn = 0; nn < 2; ++nn)
#pragma unroll
      for (int jj = 0; jj < 4; ++jj) {
        const int kc = 16 * (2 * H + nn) + jj;
        const bool ok = rowok && (!EM || (lo < kc && hi >= kc));
        const float pv = ok ? __builtin_amdgcn_exp2f(s[m][nn][jj] - SOFTMAX_SHIFT) : 0.f;
        s[m][nn][jj] = pv;
        ls += pv;
      }
    lrow[m] += ls;
    pf[m] = pack8(s[m][0], s[m][1]);
  }
}
template <int H, bool EM>
__device__ __forceinline__ void attn_sub(f32x4 (&o)[4][4], float (&mrow)[4], float (&lrow)[4], const LAS unsigned char* qf,
                                         LAS unsigned char* ldsK, LAS unsigned char* ldsV, bool rowok, int lo, int hi, int lane) {
  f32x4 s[4][2];
  bf16x8 pf[4];
  attn_qk_h<H>(s, qf, ldsK, lane & 15, lane >> 4);
  attn_softmax_h<H, EM>(s, lrow, pf, rowok, lo, hi);
  attn_pv_h<H>(o, pf, ldsV, lane);
  if (H == 0) __builtin_amdgcn_sched_barrier(0);
}
template <bool EM>
__device__ __forceinline__ void attn_tile(f32x4 (&o)[4][4], float (&mrow)[4], float (&lrow)[4], const LAS unsigned char* qf,
                                          LAS unsigned char* ldsK, LAS unsigned char* ldsV, bool rowok, int lo, int hi, int lane) {
  attn_sub<0, EM>(o, mrow, lrow, qf, ldsK, ldsV, rowok, lo, hi, lane);
  attn_sub<1, EM>(o, mrow, lrow, qf, ldsK, ldsV, rowok, lo, hi, lane);
}
template <int H>
__device__ __forceinline__ void cmp_stats(float (&mrow)[4], float (&lrow)[4], const LAS unsigned char* qf, LAS unsigned char* ldsK, int hi, int lane) {
  const int fq = lane >> 4;
  f32x4 s[4][2];
  attn_qk_h<H>(s, qf, ldsK, lane & 15, fq);
#pragma unroll
  for (int m = 0; m < 4; ++m) {
    float ls = 0.f;
#pragma unroll
    for (int nn = 0; nn < 2; ++nn)
#pragma unroll
      for (int jj = 0; jj < 4; ++jj) {
        const int kc = 16 * (2 * H + nn) + jj;
        ls += (hi >= kc) ? __builtin_amdgcn_exp2f(s[m][nn][jj] - SOFTMAX_SHIFT) : 0.f;
      }
    lrow[m] += ls;
  }
}
template <int H>
__device__ __forceinline__ void cmp_apply(f32x4 (&o)[4][4], const float (&msf)[4], const float (&linv)[4], float& lastprev, LAS float* improw,
                                          const LAS unsigned char* qf, LAS unsigned char* ldsK, LAS unsigned char* ldsV, int hi, int lane) {
  const int fq = lane >> 4;
  f32x4 s[4][2];
  bf16x8 pf[4];
  attn_qk_h<H>(s, qf, ldsK, lane & 15, fq);
#pragma unroll
  for (int m = 0; m < 4; ++m) {
#pragma unroll
    for (int nn = 0; nn < 2; ++nn)
#pragma unroll
      for (int jj = 0; jj < 4; ++jj) {
        const int kc = 16 * (2 * H + nn) + jj;
        s[m][nn][jj] = (hi >= kc) ? __builtin_amdgcn_exp2f(s[m][nn][jj] - SOFTMAX_SHIFT) * linv[m] : 0.f;
      }
    pf[m] = pack8(s[m][0], s[m][1]);
  }
#pragma unroll
  for (int nn = 0; nn < 2; ++nn) {
    float gs = 0.f, last = 0.f;
#pragma unroll
    for (int m = 0; m < 4; ++m) {
      gs += (s[m][nn][0] + s[m][nn][1]) + (s[m][nn][2] + s[m][nn][3]);
      last += s[m][nn][3];
    }
    const float pa = bpl(last, (lane + 48) & 63);
    const float pb = bpl(lastprev, (lane + 48) & 63);
    improw[(2 * H + nn) * 4 + fq] = gs + ((fq > 0) ? pa : pb);
    lastprev = last;
  }
  attn_pv_h<H>(o, pf, ldsV, lane);
}

__device__ __forceinline__ void attn_chunk(const Params& p, LAS unsigned char* lds, int b, int g, int ci) {
  int t = threadIdx.x;
  OPAQUE(t);
  int w = t >> 6, lane = t & 63, fr = lane & 15, fq = lane >> 4;
  LAS unsigned char* ldsK = lds;
  LAS unsigned char* ldsV = lds + 8192;
  LAS float* impb = (LAS float*)(lds + 18432) + w * 1024;
  LAS unsigned* unib = (LAS unsigned*)(lds + 18432 + 16384);
  int rloc = w * 16 + fr;
  const int tq = ci * 64 + rloc;
  const size_t tok = (size_t)b * S + tq;
  const float* grow = p.gn + tok * 24 + g * 12;
  float* orow = p.onsa + tok * 512 + g * 256;
  LAS unsigned char* qf = lds + 36864 + w * 8192 + lane * 16;
#pragma unroll
  for (int m = 0; m < 4; ++m)
#pragma unroll
    for (int ks = 0; ks < 2; ++ks)
      *(LAS bf16x8*)(qf + (m * 2 + ks) * 1024) = *(const bf16x8*)(p.qb + tok * 512 + (g * 4 + m) * 64 + ks * 32 + fq * 8);
  f32x4 o[4][4];
  float mrow[4], lrow[4];
  bf16x8 rk[2], rv[2];

  const int nvis = (tq >= 31) ? ((tq - 31) / 16 + 1) : 0;
  const int nvmax = 4 * ci + 3;
  const int ntc = (nvmax + 63) >> 6;
  const unsigned short* kcb = p.cmpb + (size_t)((0 * NB + b) * 2 + g) * 256 * 64;
  const unsigned short* vcb = p.cmpb + (size_t)((1 * NB + b) * 2 + g) * 256 * 64;
#pragma unroll
  for (int m = 0; m < 4; ++m) { mrow[m] = -INFINITY; lrow[m] = 0.f; }
  REDERIVE();
  for (int tc = 0; tc < ntc; ++tc) {
    tile_fetch(rk, kcb + (size_t)tc * 4096, t);
    stage_k(rk, ldsK, t);
    __syncthreads();
    const int hi = nvis - 1 - tc * 64 - 4 * fq;
    cmp_stats<0>(mrow, lrow, qf, ldsK, hi, lane);
    cmp_stats<1>(mrow, lrow, qf, ldsK, hi, lane);
    __syncthreads();
  }
  {
    float linv[4], msf[4];
#pragma unroll
    for (int m = 0; m < 4; ++m) {
      float l = lrow[m];
      l += bpx(l, lane, 16);
      l += bpx(l, lane, 32);
      linv[m] = (l > 0.f) ? 1.0f / l : 0.f;
      msf[m] = 0.f;
    }
    REDERIVE();
#pragma unroll
    for (int m = 0; m < 4; ++m)
#pragma unroll
      for (int dt = 0; dt < 4; ++dt) o[m][dt] = (f32x4){0.f, 0.f, 0.f, 0.f};
    float lastprev = 0.f;
    for (int tc = 0; tc < ntc; ++tc) {
      tile_fetch(rk, kcb + (size_t)tc * 4096, t);
      tile_fetch(rv, vcb + (size_t)tc * 4096, t);
      stage_k(rk, ldsK, t);
      stage_v(rv, ldsV, t);
      __syncthreads();
      const int hi = nvis - 1 - tc * 64 - 4 * fq;
      cmp_apply<0>(o, msf, linv, lastprev, impb + fr * 64 + tc * 16, qf, ldsK, ldsV, hi, lane);
      cmp_apply<1>(o, msf, linv, lastprev, impb + fr * 64 + tc * 16, qf, ldsK, ldsV, hi, lane);
      __syncthreads();
    }
  }
#pragma unroll
  for (int m = 0; m < 4; ++m) {
    const float gate = grow[m * 3 + 0];
#pragma unroll
    for (int dt = 0; dt < 4; ++dt) *(f32x4*)(orow + m * 64 + dt * 16 + 4 * fq) = o[m][dt] * gate;
  }
  unsigned mlo, mhi;
  REDERIVE();
  {
    WSYNC();
    float kv[16];
    const int c0 = -fq * 16, c1 = ci - fq * 16;
#pragma unroll
    for (int i = 0; i < 16; ++i) {
      const bool forced = (c0 == i) || (c1 == i) || (c1 == i + 1);
      float v = (c1 >= i) ? impb[fr * 64 + fq * 16 + i] : -INFINITY;
      if (forced) v = INFINITY;
      kv[i] = v;
    }
    WSYNC();
#pragma unroll
    for (int i = 0; i < 16; ++i) impb[fr * 64 + fq * 16 + i] = kv[i];
    WSYNC();
    int rank[16];
#pragma unroll
    for (int i = 0; i < 16; ++i) rank[i] = 0;
#pragma unroll 2
    for (int k = 0; k < 64; ++k) {
      const float ok = impb[fr * 64 + k];
      const int kq = k - fq * 16;
#pragma unroll
      for (int i = 0; i < 16; ++i) rank[i] += (ok > kv[i] || (ok == kv[i] && kq < i)) ? 1 : 0;
    }
    unsigned piece = 0;
#pragma unroll
    for (int i = 0; i < 16; ++i) piece |= (rank[i] < 16) ? (1u << i) : 0u;
    unsigned lo32 = (fq == 0) ? piece : (fq == 1) ? (piece << 16) : 0u;
    unsigned hi32 = (fq == 2) ? piece : (fq == 3) ? (piece << 16) : 0u;
    lo32 |= bpxu(lo32, lane, 16); lo32 |= bpxu(lo32, lane, 32);
    hi32 |= bpxu(hi32, lane, 16); hi32 |= bpxu(hi32, lane, 32);
    mlo = lo32; mhi = hi32;
    unsigned ulo = lo32, uhi = hi32;
#pragma unroll
    for (int off = 1; off < 16; off <<= 1) { ulo |= bpxu(ulo, lane, off); uhi |= bpxu(uhi, lane, off); }
    if (lane == 0) { unib[w * 2] = ulo; unib[w * 2 + 1] = uhi; }
    __syncthreads();
  }
  unsigned long long un;
  {
    const unsigned ulo = unib[0] | unib[2] | unib[4] | unib[6];
    const unsigned uhi = unib[1] | unib[3] | unib[5] | unib[7];
    un = ((unsigned long long)__builtin_amdgcn_readfirstlane(uhi) << 32) | (unsigned long long)__builtin_amdgcn_readfirstlane(ulo);
  }
  const unsigned long long rowmask = ((unsigned long long)mhi << 32) | mlo;

#pragma unroll 1
  for (int pass = 0; pass < 2; ++pass) {
    REDERIVE();
#pragma unroll
    for (int m = 0; m < 4; ++m) {
      mrow[m] = -INFINITY; lrow[m] = 0.f;
#pragma unroll
      for (int dt = 0; dt < 4; ++dt) o[m][dt] = (f32x4){0.f, 0.f, 0.f, 0.f};
    }
    const unsigned short* kb = p.kvb + (size_t)(((2 + 2 * pass) * NB + b) * 2 + g) * S * 64;
    const unsigned short* vb = p.kvb + (size_t)(((3 + 2 * pass) * NB + b) * 2 + g) * S * 64;
    const unsigned long long upto = (ci == 63) ? ~0ull : ((1ull << (ci + 1)) - 1ull);
    const int jlo = max(0, ci - 8);
    unsigned long long rem = pass ? (upto & ~((1ull << jlo) - 1ull)) : (un & upto);
    const int jwin0 = pass ? ci - 8 : -100;
    int j = __ffsll((long long)rem) - 1;
    tile_fetch(rk, kb + (size_t)j * 4096, t);
    tile_fetch(rv, vb + (size_t)j * 4096, t);
    while (rem) {
      rem &= rem - 1;
      stage_k(rk, ldsK, t);
      stage_v(rv, ldsV, t);
      __syncthreads();
      const int jn = rem ? (__ffsll((long long)rem) - 1) : -1;
      if (jn >= 0) {
        tile_fetch(rk, kb + (size_t)jn * 4096, t);
        tile_fetch(rv, vb + (size_t)jn * 4096, t);
      }
      const bool rowok = pass ? true : (bool)((rowmask >> j) & 1ull);
      int hi = (j == ci) ? rloc : 63;
      const int lo = ((j == jwin0) ? rloc : -1) - 4 * fq;
      hi = (rowok ? hi : -1000) - 4 * fq;
      attn_tile<true>(o, mrow, lrow, qf, ldsK, ldsV, true, lo, hi, lane);
      __syncthreads();
      j = jn;
    }
#pragma unroll
    for (int m = 0; m < 4; ++m) {
      float l = lrow[m];
      l += bpx(l, lane, 16);
      l += bpx(l, lane, 32);
      const float sc = grow[m * 3 + 1 + pass] / l;
#pragma unroll
      for (int dt = 0; dt < 4; ++dt) {
        f32x4* dst = (f32x4*)(orow + m * 64 + dt * 16 + 4 * fq);
        const f32x4 tot = *dst + o[m][dt] * sc;
        if (pass == 0) *dst = tot;
        else *(uint2*)(p.onsab + tok * 512 + g * 256 + m * 64 + dt * 16 + 4 * fq) = pack4(tot);
      }
    }
  }
}

#define XB_TMO      128
#define XB_XCNT(j)  (256  + 64 * (j))
#define XB_XSUB(j)  (1280 + 64 * (j))
#define XB_XGEN(j)  (2304 + 64 * (j))
#define XB_TOP      3328
#define XB_TOPGEN   3392
#define XCD_BAR_WORDS 3456
#define XB_SPIN_CAP (1u << 18)

__device__ __forceinline__ unsigned xb_ld(unsigned* p)              { return __hip_atomic_load(p, __ATOMIC_RELAXED, __HIP_MEMORY_SCOPE_AGENT); }
__device__ __forceinline__ unsigned xb_add(unsigned* p, unsigned v) { return __hip_atomic_fetch_add(p, v, __ATOMIC_RELAXED, __HIP_MEMORY_SCOPE_AGENT); }
__device__ __forceinline__ unsigned xb_xcc_id() { return (unsigned)__builtin_amdgcn_s_getreg((3 << 11) | 20) & 0xFu; }
#define XB_SPIN(cond, bar) do { unsigned _sp = 0; while (cond) { __builtin_amdgcn_s_sleep(1); \
    if ((++_sp & 255u) == 0u) { if (xb_ld(&(bar)[XB_TMO])) break; if (_sp > XB_SPIN_CAP) { atomicAdd(&(bar)[XB_TMO], 1u); break; } } } } while (0)

struct XcdBarrier {
    unsigned* bar; unsigned x;
    volatile LAS unsigned* st;
};

__device__ __forceinline__ XcdBarrier xcd_barrier_post(unsigned* bar, volatile LAS unsigned* st) {
    XcdBarrier b; b.bar = bar; b.x = xb_xcc_id(); b.st = st;
    if (threadIdx.x == 0) (void)xb_add(&bar[XB_XCNT(b.x)], 1u);
    return b;
}
__device__ __forceinline__ void xcd_barrier_complete(unsigned* bar, unsigned x, unsigned& nloc, unsigned& nx) {
    const unsigned G = gridDim.x * gridDim.y * gridDim.z;
    unsigned sum, cnt, mine, sp = 0u;
    for (;;) {
        sum = 0u; cnt = 0u; mine = 0u;
#pragma unroll
        for (unsigned j = 0; j < 16; ++j) { const unsigned c = xb_ld(&bar[XB_XCNT(j)]); sum += c; cnt += (c > 0u) ? 1u : 0u; mine = (j == x) ? c : mine; }
        if (sum == G) break;
        __builtin_amdgcn_s_sleep(1);
        if ((++sp & 255u) == 0u) { if (xb_ld(&bar[XB_TMO])) break; if (sp > XB_SPIN_CAP) { atomicAdd(&bar[XB_TMO], 1u); break; } }
    }
    nloc = mine > 0u ? mine : 1u; nx = cnt > 0u ? cnt : 1u;
}

__device__ __forceinline__ void xcd_barrier(const XcdBarrier& b) {
    asm volatile("s_waitcnt vmcnt(0)" ::: "memory");
    __syncthreads();
    if (threadIdx.x == 0) {
        unsigned* bar = b.bar;
        __builtin_amdgcn_s_waitcnt(0);
        unsigned nloc = b.st[0], nx = b.st[1];
        if (nloc == 0u) { xcd_barrier_complete(bar, b.x, nloc, nx); b.st[0] = nloc; b.st[1] = nx; }
        const unsigned old = xb_add(&bar[XB_XSUB(b.x)], 1u);
        const unsigned gen = old / nloc;
        if (old + 1u == (gen + 1u) * nloc) {
            __builtin_amdgcn_fence(__ATOMIC_RELEASE, "agent");
            asm volatile("s_waitcnt vmcnt(0)" ::: "memory");
            const unsigned og = xb_add(&bar[XB_TOP], 1u);
            const unsigned tg = og / nx;
            if (og + 1u == (tg + 1u) * nx) xb_add(&bar[XB_TOPGEN], 1u);
            else XB_SPIN(xb_ld(&bar[XB_TOPGEN]) == tg, bar);
            __builtin_amdgcn_fence(__ATOMIC_ACQUIRE, "agent");
            xb_add(&bar[XB_XGEN(b.x)], 1u);
            asm volatile("s_waitcnt vmcnt(0)" ::: "memory");
        } else {
            XB_SPIN(xb_ld(&bar[XB_XGEN(b.x)]) == gen, bar);
            __builtin_amdgcn_fence(__ATOMIC_ACQUIRE, "agent");
            asm volatile("s_waitcnt vmcnt(0)" ::: "memory");
        }
    }
    __syncthreads();
}


#define PHASE_IDX int t_ = threadIdx.x; OPAQUE(t_); const int tid = t_, lane = t_ & 63, wib = t_ >> 6; \
  const int gthreads = gridDim.x * 256, gtid = blockIdx.x * 256 + t_, gwaves = gridDim.x * 4, gwave = blockIdx.x * 4 + wib; \
  (void)tid; (void)lane; (void)wib; (void)gthreads; (void)gtid; (void)gwaves; (void)gwave;

constexpr int SMEM_BYTES = GEMM_RING * GEMM_STAGE;

__device__ __forceinline__ void conv_job(const float* W, int K, int N, bf16_t* Wt, int tile, LAS unsigned char* lds) {
  const int tnn = (N + 127) >> 7;
  convert_tile(W, N, N, Wt, K, (tile / tnn) * 64, (tile % tnn) * 128, lds);
}

__global__ void __launch_bounds__(256, 2) mega(Params p) {
  __shared__ __attribute__((aligned(16))) unsigned char smem_raw[SMEM_BYTES + 16];
  float* smem = (float*)smem_raw;
  LAS unsigned char* lds = (LAS unsigned char*)smem_raw;
  volatile LAS unsigned* xb_st = (volatile LAS unsigned*)(lds + SMEM_BYTES);
  if (threadIdx.x < 4) xb_st[threadIdx.x] = 0u;
  __syncthreads();
  const XcdBarrier gbar = xcd_barrier_post(p.bar, xb_st);

  {
  PHASE_IDX
  constexpr int MODB = 192;
  if (blockIdx.x < MODB) {
    for (int i = tid; i < NB * D; i += 256) smem[i] = siluf_(p.c[i]);
    __syncthreads();
    const int j = blockIdx.x * 32 + (lane & 31), kh = lane >> 5;
    float a0 = 0.f, a1 = 0.f, a2 = 0.f, a3 = 0.f;
    const float* wp = p.w_ada + (size_t)(wib * 256 + kh) * (6 * D) + j;
#pragma unroll 32
    for (int i = 0; i < 128; ++i) {
      const float w = wp[(size_t)(2 * i) * (6 * D)];
      const int kk = wib * 256 + 2 * i + kh;
      a0 = fmaf(smem[kk], w, a0); a1 = fmaf(smem[D + kk], w, a1);
      a2 = fmaf(smem[2 * D + kk], w, a2); a3 = fmaf(smem[3 * D + kk], w, a3);
    }
    a0 += bpx(a0, lane, 32); a1 += bpx(a1, lane, 32); a2 += bpx(a2, lane, 32); a3 += bpx(a3, lane, 32);
    __syncthreads();
    if (lane < 32) {
      smem[(wib * 4 + 0) * 32 + lane] = a0; smem[(wib * 4 + 1) * 32 + lane] = a1;
      smem[(wib * 4 + 2) * 32 + lane] = a2; smem[(wib * 4 + 3) * 32 + lane] = a3;
    }
    __syncthreads();
    if (lane < 32) {
      const int b = wib;
      const float v = p.b_ada[j] + ((smem[(0 * 4 + b) * 32 + lane] + smem[(1 * 4 + b) * 32 + lane]) +
                                    (smem[(2 * 4 + b) * 32 + lane] + smem[(3 * 4 + b) * 32 + lane]));
      p.mod[b * 6 * D + j] = v;
    }
    __syncthreads();
  }
  const int sb0 = (gridDim.x >= MODB + 144) ? MODB : 0;
  for (int idx = gtid - sb0 * 256; idx >= 0 && idx < 32 * 64; idx += gthreads) {
    const int g = idx / 64;
    const double dt = exp((double)p.log_dt[g]);
    const double lr = p.a_re[idx], li = p.a_im[idx];
    const double mag1 = exp(lr * dt);
    const double br = mag1 * cos(li * dt), bi = mag1 * sin(li * dt);
    {
      double pr_ = 1.0, pi_ = 0.0;
#pragma unroll 1
      for (int d = 0; d <= 16; ++d) {
        p.pw[(idx * 17 + d) * 2] = (float)pr_;
        p.pw[(idx * 17 + d) * 2 + 1] = (float)pi_;
        const double nr_ = pr_ * br - pi_ * bi, ni_ = pr_ * bi + pi_ * br;
        pr_ = nr_; pi_ = ni_;
      }
    }
    const double nr = br - 1.0, ni = bi;
    const double den = lr * lr + li * li;
    const double cr = (nr * lr + ni * li) / den, ci = (ni * lr - nr * li) / den;
    for (int q = 0; q < 16; ++q) {
      const double wr = p.b_re[idx * 16 + q], wi = p.b_im[idx * 16 + q];
      p.bbar[(idx * 16 + q) * 2] = (float)(cr * wr - ci * wi);
      p.bbar[(idx * 16 + q) * 2 + 1] = (float)(cr * wi + ci * wr);
    }
  }
  for (int idx = gtid; idx < NE; idx += gthreads) { p.cnt[idx] = 0; p.cursor[idx] = 0; }
  for (int o = gwave - (sb0 ? (sb0 + 8) * 4 : 0); o >= 0 && o < 512; o += gwaves) {
    const int kv = o >> 8, j = o & 255;
    const float* pe = kv ? p.pe_v : p.pe_k;
    const float* w1 = kv ? p.w_cmp_v1 : p.w_cmp_k1;
    float acc = 0.f;
    for (int k = lane; k < 2048; k += 64) acc = fmaf(pe[k], w1[(size_t)k * 256 + j], acc);
    acc = wsum(acc, lane);
    if (lane == 0) p.cbias[o] = acc;
  }
  {
    const int G = gridDim.x;
    const int first = (G > MODB) ? MODB : 0, nb = G - first;
    if ((int)blockIdx.x >= first) {
      for (int job = blockIdx.x - first; job < 1040; job += nb) {
        if (job < 496) conv_job(p.w_in, D, INC, p.w_inT, job, lds);
        else if (job < 560) conv_job(p.w_cmp_k1, 2048, 256, p.wc1T, job - 496, lds);
        else if (job < 624) conv_job(p.w_cmp_v1, 2048, 256, p.wc1T + 256 * 2048, job - 560, lds);
        else if (job < 656) conv_job(p.w_glu, 512, 512, p.wgluT, job - 624, lds);
        else if (job < 720) conv_job(p.w_up_attn, 512, D, p.wuaT, job - 656, lds);
        else if (job < 784) conv_job(p.w_up_ssm, 512, D, p.wusT, job - 720, lds);
        else if (job < 912) conv_job(p.w_out, D, D, p.woutT, job - 784, lds);
        else if (job < 944) conv_job(p.w_router, D, NE, p.wrT, job - 912, lds);
        else if (job < 976) conv_job(p.ws_gate, D, DE, p.wsgT, job - 944, lds);
        else if (job < 1008) conv_job(p.ws_up, D, DE, p.wsuT, job - 976, lds);
        else conv_job(p.ws_down, DE, D, p.wsdT, job - 1008, lds);
      }
    }
  }
  }
  xcd_barrier(gbar);

  {
  PHASE_IDX
  for (int row = gwave; row < NT; row += gwaves) {
    const int b = row / S;
    const float* xr = p.x + (size_t)row * D;
    f32x4 v[4];
    float ss = 0.f;
#pragma unroll
    for (int i = 0; i < 4; ++i) {
      v[i] = *(const f32x4*)(xr + i * 256 + lane * 4);
      ss += (v[i][0] * v[i][0] + v[i][1] * v[i][1]) + (v[i][2] * v[i][2] + v[i][3] * v[i][3]);
    }
    ss = wsum(ss, lane);
    const float r = rsqrtf(ss * (1.0f / D) + EPS);
    const float* md = p.mod + b * 6 * D;
#pragma unroll
    for (int i = 0; i < 4; ++i) {
      const int col = i * 256 + lane * 4;
      const f32x4 gg = *(const f32x4*)(p.g_norm1 + col), sc = *(const f32x4*)(md + D + col), sh = *(const f32x4*)(md + col);
      *(uint2*)(p.h + (size_t)row * D + col) = pack4(v[i] * r * gg * (sc + 1.0f) + sh);
    }
  }
  for (int idx = gtid; idx < 32 * 128 * 256; idx += gthreads) {
    const int k = idx & 255, col = (idx >> 8) & 127, g = idx >> 15;
    const int n = col >> 1, ri = col & 1, sidx = k >> 4, q = k & 15;
    const int gn = g * 64 + n;
    const float pr_ = p.pw[(gn * 17 + 15 - sidx) * 2], pi_ = p.pw[(gn * 17 + 15 - sidx) * 2 + 1];
    const float br = p.bbar[(gn * 16 + q) * 2], bi = p.bbar[(gn * 16 + q) * 2 + 1];
    const float v = ri ? (pr_ * bi + pi_ * br) : (pr_ * br - pi_ * bi);
    p.w1T[idx] = (bf16_t)(cvt_pk_bf16(v, 0.f) & 0xffffu);
  }
  for (int idx = gtid; idx < 32 * 16 * 256; idx += gthreads) {
    const int q = idx & 15, pp = (idx >> 4) & 15, d = (idx >> 8) & 15, g = idx >> 12;
    float acc = (d == 0 && pp == q) ? p.d_skip[g * 16 + pp] : 0.f;
    for (int n = 0; n < 64; ++n) {
      const int gn = g * 64 + n;
      const float cr = p.c_re[(g * 16 + pp) * 64 + n], ci = p.c_im[(g * 16 + pp) * 64 + n];
      const float pr_ = p.pw[(gn * 17 + d) * 2], pi_ = p.pw[(gn * 17 + d) * 2 + 1];
      const float br = p.bbar[(gn * 16 + q) * 2], bi = p.bbar[(gn * 16 + q) * 2 + 1];
      const float tr = cr * pr_ - ci * pi_, ti = cr * pi_ + ci * pr_;
      acc += tr * br - ti * bi;
    }
    p.kd[idx] = acc;
  }
  for (int idx = gtid; idx < 32 * 256 * 128; idx += gthreads) {
    const int k = idx & 127, col = (idx >> 7) & 255, g = idx >> 15;
    const int i = col >> 4, pp = col & 15, n = k >> 1, ri = k & 1;
    const int gn = g * 64 + n;
    const float cr = p.c_re[(g * 16 + pp) * 64 + n], ci = p.c_im[(g * 16 + pp) * 64 + n];
    const float pr_ = p.pw[(gn * 17 + i + 1) * 2], pi_ = p.pw[(gn * 17 + i + 1) * 2 + 1];
    const float v = ri ? -(cr * pi_ + ci * pr_) : (cr * pr_ - ci * pi_);
    p.wyT[((size_t)g * 256 + col) * 384 + k] = (bf16_t)(cvt_pk_bf16(v, 0.f) & 0xffffu);
  }
  }
  xcd_barrier(gbar);

  {
  PHASE_IDX
  {
    constexpr int TN = (INC + TNW - 1) / TNW;
    int mt_, nt_;
    for (int it = 0; xcd_tile(it, NT / TM, TN, mt_, nt_); ++it) {
      const int m0 = mt_ * TM, n0 = nt_ * TNW;
      gemm128<true>(
          D, [&](int r) { return p.h + (size_t)(m0 + r) * D; },
          [&](int c) { return p.w_inT + (size_t)min(n0 + c, INC - 1) * D; },
          [&](const f32x4 (&acc)[4][8], int wr, int wc, int fr, int fq) {
#pragma unroll
            for (int sg = 0; sg < 2; ++sg) {
              const int cw = n0 + wc * 128 + sg * 64;
              if (cw < C_GN) {
                const bool isq = cw < C_KC;
                const int slot = isq ? 0 : (cw - C_KC) >> 7, gg = isq ? 0 : ((cw - C_KC) >> 6) & 1;
                const bool norm = isq || slot == 2 || slot == 4;
                const float* gain = isq ? p.q_gain : (slot == 2 ? p.ks_gain : p.kw_gain);
                const float post = isq ? ATT_SCALE * 1.4426950408889634f : 1.0f;
#pragma unroll
                for (int m = 0; m < 4; ++m) {
                  const int tok = m0 + wr * 64 + m * 16 + fr;
                  float r = 1.0f;
                  if (norm) {
                    float ss = 0.f;
#pragma unroll
                    for (int n = 0; n < 4; ++n)
#pragma unroll
                      for (int jj = 0; jj < 4; ++jj) ss = fmaf(acc[m][sg * 4 + n][jj], acc[m][sg * 4 + n][jj], ss);
                    ss += bpx(ss, fq * 16 + fr, 16);
                    ss += bpx(ss, fq * 16 + fr, 32);
                    r = rsqrtf(ss * (1.0f / 64) + EPS) * post;
                  }
                  bf16_t* dst = isq ? p.qb + (size_t)tok * 512 + cw
                                    : p.kvb + ((size_t)((slot * NB + (tok >> 12)) * 2 + gg) * S + (tok & (S - 1))) * 64;
#pragma unroll
                  for (int n = 0; n < 4; ++n) {
                    f32x4 v = acc[m][sg * 4 + n] * r;
                    if (norm) v = v * *(const f32x4*)(gain + n * 16 + 4 * fq);
                    *(uint2*)(dst + n * 16 + 4 * fq) = pack4(v);
                  }
                }
              } else {
#pragma unroll
                for (int m = 0; m < 4; ++m) {
                  const size_t tok = m0 + wr * 64 + m * 16 + fr;
#pragma unroll
                  for (int n = 0; n < 4; ++n) {
                    const int c = cw + n * 16 + 4 * fq;
                    if (c < INC) {
                      f32x4 v = acc[m][sg * 4 + n];
                      if (c >= C_U && c < C_GA) {
                        const int ch = c - C_U;
                        *(uint2*)(p.a3 + ((size_t)(ch >> 4) * 1024 + (tok >> 4)) * 384 + 128 + (tok & 15) * 16 + (ch & 15)) = pack4(v);
                      } else {
#pragma unroll
                        for (int j = 0; j < 4; ++j) v[j] = sigmoidf_(v[j]);
                        if (c < C_U) *(f32x4*)(p.gn + tok * 24 + (c - C_GN)) = v;
                        else if (c < C_GS) *(uint2*)(p.ga + tok * D + (c - C_GA)) = pack4(v);
                        else *(uint2*)(p.gs + tok * D + (c - C_GS)) = pack4(v);
                      }
                    }
                  }
                }
              }
            }
          },
          lds);
    }
  }
  for (int idx = gtid; idx < 32 * 256 * 256; idx += gthreads) {
    const int k = idx & 255, col = (idx >> 8) & 255, g = idx >> 16;
    const int i = col >> 4, pp = col & 15, sidx = k >> 4, q = k & 15;
    const float v = (i >= sidx) ? p.kd[((g * 16 + (i - sidx)) * 16 + pp) * 16 + q] : 0.f;
    p.wyT[((size_t)g * 256 + col) * 384 + 128 + k] = (bf16_t)(cvt_pk_bf16(v, 0.f) & 0xffffu);
  }
  }
  xcd_barrier(gbar);

  {
  PHASE_IDX
  for (int job = blockIdx.x; job < 2 * 8 * 16; job += gridDim.x) {
    const int kv = job >> 7, ks = (job >> 4) & 7, m0 = (job & 15) * 128;
    float* hp = p.hidp + (size_t)(ks * 2 + kv) * 2040 * 256;
    gemm128<true>(
        256,
        [&](int r) {
          const int rr = min(m0 + r, NB * NCMP * 2 - 1);
          const int b = rr / (NCMP * 2), n = (rr >> 1) % NCMP, g = rr & 1;
          return p.kvb + ((size_t)((kv * NB + b) * 2 + g) * S + 16 * n) * 64 + ks * 256;
        },
        [&](int c) { return p.wc1T + (size_t)(kv * 256 + c) * 2048 + ks * 256; },
        [&](const f32x4 (&acc)[4][8], int wr, int wc, int fr, int fq) {
#pragma unroll
          for (int m = 0; m < 4; ++m) {
            const int r = m0 + wr * 64 + m * 16 + fr;
            if (r < NB * NCMP * 2) {
#pragma unroll
              for (int n = 0; n < 8; ++n) *(f32x4*)(hp + (size_t)r * 256 + wc * 128 + n * 16 + 4 * fq) = acc[m][n];
            }
          }
        },
        lds);
  }
  int mt_, g;
  for (int it = 0; xcd_tile(it, 8, 32, mt_, g); ++it) {
    const int m0 = mt_ * 128;
    gemm128<true>(
        256, [&](int r) { return p.a3 + ((size_t)g * 1024 + m0 + r) * 384 + 128; },
        [&](int c) { return p.w1T + ((size_t)g * 128 + (c & 127)) * 256; },
        [&](const f32x4 (&acc)[4][8], int wr, int wc, int fr, int fq) {
          if (wc == 0) {
#pragma unroll
            for (int m = 0; m < 4; ++m)
#pragma unroll
              for (int n = 0; n < 8; ++n)
                *(f32x4*)(p.lbuf + ((size_t)g * 1024 + m0 + wr * 64 + m * 16 + fr) * 128 + n * 16 + 4 * fq) = acc[m][n];
          }
        },
        lds);
  }
  }
  xcd_barrier(gbar);

  {
  PHASE_IDX
  for (int wv = gwave; wv < 2 * NB * NCMP * 2; wv += gwaves) {
    const int kv = wv / (NB * NCMP * 2), r = wv % (NB * NCMP * 2);
    const int b = r / (NCMP * 2), n = (r >> 1) % NCMP, g = r & 1;
    const float* w2 = kv ? p.w_cmp_v2 : p.w_cmp_k2;
    {
      f32x4 hsum = *(const f32x4*)(p.cbias + kv * 256 + lane * 4);
#pragma unroll
      for (int ks = 0; ks < 8; ++ks) hsum = hsum + *(const f32x4*)(p.hidp + ((size_t)(ks * 2 + kv) * 2040 + r) * 256 + lane * 4);
#pragma unroll
      for (int j = 0; j < 4; ++j) hsum[j] = geluf_(hsum[j]);
      WSYNC();
      *(f32x4*)(smem + wib * 256 + lane * 4) = hsum;
      WSYNC();
    }
    const float* hid = smem + wib * 256;
    float acc = 0.f;
    for (int j = 0; j < 256; ++j) acc = fmaf(hid[j], w2[j * 64 + lane], acc);
    if (kv == 0) {
      const float ss = wsum(acc * acc, lane);
      acc = acc * rsqrtf(ss * (1.0f / 64) + EPS) * p.kc_gain[lane];
    }
    const float other = bpx(acc, lane, 1);
    if ((lane & 1) == 0)
      *(unsigned*)(p.cmpb + ((size_t)((kv * NB + b) * 2 + g) * 256 + n) * 64 + lane) = cvt_pk_bf16(acc, other);
  }
  for (int idx = gtid; idx < 2 * NB * 2 * 32; idx += gthreads)
    *(unsigned*)(p.cmpb + ((size_t)(idx >> 5) * 256 + 255) * 64 + (idx & 31) * 2) = 0u;
  for (int idx = gtid; idx < 32 * NB * 64; idx += gthreads) {
    const int n = idx & 63, b = (idx >> 6) & 3, g = idx >> 8;
    const int gn = g * 64 + n;
    const float lr = p.pw[(gn * 17 + 16) * 2], li = p.pw[(gn * 17 + 16) * 2 + 1];
    float hr_ = 0.f, hi_ = 0.f;
    const size_t row0 = (size_t)g * 1024 + b * 256;
#pragma unroll 1
    for (int c0 = 0; c0 < 256; c0 += 16) {
      float2 l2[16];
#pragma unroll
      for (int i = 0; i < 16; ++i) l2[i] = *(const float2*)(p.lbuf + (row0 + c0 + i) * 128 + n * 2);
#pragma unroll
      for (int i = 0; i < 16; ++i) {
        *(unsigned*)(p.a3 + (row0 + c0 + i) * 384 + n * 2) = cvt_pk_bf16(hr_, hi_);
        const float nr = lr * hr_ - li * hi_ + l2[i].x;
        const float ni = lr * hi_ + li * hr_ + l2[i].y;
        hr_ = nr; hi_ = ni;
      }
    }
  }
  }
  xcd_barrier(gbar);

  {
  PHASE_IDX
  const int G = gridDim.x;
  const bool split = G >= 512;
  if (!split || blockIdx.x < 256) {
    for (int u = blockIdx.x; u < 256; u += (split ? 256 : G)) {
      const int bg = u >> 5, pr = u & 31;
      __builtin_amdgcn_s_setprio(2);
#pragma unroll 1
      for (int half = 0; half < 2; ++half) attn_chunk(p, lds, bg >> 1, bg & 1, half ? pr : 63 - pr);
      __builtin_amdgcn_s_setprio(0);
    }
  }
  if (!split || blockIdx.x >= 256) {
    const int x8 = blockIdx.x & 7, nsl = split ? ((G - 256) >> 3) : 0, sl = split ? (((int)blockIdx.x - 256) >> 3) : 0;
    for (int it = 0;; ++it) {
      int tile;
      if (split && ((G & 7) == 0)) { const int q = sl + it * nsl; if (q >= 32) break; tile = ((x8 + 8 * (q >> 3)) << 3) | (q & 7); }
      else { tile = (split ? (int)blockIdx.x - 256 : (int)blockIdx.x) + it * (split ? G - 256 : G); if (tile >= 256) break; }
      const int g = tile >> 3, m0 = (tile & 7) * 128, n0 = 0;
      gemm128(
          384, [&](int r) { return p.a3 + ((size_t)g * 1024 + m0 + r) * 384; },
          [&](int c) { return p.wyT + ((size_t)g * 256 + n0 + c) * 384; },
          [&](const f32x4 (&acc)[4][8], int wr, int wc, int fr, int fq) {
#pragma unroll
            for (int m = 0; m < 4; ++m)
#pragma unroll
              for (int n = 0; n < 8; ++n) {
                const int col = n0 + wc * 128 + n * 16 + 4 * fq;
                const size_t tok = (size_t)(m0 + wr * 64 + m * 16 + fr) * 16 + (col >> 4);
                f32x4 v = acc[m][n];
#pragma unroll
                for (int j = 0; j < 4; ++j) v[j] = geluf_(v[j]);
                *(uint2*)(p.z + tok * 512 + g * 16 + (col & 15)) = pack4(v);
              }
          },
          lds);
    }
    const int cb = split ? (int)blockIdx.x - 256 : (int)blockIdx.x, cn = split ? G - 256 : G;
    for (int job = cb; job < NE * 96; job += cn) {
      const int e = job / 96, rem = job - e * 96, which = rem >> 5, tile = rem & 31;
      if (which == 0) conv_job(p.w_gate + (size_t)e * D * DE, D, DE, p.wgT + (size_t)e * DE * D, tile, lds);
      else if (which == 1) conv_job(p.w_up + (size_t)e * D * DE, D, DE, p.wuT + (size_t)e * DE * D, tile, lds);
      else conv_job(p.w_down + (size_t)e * DE * D, DE, D, p.wdT + (size_t)e * D * DE, tile, lds);
    }
  }
  }
  xcd_barrier(gbar);

  {
  PHASE_IDX
  gemm_phase(
      NT, 512, 512, [&](int m) { return p.z + (size_t)m * 512; }, [&](int n) { return p.wgluT + (size_t)n * 512; },
      [&](int m, int n, f32x4 v) {
        const f32x4 zz = unpack4(*(const uint2*)(p.z + (size_t)m * 512 + n));
#pragma unroll
        for (int j = 0; j < 4; ++j) v[j] = zz[j] * sigmoidf_(v[j] + p.b_glu[n + j]);
        *(uint2*)(p.yssm + (size_t)m * 512 + n) = pack4(v);
      },
      lds);
  gemm_phase(
      NT, D, 512, [&](int m) { return p.onsab + (size_t)m * 512; }, [&](int n) { return p.wuaT + (size_t)n * 512; },
      [&](int m, int n, f32x4 v) {
        const f32x4 gg = unpack4(*(const uint2*)(p.ga + (size_t)m * D + n));
        *(f32x4*)(p.mtmp + (size_t)m * D + n) = gg * v;
      },
      lds);
  }
  xcd_barrier(gbar);
  {
  PHASE_IDX
  gemm_phase(
      NT, D, 512, [&](int m) { return p.yssm + (size_t)m * 512; }, [&](int n) { return p.wusT + (size_t)n * 512; },
      [&](int m, int n, f32x4 v) {
        const f32x4 gg = unpack4(*(const uint2*)(p.gs + (size_t)m * D + n));
        const f32x4 prev = *(const f32x4*)(p.mtmp + (size_t)m * D + n);
        *(uint2*)(p.merged + (size_t)m * D + n) = pack4(prev + gg * v);
      },
      lds);
  }
  xcd_barrier(gbar);
  {
  PHASE_IDX
  gemm_phase(
      NT, D, D, [&](int m) { return p.merged + (size_t)m * D; }, [&](int n) { return p.woutT + (size_t)n * D; },
      [&](int m, int n, f32x4 v) {
        const int b = m / S;
        const f32x4 xx = *(const f32x4*)(p.x + (size_t)m * D + n);
        const f32x4 gt = *(const f32x4*)(p.mod + b * 6 * D + 2 * D + n);
        *(f32x4*)(p.xmid + (size_t)m * D + n) = xx + gt * v;
      },
      lds);
  }
  xcd_barrier(gbar);

  {
  PHASE_IDX
  for (int row = gwave; row < NT; row += gwaves) {
    const int b = row / S;
    const float* xr = p.xmid + (size_t)row * D;
    f32x4 v[4];
    float ss = 0.f;
#pragma unroll
    for (int i = 0; i < 4; ++i) {
      v[i] = *(const f32x4*)(xr + i * 256 + lane * 4);
      ss += (v[i][0] * v[i][0] + v[i][1] * v[i][1]) + (v[i][2] * v[i][2] + v[i][3] * v[i][3]);
    }
    ss = wsum(ss, lane);
    const float r = rsqrtf(ss * (1.0f / D) + EPS);
    const float* md = p.mod + b * 6 * D;
#pragma unroll
    for (int i = 0; i < 4; ++i) {
      const int col = i * 256 + lane * 4;
      const f32x4 gg = *(const f32x4*)(p.g_norm2 + col), sc = *(const f32x4*)(md + 4 * D + col), sh = *(const f32x4*)(md + 3 * D + col);
      *(uint2*)(p.h + (size_t)row * D + col) = pack4(v[i] * r * gg * (sc + 1.0f) + sh);
    }
  }
  }
  xcd_barrier(gbar);

  {
  PHASE_IDX
  int mt_, nt_;
  for (int it = 0; xcd_tile(it, NT / TM, 3, mt_, nt_); ++it) {
    const int m0 = mt_ * TM;
    if (nt_ == 0) {
      gemm128<true>(
          D, [&](int r) { return p.h + (size_t)(m0 + r) * D; }, [&](int c) { return p.wrT + (size_t)c * D; },
          [&](const f32x4 (&acc)[4][8], int wr, int wc, int fr, int fq) {
#pragma unroll
            for (int m = 0; m < 4; ++m)
#pragma unroll
              for (int n = 0; n < 8; ++n) {
                f32x4 v = acc[m][n];
#pragma unroll
                for (int j = 0; j < 4; ++j) v[j] = sigmoid_acc(v[j]);
                *(f32x4*)(p.scores + (size_t)(m0 + wr * 64 + m * 16 + fr) * NE + wc * 128 + n * 16 + 4 * fq) = v;
              }
          },
          lds);
    } else {
      const int ct = nt_ - 1;
      gemm128<true>(
          D, [&](int r) { return p.h + (size_t)(m0 + r) * D; },
          [&](int c) {
            const int hid = ct * 128 + (c >> 7) * 64 + ((c >> 4) & 3) * 16 + (c & 15);
            return (((c >> 6) & 1) ? p.wsuT : p.wsgT) + (size_t)hid * D;
          },
          [&](const f32x4 (&acc)[4][8], int wr, int wc, int fr, int fq) {
#pragma unroll
            for (int m = 0; m < 4; ++m)
#pragma unroll
              for (int n = 0; n < 4; ++n) {
                f32x4 v;
#pragma unroll
                for (int j = 0; j < 4; ++j) v[j] = siluf_(acc[m][n][j]) * acc[m][n + 4][j];
                *(uint2*)(p.hs + (size_t)(m0 + wr * 64 + m * 16 + fr) * DE + ct * 128 + wc * 64 + n * 16 + 4 * fq) = pack4(v);
              }
          },
          lds);
    }
  }
  }
  xcd_barrier(gbar);

  {
  PHASE_IDX
  for (int tok = gwave; tok < NT; tok += gwaves) {
    const float4 sc4 = *reinterpret_cast<const float4*>(p.scores + (size_t)tok * NE + lane * 4);
    const float4 bi4 = *reinterpret_cast<const float4*>(p.router_bias + lane * 4);
    const float sc[4] = {sc4.x, sc4.y, sc4.z, sc4.w};
    float bz[4] = {sc4.x + bi4.x, sc4.y + bi4.y, sc4.z + bi4.z, sc4.w + bi4.w};
    float m1 = -INFINITY, m2 = -INFINITY;
#pragma unroll
    for (int i = 0; i < 4; ++i) {
      const float v = bz[i];
      if (v > m1) { m2 = m1; m1 = v; } else if (v > m2) { m2 = v; }
    }
#pragma unroll
    for (int o = 1; o < 8; o <<= 1) {
      const float o1 = bpx(m1, lane, o), o2 = bpx(m2, lane, o);
      const float n1 = fmaxf(m1, o1);
      const float n2 = fmaxf(fminf(m1, o1), fmaxf(m2, o2));
      m1 = n1; m2 = n2;
    }
    const float gs = m1 + m2;
    const int mygrp = lane >> 3;
    int grank = 0;
#pragma unroll
    for (int g2 = 0; g2 < 8; ++g2) {
      const float og = bpl(gs, g2 * 8);
      grank += (og > gs || (og == gs && g2 < mygrp)) ? 1 : 0;
    }
    const bool gsel = grank < 4;
#pragma unroll
    for (int i = 0; i < 4; ++i) if (!gsel) bz[i] = -INFINITY;
    unsigned taken = 0;
    float wsel = 0.f;
    int esel = 0;
    float wtot = 0.f;
#pragma unroll 1
    for (int k = 0; k < TOPK; ++k) {
      float bv = -INFINITY; int bidx = 1 << 30;
#pragma unroll
      for (int i = 0; i < 4; ++i) {
        if (!((taken >> i) & 1u) && bz[i] > bv) { bv = bz[i]; bidx = lane * 4 + i; }
      }
#pragma unroll
      for (int o = 32; o > 0; o >>= 1) {
        const float ov = bpx(bv, lane, o);
        const int oi = bpxi(bidx, lane, o);
        if (ov > bv || (ov == bv && oi < bidx)) { bv = ov; bidx = oi; }
      }
      const int owner = bidx >> 2, slot = bidx & 3;
      float sv = 0.f;
      if (lane == owner) {
        taken |= 1u << slot;
        sv = (slot == 0) ? sc[0] : (slot == 1) ? sc[1] : (slot == 2) ? sc[2] : sc[3];
      }
      sv = bpl(sv, owner);
      wtot += sv;
      if (lane == k) { wsel = sv; esel = bidx; }
    }
    if (lane < TOPK) {
      p.eidx[tok * TOPK + lane] = esel;
      p.ew[tok * TOPK + lane] = wsel / wtot * 2.5f;
      atomicAdd(&p.cnt[esel], 1);
    }
  }
  gemm_phase(
      NT, D, DE, [&](int m) { return p.hs + (size_t)m * DE; }, [&](int n) { return p.wsdT + (size_t)n * DE; },
      [&](int m, int n, f32x4 v) {
        const int b = m / S;
        const f32x4 xx = *(const f32x4*)(p.xmid + (size_t)m * D + n);
        const f32x4 gt = *(const f32x4*)(p.mod + b * 6 * D + 5 * D + n);
        *(f32x4*)(p.out + (size_t)m * D + n) = xx + gt * v;
      },
      lds);
  }
  xcd_barrier(gbar);

  {
  PHASE_IDX
  {
    int* soff = (int*)smem;
    int* srt = soff + 320;
    const int myc = p.cnt[tid];
    soff[tid] = myc;
    srt[tid] = (myc + 127) >> 7;
    __syncthreads();
    for (int st = 1; st < 256; st <<= 1) {
      const int a0 = (tid >= st) ? soff[tid - st] : 0;
      __syncthreads();
      soff[tid] += a0;
      __syncthreads();
    }
    const int exo = soff[tid] - myc;
    __syncthreads();
    soff[tid] = exo;
    if (blockIdx.x == 0) {
      p.off[tid] = exo;
      if (tid == 255) p.off[NE] = exo + myc;
    }
    __syncthreads();
    if (blockIdx.x == 0 && tid < 8) {
      int acc = 0;
      for (int i = 0; i < 32; ++i) { p.xrts[tid * 33 + i] = acc; acc += srt[tid + 8 * i]; }
      p.xrts[tid * 33 + 32] = acc;
    }
    for (int idx = gtid; idx < NASSIGN; idx += gthreads) {
      const int e = p.eidx[idx];
      const int pos = soff[e] + atomicAdd(&p.cursor[e], 1);
      p.stok[pos] = idx / TOPK;
      p.sw[pos] = p.ew[idx];
      p.apos[idx] = pos;
    }
    __syncthreads();
  }
  }
  xcd_barrier(gbar);

  {
  PHASE_IDX
  {
    const int x8 = blockIdx.x & 7, ns8 = ((int)gridDim.x - x8 + 7) >> 3;
    const int* xr = p.xrts + x8 * 33;
    const int total_rt = xr[32];
    for (int tile = blockIdx.x >> 3; tile < total_rt * 2; tile += ns8) {
      const int rt = tile >> 1, ct = tile & 1;
      const int ei = find_idx(xr, 32, rt);
      const int e = x8 + 8 * ei;
      const int pos0 = p.off[e] + (rt - xr[ei]) * 128;
      const int mvalid = min(128, p.off[e] + p.cnt[e] - pos0);
      const bf16_t* wg = p.wgT + (size_t)e * DE * D;
      const bf16_t* wu = p.wuT + (size_t)e * DE * D;
      gemm128<true>(
          D, [&](int r) { return p.h + (size_t)p.stok[pos0 + min(r, mvalid - 1)] * D; },
          [&](int c) {
            const int hid = ct * 128 + (c >> 7) * 64 + ((c >> 4) & 3) * 16 + (c & 15);
            return (((c >> 6) & 1) ? wu : wg) + (size_t)hid * D;
          },
          [&](const f32x4 (&acc)[4][8], int wr, int wc, int fr, int fq) {
#pragma unroll
            for (int m = 0; m < 4; ++m) {
              const int r = wr * 64 + m * 16 + fr;
              if (r < mvalid) {
#pragma unroll
                for (int n = 0; n < 4; ++n) {
                  f32x4 v;
#pragma unroll
                  for (int j = 0; j < 4; ++j) v[j] = siluf_(acc[m][n][j]) * acc[m][n + 4][j];
                  *(uint2*)(p.hr + (size_t)(pos0 + r) * DE + ct * 128 + wc * 64 + n * 16 + 4 * fq) = pack4(v);
                }
              }
            }
          },
          lds);
    }
  }
  }
  xcd_barrier(gbar);
  {
  PHASE_IDX
  {
    const int x8 = blockIdx.x & 7, ns8 = ((int)gridDim.x - x8 + 7) >> 3;
    const int* xr = p.xrts + x8 * 33;
    const int total_rt = xr[32];
    for (int rt = blockIdx.x >> 3; rt < total_rt; rt += ns8) {
      const int ei = find_idx(xr, 32, rt);
      const int e = x8 + 8 * ei;
      const int pos0 = p.off[e] + (rt - xr[ei]) * 128;
      const int mvalid = min(128, p.off[e] + p.cnt[e] - pos0);
      const bf16_t* wd = p.wdT + (size_t)e * D * DE;
      float wgt4[4];
      {
        int tq = threadIdx.x;
        OPAQUE(tq);
        const int wr_ = tq >> 7, fr_ = tq & 15;
#pragma unroll
        for (int m = 0; m < 4; ++m) wgt4[m] = p.sw[pos0 + min(wr_ * 64 + m * 16 + fr_, mvalid - 1)];
      }
      gemm128_stream<4>(
          DE, [&](int r) { return p.hr + (size_t)(pos0 + min(r, mvalid - 1)) * DE; },
          [&](int c) { return wd + (size_t)c * DE; }, (size_t)256 * DE,
          [&](int ct, const f32x4 (&acc)[4][8], int wr, int wc, int fr, int fq) {
#pragma unroll
            for (int m = 0; m < 4; ++m) {
              const int r = wr * 64 + m * 16 + fr;
              if (r < mvalid) {
#pragma unroll
                for (int n = 0; n < 8; ++n)
                  *(uint2*)(p.yk + (size_t)(pos0 + r) * D + ct * 256 + wc * 128 + n * 16 + 4 * fq) = pack4(acc[m][n] * wgt4[m]);
              }
            }
          },
          lds);
    }
  }
  }
  xcd_barrier(gbar);
  {
  PHASE_IDX
  for (int tok = gwave; tok < NT; tok += gwaves) {
    const int b = tok / S;
    const int4 ps0 = *(const int4*)(p.apos + tok * TOPK), ps1 = *(const int4*)(p.apos + tok * TOPK + 4);
    const int pos8[8] = {ps0.x, ps0.y, ps0.z, ps0.w, ps1.x, ps1.y, ps1.z, ps1.w};
    u32x4 ra_[8], rc_[8];
#pragma unroll
    for (int k = 0; k < TOPK; ++k) {
      const u32x4* src = (const u32x4*)(p.yk + (size_t)pos8[k] * D + lane * 16);
      ra_[k] = src[0]; rc_[k] = src[1];
    }
    float acc[16];
#pragma unroll
    for (int i = 0; i < 16; ++i) acc[i] = 0.f;
#pragma unroll
    for (int k = 0; k < TOPK; ++k) {
      const unsigned wv[8] = {ra_[k].x, ra_[k].y, ra_[k].z, ra_[k].w, rc_[k].x, rc_[k].y, rc_[k].z, rc_[k].w};
#pragma unroll
      for (int i = 0; i < 8; ++i) {
        acc[2 * i] += __uint_as_float(wv[i] << 16);
        acc[2 * i + 1] += __uint_as_float(wv[i] & 0xffff0000u);
      }
    }
    float* dst = p.out + (size_t)tok * D + lane * 16;
    const float* gt = p.mod + b * 6 * D + 5 * D + lane * 16;
#pragma unroll
    for (int i = 0; i < 4; ++i) {
      f32x4 o4 = *(f32x4*)(dst + 4 * i);
      const f32x4 g4 = *(const f32x4*)(gt + 4 * i);
#pragma unroll
      for (int j = 0; j < 4; ++j) o4[j] += g4[j] * acc[4 * i + j];
      *(f32x4*)(dst + 4 * i) = o4;
    }
  }
  }
}

extern "C" void kernel_launch(void* const* d_in, const int* in_sizes, int n_in, void* d_out, int out_size,
                              void* d_ws, size_t ws_size, hipStream_t stream) {
  (void)in_sizes; (void)n_in; (void)out_size;
  Params p{};
  const float* const* in = reinterpret_cast<const float* const*>(d_in);
  p.x = in[0]; p.c = in[1]; p.w_ada = in[2]; p.b_ada = in[3]; p.g_norm1 = in[4]; p.g_norm2 = in[5];
  p.w_in = in[6]; p.q_gain = in[7]; p.kc_gain = in[8]; p.ks_gain = in[9]; p.kw_gain = in[10];
  p.pe_k = in[11]; p.pe_v = in[12]; p.w_cmp_k1 = in[13]; p.w_cmp_k2 = in[14]; p.w_cmp_v1 = in[15];
  p.w_cmp_v2 = in[16]; p.a_re = in[17]; p.a_im = in[18]; p.log_dt = in[19]; p.b_re = in[20];
  p.b_im = in[21]; p.c_re = in[22]; p.c_im = in[23]; p.d_skip = in[24]; p.w_glu = in[25];
  p.b_glu = in[26]; p.w_up_attn = in[27]; p.w_up_ssm = in[28]; p.w_out = in[29]; p.w_router = in[30];
  p.router_bias = in[31]; p.w_gate = in[32]; p.w_up = in[33]; p.w_down = in[34]; p.ws_gate = in[35];
  p.ws_up = in[36]; p.ws_down = in[37];
  p.out = (float*)d_out;

  char* base = (char*)d_ws;
  size_t o = 0;
  auto take = [&](size_t bytes) { void* r = base + o; o += (bytes + 255) & ~(size_t)255; return r; };
  p.bar = (unsigned*)take(sizeof(unsigned) * XCD_BAR_WORDS);
  p.mod = (float*)take(sizeof(float) * NB * 6 * D);
  p.cbias = (float*)take(sizeof(float) * 512);
  p.w_inT = (bf16_t*)take(2 * (size_t)INC * D);
  p.wc1T = (bf16_t*)take(2 * (size_t)2 * 256 * 2048);
  p.wgluT = (bf16_t*)take(2 * (size_t)512 * 512);
  p.wuaT = (bf16_t*)take(2 * (size_t)D * 512);
  p.wusT = (bf16_t*)take(2 * (size_t)D * 512);
  p.woutT = (bf16_t*)take(2 * (size_t)D * D);
  p.wrT = (bf16_t*)take(2 * (size_t)NE * D);
  p.wsgT = (bf16_t*)take(2 * (size_t)DE * D);
  p.wsuT = (bf16_t*)take(2 * (size_t)DE * D);
  p.wsdT = (bf16_t*)take(2 * (size_t)D * DE);
  p.w1T = (bf16_t*)take(2 * (size_t)32 * 128 * 256);
  p.wyT = (bf16_t*)take(2 * (size_t)32 * 256 * 384);
  p.wgT = (bf16_t*)take(2 * (size_t)NE * DE * D);
  p.wuT = (bf16_t*)take(2 * (size_t)NE * DE * D);
  p.wdT = (bf16_t*)take(2 * (size_t)NE * D * DE);
  p.h = (bf16_t*)take(2 * (size_t)NT * D);
  p.pw = (float*)take(sizeof(float) * 2048 * 17 * 2);
  p.bbar = (float*)take(sizeof(float) * 2048 * 32);
  p.kd = (float*)take(sizeof(float) * 32 * 16 * 256);
  p.xmid = (float*)take(sizeof(float) * (size_t)NT * D);
  p.scores = (float*)take(sizeof(float) * (size_t)NT * NE);
  p.eidx = (int*)take(sizeof(int) * NASSIGN);
  p.ew = (float*)take(sizeof(float) * NASSIGN);
  p.cnt = (int*)take(sizeof(int) * NE);
  p.cursor = (int*)take(sizeof(int) * NE);
  p.off = (int*)take(sizeof(int) * (NE + 1));
  p.xrts = (int*)take(sizeof(int) * 8 * 33);
  p.stok = (int*)take(sizeof(int) * NASSIGN);
  p.sw = (float*)take(sizeof(float) * NASSIGN);
  p.apos = (int*)take(sizeof(int) * NASSIGN);
  p.hs = (bf16_t*)take(2 * (size_t)NT * DE);
  p.hr = (bf16_t*)take(2 * (size_t)NASSIGN * DE);
  const size_t early0 = o;
  p.qb = (bf16_t*)take(2 * (size_t)NT * 512);
  p.kvb = (bf16_t*)take(2 * (size_t)6 * NB * 2 * S * 64);
  p.cmpb = (bf16_t*)take(2 * (size_t)2 * NB * 2 * 256 * 64);
  p.gn = (float*)take(sizeof(float) * (size_t)NT * 24);
  p.a3 = (bf16_t*)take(2 * (size_t)32 * 1024 * 384);
  p.ga = (bf16_t*)take(2 * (size_t)NT * D);
  p.gs = (bf16_t*)take(2 * (size_t)NT * D);
  p.hidp = (float*)take(sizeof(float) * 16 * 2040 * 256);
  p.onsa = (float*)take(sizeof(float) * (size_t)NT * 512);
  p.onsab = (bf16_t*)take(2 * (size_t)NT * 512);
  p.lbuf = (float*)take(sizeof(float) * 32 * 1024 * 128);
  p.z = (bf16_t*)take(2 * (size_t)NT * 512);
  p.yssm = (bf16_t*)take(2 * (size_t)NT * 512);
  p.mtmp = (float*)take(sizeof(float) * (size_t)NT * D);
  p.merged = (bf16_t*)take(2 * (size_t)NT * D);
  const size_t early1 = o;
  p.yk = (bf16_t*)(base + early0);
  const size_t yk_bytes = 2 * (size_t)NASSIGN * D;
  if (early0 + yk_bytes > o) o = early0 + yk_bytes;
  (void)early1;
  if (o > ws_size) fprintf(stderr, "workspace too small: need %zu have %zu\n", o, ws_size);

  static int grid_blocks = 0;
  if (!grid_blocks) {
    int dev = 0, cus = 0, per_cu = 0;
    (void)hipGetDevice(&dev);
    (void)hipDeviceGetAttribute(&cus, hipDeviceAttributeMultiprocessorCount, dev);
    (void)hipOccupancyMaxActiveBlocksPerMultiprocessor(&per_cu, mega, 256, 0);
    if (per_cu > 2) per_cu = 2;
    if (per_cu < 1) per_cu = 1;
    grid_blocks = cus * per_cu;
  }
  (void)hipMemsetAsync(p.bar, 0, sizeof(unsigned) * XCD_BAR_WORDS, stream);
  hipLaunchKernelGGL(mega, dim3(grid_blocks), dim3(256), 0, stream, p);
  hipError_t e = hipPeekAtLastError();
  if (e != hipSuccess) fprintf(stderr, "launch failed: %s (grid %d)\n", hipGetErrorString(e), grid_blocks);
}
```

```cpp
#include <hip/hip_runtime.h>
#include <cstdio>
#include <cstdint>

constexpr int D = 1024;
constexpr int NB = 4;
constexpr int S = 4096;
constexpr int NT = NB * S;
constexpr int INC = 3864;
constexpr int C_Q = 0, C_KC = 512, C_VC = 640, C_KS = 768, C_VS = 896, C_KW = 1024, C_VW = 1152,
              C_GN = 1280, C_U = 1304, C_GA = 1816, C_GS = 2840;
constexpr int NCMP = 255;
constexpr int NE = 256;
constexpr int TOPK = 8;
constexpr int DE = 256;
constexpr int NASSIGN = NT * TOPK;
constexpr float EPS = 1e-6f;
constexpr float ATT_SCALE = 0.125f;
typedef unsigned short bf16_t;

struct Params {
  const float* x; const float* c; const float* w_ada; const float* b_ada; const float* g_norm1;
  const float* g_norm2; const float* w_in; const float* q_gain; const float* kc_gain;
  const float* ks_gain; const float* kw_gain; const float* pe_k; const float* pe_v;
  const float* w_cmp_k1; const float* w_cmp_k2; const float* w_cmp_v1; const float* w_cmp_v2;
  const float* a_re; const float* a_im; const float* log_dt; const float* b_re; const float* b_im;
  const float* c_re; const float* c_im; const float* d_skip; const float* w_glu; const float* b_glu;
  const float* w_up_attn; const float* w_up_ssm; const float* w_out; const float* w_router;
  const float* router_bias; const float* w_gate; const float* w_up; const float* w_down;
  const float* ws_gate; const float* ws_up; const float* ws_down;
  float* out;
  unsigned* bar;
  float* mod;
  float* cbias;
  bf16_t* w_inT;
  bf16_t* wc1T;
  bf16_t* wgluT;
  bf16_t* wuaT;
  bf16_t* wusT;
  bf16_t* woutT;
  bf16_t* wrT;
  bf16_t* wsgT;
  bf16_t* wsuT;
  bf16_t* wsdT;
  bf16_t* w1T;
  bf16_t* wyT;
  bf16_t* wgT;
  bf16_t* wuT;
  bf16_t* wdT;
  bf16_t* h;
  bf16_t* qb;
  bf16_t* kvb;
  bf16_t* cmpb;
  float* gn;
  bf16_t* a3;
  bf16_t* ga;
  bf16_t* gs;
  float* hidp;
  float* onsa;
  bf16_t* onsab;
  float* pw;
  float* bbar;
  float* kd;
  float* lbuf;
  bf16_t* z;
  bf16_t* yssm;
  bf16_t* mtmp;
  bf16_t* merged;
  float* xmid;
  float* scores;
  int* eidx;
  float* ew;
  int* cnt;
  int* cursor;
  int* off;
  int* xrts;
  int* stok;
  float* sw;
  int* apos;
  bf16_t* hs;
  bf16_t* hr;
  bf16_t* yk;
};

__device__ __forceinline__ float bpx(float v, int lane, int off) {
  return __int_as_float(__builtin_amdgcn_ds_bpermute((lane ^ off) << 2, __float_as_int(v)));
}
__device__ __forceinline__ int bpxi(int v, int lane, int off) { return __builtin_amdgcn_ds_bpermute((lane ^ off) << 2, v); }
__device__ __forceinline__ unsigned bpxu(unsigned v, int lane, int off) { return (unsigned)__builtin_amdgcn_ds_bpermute((lane ^ off) << 2, (int)v); }
__device__ __forceinline__ float bpl(float v, int src) {
  return __int_as_float(__builtin_amdgcn_ds_bpermute(src << 2, __float_as_int(v)));
}
__device__ __forceinline__ float wsum(float v, int lane) {
#pragma unroll
  for (int o = 32; o > 0; o >>= 1) v += bpx(v, lane, o);
  return v;
}
#define WSYNC() do { __builtin_amdgcn_fence(__ATOMIC_ACQ_REL, "wavefront"); __builtin_amdgcn_wave_barrier(); } while (0)
__device__ __forceinline__ float fexp_(float x) { return __builtin_amdgcn_exp2f(x * 1.4426950408889634f); }
__device__ __forceinline__ float sigmoidf_(float x) { return 1.0f / (1.0f + fexp_(-x)); }
__device__ __forceinline__ float sigmoid_acc(float x) { return 1.0f / (1.0f + expf(-x)); }
__device__ __forceinline__ float siluf_(float x) { return x / (1.0f + fexp_(-x)); }
__device__ __forceinline__ float geluf_(float x) {
  const float u2 = 1.5957691216057308f * (x + 0.044715f * x * x * x);
  return x / (1.0f + fexp_(-u2));
}
#define OPAQUE(x) asm volatile("" : "+v"(x))
typedef short bf16x8 __attribute__((ext_vector_type(8)));
typedef float f32x4 __attribute__((ext_vector_type(4)));
typedef unsigned u32x4 __attribute__((ext_vector_type(4)));
#define LAS __attribute__((address_space(3)))

__device__ __forceinline__ unsigned cvt_pk_bf16(float lo, float hi) {
  unsigned r;
  asm("v_cvt_pk_bf16_f32 %0, %1, %2" : "=v"(r) : "v"(lo), "v"(hi));
  return r;
}
__device__ __forceinline__ uint2 pack4(const f32x4 v) {
  uint2 w;
  w.x = cvt_pk_bf16(v[0], v[1]); w.y = cvt_pk_bf16(v[2], v[3]);
  return w;
}
__device__ __forceinline__ f32x4 unpack4(const uint2 w) {
  return (f32x4){__uint_as_float(w.x << 16), __uint_as_float(w.x & 0xffff0000u), __uint_as_float(w.y << 16), __uint_as_float(w.y & 0xffff0000u)};
}
__device__ __forceinline__ int lds_byte(int r, int c) {
  const int st = (r >> 4) * 2 + (c >> 5), rr = r & 15, cc = c & 31, ob = rr * 64 + cc * 2;
  return st * 1024 + (ob ^ (((ob >> 9) & 1) << 5));
}
__device__ __forceinline__ int t32_byte(int r, int c) {
  const int ob = (r & 15) * 64 + c * 2;
  return (r >> 4) * 1024 + (ob ^ (((ob >> 9) & 1) << 5));
}

constexpr int GEMM_STAGE = 24576;
constexpr int GEMM_RING = 3;
constexpr int TM = 128, TNW = 256;
template <bool GL = false, class AF, class BF, class EPW>
__device__ __forceinline__ void gemm128(int K, AF arow, BF brow, EPW epiw, LAS unsigned char* lds) {
  int t = threadIdx.x;
  OPAQUE(t);
  const int wid = t >> 6, lane = t & 63, wr = wid >> 1, wc = wid & 1, fr = lane & 15, fq = lane >> 4;
  const int sbb = lane * 16, obb = sbb ^ (((sbb >> 9) & 1) << 5);
  const int rin = obb >> 6, cel = (obb & 63) >> 1;
  const bf16_t* ga0 = arow(wid * 16 + rin) + cel;
  const bf16_t* ga1 = arow((wid + 4) * 16 + rin) + cel;
  const bf16_t* gb0 = brow(wid * 16 + rin) + cel;
  const bf16_t* gb1 = brow((wid + 4) * 16 + rin) + cel;
  const bf16_t* gb2 = brow((wid + 8) * 16 + rin) + cel;
  const bf16_t* gb3 = brow((wid + 12) * 16 + rin) + cel;
  f32x4 acc[4][8];
#pragma unroll
  for (int m = 0; m < 4; ++m)
#pragma unroll
    for (int n = 0; n < 8; ++n) acc[m][n] = (f32x4){0.f, 0.f, 0.f, 0.f};
  const int foff = t32_byte(fr, fq * 8);
  const int nk = K >> 5;
#define GEMM_COMPUTE(sa_) do { \
    bf16x8 af[4]; \
    _Pragma("unroll") for (int m = 0; m < 4; ++m) af[m] = *(const LAS bf16x8*)((sa_) + (wr * 4 + m) * 1024 + foff); \
    _Pragma("unroll") for (int nh = 0; nh < 2; ++nh) { \
      bf16x8 bf[4]; \
      _Pragma("unroll") for (int n = 0; n < 4; ++n) bf[n] = *(const LAS bf16x8*)((sa_) + 8192 + (wc * 8 + nh * 4 + n) * 1024 + foff); \
      __builtin_amdgcn_s_setprio(1); \
      _Pragma("unroll") for (int m = 0; m < 4; ++m) \
        _Pragma("unroll") for (int n = 0; n < 4; ++n) \
          acc[m][nh * 4 + n] = __builtin_amdgcn_mfma_f32_16x16x32_bf16(bf[n], af[m], acc[m][nh * 4 + n], 0, 0, 0); \
      __builtin_amdgcn_s_setprio(0); \
      if (nh == 0) __builtin_amdgcn_sched_barrier(0); } } while (0)
  if constexpr (GL) {
  LAS unsigned char* l0 = lds + t * 16;
#define GEMM_ISSUE(s_) do { LAS unsigned char* d_ = l0 + ((s_) % GEMM_RING) * GEMM_STAGE; const int ko_ = (s_) * 32; \
    __builtin_amdgcn_global_load_lds((const unsigned*)(ga0 + ko_), (LAS unsigned*)(d_), 16, 0, 0); \
    __builtin_amdgcn_global_load_lds((const unsigned*)(ga1 + ko_), (LAS unsigned*)(d_ + 4096), 16, 0, 0); \
    __builtin_amdgcn_global_load_lds((const unsigned*)(gb0 + ko_), (LAS unsigned*)(d_ + 8192), 16, 0, 0); \
    __builtin_amdgcn_global_load_lds((const unsigned*)(gb1 + ko_), (LAS unsigned*)(d_ + 12288), 16, 0, 0); \
    __builtin_amdgcn_global_load_lds((const unsigned*)(gb2 + ko_), (LAS unsigned*)(d_ + 16384), 16, 0, 0); \
    __builtin_amdgcn_global_load_lds((const unsigned*)(gb3 + ko_), (LAS unsigned*)(d_ + 20480), 16, 0, 0); } while (0)
  asm volatile("s_waitcnt vmcnt(0)" ::: "memory");
#pragma unroll
  for (int s_ = 0; s_ < GEMM_RING - 1; ++s_)
    if (s_ < nk) GEMM_ISSUE(s_);
  for (int kt = 0; kt < nk; ++kt) {
    if (kt + 1 < nk) asm volatile("s_waitcnt vmcnt(6)" ::: "memory");
    else asm volatile("s_waitcnt vmcnt(0)" ::: "memory");
    __builtin_amdgcn_s_barrier();
    asm volatile("" ::: "memory");
    if (kt + GEMM_RING - 1 < nk) GEMM_ISSUE(kt + GEMM_RING - 1);
    const LAS unsigned char* sa = lds + (kt % GEMM_RING) * GEMM_STAGE;
    GEMM_COMPUTE(sa);
  }
  __builtin_amdgcn_s_barrier();
  asm volatile("" ::: "memory");
#undef GEMM_ISSUE
  } else {
  for (int kt = 0; kt < nk; ++kt) {
    const int ko = kt * 32;
    const u32x4 a0 = *(const u32x4*)(ga0 + ko), a1 = *(const u32x4*)(ga1 + ko);
    const u32x4 b0 = *(const u32x4*)(gb0 + ko), b1 = *(const u32x4*)(gb1 + ko);
    const u32x4 b2 = *(const u32x4*)(gb2 + ko), b3 = *(const u32x4*)(gb3 + ko);
    *(LAS u32x4*)(lds + t * 16) = a0;
    *(LAS u32x4*)(lds + t * 16 + 4096) = a1;
    *(LAS u32x4*)(lds + t * 16 + 8192) = b0;
    *(LAS u32x4*)(lds + t * 16 + 12288) = b1;
    *(LAS u32x4*)(lds + t * 16 + 16384) = b2;
    *(LAS u32x4*)(lds + t * 16 + 20480) = b3;
    __syncthreads();
    GEMM_COMPUTE(lds);
    __syncthreads();
  }
  }
#undef GEMM_COMPUTE
  epiw(acc, wr, wc, fr, fq);
}

template <int NCT, class AF, class BF, class EPW>
__device__ __forceinline__ void gemm128_stream(int K, AF arow, BF brow, size_t bct, EPW epiw, LAS unsigned char* lds) {
  int t = threadIdx.x;
  OPAQUE(t);
  const int wid = t >> 6, lane = t & 63, wr = wid >> 1, wc = wid & 1, fr = lane & 15, fq = lane >> 4;
  const int sbb = lane * 16, obb = sbb ^ (((sbb >> 9) & 1) << 5);
  const int rin = obb >> 6, cel = (obb & 63) >> 1;
  const bf16_t* ga0 = arow(wid * 16 + rin) + cel;
  const bf16_t* ga1 = arow((wid + 4) * 16 + rin) + cel;
  const bf16_t* gb0 = brow(wid * 16 + rin) + cel;
  const bf16_t* gb1 = brow((wid + 4) * 16 + rin) + cel;
  const bf16_t* gb2 = brow((wid + 8) * 16 + rin) + cel;
  const bf16_t* gb3 = brow((wid + 12) * 16 + rin) + cel;
  f32x4 acc[4][8];
#pragma unroll
  for (int m = 0; m < 4; ++m)
#pragma unroll
    for (int n = 0; n < 8; ++n) acc[m][n] = (f32x4){0.f, 0.f, 0.f, 0.f};
  const int foff = t32_byte(fr, fq * 8);
  const int nk = K >> 5, ns = nk * NCT;
  LAS unsigned char* l0 = lds + t * 16;
  int iss_k = 0;
  size_t iss_b = 0;
#define GEMM_ISSUE2(s_) do { LAS unsigned char* d_ = l0 + ((s_) % GEMM_RING) * GEMM_STAGE; \
    __builtin_amdgcn_global_load_lds((const unsigned*)(ga0 + iss_k), (LAS unsigned*)(d_), 16, 0, 0); \
    __builtin_amdgcn_global_load_lds((const unsigned*)(ga1 + iss_k), (LAS unsigned*)(d_ + 4096), 16, 0, 0); \
    __builtin_amdgcn_global_load_lds((const unsigned*)(gb0 + iss_b + iss_k), (LAS unsigned*)(d_ + 8192), 16, 0, 0); \
    __builtin_amdgcn_global_load_lds((const unsigned*)(gb1 + iss_b + iss_k), (LAS unsigned*)(d_ + 12288), 16, 0, 0); \
    __builtin_amdgcn_global_load_lds((const unsigned*)(gb2 + iss_b + iss_k), (LAS unsigned*)(d_ + 16384), 16, 0, 0); \
    __builtin_amdgcn_global_load_lds((const unsigned*)(gb3 + iss_b + iss_k), (LAS unsigned*)(d_ + 20480), 16, 0, 0); \
    iss_k += 32; if (iss_k == K) { iss_k = 0; iss_b += bct; } } while (0)
  asm volatile("s_waitcnt vmcnt(0)" ::: "memory");
#pragma unroll
  for (int s_ = 0; s_ < GEMM_RING - 1; ++s_)
    if (s_ < ns) GEMM_ISSUE2(s_);
  int kt = 0, ct = 0;
  for (int s_ = 0; s_ < ns; ++s_) {
    if (s_ + 1 < ns) asm volatile("s_waitcnt vmcnt(6)" ::: "memory");
    else asm volatile("s_waitcnt vmcnt(0)" ::: "memory");
    __builtin_amdgcn_s_barrier();
    asm volatile("" ::: "memory");
    if (s_ + GEMM_RING - 1 < ns) GEMM_ISSUE2(s_ + GEMM_RING - 1);
    const LAS unsigned char* sa = lds + (s_ % GEMM_RING) * GEMM_STAGE;
    {
      bf16x8 af[4];
#pragma unroll
      for (int m = 0; m < 4; ++m) af[m] = *(const LAS bf16x8*)(sa + (wr * 4 + m) * 1024 + foff);
#pragma unroll
      for (int nh = 0; nh < 2; ++nh) {
        bf16x8 bf[4];
#pragma unroll
        for (int n = 0; n < 4; ++n) bf[n] = *(const LAS bf16x8*)(sa + 8192 + (wc * 8 + nh * 4 + n) * 1024 + foff);
#pragma unroll
        for (int m = 0; m < 4; ++m)
#pragma unroll
          for (int n = 0; n < 4; ++n)
            acc[m][nh * 4 + n] = __builtin_amdgcn_mfma_f32_16x16x32_bf16(bf[n], af[m], acc[m][nh * 4 + n], 0, 0, 0);
        if (nh == 0) __builtin_amdgcn_sched_barrier(0);
      }
    }
    if (++kt == nk) {
      epiw(ct, acc, wr, wc, fr, fq);
#pragma unroll
      for (int m = 0; m < 4; ++m)
#pragma unroll
        for (int n = 0; n < 8; ++n) acc[m][n] = (f32x4){0.f, 0.f, 0.f, 0.f};
      kt = 0; ++ct;
    }
  }
  __builtin_amdgcn_s_barrier();
  asm volatile("" ::: "memory");
#undef GEMM_ISSUE2
}

constexpr int OSTRIDE = 528;
__device__ __forceinline__ void tile_out_put(LAS unsigned char* lds, int row, int col, uint2 v) {
  typedef unsigned u32x2_t __attribute__((ext_vector_type(2)));
  *(LAS u32x2_t*)(lds + row * OSTRIDE + col * 2) = (u32x2_t){v.x, v.y};
}
__device__ __forceinline__ void tile_out_stage(LAS unsigned char* lds, int wr, int wc, int fr, int fq, int m, int n, uint2 v) {
  tile_out_put(lds, wr * 64 + m * 16 + fr, wc * 128 + n * 16 + 4 * fq, v);
}
template <class RP>
__device__ __forceinline__ void tile_out_flush128(LAS unsigned char* lds, int nrows, RP rowptr) {
  int t = threadIdx.x;
  OPAQUE(t);
  __syncthreads();
#pragma unroll 4
  for (int i = 0; i < 8; ++i) {
    const int q = t + i * 256, row = q >> 4, piece = q & 15;
    if (row < nrows) *(u32x4*)(rowptr(row) + piece * 8) = *(const LAS u32x4*)(lds + row * OSTRIDE + piece * 16);
  }
  __syncthreads();
}
template <class RP>
__device__ __forceinline__ void tile_out_flush(LAS unsigned char* lds, int nrows, RP rowptr) {
  int t = threadIdx.x;
  OPAQUE(t);
  __syncthreads();
#pragma unroll 4
  for (int i = 0; i < 16; ++i) {
    const int q = t + i * 256, row = q >> 5, piece = q & 31;
    if (row < nrows) *(u32x4*)(rowptr(row) + piece * 8) = *(const LAS u32x4*)(lds + row * OSTRIDE + piece * 16);
  }
  __syncthreads();
}

__device__ __forceinline__ bool xcd_tile(int it, int tm, int tn, int& mt, int& nt) {
  const int G = gridDim.x, x = blockIdx.x & 7, slot = blockIdx.x >> 3, ns = (G - x + 7) >> 3;
  const int q = slot + it * ns;
  if (tn >= 8) {
    const int cn = (tn - x + 7) >> 3;
    if (q >= cn * tm) return false;
    mt = q / cn; nt = x + 8 * (q % cn);
  } else {
    const int cm = (tm - x + 7) >> 3;
    if (cm <= 0 || q >= cm * tn) return false;
    mt = x + 8 * (q / tn); nt = q % tn;
  }
  return true;
}
__device__ __forceinline__ int find_idx(const int* pre, int n, int v) {
  int lo = 0, hi = n;
  while (hi - lo > 1) {
    const int mid = (lo + hi) >> 1;
    if (pre[mid] <= v) lo = mid; else hi = mid;
  }
  return lo;
}

template <class AL, class BL, class EP>
__device__ __forceinline__ void gemm_phase(int M, int N, int K, AL al, BL bl, EP ep, LAS unsigned char* lds) {
  const int tn = (N + TNW - 1) / TNW, tm = (M + TM - 1) / TM;
  int mt, nt;
  for (int it = 0; xcd_tile(it, tm, tn, mt, nt); ++it) {
    const int m0 = mt * TM, n0 = nt * TNW;
    gemm128<true>(
        K, [&](int r) { return al(min(m0 + r, M - 1)); }, [&](int c) { return bl(min(n0 + c, N - 1)); },
        [&](const f32x4 (&acc)[4][8], int wr, int wc, int fr, int fq) {
#pragma unroll
          for (int m = 0; m < 4; ++m)
#pragma unroll
            for (int n = 0; n < 8; ++n) {
              const int r = m0 + wr * 64 + m * 16 + fr, c = n0 + wc * 128 + n * 16 + 4 * fq;
              if (r < M && c < N) ep(r, c, acc[m][n]);
            }
        },
        lds);
  }
}

template <class AL, class BL, class XF>
__device__ __forceinline__ void gemm_phase_bf16(int M, int N, int K, AL al, BL bl, XF xf, bf16_t* out, int ldo, LAS unsigned char* lds) {
  const int tn = N / TNW, tm = M / TM;
  int mt, nt;
  for (int it = 0; xcd_tile(it, tm, tn, mt, nt); ++it) {
    const int m0 = mt * TM, n0 = nt * TNW;
    gemm128<true>(
        K, [&](int r) { return al(m0 + r); }, [&](int c) { return bl(n0 + c); },
        [&](const f32x4 (&acc)[4][8], int wr, int wc, int fr, int fq) {
#pragma unroll
          for (int m = 0; m < 4; ++m)
#pragma unroll
            for (int n = 0; n < 8; ++n)
              tile_out_stage(lds, wr, wc, fr, fq, m, n, pack4(xf(m0 + wr * 64 + m * 16 + fr, n0 + wc * 128 + n * 16 + 4 * fq, acc[m][n])));
        },
        lds);
    tile_out_flush(lds, TM, [&](int r) { return out + (size_t)(m0 + r) * ldo + n0; });
  }
}

__device__ __forceinline__ void convert_tile(const float* W, int ldw, int nvalid, bf16_t* Wt, int ldt, int k0, int n0, LAS unsigned char* lds) {
  int t = threadIdx.x;
  OPAQUE(t);
  const int n4 = t & 31, kg = t >> 5;
  const int ncol = n0 + n4 * 4;
  f32x4 rb[8];
#pragma unroll
  for (int j = 0; j < 8; ++j)
    rb[j] = (ncol < nvalid) ? *(const f32x4*)(W + (size_t)(k0 + kg * 8 + j) * ldw + ncol) : (f32x4){0.f, 0.f, 0.f, 0.f};
#pragma unroll
  for (int c = 0; c < 4; ++c) {
    u32x4 w;
    w.x = cvt_pk_bf16(rb[0][c], rb[1][c]); w.y = cvt_pk_bf16(rb[2][c], rb[3][c]);
    w.z = cvt_pk_bf16(rb[4][c], rb[5][c]); w.w = cvt_pk_bf16(rb[6][c], rb[7][c]);
    *(LAS u32x4*)(lds + (n4 * 4 + c) * 144 + kg * 16) = w;
  }
  __syncthreads();
#pragma unroll
  for (int i = 0; i < 4; ++i) {
    const int q = t + i * 256, row = q >> 3, piece = q & 7;
    if (n0 + row < nvalid) *(u32x4*)(Wt + (size_t)(n0 + row) * ldt + k0 + piece * 8) = *(const LAS u32x4*)(lds + row * 144 + piece * 16);
  }
  __syncthreads();
}

typedef short s16x4 __attribute__((ext_vector_type(4)));
#define REDERIVE() do { OPAQUE(t); w = t >> 6; lane = t & 63; fr = lane & 15; fq = lane >> 4; rloc = w * 16 + fr; } while (0)
constexpr int VROW = 160;

__device__ __forceinline__ bf16x8 pack8(const f32x4 a, const f32x4 b) {
  u32x4 w;
  w.x = cvt_pk_bf16(a[0], a[1]); w.y = cvt_pk_bf16(a[2], a[3]);
  w.z = cvt_pk_bf16(b[0], b[1]); w.w = cvt_pk_bf16(b[2], b[3]);
  return __builtin_bit_cast(bf16x8, w);
}
__device__ __forceinline__ void tile_fetch(bf16x8 (&r)[2], const unsigned short* base, int t) {
  const bf16x8* q = (const bf16x8*)(base + t * 16);
  r[0] = q[0];
  r[1] = q[1];
}
__device__ __forceinline__ void stage_k(const bf16x8 (&r)[2], LAS unsigned char* ldsK, int t) {
  const int row = t >> 2, c0 = (t & 3) * 16;
  *(LAS bf16x8*)(ldsK + lds_byte(row, c0)) = r[0];
  *(LAS bf16x8*)(ldsK + lds_byte(row, c0 + 8)) = r[1];
}
__device__ __forceinline__ void stage_v(const bf16x8 (&r)[2], LAS unsigned char* ldsV, int t) {
  const int row = t >> 2, c0 = (t & 3) * 16;
  *(LAS bf16x8*)(ldsV + row * VROW + c0 * 2) = r[0];
  *(LAS bf16x8*)(ldsV + row * VROW + c0 * 2 + 16) = r[1];
}
template <int H>
__device__ __forceinline__ void attn_qk_h(f32x4 (&s)[4][2], const LAS unsigned char* qf, LAS unsigned char* ldsK, int fr, int fq) {
  const int koff = lds_byte(fr, fq * 8);
#pragma unroll
  for (int m = 0; m < 4; ++m)
#pragma unroll
    for (int nn = 0; nn < 2; ++nn) s[m][nn] = (f32x4){0.f, 0.f, 0.f, 0.f};
#pragma unroll
  for (int nn = 0; nn < 2; ++nn)
#pragma unroll
    for (int ks = 0; ks < 2; ++ks) {
      const bf16x8 kf = *(const LAS bf16x8*)(ldsK + koff + (2 * H + nn) * 2048 + ks * 1024);
#pragma unroll
      for (int m = 0; m < 4; ++m)
        s[m][nn] = __builtin_amdgcn_mfma_f32_16x16x32_bf16(kf, *(const LAS bf16x8*)(qf + (m * 2 + ks) * 1024), s[m][nn], 0, 0, 0);
    }
}
template <int H>
__device__ __forceinline__ void attn_pv_h(f32x4 (&o)[4][4], const bf16x8 (&pf)[4], LAS unsigned char* ldsV, int lane) {
  const int fq = lane >> 4, i = lane & 15;
  const int vbase = (4 * fq + (i >> 2)) * VROW + (i & 3) * 8;
#pragma unroll
  for (int dt = 0; dt < 4; ++dt) {
    LAS unsigned char* a0 = ldsV + vbase + H * 32 * VROW + dt * 32;
    const s16x4 v0 = __builtin_amdgcn_ds_read_tr16_b64_v4i16((LAS s16x4*)a0);
    const s16x4 v1 = __builtin_amdgcn_ds_read_tr16_b64_v4i16((LAS s16x4*)(a0 + 16 * VROW));
    bf16x8 vf;
    vf[0] = v0[0]; vf[1] = v0[1]; vf[2] = v0[2]; vf[3] = v0[3];
    vf[4] = v1[0]; vf[5] = v1[1]; vf[6] = v1[2]; vf[7] = v1[3];
#pragma unroll
    for (int m = 0; m < 4; ++m) o[m][dt] = __builtin_amdgcn_mfma_f32_16x16x32_bf16(vf, pf[m], o[m][dt], 0, 0, 0);
  }
}
constexpr float SOFTMAX_SHIFT = 12.0f;
template <int H, bool EM>
__device__ __forceinline__ void attn_softmax_h(f32x4 (&s)[4][2], float (&lrow)[4], bf16x8 (&pf)[4], bool rowok, int lo, int hi) {
#pragma unroll
  for (int m = 0; m < 4; ++m) {
    float ls = 0.f;
#pragma unroll
    for (int nn = 0; nn < 2; ++nn)
#pragma unroll
      for (int jj = 0; jj < 4; ++jj) {
        const int kc = 16 * (2 * H + nn) + jj;
        const bool ok = rowok && (!EM || (lo < kc && hi >= kc));
        const float pv = ok ? __builtin_amdgcn_exp2f(s[m][nn][jj] - SOFTMAX_SHIFT) : 0.f;
        s[m][nn][jj] = pv;
        ls += pv;
      }
    lrow[m] += ls;
    pf[m] = pack8(s[m][0], s[m][1]);
  }
}
template <int H, bool EM>
__device__ __forceinline__ void attn_sub(f32x4 (&o)[4][4], float (&mrow)[4], float (&lrow)[4], const LAS unsigned char* qf,
                                         LAS unsigned char* ldsK, LAS unsigned char* ldsV, bool rowok, int lo, int hi, int lane) {
  f32x4 s[4][2];
  bf16x8 pf[4];
  attn_qk_h<H>(s, qf, ldsK, lane & 15, lane >> 4);
  attn_softmax_h<H, EM>(s, lrow, pf, rowok, lo, hi);
  attn_pv_h<H>(o, pf, ldsV, lane);
  if (H == 0) __builtin_amdgcn_sched_barrier(0);
}
template <bool EM>
__device__ __forceinline__ void attn_tile(f32x4 (&o)[4][4], float (&mrow)[4], float (&lrow)[4], const LAS unsigned char* qf,
                                          LAS unsigned char* ldsK, LAS unsigned char* ldsV, bool rowok, int lo, int hi, int lane) {
  attn_sub<0, EM>(o, mrow, lrow, qf, ldsK, ldsV, rowok, lo, hi, lane);
  attn_sub<1, EM>(o, mrow, lrow, qf, ldsK, ldsV, rowok, lo, hi, lane);
}
template <int H>
__device__ __forceinline__ void cmp_stats(float (&mrow)[4], float (&lrow)[4], const LAS unsigned char* qf, LAS unsigned char* ldsK, int hi, int lane) {
  const int fq = lane >> 4;
  f32x4 s[4][2];
  attn_qk_h<H>(s, qf, ldsK, lane & 15, fq);
#pragma unroll
  for (int m = 0; m < 4; ++m) {
    float ls = 0.f;
#pragma unroll
    for (int nn = 0; nn < 2; ++nn)
#pragma unroll
      for (int jj = 0; jj < 4; ++jj) {
        const int kc = 16 * (2 * H + nn) + jj;
        ls += (hi >= kc) ? __builtin_amdgcn_exp2f(s[m][nn][jj] - SOFTMAX_SHIFT) : 0.f;
      }
    lrow[m] += ls;
  }
}
template <int H>
__device__ __forceinline__ void cmp_apply(f32x4 (&o)[4][4], const float (&msf)[4], const float (&linv)[4], float& lastprev, LAS float* improw,
                                          const LAS unsigned char* qf, LAS unsigned char* ldsK, LAS unsigned char* ldsV, int hi, int lane) {
  const int fq = lane >> 4;
  f32x4 s[4][2];
  bf16x8 pf[4];
  attn_qk_h<H>(s, qf, ldsK, lane & 15, fq);
#pragma unroll
  for (int m = 0; m < 4; ++m) {
#pragma unroll
    for (int nn = 0; nn < 2; ++nn)
#pragma unroll
      for (int jj = 0; jj < 4; ++jj) {
        const int kc = 16 * (2 * H + nn) + jj;
        s[m][nn][jj] = (hi >= kc) ? __builtin_amdgcn_exp2f(s[m][nn][jj] - SOFTMAX_SHIFT) * linv[m] : 0.f;
      }
    pf[m] = pack8(s[m][0], s[m][1]);
  }
#pragma unroll
  for (int nn = 0; nn < 2; ++nn) {
    float gs = 0.f, last = 0.f;
#pragma unroll
    for (int m = 0; m < 4; ++m) {
      gs += (s[m][nn][0] + s[m][nn][1]) + (s[m][nn][2] + s[m][nn][3]);
      last += s[m][nn][3];
    }
    const float pa = bpl(last, (lane + 48) & 63);
    const float pb = bpl(lastprev, (lane + 48) & 63);
    improw[(2 * H + nn) * 4 + fq] = gs + ((fq > 0) ? pa : pb);
    lastprev = last;
  }
  attn_pv_h<H>(o, pf, ldsV, lane);
}

__device__ __forceinline__ void attn_chunk(const Params& p, LAS unsigned char* lds, int b, int g, int ci) {
  int t = threadIdx.x;
  OPAQUE(t);
  int w = t >> 6, lane = t & 63, fr = lane & 15, fq = lane >> 4;
  LAS unsigned char* ldsK = lds;
  LAS unsigned char* ldsV = lds + 8192;
  LAS float* impb = (LAS float*)(lds + 18432) + w * 1024;
  LAS unsigned* unib = (LAS unsigned*)(lds + 18432 + 16384);
  int rloc = w * 16 + fr;
  const int tq = ci * 64 + rloc;
  const size_t tok = (size_t)b * S + tq;
  const float* grow = p.gn + tok * 24 + g * 12;
  float* orow = p.onsa + tok * 512 + g * 256;
  LAS unsigned char* qf = lds + 36864 + w * 8192 + lane * 16;
#pragma unroll
  for (int m = 0; m < 4; ++m)
#pragma unroll
    for (int ks = 0; ks < 2; ++ks)
      *(LAS bf16x8*)(qf + (m * 2 + ks) * 1024) = *(const bf16x8*)(p.qb + tok * 512 + (g * 4 + m) * 64 + ks * 32 + fq * 8);
  f32x4 o[4][4];
  float mrow[4], lrow[4];
  bf16x8 rk[2], rv[2];

  const int nvis = (tq >= 31) ? ((tq - 31) / 16 + 1) : 0;
  const int nvmax = 4 * ci + 3;
  const int ntc = (nvmax + 63) >> 6;
  const unsigned short* kcb = p.cmpb + (size_t)((0 * NB + b) * 2 + g) * 256 * 64;
  const unsigned short* vcb = p.cmpb + (size_t)((1 * NB + b) * 2 + g) * 256 * 64;
#pragma unroll
  for (int m = 0; m < 4; ++m) { mrow[m] = -INFINITY; lrow[m] = 0.f; }
  REDERIVE();
  for (int tc = 0; tc < ntc; ++tc) {
    tile_fetch(rk, kcb + (size_t)tc * 4096, t);
    stage_k(rk, ldsK, t);
    __syncthreads();
    const int hi = nvis - 1 - tc * 64 - 4 * fq;
    cmp_stats<0>(mrow, lrow, qf, ldsK, hi, lane);
    cmp_stats<1>(mrow, lrow, qf, ldsK, hi, lane);
    __syncthreads();
  }
  {
    float linv[4], msf[4];
#pragma unroll
    for (int m = 0; m < 4; ++m) {
      float l = lrow[m];
      l += bpx(l, lane, 16);
      l += bpx(l, lane, 32);
      linv[m] = (l > 0.f) ? 1.0f / l : 0.f;
      msf[m] = 0.f;
    }
    REDERIVE();
#pragma unroll
    for (int m = 0; m < 4; ++m)
#pragma unroll
      for (int dt = 0; dt < 4; ++dt) o[m][dt] = (f32x4){0.f, 0.f, 0.f, 0.f};
    float lastprev = 0.f;
    for (int tc = 0; tc < ntc; ++tc) {
      tile_fetch(rk, kcb + (size_t)tc * 4096, t);
      tile_fetch(rv, vcb + (size_t)tc * 4096, t);
      stage_k(rk, ldsK, t);
      stage_v(rv, ldsV, t);
      __syncthreads();
      const int hi = nvis - 1 - tc * 64 - 4 * fq;
      cmp_apply<0>(o, msf, linv, lastprev, impb + fr * 64 + tc * 16, qf, ldsK, ldsV, hi, lane);
      cmp_apply<1>(o, msf, linv, lastprev, impb + fr * 64 + tc * 16, qf, ldsK, ldsV, hi, lane);
      __syncthreads();
    }
  }
#pragma unroll
  for (int m = 0; m < 4; ++m) {
    const float gate = grow[m * 3 + 0];
#pragma unroll
    for (int dt = 0; dt < 4; ++dt) *(f32x4*)(orow + m * 64 + dt * 16 + 4 * fq) = o[m][dt] * gate;
  }
  unsigned mlo, mhi;
  REDERIVE();
  {
    WSYNC();
    float kv[16];
    const int c0 = -fq * 16, c1 = ci - fq * 16;
#pragma unroll
    for (int i = 0; i < 16; ++i) {
      const bool forced = (c0 == i) || (c1 == i) || (c1 == i + 1);
      float v = (c1 >= i) ? impb[fr * 64 + fq * 16 + i] : -INFINITY;
      if (forced) v = INFINITY;
      kv[i] = v;
    }
    WSYNC();
#pragma unroll
    for (int i = 0; i < 16; ++i) impb[fr * 64 + fq * 16 + i] = kv[i];
    WSYNC();
    int rank[16];
#pragma unroll
    for (int i = 0; i < 16; ++i) rank[i] = 0;
#pragma unroll 2
    for (int k = 0; k < 64; ++k) {
      const float ok = impb[fr * 64 + k];
      const int kq = k - fq * 16;
#pragma unroll
      for (int i = 0; i < 16; ++i) rank[i] += (ok > kv[i] || (ok == kv[i] && kq < i)) ? 1 : 0;
    }
    unsigned piece = 0;
#pragma unroll
    for (int i = 0; i < 16; ++i) piece |= (rank[i] < 16) ? (1u << i) : 0u;
    unsigned lo32 = (fq == 0) ? piece : (fq == 1) ? (piece << 16) : 0u;
    unsigned hi32 = (fq == 2) ? piece : (fq == 3) ? (piece << 16) : 0u;
    lo32 |= bpxu(lo32, lane, 16); lo32 |= bpxu(lo32, lane, 32);
    hi32 |= bpxu(hi32, lane, 16); hi32 |= bpxu(hi32, lane, 32);
    mlo = lo32; mhi = hi32;
    unsigned ulo = lo32, uhi = hi32;
#pragma unroll
    for (int off = 1; off < 16; off <<= 1) { ulo |= bpxu(ulo, lane, off); uhi |= bpxu(uhi, lane, off); }
    if (lane == 0) { unib[w * 2] = ulo; unib[w * 2 + 1] = uhi; }
    __syncthreads();
  }
  unsigned long long un;
  {
    const unsigned ulo = unib[0] | unib[2] | unib[4] | unib[6];
    const unsigned uhi = unib[1] | unib[3] | unib[5] | unib[7];
    un = ((unsigned long long)__builtin_amdgcn_readfirstlane(uhi) << 32) | (unsigned long long)__builtin_amdgcn_readfirstlane(ulo);
  }
  const unsigned long long rowmask = ((unsigned long long)mhi << 32) | mlo;

#pragma unroll 1
  for (int pass = 0; pass < 2; ++pass) {
    REDERIVE();
#pragma unroll
    for (int m = 0; m < 4; ++m) {
      mrow[m] = -INFINITY; lrow[m] = 0.f;
#pragma unroll
      for (int dt = 0; dt < 4; ++dt) o[m][dt] = (f32x4){0.f, 0.f, 0.f, 0.f};
    }
    const unsigned short* kb = p.kvb + (size_t)(((2 + 2 * pass) * NB + b) * 2 + g) * S * 64;
    const unsigned short* vb = p.kvb + (size_t)(((3 + 2 * pass) * NB + b) * 2 + g) * S * 64;
    const unsigned long long upto = (ci == 63) ? ~0ull : ((1ull << (ci + 1)) - 1ull);
    const int jlo = max(0, ci - 8);
    unsigned long long rem = pass ? (upto & ~((1ull << jlo) - 1ull)) : (un & upto);
    const int jwin0 = pass ? ci - 8 : -100;
    int j = __ffsll((long long)rem) - 1;
    tile_fetch(rk, kb + (size_t)j * 4096, t);
    tile_fetch(rv, vb + (size_t)j * 4096, t);
    while (rem) {
      rem &= rem - 1;
      stage_k(rk, ldsK, t);
      stage_v(rv, ldsV, t);
      __syncthreads();
      const int jn = rem ? (__ffsll((long long)rem) - 1) : -1;
      if (jn >= 0) {
        tile_fetch(rk, kb + (size_t)jn * 4096, t);
        tile_fetch(rv, vb + (size_t)jn * 4096, t);
      }
      const bool rowok = pass ? true : (bool)((rowmask >> j) & 1ull);
      int hi = (j == ci) ? rloc : 63;
      const int lo = ((j == jwin0) ? rloc : -1) - 4 * fq;
      hi = (rowok ? hi : -1000) - 4 * fq;
      attn_tile<true>(o, mrow, lrow, qf, ldsK, ldsV, true, lo, hi, lane);
      __syncthreads();
      j = jn;
    }
#pragma unroll
    for (int m = 0; m < 4; ++m) {
      float l = lrow[m];
      l += bpx(l, lane, 16);
      l += bpx(l, lane, 32);
      const float sc = grow[m * 3 + 1 + pass] / l;
#pragma unroll
      for (int dt = 0; dt < 4; ++dt) {
        f32x4* dst = (f32x4*)(orow + m * 64 + dt * 16 + 4 * fq);
        const f32x4 tot = *dst + o[m][dt] * sc;
        if (pass == 0) *dst = tot;
        else *(uint2*)(p.onsab + tok * 512 + g * 256 + m * 64 + dt * 16 + 4 * fq) = pack4(tot);
      }
    }
  }
}

#define XB_TMO      128
#define XB_XCNT(j)  (256  + 64 * (j))
#define XB_XSUB(j)  (1280 + 64 * (j))
#define XB_XGEN(j)  (2304 + 64 * (j))
#define XB_TOP      3328
#define XB_TOPGEN   3392
#define XCD_BAR_WORDS 3456
#define XB_SPIN_CAP (1u << 18)

__device__ __forceinline__ unsigned xb_ld(unsigned* p)              { return __hip_atomic_load(p, __ATOMIC_RELAXED, __HIP_MEMORY_SCOPE_AGENT); }
__device__ __forceinline__ unsigned xb_add(unsigned* p, unsigned v) { return __hip_atomic_fetch_add(p, v, __ATOMIC_RELAXED, __HIP_MEMORY_SCOPE_AGENT); }
__device__ __forceinline__ unsigned xb_xcc_id() { return (unsigned)__builtin_amdgcn_s_getreg((3 << 11) | 20) & 0xFu; }
#define XB_SPIN(cond, bar) do { unsigned _sp = 0; while (cond) { __builtin_amdgcn_s_sleep(1); \
    if ((++_sp & 255u) == 0u) { if (xb_ld(&(bar)[XB_TMO])) break; if (_sp > XB_SPIN_CAP) { atomicAdd(&(bar)[XB_TMO], 1u); break; } } } } while (0)

struct XcdBarrier {
    unsigned* bar; unsigned x;
    volatile LAS unsigned* st;
};

__device__ __forceinline__ XcdBarrier xcd_barrier_post(unsigned* bar, volatile LAS unsigned* st) {
    XcdBarrier b; b.bar = bar; b.x = xb_xcc_id(); b.st = st;
    if (threadIdx.x == 0) (void)xb_add(&bar[XB_XCNT(b.x)], 1u);
    return b;
}
__device__ __forceinline__ void xcd_barrier_complete(unsigned* bar, unsigned x, unsigned& nloc, unsigned& nx) {
    const unsigned G = gridDim.x * gridDim.y * gridDim.z;
    unsigned sum, cnt, mine, sp = 0u;
    for (;;) {
        sum = 0u; cnt = 0u; mine = 0u;
#pragma unroll
        for (unsigned j = 0; j < 16; ++j) { const unsigned c = xb_ld(&bar[XB_XCNT(j)]); sum += c; cnt += (c > 0u) ? 1u : 0u; mine = (j == x) ? c : mine; }
        if (sum == G) break;
        __builtin_amdgcn_s_sleep(1);
        if ((++sp & 255u) == 0u) { if (xb_ld(&bar[XB_TMO])) break; if (sp > XB_SPIN_CAP) { atomicAdd(&bar[XB_TMO], 1u); break; } }
    }
    nloc = mine > 0u ? mine : 1u; nx = cnt > 0u ? cnt : 1u;
}

__device__ __forceinline__ void xcd_barrier(const XcdBarrier& b) {
    asm volatile("s_waitcnt vmcnt(0)" ::: "memory");
    __syncthreads();
    if (threadIdx.x == 0) {
        unsigned* bar = b.bar;
        __builtin_amdgcn_s_waitcnt(0);
        unsigned nloc = b.st[0], nx = b.st[1];
        if (nloc == 0u) { xcd_barrier_complete(bar, b.x, nloc, nx); b.st[0] = nloc; b.st[1] = nx; }
        const unsigned old = xb_add(&bar[XB_XSUB(b.x)], 1u);
        const unsigned gen = old / nloc;
        if (old + 1u == (gen + 1u) * nloc) {
            __builtin_amdgcn_fence(__ATOMIC_RELEASE, "agent");
            asm volatile("s_waitcnt vmcnt(0)" ::: "memory");
            const unsigned og = xb_add(&bar[XB_TOP], 1u);
            const unsigned tg = og / nx;
            if (og + 1u == (tg + 1u) * nx) xb_add(&bar[XB_TOPGEN], 1u);
            else XB_SPIN(xb_ld(&bar[XB_TOPGEN]) == tg, bar);
            __builtin_amdgcn_fence(__ATOMIC_ACQUIRE, "agent");
            xb_add(&bar[XB_XGEN(b.x)], 1u);
            asm volatile("s_waitcnt vmcnt(0)" ::: "memory");
        } else {
            XB_SPIN(xb_ld(&bar[XB_XGEN(b.x)]) == gen, bar);
            __builtin_amdgcn_fence(__ATOMIC_ACQUIRE, "agent");
            asm volatile("s_waitcnt vmcnt(0)" ::: "memory");
        }
    }
    __syncthreads();
}


#define PHASE_IDX int t_ = threadIdx.x; OPAQUE(t_); const int tid = t_, lane = t_ & 63, wib = t_ >> 6; \
  const int gthreads = gridDim.x * 256, gtid = blockIdx.x * 256 + t_, gwaves = gridDim.x * 4, gwave = blockIdx.x * 4 + wib; \
  (void)tid; (void)lane; (void)wib; (void)gthreads; (void)gtid; (void)gwaves; (void)gwave;

constexpr int SMEM_BYTES = GEMM_RING * GEMM_STAGE;

__device__ __forceinline__ void conv_job(const float* W, int K, int N, bf16_t* Wt, int tile, LAS unsigned char* lds) {
  const int tnn = (N + 127) >> 7;
  convert_tile(W, N, N, Wt, K, (tile / tnn) * 64, (tile % tnn) * 128, lds);
}

__global__ void __launch_bounds__(256, 2) mega(Params p) {
  __shared__ __attribute__((aligned(16))) unsigned char smem_raw[SMEM_BYTES + 16];
  float* smem = (float*)smem_raw;
  LAS unsigned char* lds = (LAS unsigned char*)smem_raw;
  volatile LAS unsigned* xb_st = (volatile LAS unsigned*)(lds + SMEM_BYTES);
  if (threadIdx.x < 4) xb_st[threadIdx.x] = 0u;
  __syncthreads();
  const XcdBarrier gbar = xcd_barrier_post(p.bar, xb_st);

  {
  PHASE_IDX
  constexpr int MODB = 192;
  if (blockIdx.x < MODB) {
    for (int i = tid; i < NB * D; i += 256) smem[i] = siluf_(p.c[i]);
    __syncthreads();
    const int j = blockIdx.x * 32 + (lane & 31), kh = lane >> 5;
    float a0 = 0.f, a1 = 0.f, a2 = 0.f, a3 = 0.f;
    const float* wp = p.w_ada + (size_t)(wib * 256 + kh) * (6 * D) + j;
#pragma unroll 32
    for (int i = 0; i < 128; ++i) {
      const float w = wp[(size_t)(2 * i) * (6 * D)];
      const int kk = wib * 256 + 2 * i + kh;
      a0 = fmaf(smem[kk], w, a0); a1 = fmaf(smem[D + kk], w, a1);
      a2 = fmaf(smem[2 * D + kk], w, a2); a3 = fmaf(smem[3 * D + kk], w, a3);
    }
    a0 += bpx(a0, lane, 32); a1 += bpx(a1, lane, 32); a2 += bpx(a2, lane, 32); a3 += bpx(a3, lane, 32);
    __syncthreads();
    if (lane < 32) {
      smem[(wib * 4 + 0) * 32 + lane] = a0; smem[(wib * 4 + 1) * 32 + lane] = a1;
      smem[(wib * 4 + 2) * 32 + lane] = a2; smem[(wib * 4 + 3) * 32 + lane] = a3;
    }
    __syncthreads();
    if (lane < 32) {
      const int b = wib;
      const float v = p.b_ada[j] + ((smem[(0 * 4 + b) * 32 + lane] + smem[(1 * 4 + b) * 32 + lane]) +
                                    (smem[(2 * 4 + b) * 32 + lane] + smem[(3 * 4 + b) * 32 + lane]));
      p.mod[b * 6 * D + j] = v;
    }
    __syncthreads();
  }
  const int sb0 = (gridDim.x >= MODB + 144) ? MODB : 0;
  for (int idx = gtid - sb0 * 256; idx >= 0 && idx < 32 * 64; idx += gthreads) {
    const int g = idx / 64;
    const double dt = exp((double)p.log_dt[g]);
    const double lr = p.a_re[idx], li = p.a_im[idx];
    const double mag1 = exp(lr * dt);
    const double br = mag1 * cos(li * dt), bi = mag1 * sin(li * dt);
    {
      double pr_ = 1.0, pi_ = 0.0;
#pragma unroll 1
      for (int d = 0; d <= 16; ++d) {
        p.pw[(idx * 17 + d) * 2] = (float)pr_;
        p.pw[(idx * 17 + d) * 2 + 1] = (float)pi_;
        const double nr_ = pr_ * br - pi_ * bi, ni_ = pr_ * bi + pi_ * br;
        pr_ = nr_; pi_ = ni_;
      }
    }
    const double nr = br - 1.0, ni = bi;
    const double den = lr * lr + li * li;
    const double cr = (nr * lr + ni * li) / den, ci = (ni * lr - nr * li) / den;
    for (int q = 0; q < 16; ++q) {
      const double wr = p.b_re[idx * 16 + q], wi = p.b_im[idx * 16 + q];
      p.bbar[(idx * 16 + q) * 2] = (float)(cr * wr - ci * wi);
      p.bbar[(idx * 16 + q) * 2 + 1] = (float)(cr * wi + ci * wr);
    }
  }
  for (int idx = gtid; idx < NE; idx += gthreads) { p.cnt[idx] = 0; p.cursor[idx] = 0; }
  for (int o = gwave - (sb0 ? (sb0 + 8) * 4 : 0); o >= 0 && o < 512; o += gwaves) {
    const int kv = o >> 8, j = o & 255;
    const float* pe = kv ? p.pe_v : p.pe_k;
    const float* w1 = kv ? p.w_cmp_v1 : p.w_cmp_k1;
    float acc = 0.f;
    for (int k = lane; k < 2048; k += 64) acc = fmaf(pe[k], w1[(size_t)k * 256 + j], acc);
    acc = wsum(acc, lane);
    if (lane == 0) p.cbias[o] = acc;
  }
  {
    const int G = gridDim.x;
    const int first = (G > MODB) ? MODB : 0, nb = G - first;
    if ((int)blockIdx.x >= first) {
      for (int job = blockIdx.x - first; job < 1040; job += nb) {
        if (job < 496) conv_job(p.w_in, D, INC, p.w_inT, job, lds);
        else if (job < 560) conv_job(p.w_cmp_k1, 2048, 256, p.wc1T, job - 496, lds);
        else if (job < 624) conv_job(p.w_cmp_v1, 2048, 256, p.wc1T + 256 * 2048, job - 560, lds);
        else if (job < 656) conv_job(p.w_glu, 512, 512, p.wgluT, job - 624, lds);
        else if (job < 720) conv_job(p.w_up_attn, 512, D, p.wuaT, job - 656, lds);
        else if (job < 784) conv_job(p.w_up_ssm, 512, D, p.wusT, job - 720, lds);
        else if (job < 912) conv_job(p.w_out, D, D, p.woutT, job - 784, lds);
        else if (job < 944) conv_job(p.w_router, D, NE, p.wrT, job - 912, lds);
        else if (job < 976) conv_job(p.ws_gate, D, DE, p.wsgT, job - 944, lds);
        else if (job < 1008) conv_job(p.ws_up, D, DE, p.wsuT, job - 976, lds);
        else conv_job(p.ws_down, DE, D, p.wsdT, job - 1008, lds);
      }
    }
  }
  }
  xcd_barrier(gbar);

  {
  PHASE_IDX
  for (int row = gwave; row < NT; row += gwaves) {
    const int b = row / S;
    const float* xr = p.x + (size_t)row * D;
    f32x4 v[4];
    float ss = 0.f;
#pragma unroll
    for (int i = 0; i < 4; ++i) {
      v[i] = *(const f32x4*)(xr + i * 256 + lane * 4);
      ss += (v[i][0] * v[i][0] + v[i][1] * v[i][1]) + (v[i][2] * v[i][2] + v[i][3] * v[i][3]);
    }
    ss = wsum(ss, lane);
    const float r = rsqrtf(ss * (1.0f / D) + EPS);
    const float* md = p.mod + b * 6 * D;
#pragma unroll
    for (int i = 0; i < 4; ++i) {
      const int col = i * 256 + lane * 4;
      const f32x4 gg = *(const f32x4*)(p.g_norm1 + col), sc = *(const f32x4*)(md + D + col), sh = *(const f32x4*)(md + col);
      *(uint2*)(p.h + (size_t)row * D + col) = pack4(v[i] * r * gg * (sc + 1.0f) + sh);
    }
  }
  for (int idx = gtid; idx < 32 * 128 * 256; idx += gthreads) {
    const int k = idx & 255, col = (idx >> 8) & 127, g = idx >> 15;
    const int n = col >> 1, ri = col & 1, sidx = k >> 4, q = k & 15;
    const int gn = g * 64 + n;
    const float pr_ = p.pw[(gn * 17 + 15 - sidx) * 2], pi_ = p.pw[(gn * 17 + 15 - sidx) * 2 + 1];
    const float br = p.bbar[(gn * 16 + q) * 2], bi = p.bbar[(gn * 16 + q) * 2 + 1];
    const float v = ri ? (pr_ * bi + pi_ * br) : (pr_ * br - pi_ * bi);
    p.w1T[idx] = (bf16_t)(cvt_pk_bf16(v, 0.f) & 0xffffu);
  }
  for (int idx = gtid; idx < 32 * 16 * 256; idx += gthreads) {
    const int q = idx & 15, pp = (idx >> 4) & 15, d = (idx >> 8) & 15, g = idx >> 12;
    float acc = (d == 0 && pp == q) ? p.d_skip[g * 16 + pp] : 0.f;
    for (int n = 0; n < 64; ++n) {
      const int gn = g * 64 + n;
      const float cr = p.c_re[(g * 16 + pp) * 64 + n], ci = p.c_im[(g * 16 + pp) * 64 + n];
      const float pr_ = p.pw[(gn * 17 + d) * 2], pi_ = p.pw[(gn * 17 + d) * 2 + 1];
      const float br = p.bbar[(gn * 16 + q) * 2], bi = p.bbar[(gn * 16 + q) * 2 + 1];
      const float tr = cr * pr_ - ci * pi_, ti = cr * pi_ + ci * pr_;
      acc += tr * br - ti * bi;
    }
    p.kd[idx] = acc;
  }
  for (int idx = gtid; idx < 32 * 256 * 128; idx += gthreads) {
    const int k = idx & 127, col = (idx >> 7) & 255, g = idx >> 15;
    const int i = col >> 4, pp = col & 15, n = k >> 1, ri = k & 1;
    const int gn = g * 64 + n;
    const float cr = p.c_re[(g * 16 + pp) * 64 + n], ci = p.c_im[(g * 16 + pp) * 64 + n];
    const float pr_ = p.pw[(gn * 17 + i + 1) * 2], pi_ = p.pw[(gn * 17 + i + 1) * 2 + 1];
    const float v = ri ? -(cr * pi_ + ci * pr_) : (cr * pr_ - ci * pi_);
    p.wyT[((size_t)g * 256 + col) * 384 + k] = (bf16_t)(cvt_pk_bf16(v, 0.f) & 0xffffu);
  }
  }
  xcd_barrier(gbar);

  {
  PHASE_IDX
  {
    constexpr int TN = (INC + TNW - 1) / TNW;
    int mt_, nt_;
    for (int it = 0; xcd_tile(it, NT / TM, TN, mt_, nt_); ++it) {
      const int m0 = mt_ * TM, n0 = nt_ * TNW;
      gemm128<true>(
          D, [&](int r) { return p.h + (size_t)(m0 + r) * D; },
          [&](int c) { return p.w_inT + (size_t)min(n0 + c, INC - 1) * D; },
          [&](const f32x4 (&acc)[4][8], int wr, int wc, int fr, int fq) {
#pragma unroll
            for (int sg = 0; sg < 2; ++sg) {
              const int cw = n0 + wc * 128 + sg * 64;
              if (cw < C_GN) {
                const bool isq = cw < C_KC;
                const int slot = isq ? 0 : (cw - C_KC) >> 7;
                const bool norm = isq || slot == 2 || slot == 4;
                const float* gain = isq ? p.q_gain : (slot == 2 ? p.ks_gain : p.kw_gain);
                const float post = isq ? ATT_SCALE * 1.4426950408889634f : 1.0f;
#pragma unroll
                for (int m = 0; m < 4; ++m) {
                  float r = 1.0f;
                  if (norm) {
                    float ss = 0.f;
#pragma unroll
                    for (int n = 0; n < 4; ++n)
#pragma unroll
                      for (int jj = 0; jj < 4; ++jj) ss = fmaf(acc[m][sg * 4 + n][jj], acc[m][sg * 4 + n][jj], ss);
                    ss += bpx(ss, fq * 16 + fr, 16);
                    ss += bpx(ss, fq * 16 + fr, 32);
                    r = rsqrtf(ss * (1.0f / 64) + EPS) * post;
                  }
#pragma unroll
                  for (int n = 0; n < 4; ++n) {
                    f32x4 v = acc[m][sg * 4 + n] * r;
                    if (norm) v = v * *(const f32x4*)(gain + n * 16 + 4 * fq);
                    tile_out_stage(lds, wr, wc, fr, fq, m, sg * 4 + n, pack4(v));
                  }
                }
              } else {
#pragma unroll
                for (int m = 0; m < 4; ++m) {
                  const size_t tok = m0 + wr * 64 + m * 16 + fr;
#pragma unroll
                  for (int n = 0; n < 4; ++n) {
                    const int c = cw + n * 16 + 4 * fq;
                    f32x4 v = acc[m][sg * 4 + n];
                    if (c >= C_U && c < C_GA) {
                      tile_out_stage(lds, wr, wc, fr, fq, m, sg * 4 + n, pack4(v));
                    } else {
#pragma unroll
                      for (int j = 0; j < 4; ++j) v[j] = sigmoidf_(v[j]);
                      if (c < C_U) *(f32x4*)(p.gn + tok * 24 + (c - C_GN)) = v;
                      else tile_out_stage(lds, wr, wc, fr, fq, m, sg * 4 + n, pack4(v));
                    }
                  }
                }
              }
            }
          },
          lds);
      {
        int t = threadIdx.x;
        OPAQUE(t);
        __syncthreads();
#pragma unroll 4
        for (int i = 0; i < 16; ++i) {
          const int q = t + i * 256, row = q >> 5, piece = q & 31;
          const int c = n0 + piece * 8;
          const size_t tok = m0 + row;
          bf16_t* dst = nullptr;
          if (c < C_KC) dst = p.qb + tok * 512 + c;
          else if (c < C_GN) {
            const int slot = (c - C_KC) >> 7, gg = ((c - C_KC) >> 6) & 1;
            dst = p.kvb + ((size_t)((slot * NB + (tok >> 12)) * 2 + gg) * S + (tok & (S - 1))) * 64 + (c & 63);
          } else if (c < C_U) dst = nullptr;
          else if (c < C_GA) { const int ch = c - C_U; dst = p.a3 + ((size_t)(ch >> 4) * 1024 + (tok >> 4)) * 384 + 128 + (tok & 15) * 16 + (ch & 15); }
          else if (c < C_GS) dst = p.ga + tok * D + (c - C_GA);
          else if (c < INC) dst = p.gs + tok * D + (c - C_GS);
          if (dst) *(u32x4*)dst = *(const LAS u32x4*)(lds + row * OSTRIDE + piece * 16);
        }
        __syncthreads();
      }
    }
  }
  for (int idx = gtid; idx < 32 * 256 * 256; idx += gthreads) {
    const int k = idx & 255, col = (idx >> 8) & 255, g = idx >> 16;
    const int i = col >> 4, pp = col & 15, sidx = k >> 4, q = k & 15;
    const float v = (i >= sidx) ? p.kd[((g * 16 + (i - sidx)) * 16 + pp) * 16 + q] : 0.f;
    p.wyT[((size_t)g * 256 + col) * 384 + 128 + k] = (bf16_t)(cvt_pk_bf16(v, 0.f) & 0xffffu);
  }
  }
  xcd_barrier(gbar);

  {
  PHASE_IDX
  for (int job = blockIdx.x; job < 2 * 8 * 16; job += gridDim.x) {
    const int kv = job >> 7, ks = (job >> 4) & 7, m0 = (job & 15) * 128;
    float* hp = p.hidp + (size_t)(ks * 2 + kv) * 2040 * 256;
    gemm128<true>(
        256,
        [&](int r) {
          const int rr = min(m0 + r, NB * NCMP * 2 - 1);
          const int b = rr / (NCMP * 2), n = (rr >> 1) % NCMP, g = rr & 1;
          return p.kvb + ((size_t)((kv * NB + b) * 2 + g) * S + 16 * n) * 64 + ks * 256;
        },
        [&](int c) { return p.wc1T + (size_t)(kv * 256 + c) * 2048 + ks * 256; },
        [&](const f32x4 (&acc)[4][8], int wr, int wc, int fr, int fq) {
#pragma unroll
          for (int m = 0; m < 4; ++m) {
            const int r = m0 + wr * 64 + m * 16 + fr;
            if (r < NB * NCMP * 2) {
#pragma unroll
              for (int n = 0; n < 8; ++n) *(f32x4*)(hp + (size_t)r * 256 + wc * 128 + n * 16 + 4 * fq) = acc[m][n];
            }
          }
        },
        lds);
  }
  int mt_, g;
  for (int it = 0; xcd_tile(it, 8, 32, mt_, g); ++it) {
    const int m0 = mt_ * 128;
    gemm128<true>(
        256, [&](int r) { return p.a3 + ((size_t)g * 1024 + m0 + r) * 384 + 128; },
        [&](int c) { return p.w1T + ((size_t)g * 128 + (c & 127)) * 256; },
        [&](const f32x4 (&acc)[4][8], int wr, int wc, int fr, int fq) {
          if (wc == 0) {
#pragma unroll
            for (int m = 0; m < 4; ++m)
#pragma unroll
              for (int n = 0; n < 8; ++n)
                *(f32x4*)(p.lbuf + ((size_t)g * 1024 + m0 + wr * 64 + m * 16 + fr) * 128 + n * 16 + 4 * fq) = acc[m][n];
          }
        },
        lds);
  }
  }
  xcd_barrier(gbar);

  {
  PHASE_IDX
  for (int wv = gwave; wv < 2 * NB * NCMP * 2; wv += gwaves) {
    const int kv = wv / (NB * NCMP * 2), r = wv % (NB * NCMP * 2);
    const int b = r / (NCMP * 2), n = (r >> 1) % NCMP, g = r & 1;
    const float* w2 = kv ? p.w_cmp_v2 : p.w_cmp_k2;
    {
      f32x4 hsum = *(const f32x4*)(p.cbias + kv * 256 + lane * 4);
#pragma unroll
      for (int ks = 0; ks < 8; ++ks) hsum = hsum + *(const f32x4*)(p.hidp + ((size_t)(ks * 2 + kv) * 2040 + r) * 256 + lane * 4);
#pragma unroll
      for (int j = 0; j < 4; ++j) hsum[j] = geluf_(hsum[j]);
      WSYNC();
      *(f32x4*)(smem + wib * 256 + lane * 4) = hsum;
      WSYNC();
    }
    const float* hid = smem + wib * 256;
    float acc = 0.f;
    for (int j = 0; j < 256; ++j) acc = fmaf(hid[j], w2[j * 64 + lane], acc);
    if (kv == 0) {
      const float ss = wsum(acc * acc, lane);
      acc = acc * rsqrtf(ss * (1.0f / 64) + EPS) * p.kc_gain[lane];
    }
    const float other = bpx(acc, lane, 1);
    if ((lane & 1) == 0)
      *(unsigned*)(p.cmpb + ((size_t)((kv * NB + b) * 2 + g) * 256 + n) * 64 + lane) = cvt_pk_bf16(acc, other);
  }
  for (int idx = gtid; idx < 2 * NB * 2 * 32; idx += gthreads)
    *(unsigned*)(p.cmpb + ((size_t)(idx >> 5) * 256 + 255) * 64 + (idx & 31) * 2) = 0u;
  for (int idx = gtid; idx < 32 * NB * 64; idx += gthreads) {
    const int n = idx & 63, b = (idx >> 6) & 3, g = idx >> 8;
    const int gn = g * 64 + n;
    const float lr = p.pw[(gn * 17 + 16) * 2], li = p.pw[(gn * 17 + 16) * 2 + 1];
    float hr_ = 0.f, hi_ = 0.f;
    const size_t row0 = (size_t)g * 1024 + b * 256;
#pragma unroll 1
    for (int c0 = 0; c0 < 256; c0 += 16) {
      float2 l2[16];
#pragma unroll
      for (int i = 0; i < 16; ++i) l2[i] = *(const float2*)(p.lbuf + (row0 + c0 + i) * 128 + n * 2);
#pragma unroll
      for (int i = 0; i < 16; ++i) {
        *(unsigned*)(p.a3 + (row0 + c0 + i) * 384 + n * 2) = cvt_pk_bf16(hr_, hi_);
        const float nr = lr * hr_ - li * hi_ + l2[i].x;
        const float ni = lr * hi_ + li * hr_ + l2[i].y;
        hr_ = nr; hi_ = ni;
      }
    }
  }
  }
  xcd_barrier(gbar);

  {
  PHASE_IDX
  const int G = gridDim.x;
  const bool split = G >= 512;
  if (!split || blockIdx.x < 256) {
    for (int u = blockIdx.x; u < 256; u += (split ? 256 : G)) {
      const int bg = u >> 5, pr = u & 31;
      __builtin_amdgcn_s_setprio(2);
#pragma unroll 1
      for (int half = 0; half < 2; ++half) attn_chunk(p, lds, bg >> 1, bg & 1, half ? pr : 63 - pr);
      __builtin_amdgcn_s_setprio(0);
    }
  }
  if (!split || blockIdx.x >= 256) {
    const int x8 = blockIdx.x & 7, nsl = split ? ((G - 256) >> 3) : 0, sl = split ? (((int)blockIdx.x - 256) >> 3) : 0;
    for (int it = 0;; ++it) {
      int tile;
      if (split && ((G & 7) == 0)) { const int q = sl + it * nsl; if (q >= 32) break; tile = ((x8 + 8 * (q >> 3)) << 3) | (q & 7); }
      else { tile = (split ? (int)blockIdx.x - 256 : (int)blockIdx.x) + it * (split ? G - 256 : G); if (tile >= 256) break; }
      const int g = tile >> 3, m0 = (tile & 7) * 128, n0 = 0;
      gemm128(
          384, [&](int r) { return p.a3 + ((size_t)g * 1024 + m0 + r) * 384; },
          [&](int c) { return p.wyT + ((size_t)g * 256 + n0 + c) * 384; },
          [&](const f32x4 (&acc)[4][8], int wr, int wc, int fr, int fq) {
#pragma unroll
            for (int m = 0; m < 4; ++m)
#pragma unroll
              for (int n = 0; n < 8; ++n) {
                const int col = n0 + wc * 128 + n * 16 + 4 * fq;
                const size_t tok = (size_t)(m0 + wr * 64 + m * 16 + fr) * 16 + (col >> 4);
                f32x4 v = acc[m][n];
#pragma unroll
                for (int j = 0; j < 4; ++j) v[j] = geluf_(v[j]);
                *(uint2*)(p.z + tok * 512 + g * 16 + (col & 15)) = pack4(v);
              }
          },
          lds);
    }
    const int cb = split ? (int)blockIdx.x - 256 : (int)blockIdx.x, cn = split ? G - 256 : G;
    for (int job = cb; job < NE * 96; job += cn) {
      const int e = job / 96, rem = job - e * 96, which = rem >> 5, tile = rem & 31;
      if (which == 0) conv_job(p.w_gate + (size_t)e * D * DE, D, DE, p.wgT + (size_t)e * DE * D, tile, lds);
      else if (which == 1) conv_job(p.w_up + (size_t)e * D * DE, D, DE, p.wuT + (size_t)e * DE * D, tile, lds);
      else conv_job(p.w_down + (size_t)e * DE * D, DE, D, p.wdT + (size_t)e * D * DE, tile, lds);
    }
  }
  }
  xcd_barrier(gbar);

  {
  PHASE_IDX
  gemm_phase_bf16(
      NT, 512, 512, [&](int m) { return p.z + (size_t)m * 512; }, [&](int n) { return p.wgluT + (size_t)n * 512; },
      [&](int m, int n, f32x4 v) {
        const f32x4 zz = unpack4(*(const uint2*)(p.z + (size_t)m * 512 + n));
#pragma unroll
        for (int j = 0; j < 4; ++j) v[j] = zz[j] * sigmoidf_(v[j] + p.b_glu[n + j]);
        return v;
      },
      p.yssm, 512, lds);
  gemm_phase_bf16(
      NT, D, 512, [&](int m) { return p.onsab + (size_t)m * 512; }, [&](int n) { return p.wuaT + (size_t)n * 512; },
      [&](int m, int n, f32x4 v) {
        const f32x4 gg = unpack4(*(const uint2*)(p.ga + (size_t)m * D + n));
        return gg * v;
      },
      p.mtmp, D, lds);
  }
  xcd_barrier(gbar);
  {
  PHASE_IDX
  gemm_phase_bf16(
      NT, D, 512, [&](int m) { return p.yssm + (size_t)m * 512; }, [&](int n) { return p.wusT + (size_t)n * 512; },
      [&](int m, int n, f32x4 v) {
        const f32x4 gg = unpack4(*(const uint2*)(p.gs + (size_t)m * D + n));
        const f32x4 prev = unpack4(*(const uint2*)(p.mtmp + (size_t)m * D + n));
        return prev + gg * v;
      },
      p.merged, D, lds);
  }
  xcd_barrier(gbar);
  {
  PHASE_IDX
  gemm_phase(
      NT, D, D, [&](int m) { return p.merged + (size_t)m * D; }, [&](int n) { return p.woutT + (size_t)n * D; },
      [&](int m, int n, f32x4 v) {
        const int b = m / S;
        const f32x4 xx = *(const f32x4*)(p.x + (size_t)m * D + n);
        const f32x4 gt = *(const f32x4*)(p.mod + b * 6 * D + 2 * D + n);
        *(f32x4*)(p.xmid + (size_t)m * D + n) = xx + gt * v;
      },
      lds);
  }
  xcd_barrier(gbar);

  {
  PHASE_IDX
  for (int row = gwave; row < NT; row += gwaves) {
    const int b = row / S;
    const float* xr = p.xmid + (size_t)row * D;
    f32x4 v[4];
    float ss = 0.f;
#pragma unroll
    for (int i = 0; i < 4; ++i) {
      v[i] = *(const f32x4*)(xr + i * 256 + lane * 4);
      ss += (v[i][0] * v[i][0] + v[i][1] * v[i][1]) + (v[i][2] * v[i][2] + v[i][3] * v[i][3]);
    }
    ss = wsum(ss, lane);
    const float r = rsqrtf(ss * (1.0f / D) + EPS);
    const float* md = p.mod + b * 6 * D;
#pragma unroll
    for (int i = 0; i < 4; ++i) {
      const int col = i * 256 + lane * 4;
      const f32x4 gg = *(const f32x4*)(p.g_norm2 + col), sc = *(const f32x4*)(md + 4 * D + col), sh = *(const f32x4*)(md + 3 * D + col);
      *(uint2*)(p.h + (size_t)row * D + col) = pack4(v[i] * r * gg * (sc + 1.0f) + sh);
    }
  }
  }
  xcd_barrier(gbar);

  {
  PHASE_IDX
  int mt_, nt_;
  for (int it = 0; xcd_tile(it, NT / TM, 3, mt_, nt_); ++it) {
    const int m0 = mt_ * TM;
    if (nt_ == 0) {
      gemm128<true>(
          D, [&](int r) { return p.h + (size_t)(m0 + r) * D; }, [&](int c) { return p.wrT + (size_t)c * D; },
          [&](const f32x4 (&acc)[4][8], int wr, int wc, int fr, int fq) {
#pragma unroll
            for (int m = 0; m < 4; ++m)
#pragma unroll
              for (int n = 0; n < 8; ++n) {
                f32x4 v = acc[m][n];
#pragma unroll
                for (int j = 0; j < 4; ++j) v[j] = sigmoid_acc(v[j]);
                *(f32x4*)(p.scores + (size_t)(m0 + wr * 64 + m * 16 + fr) * NE + wc * 128 + n * 16 + 4 * fq) = v;
              }
          },
          lds);
    } else {
      const int ct = nt_ - 1;
      gemm128<true>(
          D, [&](int r) { return p.h + (size_t)(m0 + r) * D; },
          [&](int c) {
            const int hid = ct * 128 + (c >> 7) * 64 + ((c >> 4) & 3) * 16 + (c & 15);
            return (((c >> 6) & 1) ? p.wsuT : p.wsgT) + (size_t)hid * D;
          },
          [&](const f32x4 (&acc)[4][8], int wr, int wc, int fr, int fq) {
#pragma unroll
            for (int m = 0; m < 4; ++m)
#pragma unroll
              for (int n = 0; n < 4; ++n) {
                f32x4 v;
#pragma unroll
                for (int j = 0; j < 4; ++j) v[j] = siluf_(acc[m][n][j]) * acc[m][n + 4][j];
                tile_out_put(lds, wr * 64 + m * 16 + fr, wc * 64 + n * 16 + 4 * fq, pack4(v));
              }
          },
          lds);
      tile_out_flush128(lds, 128, [&](int r) { return p.hs + (size_t)(m0 + r) * DE + ct * 128; });
    }
  }
  }
  xcd_barrier(gbar);

  {
  PHASE_IDX
  for (int tok = gwave; tok < NT; tok += gwaves) {
    const float4 sc4 = *reinterpret_cast<const float4*>(p.scores + (size_t)tok * NE + lane * 4);
    const float4 bi4 = *reinterpret_cast<const float4*>(p.router_bias + lane * 4);
    const float sc[4] = {sc4.x, sc4.y, sc4.z, sc4.w};
    float bz[4] = {sc4.x + bi4.x, sc4.y + bi4.y, sc4.z + bi4.z, sc4.w + bi4.w};
    float m1 = -INFINITY, m2 = -INFINITY;
#pragma unroll
    for (int i = 0; i < 4; ++i) {
      const float v = bz[i];
      if (v > m1) { m2 = m1; m1 = v; } else if (v > m2) { m2 = v; }
    }
#pragma unroll
    for (int o = 1; o < 8; o <<= 1) {
      const float o1 = bpx(m1, lane, o), o2 = bpx(m2, lane, o);
      const float n1 = fmaxf(m1, o1);
      const float n2 = fmaxf(fminf(m1, o1), fmaxf(m2, o2));
      m1 = n1; m2 = n2;
    }
    const float gs = m1 + m2;
    const int mygrp = lane >> 3;
    int grank = 0;
#pragma unroll
    for (int g2 = 0; g2 < 8; ++g2) {
      const float og = bpl(gs, g2 * 8);
      grank += (og > gs || (og == gs && g2 < mygrp)) ? 1 : 0;
    }
    const bool gsel = grank < 4;
#pragma unroll
    for (int i = 0; i < 4; ++i) if (!gsel) bz[i] = -INFINITY;
    unsigned taken = 0;
    float wsel = 0.f;
    int esel = 0;
    float wtot = 0.f;
#pragma unroll 1
    for (int k = 0; k < TOPK; ++k) {
      float bv = -INFINITY; int bidx = 1 << 30;
#pragma unroll
      for (int i = 0; i < 4; ++i) {
        if (!((taken >> i) & 1u) && bz[i] > bv) { bv = bz[i]; bidx = lane * 4 + i; }
      }
#pragma unroll
      for (int o = 32; o > 0; o >>= 1) {
        const float ov = bpx(bv, lane, o);
        const int oi = bpxi(bidx, lane, o);
        if (ov > bv || (ov == bv && oi < bidx)) { bv = ov; bidx = oi; }
      }
      const int owner = bidx >> 2, slot = bidx & 3;
      float sv = 0.f;
      if (lane == owner) {
        taken |= 1u << slot;
        sv = (slot == 0) ? sc[0] : (slot == 1) ? sc[1] : (slot == 2) ? sc[2] : sc[3];
      }
      sv = bpl(sv, owner);
      wtot += sv;
      if (lane == k) { wsel = sv; esel = bidx; }
    }
    if (lane < TOPK) {
      p.eidx[tok * TOPK + lane] = esel;
      p.ew[tok * TOPK + lane] = wsel / wtot * 2.5f;
      atomicAdd(&p.cnt[esel], 1);
    }
  }
  gemm_phase(
      NT, D, DE, [&](int m) { return p.hs + (size_t)m * DE; }, [&](int n) { return p.wsdT + (size_t)n * DE; },
      [&](int m, int n, f32x4 v) {
        const int b = m / S;
        const f32x4 xx = *(const f32x4*)(p.xmid + (size_t)m * D + n);
        const f32x4 gt = *(const f32x4*)(p.mod + b * 6 * D + 5 * D + n);
        *(f32x4*)(p.out + (size_t)m * D + n) = xx + gt * v;
      },
      lds);
  }
  xcd_barrier(gbar);

  {
  PHASE_IDX
  {
    int* soff = (int*)smem;
    int* srt = soff + 320;
    const int myc = p.cnt[tid];
    soff[tid] = myc;
    srt[tid] = (myc + 127) >> 7;
    __syncthreads();
    for (int st = 1; st < 256; st <<= 1) {
      const int a0 = (tid >= st) ? soff[tid - st] : 0;
      __syncthreads();
      soff[tid] += a0;
      __syncthreads();
    }
    const int exo = soff[tid] - myc;
    __syncthreads();
    soff[tid] = exo;
    if (blockIdx.x == 0) {
      p.off[tid] = exo;
      if (tid == 255) p.off[NE] = exo + myc;
    }
    __syncthreads();
    if (blockIdx.x == 0 && tid < 8) {
      int acc = 0;
      for (int i = 0; i < 32; ++i) { p.xrts[tid * 33 + i] = acc; acc += srt[tid + 8 * i]; }
      p.xrts[tid * 33 + 32] = acc;
    }
    for (int idx = gtid; idx < NASSIGN; idx += gthreads) {
      const int e = p.eidx[idx];
      const int pos = soff[e] + atomicAdd(&p.cursor[e], 1);
      p.stok[pos] = idx / TOPK;
      p.sw[pos] = p.ew[idx];
      p.apos[idx] = pos;
    }
    __syncthreads();
  }
  }
  xcd_barrier(gbar);

  {
  PHASE_IDX
  {
    const int x8 = blockIdx.x & 7, ns8 = ((int)gridDim.x - x8 + 7) >> 3;
    const int* xr = p.xrts + x8 * 33;
    const int total_rt = xr[32];
    for (int tile = blockIdx.x >> 3; tile < total_rt * 2; tile += ns8) {
      const int rt = tile >> 1, ct = tile & 1;
      const int ei = find_idx(xr, 32, rt);
      const int e = x8 + 8 * ei;
      const int pos0 = p.off[e] + (rt - xr[ei]) * 128;
      const int mvalid = min(128, p.off[e] + p.cnt[e] - pos0);
      const bf16_t* wg = p.wgT + (size_t)e * DE * D;
      const bf16_t* wu = p.wuT + (size_t)e * DE * D;
      gemm128<true>(
          D, [&](int r) { return p.h + (size_t)p.stok[pos0 + min(r, mvalid - 1)] * D; },
          [&](int c) {
            const int hid = ct * 128 + (c >> 7) * 64 + ((c >> 4) & 3) * 16 + (c & 15);
            return (((c >> 6) & 1) ? wu : wg) + (size_t)hid * D;
          },
          [&](const f32x4 (&acc)[4][8], int wr, int wc, int fr, int fq) {
#pragma unroll
            for (int m = 0; m < 4; ++m)
#pragma unroll
              for (int n = 0; n < 4; ++n) {
                f32x4 v;
#pragma unroll
                for (int j = 0; j < 4; ++j) v[j] = siluf_(acc[m][n][j]) * acc[m][n + 4][j];
                tile_out_put(lds, wr * 64 + m * 16 + fr, wc * 64 + n * 16 + 4 * fq, pack4(v));
              }
          },
          lds);
      tile_out_flush128(lds, mvalid, [&](int r) { return p.hr + (size_t)(pos0 + r) * DE + ct * 128; });
    }
  }
  }
  xcd_barrier(gbar);
  {
  PHASE_IDX
  {
    const int x8 = blockIdx.x & 7, ns8 = ((int)gridDim.x - x8 + 7) >> 3;
    const int* xr = p.xrts + x8 * 33;
    const int total_rt = xr[32];
    for (int tile = blockIdx.x >> 3; tile < total_rt * 4; tile += ns8) {
      const int rt = tile >> 2, ct = tile & 3;
      const int ei = find_idx(xr, 32, rt);
      const int e = x8 + 8 * ei;
      const int pos0 = p.off[e] + (rt - xr[ei]) * 128;
      const int mvalid = min(128, p.off[e] + p.cnt[e] - pos0);
      const bf16_t* wd = p.wdT + (size_t)e * D * DE + (size_t)(ct * 256) * DE;
      gemm128<true>(
          DE, [&](int r) { return p.hr + (size_t)(pos0 + min(r, mvalid - 1)) * DE; },
          [&](int c) { return wd + (size_t)c * DE; },
          [&](const f32x4 (&acc)[4][8], int wr, int wc, int fr, int fq) {
#pragma unroll
            for (int m = 0; m < 4; ++m) {
              const float wgt = p.sw[pos0 + min(wr * 64 + m * 16 + fr, mvalid - 1)];
#pragma unroll
              for (int n = 0; n < 8; ++n) tile_out_stage(lds, wr, wc, fr, fq, m, n, pack4(acc[m][n] * wgt));
            }
          },
          lds);
      tile_out_flush(lds, mvalid, [&](int r) { return p.yk + (size_t)(pos0 + r) * D + ct * 256; });
    }
  }
  }
  xcd_barrier(gbar);
  {
  PHASE_IDX
  for (int tok = gwave; tok < NT; tok += gwaves) {
    const int b = tok / S;
    const int4 ps0 = *(const int4*)(p.apos + tok * TOPK), ps1 = *(const int4*)(p.apos + tok * TOPK + 4);
    const int pos8[8] = {ps0.x, ps0.y, ps0.z, ps0.w, ps1.x, ps1.y, ps1.z, ps1.w};
    u32x4 ra_[8], rc_[8];
#pragma unroll
    for (int k = 0; k < TOPK; ++k) {
      const u32x4* src = (const u32x4*)(p.yk + (size_t)pos8[k] * D + lane * 16);
      ra_[k] = src[0]; rc_[k] = src[1];
    }
    float acc[16];
#pragma unroll
    for (int i = 0; i < 16; ++i) acc[i] = 0.f;
#pragma unroll
    for (int k = 0; k < TOPK; ++k) {
      const unsigned wv[8] = {ra_[k].x, ra_[k].y, ra_[k].z, ra_[k].w, rc_[k].x, rc_[k].y, rc_[k].z, rc_[k].w};
#pragma unroll
      for (int i = 0; i < 8; ++i) {
        acc[2 * i] += __uint_as_float(wv[i] << 16);
        acc[2 * i + 1] += __uint_as_float(wv[i] & 0xffff0000u);
      }
    }
    float* dst = p.out + (size_t)tok * D + lane * 16;
    const float* gt = p.mod + b * 6 * D + 5 * D + lane * 16;
#pragma unroll
    for (int i = 0; i < 4; ++i) {
      f32x4 o4 = *(f32x4*)(dst + 4 * i);
      const f32x4 g4 = *(const f32x4*)(gt + 4 * i);
#pragma unroll
      for (int j = 0; j < 4; ++j) o4[j] += g4[j] * acc[4 * i + j];
      *(f32x4*)(dst + 4 * i) = o4;
    }
  }
  }
}

extern "C" void kernel_launch(void* const* d_in, const int* in_sizes, int n_in, void* d_out, int out_size,
                              void* d_ws, size_t ws_size, hipStream_t stream) {
  (void)in_sizes; (void)n_in; (void)out_size;
  Params p{};
  const float* const* in = reinterpret_cast<const float* const*>(d_in);
  p.x = in[0]; p.c = in[1]; p.w_ada = in[2]; p.b_ada = in[3]; p.g_norm1 = in[4]; p.g_norm2 = in[5];
  p.w_in = in[6]; p.q_gain = in[7]; p.kc_gain = in[8]; p.ks_gain = in[9]; p.kw_gain = in[10];
  p.pe_k = in[11]; p.pe_v = in[12]; p.w_cmp_k1 = in[13]; p.w_cmp_k2 = in[14]; p.w_cmp_v1 = in[15];
  p.w_cmp_v2 = in[16]; p.a_re = in[17]; p.a_im = in[18]; p.log_dt = in[19]; p.b_re = in[20];
  p.b_im = in[21]; p.c_re = in[22]; p.c_im = in[23]; p.d_skip = in[24]; p.w_glu = in[25];
  p.b_glu = in[26]; p.w_up_attn = in[27]; p.w_up_ssm = in[28]; p.w_out = in[29]; p.w_router = in[30];
  p.router_bias = in[31]; p.w_gate = in[32]; p.w_up = in[33]; p.w_down = in[34]; p.ws_gate = in[35];
  p.ws_up = in[36]; p.ws_down = in[37];
  p.out = (float*)d_out;

  char* base = (char*)d_ws;
  size_t o = 0;
  auto take = [&](size_t bytes) { void* r = base + o; o += (bytes + 255) & ~(size_t)255; return r; };
  p.bar = (unsigned*)take(sizeof(unsigned) * XCD_BAR_WORDS);
  p.mod = (float*)take(sizeof(float) * NB * 6 * D);
  p.cbias = (float*)take(sizeof(float) * 512);
  p.w_inT = (bf16_t*)take(2 * (size_t)INC * D);
  p.wc1T = (bf16_t*)take(2 * (size_t)2 * 256 * 2048);
  p.wgluT = (bf16_t*)take(2 * (size_t)512 * 512);
  p.wuaT = (bf16_t*)take(2 * (size_t)D * 512);
  p.wusT = (bf16_t*)take(2 * (size_t)D * 512);
  p.woutT = (bf16_t*)take(2 * (size_t)D * D);
  p.wrT = (bf16_t*)take(2 * (size_t)NE * D);
  p.wsgT = (bf16_t*)take(2 * (size_t)DE * D);
  p.wsuT = (bf16_t*)take(2 * (size_t)DE * D);
  p.wsdT = (bf16_t*)take(2 * (size_t)D * DE);
  p.w1T = (bf16_t*)take(2 * (size_t)32 * 128 * 256);
  p.wyT = (bf16_t*)take(2 * (size_t)32 * 256 * 384);
  p.wgT = (bf16_t*)take(2 * (size_t)NE * DE * D);
  p.wuT = (bf16_t*)take(2 * (size_t)NE * DE * D);
  p.wdT = (bf16_t*)take(2 * (size_t)NE * D * DE);
  p.h = (bf16_t*)take(2 * (size_t)NT * D);
  p.pw = (float*)take(sizeof(float) * 2048 * 17 * 2);
  p.bbar = (float*)take(sizeof(float) * 2048 * 32);
  p.kd = (float*)take(sizeof(float) * 32 * 16 * 256);
  p.xmid = (float*)take(sizeof(float) * (size_t)NT * D);
  p.scores = (float*)take(sizeof(float) * (size_t)NT * NE);
  p.eidx = (int*)take(sizeof(int) * NASSIGN);
  p.ew = (float*)take(sizeof(float) * NASSIGN);
  p.cnt = (int*)take(sizeof(int) * NE);
  p.cursor = (int*)take(sizeof(int) * NE);
  p.off = (int*)take(sizeof(int) * (NE + 1));
  p.xrts = (int*)take(sizeof(int) * 8 * 33);
  p.stok = (int*)take(sizeof(int) * NASSIGN);
  p.sw = (float*)take(sizeof(float) * NASSIGN);
  p.apos = (int*)take(sizeof(int) * NASSIGN);
  p.hs = (bf16_t*)take(2 * (size_t)NT * DE);
  p.hr = (bf16_t*)take(2 * (size_t)NASSIGN * DE);
  const size_t early0 = o;
  p.qb = (bf16_t*)take(2 * (size_t)NT * 512);
  p.kvb = (bf16_t*)take(2 * (size_t)6 * NB * 2 * S * 64);
  p.cmpb = (bf16_t*)take(2 * (size_t)2 * NB * 2 * 256 * 64);
  p.gn = (float*)take(sizeof(float) * (size_t)NT * 24);
  p.a3 = (bf16_t*)take(2 * (size_t)32 * 1024 * 384);
  p.ga = (bf16_t*)take(2 * (size_t)NT * D);
  p.gs = (bf16_t*)take(2 * (size_t)NT * D);
  p.hidp = (float*)take(sizeof(float) * 16 * 2040 * 256);
  p.onsa = (float*)take(sizeof(float) * (size_t)NT * 512);
  p.onsab = (bf16_t*)take(2 * (size_t)NT * 512);
  p.lbuf = (float*)take(sizeof(float) * 32 * 1024 * 128);
  p.z = (bf16_t*)take(2 * (size_t)NT * 512);
  p.yssm = (bf16_t*)take(2 * (size_t)NT * 512);
  p.mtmp = (bf16_t*)take(2 * (size_t)NT * D);
  p.merged = (bf16_t*)take(2 * (size_t)NT * D);
  const size_t early1 = o;
  p.yk = (bf16_t*)(base + early0);
  const size_t yk_bytes = 2 * (size_t)NASSIGN * D;
  if (early0 + yk_bytes > o) o = early0 + yk_bytes;
  (void)early1;
  if (o > ws_size) fprintf(stderr, "workspace too small: need %zu have %zu\n", o, ws_size);

  static int grid_blocks = 0;
  if (!grid_blocks) {
    int dev = 0, cus = 0, per_cu = 0;
    (void)hipGetDevice(&dev);
    (void)hipDeviceGetAttribute(&cus, hipDeviceAttributeMultiprocessorCount, dev);
    (void)hipOccupancyMaxActiveBlocksPerMultiprocessor(&per_cu, mega, 256, 0);
    if (per_cu > 2) per_cu = 2;
    if (per_cu < 1) per_cu = 1;
    grid_blocks = cus * per_cu;
  }
  (void)hipMemsetAsync(p.bar, 0, sizeof(unsigned) * XCD_BAR_WORDS, stream);
  hipLaunchKernelGGL(mega, dim3(grid_blocks), dim3(256), 0, stream, p);
  hipError_t e = hipPeekAtLastError();
  if (e != hipSuccess) fprintf(stderr, "launch failed: %s (grid %d)\n", hipGetErrorString(e), grid_blocks);
}
```

```cpp
#include <hip/hip_runtime.h>
#include <cstdio>
#include <cstdint>

constexpr int D = 1024;
constexpr int NB = 4;
constexpr int S = 4096;
constexpr int NT = NB * S;
constexpr int INC = 3864;
constexpr int C_Q = 0, C_KC = 512, C_VC = 640, C_KS = 768, C_VS = 896, C_KW = 1024, C_VW = 1152,
              C_GN = 1280, C_U = 1304, C_GA = 1816, C_GS = 2840;
constexpr int NCMP = 255;
constexpr int NE = 256;
constexpr int TOPK = 8;
constexpr int DE = 256;
constexpr int NASSIGN = NT * TOPK;
constexpr float EPS = 1e-6f;
constexpr float ATT_SCALE = 0.125f;
typedef unsigned short bf16_t;

struct Params {
  const float* x; const float* c; const float* w_ada; const float* b_ada; const float* g_norm1;
  const float* g_norm2; const float* w_in; const float* q_gain; const float* kc_gain;
  const float* ks_gain; const float* kw_gain; const float* pe_k; const float* pe_v;
  const float* w_cmp_k1; const float* w_cmp_k2; const float* w_cmp_v1; const float* w_cmp_v2;
  const float* a_re; const float* a_im; const float* log_dt; const float* b_re; const float* b_im;
  const float* c_re; const float* c_im; const float* d_skip; const float* w_glu; const float* b_glu;
  const float* w_up_attn; const float* w_up_ssm; const float* w_out; const float* w_router;
  const float* router_bias; const float* w_gate; const float* w_up; const float* w_down;
  const float* ws_gate; const float* ws_up; const float* ws_down;
  float* out;
  unsigned* bar;
  float* mod;
  float* cbias;
  bf16_t* w_inT;
  bf16_t* wc1T;
  bf16_t* wgluT;
  bf16_t* wuaT;
  bf16_t* wusT;
  bf16_t* woutT;
  bf16_t* wrT;
  bf16_t* wsgT;
  bf16_t* wsuT;
  bf16_t* wsdT;
  bf16_t* w1T;
  bf16_t* wyT;
  bf16_t* wgT;
  bf16_t* wuT;
  bf16_t* wdT;
  bf16_t* h;
  bf16_t* qb;
  bf16_t* kvb;
  bf16_t* cmpb;
  float* gn;
  bf16_t* a3;
  bf16_t* ga;
  bf16_t* gs;
  float* hidp;
  float* onsa;
  bf16_t* onsab;
  float* pw;
  float* bbar;
  float* kd;
  float* lbuf;
  bf16_t* z;
  bf16_t* yssm;
  bf16_t* mtmp;
  bf16_t* merged;
  float* xmid;
  float* scores;
  int* eidx;
  float* ew;
  int* cnt;
  int* cursor;
  int* off;
  int* xrts;
  int* stok;
  float* sw;
  int* apos;
  bf16_t* hs;
  bf16_t* hr;
  bf16_t* yk;
};

__device__ __forceinline__ float bpx(float v, int lane, int off) {
  return __int_as_float(__builtin_amdgcn_ds_bpermute((lane ^ off) << 2, __float_as_int(v)));
}
__device__ __forceinline__ int bpxi(int v, int lane, int off) { return __builtin_amdgcn_ds_bpermute((lane ^ off) << 2, v); }
__device__ __forceinline__ unsigned bpxu(unsigned v, int lane, int off) { return (unsigned)__builtin_amdgcn_ds_bpermute((lane ^ off) << 2, (int)v); }
__device__ __forceinline__ float bpl(float v, int src) {
  return __int_as_float(__builtin_amdgcn_ds_bpermute(src << 2, __float_as_int(v)));
}
__device__ __forceinline__ float wsum(float v, int lane) {
#pragma unroll
  for (int o = 32; o > 0; o >>= 1) v += bpx(v, lane, o);
  return v;
}
#define WSYNC() do { __builtin_amdgcn_fence(__ATOMIC_ACQ_REL, "wavefront"); __builtin_amdgcn_wave_barrier(); } while (0)
__device__ __forceinline__ float fexp_(float x) { return __builtin_amdgcn_exp2f(x * 1.4426950408889634f); }
__device__ __forceinline__ float sigmoidf_(float x) { return 1.0f / (1.0f + fexp_(-x)); }
__device__ __forceinline__ float sigmoid_acc(float x) { return 1.0f / (1.0f + expf(-x)); }
__device__ __forceinline__ float siluf_(float x) { return x / (1.0f + fexp_(-x)); }
__device__ __forceinline__ float geluf_(float x) {
  const float u2 = 1.5957691216057308f * (x + 0.044715f * x * x * x);
  return x / (1.0f + fexp_(-u2));
}
#define OPAQUE(x) asm volatile("" : "+v"(x))
typedef short bf16x8 __attribute__((ext_vector_type(8)));
typedef float f32x4 __attribute__((ext_vector_type(4)));
typedef unsigned u32x4 __attribute__((ext_vector_type(4)));
#define LAS __attribute__((address_space(3)))

__device__ __forceinline__ unsigned cvt_pk_bf16(float lo, float hi) {
  unsigned r;
  asm("v_cvt_pk_bf16_f32 %0, %1, %2" : "=v"(r) : "v"(lo), "v"(hi));
  return r;
}
__device__ __forceinline__ uint2 pack4(const f32x4 v) {
  uint2 w;
  w.x = cvt_pk_bf16(v[0], v[1]); w.y = cvt_pk_bf16(v[2], v[3]);
  return w;
}
__device__ __forceinline__ f32x4 unpack4(const uint2 w) {
  return (f32x4){__uint_as_float(w.x << 16), __uint_as_float(w.x & 0xffff0000u), __uint_as_float(w.y << 16), __uint_as_float(w.y & 0xffff0000u)};
}
__device__ __forceinline__ int lds_byte(int r, int c) {
  const int st = (r >> 4) * 2 + (c >> 5), rr = r & 15, cc = c & 31, ob = rr * 64 + cc * 2;
  return st * 1024 + (ob ^ (((ob >> 9) & 1) << 5));
}
__device__ __forceinline__ int t32_byte(int r, int c) {
  const int ob = (r & 15) * 64 + c * 2;
  return (r >> 4) * 1024 + (ob ^ (((ob >> 9) & 1) << 5));
}

constexpr int GEMM_STAGE = 24576;
constexpr int GEMM_RING = 3;
constexpr int TM = 128, TNW = 256;
template <bool GL = false, class AF, class BF, class EPW>
__device__ __forceinline__ void gemm128(int K, AF arow, BF brow, EPW epiw, LAS unsigned char* lds, int aks = 32, int bks = 32) {
  int t = threadIdx.x;
  OPAQUE(t);
  const int wid = t >> 6, lane = t & 63, wr = wid >> 1, wc = wid & 1, fr = lane & 15, fq = lane >> 4;
  const int sbb = lane * 16, obb = sbb ^ (((sbb >> 9) & 1) << 5);
  const int rin = obb >> 6, cel = (obb & 63) >> 1;
  const bf16_t* ga0 = arow(wid * 16 + rin) + cel;
  const bf16_t* ga1 = arow((wid + 4) * 16 + rin) + cel;
  const bf16_t* gb0 = brow(wid * 16 + rin) + cel;
  const bf16_t* gb1 = brow((wid + 4) * 16 + rin) + cel;
  const bf16_t* gb2 = brow((wid + 8) * 16 + rin) + cel;
  const bf16_t* gb3 = brow((wid + 12) * 16 + rin) + cel;
  f32x4 acc[4][8];
#pragma unroll
  for (int m = 0; m < 4; ++m)
#pragma unroll
    for (int n = 0; n < 8; ++n) acc[m][n] = (f32x4){0.f, 0.f, 0.f, 0.f};
  const int foff = t32_byte(fr, fq * 8);
  const int nk = K >> 5;
#define GEMM_COMPUTE(sa_) do { \
    bf16x8 af[4]; \
    _Pragma("unroll") for (int m = 0; m < 4; ++m) af[m] = *(const LAS bf16x8*)((sa_) + (wr * 4 + m) * 1024 + foff); \
    _Pragma("unroll") for (int nh = 0; nh < 2; ++nh) { \
      bf16x8 bf[4]; \
      _Pragma("unroll") for (int n = 0; n < 4; ++n) bf[n] = *(const LAS bf16x8*)((sa_) + 8192 + (wc * 8 + nh * 4 + n) * 1024 + foff); \
      __builtin_amdgcn_s_setprio(1); \
      _Pragma("unroll") for (int m = 0; m < 4; ++m) \
        _Pragma("unroll") for (int n = 0; n < 4; ++n) \
          acc[m][nh * 4 + n] = __builtin_amdgcn_mfma_f32_16x16x32_bf16(bf[n], af[m], acc[m][nh * 4 + n], 0, 0, 0); \
      __builtin_amdgcn_s_setprio(0); \
      if (nh == 0) __builtin_amdgcn_sched_barrier(0); } } while (0)
  if constexpr (GL) {
  LAS unsigned char* l0 = lds + t * 16;
#define GEMM_ISSUE(s_) do { LAS unsigned char* d_ = l0 + ((s_) % GEMM_RING) * GEMM_STAGE; const int ko_ = (s_) * aks, kb_ = (s_) * bks; \
    __builtin_amdgcn_global_load_lds((const unsigned*)(ga0 + ko_), (LAS unsigned*)(d_), 16, 0, 0); \
    __builtin_amdgcn_global_load_lds((const unsigned*)(ga1 + ko_), (LAS unsigned*)(d_ + 4096), 16, 0, 0); \
    __builtin_amdgcn_global_load_lds((const unsigned*)(gb0 + kb_), (LAS unsigned*)(d_ + 8192), 16, 0, 0); \
    __builtin_amdgcn_global_load_lds((const unsigned*)(gb1 + kb_), (LAS unsigned*)(d_ + 12288), 16, 0, 0); \
    __builtin_amdgcn_global_load_lds((const unsigned*)(gb2 + kb_), (LAS unsigned*)(d_ + 16384), 16, 0, 0); \
    __builtin_amdgcn_global_load_lds((const unsigned*)(gb3 + kb_), (LAS unsigned*)(d_ + 20480), 16, 0, 0); } while (0)
  asm volatile("s_waitcnt vmcnt(0)" ::: "memory");
#pragma unroll
  for (int s_ = 0; s_ < GEMM_RING - 1; ++s_)
    if (s_ < nk) GEMM_ISSUE(s_);
  for (int kt = 0; kt < nk; ++kt) {
    if (kt + 1 < nk) asm volatile("s_waitcnt vmcnt(6)" ::: "memory");
    else asm volatile("s_waitcnt vmcnt(0)" ::: "memory");
    __builtin_amdgcn_s_barrier();
    asm volatile("" ::: "memory");
    if (kt + GEMM_RING - 1 < nk) GEMM_ISSUE(kt + GEMM_RING - 1);
    const LAS unsigned char* sa = lds + (kt % GEMM_RING) * GEMM_STAGE;
    GEMM_COMPUTE(sa);
  }
  __builtin_amdgcn_s_barrier();
  asm volatile("" ::: "memory");
#undef GEMM_ISSUE
  } else {
  for (int kt = 0; kt < nk; ++kt) {
    const int ko = kt * aks, kb = kt * bks;
    const u32x4 a0 = *(const u32x4*)(ga0 + ko), a1 = *(const u32x4*)(ga1 + ko);
    const u32x4 b0 = *(const u32x4*)(gb0 + kb), b1 = *(const u32x4*)(gb1 + kb);
    const u32x4 b2 = *(const u32x4*)(gb2 + kb), b3 = *(const u32x4*)(gb3 + kb);
    *(LAS u32x4*)(lds + t * 16) = a0;
    *(LAS u32x4*)(lds + t * 16 + 4096) = a1;
    *(LAS u32x4*)(lds + t * 16 + 8192) = b0;
    *(LAS u32x4*)(lds + t * 16 + 12288) = b1;
    *(LAS u32x4*)(lds + t * 16 + 16384) = b2;
    *(LAS u32x4*)(lds + t * 16 + 20480) = b3;
    __syncthreads();
    GEMM_COMPUTE(lds);
    __syncthreads();
  }
  }
#undef GEMM_COMPUTE
  epiw(acc, wr, wc, fr, fq);
}

template <int NCT, class AF, class BF, class EPW>
__device__ __forceinline__ void gemm128_stream(int K, AF arow, BF brow, size_t bct, EPW epiw, LAS unsigned char* lds) {
  int t = threadIdx.x;
  OPAQUE(t);
  const int wid = t >> 6, lane = t & 63, wr = wid >> 1, wc = wid & 1, fr = lane & 15, fq = lane >> 4;
  const int sbb = lane * 16, obb = sbb ^ (((sbb >> 9) & 1) << 5);
  const int rin = obb >> 6, cel = (obb & 63) >> 1;
  const bf16_t* ga0 = arow(wid * 16 + rin) + cel;
  const bf16_t* ga1 = arow((wid + 4) * 16 + rin) + cel;
  const bf16_t* gb0 = brow(wid * 16 + rin) + cel;
  const bf16_t* gb1 = brow((wid + 4) * 16 + rin) + cel;
  const bf16_t* gb2 = brow((wid + 8) * 16 + rin) + cel;
  const bf16_t* gb3 = brow((wid + 12) * 16 + rin) + cel;
  f32x4 acc[4][8];
#pragma unroll
  for (int m = 0; m < 4; ++m)
#pragma unroll
    for (int n = 0; n < 8; ++n) acc[m][n] = (f32x4){0.f, 0.f, 0.f, 0.f};
  const int foff = t32_byte(fr, fq * 8);
  const int nk = K >> 5, ns = nk * NCT;
  LAS unsigned char* l0 = lds + t * 16;
  int iss_k = 0;
  size_t iss_b = 0;
#define GEMM_ISSUE2(s_) do { LAS unsigned char* d_ = l0 + ((s_) % GEMM_RING) * GEMM_STAGE; \
    __builtin_amdgcn_global_load_lds((const unsigned*)(ga0 + iss_k), (LAS unsigned*)(d_), 16, 0, 0); \
    __builtin_amdgcn_global_load_lds((const unsigned*)(ga1 + iss_k), (LAS unsigned*)(d_ + 4096), 16, 0, 0); \
    __builtin_amdgcn_global_load_lds((const unsigned*)(gb0 + iss_b + iss_k), (LAS unsigned*)(d_ + 8192), 16, 0, 0); \
    __builtin_amdgcn_global_load_lds((const unsigned*)(gb1 + iss_b + iss_k), (LAS unsigned*)(d_ + 12288), 16, 0, 0); \
    __builtin_amdgcn_global_load_lds((const unsigned*)(gb2 + iss_b + iss_k), (LAS unsigned*)(d_ + 16384), 16, 0, 0); \
    __builtin_amdgcn_global_load_lds((const unsigned*)(gb3 + iss_b + iss_k), (LAS unsigned*)(d_ + 20480), 16, 0, 0); \
    iss_k += 32; if (iss_k == K) { iss_k = 0; iss_b += bct; } } while (0)
  asm volatile("s_waitcnt vmcnt(0)" ::: "memory");
#pragma unroll
  for (int s_ = 0; s_ < GEMM_RING - 1; ++s_)
    if (s_ < ns) GEMM_ISSUE2(s_);
  int kt = 0, ct = 0;
  for (int s_ = 0; s_ < ns; ++s_) {
    if (s_ + 1 < ns) asm volatile("s_waitcnt vmcnt(6)" ::: "memory");
    else asm volatile("s_waitcnt vmcnt(0)" ::: "memory");
    __builtin_amdgcn_s_barrier();
    asm volatile("" ::: "memory");
    if (s_ + GEMM_RING - 1 < ns) GEMM_ISSUE2(s_ + GEMM_RING - 1);
    const LAS unsigned char* sa = lds + (s_ % GEMM_RING) * GEMM_STAGE;
    {
      bf16x8 af[4];
#pragma unroll
      for (int m = 0; m < 4; ++m) af[m] = *(const LAS bf16x8*)(sa + (wr * 4 + m) * 1024 + foff);
#pragma unroll
      for (int nh = 0; nh < 2; ++nh) {
        bf16x8 bf[4];
#pragma unroll
        for (int n = 0; n < 4; ++n) bf[n] = *(const LAS bf16x8*)(sa + 8192 + (wc * 8 + nh * 4 + n) * 1024 + foff);
#pragma unroll
        for (int m = 0; m < 4; ++m)
#pragma unroll
          for (int n = 0; n < 4; ++n)
            acc[m][nh * 4 + n] = __builtin_amdgcn_mfma_f32_16x16x32_bf16(bf[n], af[m], acc[m][nh * 4 + n], 0, 0, 0);
        if (nh == 0) __builtin_amdgcn_sched_barrier(0);
      }
    }
    if (++kt == nk) {
      epiw(ct, acc, wr, wc, fr, fq);
#pragma unroll
      for (int m = 0; m < 4; ++m)
#pragma unroll
        for (int n = 0; n < 8; ++n) acc[m][n] = (f32x4){0.f, 0.f, 0.f, 0.f};
      kt = 0; ++ct;
    }
  }
  __builtin_amdgcn_s_barrier();
  asm volatile("" ::: "memory");
#undef GEMM_ISSUE2
}

constexpr int OSTRIDE = 528;
__device__ __forceinline__ void tile_out_put(LAS unsigned char* lds, int row, int col, uint2 v) {
  typedef unsigned u32x2_t __attribute__((ext_vector_type(2)));
  *(LAS u32x2_t*)(lds + row * OSTRIDE + col * 2) = (u32x2_t){v.x, v.y};
}
__device__ __forceinline__ void tile_out_stage(LAS unsigned char* lds, int wr, int wc, int fr, int fq, int m, int n, uint2 v) {
  tile_out_put(lds, wr * 64 + m * 16 + fr, wc * 128 + n * 16 + 4 * fq, v);
}
template <class RP>
__device__ __forceinline__ void tile_out_flush128(LAS unsigned char* lds, int nrows, RP rowptr) {
  int t = threadIdx.x;
  OPAQUE(t);
  __syncthreads();
#pragma unroll 4
  for (int i = 0; i < 8; ++i) {
    const int q = t + i * 256, row = q >> 4, piece = q & 15;
    if (row < nrows) *(u32x4*)(rowptr(row) + piece * 8) = *(const LAS u32x4*)(lds + row * OSTRIDE + piece * 16);
  }
  __syncthreads();
}
template <class RP>
__device__ __forceinline__ void tile_out_flush(LAS unsigned char* lds, int nrows, RP rowptr) {
  int t = threadIdx.x;
  OPAQUE(t);
  __syncthreads();
#pragma unroll 4
  for (int i = 0; i < 16; ++i) {
    const int q = t + i * 256, row = q >> 5, piece = q & 31;
    if (row < nrows) *(u32x4*)(rowptr(row) + piece * 8) = *(const LAS u32x4*)(lds + row * OSTRIDE + piece * 16);
  }
  __syncthreads();
}

__device__ __forceinline__ bool xcd_tile(int it, int tm, int tn, int& mt, int& nt) {
  const int G = gridDim.x, x = blockIdx.x & 7, slot = blockIdx.x >> 3, ns = (G - x + 7) >> 3;
  const int q = slot + it * ns;
  if (tn >= 8) {
    const int cn = (tn - x + 7) >> 3;
    if (q >= cn * tm) return false;
    mt = q / cn; nt = x + 8 * (q % cn);
  } else {
    const int cm = (tm - x + 7) >> 3;
    if (cm <= 0 || q >= cm * tn) return false;
    mt = x + 8 * (q / tn); nt = q % tn;
  }
  return true;
}
__device__ __forceinline__ int find_idx(const int* pre, int n, int v) {
  int lo = 0, hi = n;
  while (hi - lo > 1) {
    const int mid = (lo + hi) >> 1;
    if (pre[mid] <= v) lo = mid; else hi = mid;
  }
  return lo;
}

template <class AL, class BL, class EP>
__device__ __forceinline__ void gemm_phase(int M, int N, int K, AL al, BL bl, EP ep, LAS unsigned char* lds, int bks = 32) {
  const int tn = (N + TNW - 1) / TNW, tm = (M + TM - 1) / TM;
  int mt, nt;
  for (int it = 0; xcd_tile(it, tm, tn, mt, nt); ++it) {
    const int m0 = mt * TM, n0 = nt * TNW;
    gemm128<true>(
        K, [&](int r) { return al(min(m0 + r, M - 1)); }, [&](int c) { return bl(min(n0 + c, N - 1)); },
        [&](const f32x4 (&acc)[4][8], int wr, int wc, int fr, int fq) {
#pragma unroll
          for (int m = 0; m < 4; ++m)
#pragma unroll
            for (int n = 0; n < 8; ++n) {
              const int r = m0 + wr * 64 + m * 16 + fr, c = n0 + wc * 128 + n * 16 + 4 * fq;
              if (r < M && c < N) ep(r, c, acc[m][n]);
            }
        },
        lds, 32, bks);
  }
}

template <class AL, class BL, class XF>
__device__ __forceinline__ void gemm_phase_bf16(int M, int N, int K, AL al, BL bl, XF xf, bf16_t* out, int ldo, LAS unsigned char* lds, int bks = 32) {
  const int tn = N / TNW, tm = M / TM;
  int mt, nt;
  for (int it = 0; xcd_tile(it, tm, tn, mt, nt); ++it) {
    const int m0 = mt * TM, n0 = nt * TNW;
    gemm128<true>(
        K, [&](int r) { return al(m0 + r); }, [&](int c) { return bl(n0 + c); },
        [&](const f32x4 (&acc)[4][8], int wr, int wc, int fr, int fq) {
#pragma unroll
          for (int m = 0; m < 4; ++m)
#pragma unroll
            for (int n = 0; n < 8; ++n)
              tile_out_stage(lds, wr, wc, fr, fq, m, n, pack4(xf(m0 + wr * 64 + m * 16 + fr, n0 + wc * 128 + n * 16 + 4 * fq, acc[m][n])));
        },
        lds, 32, bks);
    tile_out_flush(lds, TM, [&](int r) { return out + (size_t)(m0 + r) * ldo + n0; });
  }
}

__device__ __forceinline__ void convert_tile(const float* W, int ldw, int nvalid, bf16_t* Wt, int ldt, int k0, int n0, LAS unsigned char* lds) {
  int t = threadIdx.x;
  OPAQUE(t);
  const int n4 = t & 31, kg = t >> 5;
  const int ncol = n0 + n4 * 4;
  f32x4 rb[8];
#pragma unroll
  for (int j = 0; j < 8; ++j)
    rb[j] = (ncol < nvalid) ? *(const f32x4*)(W + (size_t)(k0 + kg * 8 + j) * ldw + ncol) : (f32x4){0.f, 0.f, 0.f, 0.f};
#pragma unroll
  for (int c = 0; c < 4; ++c) {
    u32x4 w;
    w.x = cvt_pk_bf16(rb[0][c], rb[1][c]); w.y = cvt_pk_bf16(rb[2][c], rb[3][c]);
    w.z = cvt_pk_bf16(rb[4][c], rb[5][c]); w.w = cvt_pk_bf16(rb[6][c], rb[7][c]);
    *(LAS u32x4*)(lds + (n4 * 4 + c) * 144 + kg * 16) = w;
  }
  __syncthreads();
#pragma unroll
  for (int i = 0; i < 4; ++i) {
    const int q = t + i * 256, kbh = q >> 9, row = (q >> 2) & 127, pc = q & 3;
    if (n0 + row < nvalid)
      *(u32x4*)(Wt + ((size_t)((k0 >> 5) + kbh) * nvalid + n0 + row) * 32 + pc * 8) = *(const LAS u32x4*)(lds + row * 144 + (kbh * 4 + pc) * 16);
  }
  __syncthreads();
}

typedef short s16x4 __attribute__((ext_vector_type(4)));
#define REDERIVE() do { OPAQUE(t); w = t >> 6; lane = t & 63; fr = lane & 15; fq = lane >> 4; rloc = w * 16 + fr; } while (0)
constexpr int VROW = 160;

__device__ __forceinline__ bf16x8 pack8(const f32x4 a, const f32x4 b) {
  u32x4 w;
  w.x = cvt_pk_bf16(a[0], a[1]); w.y = cvt_pk_bf16(a[2], a[3]);
  w.z = cvt_pk_bf16(b[0], b[1]); w.w = cvt_pk_bf16(b[2], b[3]);
  return __builtin_bit_cast(bf16x8, w);
}
__device__ __forceinline__ void tile_fetch(bf16x8 (&r)[2], const unsigned short* base, int t) {
  const bf16x8* q = (const bf16x8*)(base + t * 16);
  r[0] = q[0];
  r[1] = q[1];
}
__device__ __forceinline__ void stage_k(const bf16x8 (&r)[2], LAS unsigned char* ldsK, int t) {
  const int row = t >> 2, c0 = (t & 3) * 16;
  *(LAS bf16x8*)(ldsK + lds_byte(row, c0)) = r[0];
  *(LAS bf16x8*)(ldsK + lds_byte(row, c0 + 8)) = r[1];
}
__device__ __forceinline__ void stage_v(const bf16x8 (&r)[2], LAS unsigned char* ldsV, int t) {
  const int row = t >> 2, c0 = (t & 3) * 16;
  *(LAS bf16x8*)(ldsV + row * VROW + c0 * 2) = r[0];
  *(LAS bf16x8*)(ldsV + row * VROW + c0 * 2 + 16) = r[1];
}
template <int H>
__device__ __forceinline__ void attn_qk_h(f32x4 (&s)[4][2], const LAS unsigned char* qf, LAS unsigned char* ldsK, int fr, int fq) {
  const int koff = lds_byte(fr, fq * 8);
#pragma unroll
  for (int m = 0; m < 4; ++m)
#pragma unroll
    for (int nn = 0; nn < 2; ++nn) s[m][nn] = (f32x4){0.f, 0.f, 0.f, 0.f};
#pragma unroll
  for (int nn = 0; nn < 2; ++nn)
#pragma unroll
    for (int ks = 0; ks < 2; ++ks) {
      const bf16x8 kf = *(const LAS bf16x8*)(ldsK + koff + (2 * H + nn) * 2048 + ks * 1024);
#pragma unroll
      for (int m = 0; m < 4; ++m)
        s[m][nn] = __builtin_amdgcn_mfma_f32_16x16x32_bf16(kf, *(const LAS bf16x8*)(qf + (m * 2 + ks) * 1024), s[m][nn], 0, 0, 0);
    }
}
template <int H>
__device__ __forceinline__ void attn_pv_h(f32x4 (&o)[4][4], const bf16x8 (&pf)[4], LAS unsigned char* ldsV, int lane) {
  const int fq = lane >> 4, i = lane & 15;
  const int vbase = (4 * fq + (i >> 2)) * VROW + (i & 3) * 8;
#pragma unroll
  for (int dt = 0; dt < 4; ++dt) {
    LAS unsigned char* a0 = ldsV + vbase + H * 32 * VROW + dt * 32;
    const s16x4 v0 = __builtin_amdgcn_ds_read_tr16_b64_v4i16((LAS s16x4*)a0);
    const s16x4 v1 = __builtin_amdgcn_ds_read_tr16_b64_v4i16((LAS s16x4*)(a0 + 16 * VROW));
    bf16x8 vf;
    vf[0] = v0[0]; vf[1] = v0[1]; vf[2] = v0[2]; vf[3] = v0[3];
    vf[4] = v1[0]; vf[5] = v1[1]; vf[6] = v1[2]; vf[7] = v1[3];
#pragma unroll
    for (int m = 0; m < 4; ++m) o[m][dt] = __builtin_amdgcn_mfma_f32_16x16x32_bf16(vf, pf[m], o[m][dt], 0, 0, 0);
  }
}
constexpr float SOFTMAX_SHIFT = 12.0f;
template <int H, bool EM>
__device__ __forceinline__ void attn_softmax_h(f32x4 (&s)[4][2], float (&lrow)[4], bf16x8 (&pf)[4], bool rowok, int lo, int hi) {
#pragma unroll
  for (int m = 0; m < 4; ++m) {
    float ls = 0.f;
#pragma unroll
    for (int nn = 0; nn < 2; ++nn)
#pragma unroll
      for (int jj = 0; jj < 4; ++jj) {
        const int kc = 16 * (2 * H + nn) + jj;
        const bool ok = rowok && (!EM || (lo < kc && hi >= kc));
        const float pv = ok ? __builtin_amdgcn_exp2f(s[m][nn][jj] - SOFTMAX_SHIFT) : 0.f;
        s[m][nn][jj] = pv;
        ls += pv;
      }
    lrow[m] += ls;
    pf[m] = pack8(s[m][0], s[m][1]);
  }
}
template <int H, bool EM>
__device__ __forceinline__ void attn_sub(f32x4 (&o)[4][4], float (&mrow)[4], float (&lrow)[4], const LAS unsigned char* qf,
                                         LAS unsigned char* ldsK, LAS unsigned char* ldsV, bool rowok, int lo, int hi, int lane) {
  f32x4 s[4][2];
  bf16x8 pf[4];
  attn_qk_h<H>(s, qf, ldsK, lane & 15, lane >> 4);
  attn_softmax_h<H, EM>(s, lrow, pf, rowok, lo, hi);
  attn_pv_h<H>(o, pf, ldsV, lane);
  if (H == 0) __builtin_amdgcn_sched_barrier(0);
}
template <bool EM>
__device__ __forceinline__ void attn_tile(f32x4 (&o)[4][4], float (&mrow)[4], float (&lrow)[4], const LAS unsigned char* qf,
                                          LAS unsigned char* ldsK, LAS unsigned char* ldsV, bool rowok, int lo, int hi, int lane) {
  attn_sub<0, EM>(o, mrow, lrow, qf, ldsK, ldsV, rowok, lo, hi, lane);
  attn_sub<1, EM>(o, mrow, lrow, qf, ldsK, ldsV, rowok, lo, hi, lane);
}
template <int H>
__device__ __forceinline__ void cmp_stats(float (&mrow)[4], float (&lrow)[4], const LAS unsigned char* qf, LAS unsigned char* ldsK, int hi, int lane) {
  const int fq = lane >> 4;
  f32x4 s[4][2];
  attn_qk_h<H>(s, qf, ldsK, lane & 15, fq);
#pragma unroll
  for (int m = 0; m < 4; ++m) {
    float ls = 0.f;
#pragma unroll
    for (int nn = 0; nn < 2; ++nn)
#pragma unroll
      for (int jj = 0; jj < 4; ++jj) {
        const int kc = 16 * (2 * H + nn) + jj;
        ls += (hi >= kc) ? __builtin_amdgcn_exp2f(s[m][nn][jj] - SOFTMAX_SHIFT) : 0.f;
      }
    lrow[m] += ls;
  }
}
template <int H>
__device__ __forceinline__ void cmp_apply(f32x4 (&o)[4][4], const float (&msf)[4], const float (&linv)[4], float& lastprev, LAS float* improw,
                                          const LAS unsigned char* qf, LAS unsigned char* ldsK, LAS unsigned char* ldsV, int hi, int lane) {
  const int fq = lane >> 4;
  f32x4 s[4][2];
  bf16x8 pf[4];
  attn_qk_h<H>(s, qf, ldsK, lane & 15, fq);
#pragma unroll
  for (int m = 0; m < 4; ++m) {
#pragma unroll
    for (int nn = 0; nn < 2; ++nn)
#pragma unroll
      for (int jj = 0; jj < 4; ++jj) {
        const int kc = 16 * (2 * H + nn) + jj;
        s[m][nn][jj] = (hi >= kc) ? __builtin_amdgcn_exp2f(s[m][nn][jj] - SOFTMAX_SHIFT) * linv[m] : 0.f;
      }
    pf[m] = pack8(s[m][0], s[m][1]);
  }
#pragma unroll
  for (int nn = 0; nn < 2; ++nn) {
    float gs = 0.f, last = 0.f;
#pragma unroll
    for (int m = 0; m < 4; ++m) {
      gs += (s[m][nn][0] + s[m][nn][1]) + (s[m][nn][2] + s[m][nn][3]);
      last += s[m][nn][3];
    }
    const float pa = bpl(last, (lane + 48) & 63);
    const float pb = bpl(lastprev, (lane + 48) & 63);
    improw[(2 * H + nn) * 4 + fq] = gs + ((fq > 0) ? pa : pb);
    lastprev = last;
  }
  attn_pv_h<H>(o, pf, ldsV, lane);
}

__device__ __forceinline__ void attn_chunk(const Params& p, LAS unsigned char* lds, int b, int g, int ci) {
  int t = threadIdx.x;
  OPAQUE(t);
  int w = t >> 6, lane = t & 63, fr = lane & 15, fq = lane >> 4;
  LAS unsigned char* ldsK = lds;
  LAS unsigned char* ldsV = lds + 8192;
  LAS float* impb = (LAS float*)(lds + 18432) + w * 1024;
  LAS unsigned* unib = (LAS unsigned*)(lds + 18432 + 16384);
  int rloc = w * 16 + fr;
  const int tq = ci * 64 + rloc;
  const size_t tok = (size_t)b * S + tq;
  const float* grow = p.gn + tok * 24 + g * 12;
  float* orow = p.onsa + tok * 512 + g * 256;
  LAS unsigned char* qf = lds + 36864 + w * 8192 + lane * 16;
#pragma unroll
  for (int m = 0; m < 4; ++m)
#pragma unroll
    for (int ks = 0; ks < 2; ++ks)
      *(LAS bf16x8*)(qf + (m * 2 + ks) * 1024) = *(const bf16x8*)(p.qb + tok * 512 + (g * 4 + m) * 64 + ks * 32 + fq * 8);
  f32x4 o[4][4];
  float mrow[4], lrow[4];
  bf16x8 rk[2], rv[2];

  const int nvis = (tq >= 31) ? ((tq - 31) / 16 + 1) : 0;
  const int nvmax = 4 * ci + 3;
  const int ntc = (nvmax + 63) >> 6;
  const unsigned short* kcb = p.cmpb + (size_t)((0 * NB + b) * 2 + g) * 256 * 64;
  const unsigned short* vcb = p.cmpb + (size_t)((1 * NB + b) * 2 + g) * 256 * 64;
#pragma unroll
  for (int m = 0; m < 4; ++m) { mrow[m] = -INFINITY; lrow[m] = 0.f; }
  REDERIVE();
  for (int tc = 0; tc < ntc; ++tc) {
    tile_fetch(rk, kcb + (size_t)tc * 4096, t);
    stage_k(rk, ldsK, t);
    __syncthreads();
    const int hi = nvis - 1 - tc * 64 - 4 * fq;
    cmp_stats<0>(mrow, lrow, qf, ldsK, hi, lane);
    cmp_stats<1>(mrow, lrow, qf, ldsK, hi, lane);
    __syncthreads();
  }
  {
    float linv[4], msf[4];
#pragma unroll
    for (int m = 0; m < 4; ++m) {
      float l = lrow[m];
      l += bpx(l, lane, 16);
      l += bpx(l, lane, 32);
      linv[m] = (l > 0.f) ? 1.0f / l : 0.f;
      msf[m] = 0.f;
    }
    REDERIVE();
#pragma unroll
    for (int m = 0; m < 4; ++m)
#pragma unroll
      for (int dt = 0; dt < 4; ++dt) o[m][dt] = (f32x4){0.f, 0.f, 0.f, 0.f};
    float lastprev = 0.f;
    for (int tc = 0; tc < ntc; ++tc) {
      tile_fetch(rk, kcb + (size_t)tc * 4096, t);
      tile_fetch(rv, vcb + (size_t)tc * 4096, t);
      stage_k(rk, ldsK, t);
      stage_v(rv, ldsV, t);
      __syncthreads();
      const int hi = nvis - 1 - tc * 64 - 4 * fq;
      cmp_apply<0>(o, msf, linv, lastprev, impb + fr * 64 + tc * 16, qf, ldsK, ldsV, hi, lane);
      cmp_apply<1>(o, msf, linv, lastprev, impb + fr * 64 + tc * 16, qf, ldsK, ldsV, hi, lane);
      __syncthreads();
    }
  }
#pragma unroll
  for (int m = 0; m < 4; ++m) {
    const float gate = grow[m * 3 + 0];
#pragma unroll
    for (int dt = 0; dt < 4; ++dt) *(f32x4*)(orow + m * 64 + dt * 16 + 4 * fq) = o[m][dt] * gate;
  }
  unsigned mlo, mhi;
  REDERIVE();
  {
    WSYNC();
    float kv[16];
    const int c0 = -fq * 16, c1 = ci - fq * 16;
#pragma unroll
    for (int i = 0; i < 16; ++i) {
      const bool forced = (c0 == i) || (c1 == i) || (c1 == i + 1);
      float v = (c1 >= i) ? impb[fr * 64 + fq * 16 + i] : -INFINITY;
      if (forced) v = INFINITY;
      kv[i] = v;
    }
    WSYNC();
#pragma unroll
    for (int i = 0; i < 16; ++i) impb[fr * 64 + fq * 16 + i] = kv[i];
    WSYNC();
    int rank[16];
#pragma unroll
    for (int i = 0; i < 16; ++i) rank[i] = 0;
#pragma unroll 2
    for (int k = 0; k < 64; ++k) {
      const float ok = impb[fr * 64 + k];
      const int kq = k - fq * 16;
#pragma unroll
      for (int i = 0; i < 16; ++i) rank[i] += (ok > kv[i] || (ok == kv[i] && kq < i)) ? 1 : 0;
    }
    unsigned piece = 0;
#pragma unroll
    for (int i = 0; i < 16; ++i) piece |= (rank[i] < 16) ? (1u << i) : 0u;
    unsigned lo32 = (fq == 0) ? piece : (fq == 1) ? (piece << 16) : 0u;
    unsigned hi32 = (fq == 2) ? piece : (fq == 3) ? (piece << 16) : 0u;
    lo32 |= bpxu(lo32, lane, 16); lo32 |= bpxu(lo32, lane, 32);
    hi32 |= bpxu(hi32, lane, 16); hi32 |= bpxu(hi32, lane, 32);
    mlo = lo32; mhi = hi32;
    unsigned ulo = lo32, uhi = hi32;
#pragma unroll
    for (int off = 1; off < 16; off <<= 1) { ulo |= bpxu(ulo, lane, off); uhi |= bpxu(uhi, lane, off); }
    if (lane == 0) { unib[w * 2] = ulo; unib[w * 2 + 1] = uhi; }
    __syncthreads();
  }
  unsigned long long un;
  {
    const unsigned ulo = unib[0] | unib[2] | unib[4] | unib[6];
    const unsigned uhi = unib[1] | unib[3] | unib[5] | unib[7];
    un = ((unsigned long long)__builtin_amdgcn_readfirstlane(uhi) << 32) | (unsigned long long)__builtin_amdgcn_readfirstlane(ulo);
  }
  const unsigned long long rowmask = ((unsigned long long)mhi << 32) | mlo;

#pragma unroll 1
  for (int pass = 0; pass < 2; ++pass) {
    REDERIVE();
#pragma unroll
    for (int m = 0; m < 4; ++m) {
      mrow[m] = -INFINITY; lrow[m] = 0.f;
#pragma unroll
      for (int dt = 0; dt < 4; ++dt) o[m][dt] = (f32x4){0.f, 0.f, 0.f, 0.f};
    }
    const unsigned short* kb = p.kvb + (size_t)(((2 + 2 * pass) * NB + b) * 2 + g) * S * 64;
    const unsigned short* vb = p.kvb + (size_t)(((3 + 2 * pass) * NB + b) * 2 + g) * S * 64;
    const unsigned long long upto = (ci == 63) ? ~0ull : ((1ull << (ci + 1)) - 1ull);
    const int jlo = max(0, ci - 8);
    unsigned long long rem = pass ? (upto & ~((1ull << jlo) - 1ull)) : (un & upto);
    const int jwin0 = pass ? ci - 8 : -100;
    int j = __ffsll((long long)rem) - 1;
    tile_fetch(rk, kb + (size_t)j * 4096, t);
    tile_fetch(rv, vb + (size_t)j * 4096, t);
    while (rem) {
      rem &= rem - 1;
      stage_k(rk, ldsK, t);
      stage_v(rv, ldsV, t);
      __syncthreads();
      const int jn = rem ? (__ffsll((long long)rem) - 1) : -1;
      if (jn >= 0) {
        tile_fetch(rk, kb + (size_t)jn * 4096, t);
        tile_fetch(rv, vb + (size_t)jn * 4096, t);
      }
      const bool rowok = pass ? true : (bool)((rowmask >> j) & 1ull);
      int hi = (j == ci) ? rloc : 63;
      const int lo = ((j == jwin0) ? rloc : -1) - 4 * fq;
      hi = (rowok ? hi : -1000) - 4 * fq;
      attn_tile<true>(o, mrow, lrow, qf, ldsK, ldsV, true, lo, hi, lane);
      __syncthreads();
      j = jn;
    }
#pragma unroll
    for (int m = 0; m < 4; ++m) {
      float l = lrow[m];
      l += bpx(l, lane, 16);
      l += bpx(l, lane, 32);
      const float sc = grow[m * 3 + 1 + pass] / l;
#pragma unroll
      for (int dt = 0; dt < 4; ++dt) {
        f32x4* dst = (f32x4*)(orow + m * 64 + dt * 16 + 4 * fq);
        const f32x4 tot = *dst + o[m][dt] * sc;
        if (pass == 0) *dst = tot;
        else *(uint2*)(p.onsab + tok * 512 + g * 256 + m * 64 + dt * 16 + 4 * fq) = pack4(tot);
      }
    }
  }
}

#define XB_TMO      128
#define XB_XCNT(j)  (256  + 64 * (j))
#define XB_XSUB(j)  (1280 + 64 * (j))
#define XB_XGEN(j)  (2304 + 64 * (j))
#define XB_TOP      3328
#define XB_TOPGEN   3392
#define XCD_BAR_WORDS 3456
#define XB_SPIN_CAP (1u << 18)

__device__ __forceinline__ unsigned xb_ld(unsigned* p)              { return __hip_atomic_load(p, __ATOMIC_RELAXED, __HIP_MEMORY_SCOPE_AGENT); }
__device__ __forceinline__ unsigned xb_add(unsigned* p, unsigned v) { return __hip_atomic_fetch_add(p, v, __ATOMIC_RELAXED, __HIP_MEMORY_SCOPE_AGENT); }
__device__ __forceinline__ unsigned xb_xcc_id() { return (unsigned)__builtin_amdgcn_s_getreg((3 << 11) | 20) & 0xFu; }
#define XB_SPIN(cond, bar) do { unsigned _sp = 0; while (cond) { __builtin_amdgcn_s_sleep(1); \
    if ((++_sp & 255u) == 0u) { if (xb_ld(&(bar)[XB_TMO])) break; if (_sp > XB_SPIN_CAP) { atomicAdd(&(bar)[XB_TMO], 1u); break; } } } } while (0)

struct XcdBarrier {
    unsigned* bar; unsigned x;
    volatile LAS unsigned* st;
};

__device__ __forceinline__ XcdBarrier xcd_barrier_post(unsigned* bar, volatile LAS unsigned* st) {
    XcdBarrier b; b.bar = bar; b.x = xb_xcc_id(); b.st = st;
    if (threadIdx.x == 0) (void)xb_add(&bar[XB_XCNT(b.x)], 1u);
    return b;
}
__device__ __forceinline__ void xcd_barrier_complete(unsigned* bar, unsigned x, unsigned& nloc, unsigned& nx) {
    const unsigned G = gridDim.x * gridDim.y * gridDim.z;
    unsigned sum, cnt, mine, sp = 0u;
    for (;;) {
        sum = 0u; cnt = 0u; mine = 0u;
#pragma unroll
        for (unsigned j = 0; j < 16; ++j) { const unsigned c = xb_ld(&bar[XB_XCNT(j)]); sum += c; cnt += (c > 0u) ? 1u : 0u; mine = (j == x) ? c : mine; }
        if (sum == G) break;
        __builtin_amdgcn_s_sleep(1);
        if ((++sp & 255u) == 0u) { if (xb_ld(&bar[XB_TMO])) break; if (sp > XB_SPIN_CAP) { atomicAdd(&bar[XB_TMO], 1u); break; } }
    }
    nloc = mine > 0u ? mine : 1u; nx = cnt > 0u ? cnt : 1u;
}

__device__ __forceinline__ void xcd_barrier(const XcdBarrier& b) {
    asm volatile("s_waitcnt vmcnt(0)" ::: "memory");
    __syncthreads();
    if (threadIdx.x == 0) {
        unsigned* bar = b.bar;
        __builtin_amdgcn_s_waitcnt(0);
        unsigned nloc = b.st[0], nx = b.st[1];
        if (nloc == 0u) { xcd_barrier_complete(bar, b.x, nloc, nx); b.st[0] = nloc; b.st[1] = nx; }
        const unsigned old = xb_add(&bar[XB_XSUB(b.x)], 1u);
        const unsigned gen = old / nloc;
        if (old + 1u == (gen + 1u) * nloc) {
            __builtin_amdgcn_fence(__ATOMIC_RELEASE, "agent");
            asm volatile("s_waitcnt vmcnt(0)" ::: "memory");
            const unsigned og = xb_add(&bar[XB_TOP], 1u);
            const unsigned tg = og / nx;
            if (og + 1u == (tg + 1u) * nx) xb_add(&bar[XB_TOPGEN], 1u);
            else XB_SPIN(xb_ld(&bar[XB_TOPGEN]) == tg, bar);
            __builtin_amdgcn_fence(__ATOMIC_ACQUIRE, "agent");
            xb_add(&bar[XB_XGEN(b.x)], 1u);
            asm volatile("s_waitcnt vmcnt(0)" ::: "memory");
        } else {
            XB_SPIN(xb_ld(&bar[XB_XGEN(b.x)]) == gen, bar);
            __builtin_amdgcn_fence(__ATOMIC_ACQUIRE, "agent");
            asm volatile("s_waitcnt vmcnt(0)" ::: "memory");
        }
    }
    __syncthreads();
}


#define PHASE_IDX int t_ = threadIdx.x; OPAQUE(t_); const int tid = t_, lane = t_ & 63, wib = t_ >> 6; \
  const int gthreads = gridDim.x * 256, gtid = blockIdx.x * 256 + t_, gwaves = gridDim.x * 4, gwave = blockIdx.x * 4 + wib; \
  (void)tid; (void)lane; (void)wib; (void)gthreads; (void)gtid; (void)gwaves; (void)gwave;

constexpr int SMEM_BYTES = GEMM_RING * GEMM_STAGE;

__device__ __forceinline__ void conv_job(const float* W, int K, int N, bf16_t* Wt, int tile, LAS unsigned char* lds) {
  const int tnn = (N + 127) >> 7;
  convert_tile(W, N, N, Wt, K, (tile / tnn) * 64, (tile % tnn) * 128, lds);
}

__global__ void __launch_bounds__(256, 2) mega(Params p) {
  __shared__ __attribute__((aligned(16))) unsigned char smem_raw[SMEM_BYTES + 16];
  float* smem = (float*)smem_raw;
  LAS unsigned char* lds = (LAS unsigned char*)smem_raw;
  volatile LAS unsigned* xb_st = (volatile LAS unsigned*)(lds + SMEM_BYTES);
  if (threadIdx.x < 4) xb_st[threadIdx.x] = 0u;
  __syncthreads();
  const XcdBarrier gbar = xcd_barrier_post(p.bar, xb_st);

  {
  PHASE_IDX
  constexpr int MODB = 192;
  if (blockIdx.x < MODB) {
    for (int i = tid; i < NB * D; i += 256) smem[i] = siluf_(p.c[i]);
    __syncthreads();
    const int j = blockIdx.x * 32 + (lane & 31), kh = lane >> 5;
    float a0 = 0.f, a1 = 0.f, a2 = 0.f, a3 = 0.f;
    const float* wp = p.w_ada + (size_t)(wib * 256 + kh) * (6 * D) + j;
#pragma unroll 32
    for (int i = 0; i < 128; ++i) {
      const float w = wp[(size_t)(2 * i) * (6 * D)];
      const int kk = wib * 256 + 2 * i + kh;
      a0 = fmaf(smem[kk], w, a0); a1 = fmaf(smem[D + kk], w, a1);
      a2 = fmaf(smem[2 * D + kk], w, a2); a3 = fmaf(smem[3 * D + kk], w, a3);
    }
    a0 += bpx(a0, lane, 32); a1 += bpx(a1, lane, 32); a2 += bpx(a2, lane, 32); a3 += bpx(a3, lane, 32);
    __syncthreads();
    if (lane < 32) {
      smem[(wib * 4 + 0) * 32 + lane] = a0; smem[(wib * 4 + 1) * 32 + lane] = a1;
      smem[(wib * 4 + 2) * 32 + lane] = a2; smem[(wib * 4 + 3) * 32 + lane] = a3;
    }
    __syncthreads();
    if (lane < 32) {
      const int b = wib;
      const float v = p.b_ada[j] + ((smem[(0 * 4 + b) * 32 + lane] + smem[(1 * 4 + b) * 32 + lane]) +
                                    (smem[(2 * 4 + b) * 32 + lane] + smem[(3 * 4 + b) * 32 + lane]));
      p.mod[b * 6 * D + j] = v;
    }
    __syncthreads();
  }
  const int sb0 = (gridDim.x >= MODB + 144) ? MODB : 0;
  for (int idx = gtid - sb0 * 256; idx >= 0 && idx < 32 * 64; idx += gthreads) {
    const int g = idx / 64;
    const double dt = exp((double)p.log_dt[g]);
    const double lr = p.a_re[idx], li = p.a_im[idx];
    const double mag1 = exp(lr * dt);
    const double br = mag1 * cos(li * dt), bi = mag1 * sin(li * dt);
    {
      double pr_ = 1.0, pi_ = 0.0;
#pragma unroll 1
      for (int d = 0; d <= 16; ++d) {
        p.pw[(idx * 17 + d) * 2] = (float)pr_;
        p.pw[(idx * 17 + d) * 2 + 1] = (float)pi_;
        const double nr_ = pr_ * br - pi_ * bi, ni_ = pr_ * bi + pi_ * br;
        pr_ = nr_; pi_ = ni_;
      }
    }
    const double nr = br - 1.0, ni = bi;
    const double den = lr * lr + li * li;
    const double cr = (nr * lr + ni * li) / den, ci = (ni * lr - nr * li) / den;
    for (int q = 0; q < 16; ++q) {
      const double wr = p.b_re[idx * 16 + q], wi = p.b_im[idx * 16 + q];
      p.bbar[(idx * 16 + q) * 2] = (float)(cr * wr - ci * wi);
      p.bbar[(idx * 16 + q) * 2 + 1] = (float)(cr * wi + ci * wr);
    }
  }
  for (int idx = gtid; idx < NE; idx += gthreads) { p.cnt[idx] = 0; p.cursor[idx] = 0; }
  for (int o = gwave - (sb0 ? (sb0 + 8) * 4 : 0); o >= 0 && o < 512; o += gwaves) {
    const int kv = o >> 8, j = o & 255;
    const float* pe = kv ? p.pe_v : p.pe_k;
    const float* w1 = kv ? p.w_cmp_v1 : p.w_cmp_k1;
    float acc = 0.f;
    for (int k = lane; k < 2048; k += 64) acc = fmaf(pe[k], w1[(size_t)k * 256 + j], acc);
    acc = wsum(acc, lane);
    if (lane == 0) p.cbias[o] = acc;
  }
  {
    const int G = gridDim.x;
    const int first = (G > MODB) ? MODB : 0, nb = G - first;
    if ((int)blockIdx.x >= first) {
      for (int job = blockIdx.x - first; job < 1040; job += nb) {
        if (job < 496) conv_job(p.w_in, D, INC, p.w_inT, job, lds);
        else if (job < 560) conv_job(p.w_cmp_k1, 2048, 256, p.wc1T, job - 496, lds);
        else if (job < 624) conv_job(p.w_cmp_v1, 2048, 256, p.wc1T + 256 * 2048, job - 560, lds);
        else if (job < 656) conv_job(p.w_glu, 512, 512, p.wgluT, job - 624, lds);
        else if (job < 720) conv_job(p.w_up_attn, 512, D, p.wuaT, job - 656, lds);
        else if (job < 784) conv_job(p.w_up_ssm, 512, D, p.wusT, job - 720, lds);
        else if (job < 912) conv_job(p.w_out, D, D, p.woutT, job - 784, lds);
        else if (job < 944) conv_job(p.w_router, D, NE, p.wrT, job - 912, lds);
        else if (job < 976) conv_job(p.ws_gate, D, DE, p.wsgT, job - 944, lds);
        else if (job < 1008) conv_job(p.ws_up, D, DE, p.wsuT, job - 976, lds);
        else conv_job(p.ws_down, DE, D, p.wsdT, job - 1008, lds);
      }
    }
  }
  }
  xcd_barrier(gbar);

  {
  PHASE_IDX
  for (int row = gwave; row < NT; row += gwaves) {
    const int b = row / S;
    const float* xr = p.x + (size_t)row * D;
    f32x4 v[4];
    float ss = 0.f;
#pragma unroll
    for (int i = 0; i < 4; ++i) {
      v[i] = *(const f32x4*)(xr + i * 256 + lane * 4);
      ss += (v[i][0] * v[i][0] + v[i][1] * v[i][1]) + (v[i][2] * v[i][2] + v[i][3] * v[i][3]);
    }
    ss = wsum(ss, lane);
    const float r = rsqrtf(ss * (1.0f / D) + EPS);
    const float* md = p.mod + b * 6 * D;
#pragma unroll
    for (int i = 0; i < 4; ++i) {
      const int col = i * 256 + lane * 4;
      const f32x4 gg = *(const f32x4*)(p.g_norm1 + col), sc = *(const f32x4*)(md + D + col), sh = *(const f32x4*)(md + col);
      *(uint2*)(p.h + (size_t)row * D + col) = pack4(v[i] * r * gg * (sc + 1.0f) + sh);
    }
  }
  for (int idx = gtid; idx < 32 * 128 * 256; idx += gthreads) {
    const int k = idx & 255, col = (idx >> 8) & 127, g = idx >> 15;
    const int n = col >> 1, ri = col & 1, sidx = k >> 4, q = k & 15;
    const int gn = g * 64 + n;
    const float pr_ = p.pw[(gn * 17 + 15 - sidx) * 2], pi_ = p.pw[(gn * 17 + 15 - sidx) * 2 + 1];
    const float br = p.bbar[(gn * 16 + q) * 2], bi = p.bbar[(gn * 16 + q) * 2 + 1];
    const float v = ri ? (pr_ * bi + pi_ * br) : (pr_ * br - pi_ * bi);
    p.w1T[idx] = (bf16_t)(cvt_pk_bf16(v, 0.f) & 0xffffu);
  }
  for (int idx = gtid; idx < 32 * 16 * 256; idx += gthreads) {
    const int q = idx & 15, pp = (idx >> 4) & 15, d = (idx >> 8) & 15, g = idx >> 12;
    float acc = (d == 0 && pp == q) ? p.d_skip[g * 16 + pp] : 0.f;
    for (int n = 0; n < 64; ++n) {
      const int gn = g * 64 + n;
      const float cr = p.c_re[(g * 16 + pp) * 64 + n], ci = p.c_im[(g * 16 + pp) * 64 + n];
      const float pr_ = p.pw[(gn * 17 + d) * 2], pi_ = p.pw[(gn * 17 + d) * 2 + 1];
      const float br = p.bbar[(gn * 16 + q) * 2], bi = p.bbar[(gn * 16 + q) * 2 + 1];
      const float tr = cr * pr_ - ci * pi_, ti = cr * pi_ + ci * pr_;
      acc += tr * br - ti * bi;
    }
    p.kd[idx] = acc;
  }
  for (int idx = gtid; idx < 32 * 256 * 128; idx += gthreads) {
    const int k = idx & 127, col = (idx >> 7) & 255, g = idx >> 15;
    const int i = col >> 4, pp = col & 15, n = k >> 1, ri = k & 1;
    const int gn = g * 64 + n;
    const float cr = p.c_re[(g * 16 + pp) * 64 + n], ci = p.c_im[(g * 16 + pp) * 64 + n];
    const float pr_ = p.pw[(gn * 17 + i + 1) * 2], pi_ = p.pw[(gn * 17 + i + 1) * 2 + 1];
    const float v = ri ? -(cr * pi_ + ci * pr_) : (cr * pr_ - ci * pi_);
    p.wyT[((size_t)g * 256 + col) * 384 + k] = (bf16_t)(cvt_pk_bf16(v, 0.f) & 0xffffu);
  }
  }
  xcd_barrier(gbar);

  {
  PHASE_IDX
  {
    constexpr int TN = (INC + TNW - 1) / TNW;
    int mt_, nt_;
    for (int it = 0; xcd_tile(it, NT / TM, TN, mt_, nt_); ++it) {
      const int m0 = mt_ * TM, n0 = nt_ * TNW;
      gemm128<true>(
          D, [&](int r) { return p.h + (size_t)(m0 + r) * D; },
          [&](int c) { return p.w_inT + (size_t)min(n0 + c, INC - 1) * 32; },
          [&](const f32x4 (&acc)[4][8], int wr, int wc, int fr, int fq) {
#pragma unroll
            for (int sg = 0; sg < 2; ++sg) {
              const int cw = n0 + wc * 128 + sg * 64;
              if (cw < C_GN) {
                const bool isq = cw < C_KC;
                const int slot = isq ? 0 : (cw - C_KC) >> 7;
                const bool norm = isq || slot == 2 || slot == 4;
                const float* gain = isq ? p.q_gain : (slot == 2 ? p.ks_gain : p.kw_gain);
                const float post = isq ? ATT_SCALE * 1.4426950408889634f : 1.0f;
#pragma unroll
                for (int m = 0; m < 4; ++m) {
                  float r = 1.0f;
                  if (norm) {
                    float ss = 0.f;
#pragma unroll
                    for (int n = 0; n < 4; ++n)
#pragma unroll
                      for (int jj = 0; jj < 4; ++jj) ss = fmaf(acc[m][sg * 4 + n][jj], acc[m][sg * 4 + n][jj], ss);
                    ss += bpx(ss, fq * 16 + fr, 16);
                    ss += bpx(ss, fq * 16 + fr, 32);
                    r = rsqrtf(ss * (1.0f / 64) + EPS) * post;
                  }
#pragma unroll
                  for (int n = 0; n < 4; ++n) {
                    f32x4 v = acc[m][sg * 4 + n] * r;
                    if (norm) v = v * *(const f32x4*)(gain + n * 16 + 4 * fq);
                    tile_out_stage(lds, wr, wc, fr, fq, m, sg * 4 + n, pack4(v));
                  }
                }
              } else {
#pragma unroll
                for (int m = 0; m < 4; ++m) {
                  const size_t tok = m0 + wr * 64 + m * 16 + fr;
#pragma unroll
                  for (int n = 0; n < 4; ++n) {
                    const int c = cw + n * 16 + 4 * fq;
                    f32x4 v = acc[m][sg * 4 + n];
                    if (c >= C_U && c < C_GA) {
                      tile_out_stage(lds, wr, wc, fr, fq, m, sg * 4 + n, pack4(v));
                    } else {
#pragma unroll
                      for (int j = 0; j < 4; ++j) v[j] = sigmoidf_(v[j]);
                      if (c < C_U) *(f32x4*)(p.gn + tok * 24 + (c - C_GN)) = v;
                      else tile_out_stage(lds, wr, wc, fr, fq, m, sg * 4 + n, pack4(v));
                    }
                  }
                }
              }
            }
          },
          lds, 32, INC * 32);
      {
        int t = threadIdx.x;
        OPAQUE(t);
        __syncthreads();
#pragma unroll 4
        for (int i = 0; i < 16; ++i) {
          const int q = t + i * 256, row = q >> 5, piece = q & 31;
          const int c = n0 + piece * 8;
          const size_t tok = m0 + row;
          bf16_t* dst = nullptr;
          if (c < C_KC) dst = p.qb + tok * 512 + c;
          else if (c < C_GN) {
            const int slot = (c - C_KC) >> 7, gg = ((c - C_KC) >> 6) & 1;
            dst = p.kvb + ((size_t)((slot * NB + (tok >> 12)) * 2 + gg) * S + (tok & (S - 1))) * 64 + (c & 63);
          } else if (c < C_U) dst = nullptr;
          else if (c < C_GA) { const int ch = c - C_U; dst = p.a3 + ((size_t)(ch >> 4) * 1024 + (tok >> 4)) * 384 + 128 + (tok & 15) * 16 + (ch & 15); }
          else if (c < C_GS) dst = p.ga + tok * D + (c - C_GA);
          else if (c < INC) dst = p.gs + tok * D + (c - C_GS);
          if (dst) *(u32x4*)dst = *(const LAS u32x4*)(lds + row * OSTRIDE + piece * 16);
        }
        __syncthreads();
      }
    }
  }
  for (int idx = gtid; idx < 32 * 256 * 256; idx += gthreads) {
    const int k = idx & 255, col = (idx >> 8) & 255, g = idx >> 16;
    const int i = col >> 4, pp = col & 15, sidx = k >> 4, q = k & 15;
    const float v = (i >= sidx) ? p.kd[((g * 16 + (i - sidx)) * 16 + pp) * 16 + q] : 0.f;
    p.wyT[((size_t)g * 256 + col) * 384 + 128 + k] = (bf16_t)(cvt_pk_bf16(v, 0.f) & 0xffffu);
  }
  }
  xcd_barrier(gbar);

  {
  PHASE_IDX
  for (int job = blockIdx.x; job < 2 * 8 * 16; job += gridDim.x) {
    const int kv = job >> 7, ks = (job >> 4) & 7, m0 = (job & 15) * 128;
    float* hp = p.hidp + (size_t)(ks * 2 + kv) * 2040 * 256;
    gemm128<true>(
        256,
        [&](int r) {
          const int rr = min(m0 + r, NB * NCMP * 2 - 1);
          const int b = rr / (NCMP * 2), n = (rr >> 1) % NCMP, g = rr & 1;
          return p.kvb + ((size_t)((kv * NB + b) * 2 + g) * S + 16 * n) * 64 + ks * 256;
        },
        [&](int c) { return p.wc1T + (size_t)kv * 256 * 2048 + (size_t)(ks * 8 * 256 + c) * 32; },
        [&](const f32x4 (&acc)[4][8], int wr, int wc, int fr, int fq) {
#pragma unroll
          for (int m = 0; m < 4; ++m) {
            const int r = m0 + wr * 64 + m * 16 + fr;
            if (r < NB * NCMP * 2) {
#pragma unroll
              for (int n = 0; n < 8; ++n) *(f32x4*)(hp + (size_t)r * 256 + wc * 128 + n * 16 + 4 * fq) = acc[m][n];
            }
          }
        },
        lds, 32, 256 * 32);
  }
  int mt_, g;
  for (int it = 0; xcd_tile(it, 8, 32, mt_, g); ++it) {
    const int m0 = mt_ * 128;
    gemm128<true>(
        256, [&](int r) { return p.a3 + ((size_t)g * 1024 + m0 + r) * 384 + 128; },
        [&](int c) { return p.w1T + ((size_t)g * 128 + (c & 127)) * 256; },
        [&](const f32x4 (&acc)[4][8], int wr, int wc, int fr, int fq) {
          if (wc == 0) {
#pragma unroll
            for (int m = 0; m < 4; ++m)
#pragma unroll
              for (int n = 0; n < 8; ++n)
                *(f32x4*)(p.lbuf + ((size_t)g * 1024 + m0 + wr * 64 + m * 16 + fr) * 128 + n * 16 + 4 * fq) = acc[m][n];
          }
        },
        lds);
  }
  }
  xcd_barrier(gbar);

  {
  PHASE_IDX
  for (int wv = gwave; wv < 2 * NB * NCMP * 2; wv += gwaves) {
    const int kv = wv / (NB * NCMP * 2), r = wv % (NB * NCMP * 2);
    const int b = r / (NCMP * 2), n = (r >> 1) % NCMP, g = r & 1;
    const float* w2 = kv ? p.w_cmp_v2 : p.w_cmp_k2;
    {
      f32x4 hsum = *(const f32x4*)(p.cbias + kv * 256 + lane * 4);
#pragma unroll
      for (int ks = 0; ks < 8; ++ks) hsum = hsum + *(const f32x4*)(p.hidp + ((size_t)(ks * 2 + kv) * 2040 + r) * 256 + lane * 4);
#pragma unroll
      for (int j = 0; j < 4; ++j) hsum[j] = geluf_(hsum[j]);
      WSYNC();
      *(f32x4*)(smem + wib * 256 + lane * 4) = hsum;
      WSYNC();
    }
    const float* hid = smem + wib * 256;
    float acc = 0.f;
    for (int j = 0; j < 256; ++j) acc = fmaf(hid[j], w2[j * 64 + lane], acc);
    if (kv == 0) {
      const float ss = wsum(acc * acc, lane);
      acc = acc * rsqrtf(ss * (1.0f / 64) + EPS) * p.kc_gain[lane];
    }
    const float other = bpx(acc, lane, 1);
    if ((lane & 1) == 0)
      *(unsigned*)(p.cmpb + ((size_t)((kv * NB + b) * 2 + g) * 256 + n) * 64 + lane) = cvt_pk_bf16(acc, other);
  }
  for (int idx = gtid; idx < 2 * NB * 2 * 32; idx += gthreads)
    *(unsigned*)(p.cmpb + ((size_t)(idx >> 5) * 256 + 255) * 64 + (idx & 31) * 2) = 0u;
  for (int idx = gtid; idx < 32 * NB * 64; idx += gthreads) {
    const int n = idx & 63, b = (idx >> 6) & 3, g = idx >> 8;
    const int gn = g * 64 + n;
    const float lr = p.pw[(gn * 17 + 16) * 2], li = p.pw[(gn * 17 + 16) * 2 + 1];
    float hr_ = 0.f, hi_ = 0.f;
    const size_t row0 = (size_t)g * 1024 + b * 256;
#pragma unroll 1
    for (int c0 = 0; c0 < 256; c0 += 16) {
      float2 l2[16];
#pragma unroll
      for (int i = 0; i < 16; ++i) l2[i] = *(const float2*)(p.lbuf + (row0 + c0 + i) * 128 + n * 2);
#pragma unroll
      for (int i = 0; i < 16; ++i) {
        *(unsigned*)(p.a3 + (row0 + c0 + i) * 384 + n * 2) = cvt_pk_bf16(hr_, hi_);
        const float nr = lr * hr_ - li * hi_ + l2[i].x;
        const float ni = lr * hi_ + li * hr_ + l2[i].y;
        hr_ = nr; hi_ = ni;
      }
    }
  }
  }
  xcd_barrier(gbar);

  {
  PHASE_IDX
  const int G = gridDim.x;
  const bool split = G >= 512;
  if (!split || blockIdx.x < 256) {
    for (int u = blockIdx.x; u < 256; u += (split ? 256 : G)) {
      const int bg = u >> 5, pr = u & 31;
      __builtin_amdgcn_s_setprio(2);
#pragma unroll 1
      for (int half = 0; half < 2; ++half) attn_chunk(p, lds, bg >> 1, bg & 1, half ? pr : 63 - pr);
      __builtin_amdgcn_s_setprio(0);
    }
  }
  if (!split || blockIdx.x >= 256) {
    const int x8 = blockIdx.x & 7, nsl = split ? ((G - 256) >> 3) : 0, sl = split ? (((int)blockIdx.x - 256) >> 3) : 0;
    for (int it = 0;; ++it) {
      int tile;
      if (split && ((G & 7) == 0)) { const int q = sl + it * nsl; if (q >= 32) break; tile = ((x8 + 8 * (q >> 3)) << 3) | (q & 7); }
      else { tile = (split ? (int)blockIdx.x - 256 : (int)blockIdx.x) + it * (split ? G - 256 : G); if (tile >= 256) break; }
      const int g = tile >> 3, m0 = (tile & 7) * 128, n0 = 0;
      gemm128(
          384, [&](int r) { return p.a3 + ((size_t)g * 1024 + m0 + r) * 384; },
          [&](int c) { return p.wyT + ((size_t)g * 256 + n0 + c) * 384; },
          [&](const f32x4 (&acc)[4][8], int wr, int wc, int fr, int fq) {
#pragma unroll
            for (int m = 0; m < 4; ++m)
#pragma unroll
              for (int n = 0; n < 8; ++n) {
                const int col = n0 + wc * 128 + n * 16 + 4 * fq;
                const size_t tok = (size_t)(m0 + wr * 64 + m * 16 + fr) * 16 + (col >> 4);
                f32x4 v = acc[m][n];
#pragma unroll
                for (int j = 0; j < 4; ++j) v[j] = geluf_(v[j]);
                *(uint2*)(p.z + tok * 512 + g * 16 + (col & 15)) = pack4(v);
              }
          },
          lds);
    }
    const int cb = split ? (int)blockIdx.x - 256 : (int)blockIdx.x, cn = split ? G - 256 : G;
    for (int job = cb; job < NE * 96; job += cn) {
      const int e = job / 96, rem = job - e * 96, which = rem >> 5, tile = rem & 31;
      if (which == 0) conv_job(p.w_gate + (size_t)e * D * DE, D, DE, p.wgT + (size_t)e * DE * D, tile, lds);
      else if (which == 1) conv_job(p.w_up + (size_t)e * D * DE, D, DE, p.wuT + (size_t)e * DE * D, tile, lds);
      else conv_job(p.w_down + (size_t)e * DE * D, DE, D, p.wdT + (size_t)e * D * DE, tile, lds);
    }
  }
  }
  xcd_barrier(gbar);

  {
  PHASE_IDX
  gemm_phase_bf16(
      NT, 512, 512, [&](int m) { return p.z + (size_t)m * 512; }, [&](int n) { return p.wgluT + (size_t)n * 32; },
      [&](int m, int n, f32x4 v) {
        const f32x4 zz = unpack4(*(const uint2*)(p.z + (size_t)m * 512 + n));
#pragma unroll
        for (int j = 0; j < 4; ++j) v[j] = zz[j] * sigmoidf_(v[j] + p.b_glu[n + j]);
        return v;
      },
      p.yssm, 512, lds, 512 * 32);
  gemm_phase_bf16(
      NT, D, 512, [&](int m) { return p.onsab + (size_t)m * 512; }, [&](int n) { return p.wuaT + (size_t)n * 32; },
      [&](int m, int n, f32x4 v) {
        const f32x4 gg = unpack4(*(const uint2*)(p.ga + (size_t)m * D + n));
        return gg * v;
      },
      p.mtmp, D, lds, D * 32);
  }
  xcd_barrier(gbar);
  {
  PHASE_IDX
  gemm_phase_bf16(
      NT, D, 512, [&](int m) { return p.yssm + (size_t)m * 512; }, [&](int n) { return p.wusT + (size_t)n * 32; },
      [&](int m, int n, f32x4 v) {
        const f32x4 gg = unpack4(*(const uint2*)(p.gs + (size_t)m * D + n));
        const f32x4 prev = unpack4(*(const uint2*)(p.mtmp + (size_t)m * D + n));
        return prev + gg * v;
      },
      p.merged, D, lds, D * 32);
  }
  xcd_barrier(gbar);
  {
  PHASE_IDX
  gemm_phase(
      NT, D, D, [&](int m) { return p.merged + (size_t)m * D; }, [&](int n) { return p.woutT + (size_t)n * 32; },
      [&](int m, int n, f32x4 v) {
        const int b = m / S;
        const f32x4 xx = *(const f32x4*)(p.x + (size_t)m * D + n);
        const f32x4 gt = *(const f32x4*)(p.mod + b * 6 * D + 2 * D + n);
        *(f32x4*)(p.xmid + (size_t)m * D + n) = xx + gt * v;
      },
      lds, D * 32);
  }
  xcd_barrier(gbar);

  {
  PHASE_IDX
  for (int row = gwave; row < NT; row += gwaves) {
    const int b = row / S;
    const float* xr = p.xmid + (size_t)row * D;
    f32x4 v[4];
    float ss = 0.f;
#pragma unroll
    for (int i = 0; i < 4; ++i) {
      v[i] = *(const f32x4*)(xr + i * 256 + lane * 4);
      ss += (v[i][0] * v[i][0] + v[i][1] * v[i][1]) + (v[i][2] * v[i][2] + v[i][3] * v[i][3]);
    }
    ss = wsum(ss, lane);
    const float r = rsqrtf(ss * (1.0f / D) + EPS);
    const float* md = p.mod + b * 6 * D;
#pragma unroll
    for (int i = 0; i < 4; ++i) {
      const int col = i * 256 + lane * 4;
      const f32x4 gg = *(const f32x4*)(p.g_norm2 + col), sc = *(const f32x4*)(md + 4 * D + col), sh = *(const f32x4*)(md + 3 * D + col);
      *(uint2*)(p.h + (size_t)row * D + col) = pack4(v[i] * r * gg * (sc + 1.0f) + sh);
    }
  }
  }
  xcd_barrier(gbar);

  {
  PHASE_IDX
  int mt_, nt_;
  for (int it = 0; xcd_tile(it, NT / TM, 3, mt_, nt_); ++it) {
    const int m0 = mt_ * TM;
    if (nt_ == 0) {
      gemm128<true>(
          D, [&](int r) { return p.h + (size_t)(m0 + r) * D; }, [&](int c) { return p.wrT + (size_t)c * 32; },
          [&](const f32x4 (&acc)[4][8], int wr, int wc, int fr, int fq) {
#pragma unroll
            for (int m = 0; m < 4; ++m)
#pragma unroll
              for (int n = 0; n < 8; ++n) {
                f32x4 v = acc[m][n];
#pragma unroll
                for (int j = 0; j < 4; ++j) v[j] = sigmoid_acc(v[j]);
                *(f32x4*)(p.scores + (size_t)(m0 + wr * 64 + m * 16 + fr) * NE + wc * 128 + n * 16 + 4 * fq) = v;
              }
          },
          lds, 32, NE * 32);
    } else {
      const int ct = nt_ - 1;
      gemm128<true>(
          D, [&](int r) { return p.h + (size_t)(m0 + r) * D; },
          [&](int c) {
            const int hid = ct * 128 + (c >> 7) * 64 + ((c >> 4) & 3) * 16 + (c & 15);
            return (((c >> 6) & 1) ? p.wsuT : p.wsgT) + (size_t)hid * 32;
          },
          [&](const f32x4 (&acc)[4][8], int wr, int wc, int fr, int fq) {
#pragma unroll
            for (int m = 0; m < 4; ++m)
#pragma unroll
              for (int n = 0; n < 4; ++n) {
                f32x4 v;
#pragma unroll
                for (int j = 0; j < 4; ++j) v[j] = siluf_(acc[m][n][j]) * acc[m][n + 4][j];
                tile_out_put(lds, wr * 64 + m * 16 + fr, wc * 64 + n * 16 + 4 * fq, pack4(v));
              }
          },
          lds, 32, DE * 32);
      tile_out_flush128(lds, 128, [&](int r) { return p.hs + (size_t)(m0 + r) * DE + ct * 128; });
    }
  }
  }
  xcd_barrier(gbar);

  {
  PHASE_IDX
  for (int tok = gwave; tok < NT; tok += gwaves) {
    const float4 sc4 = *reinterpret_cast<const float4*>(p.scores + (size_t)tok * NE + lane * 4);
    const float4 bi4 = *reinterpret_cast<const float4*>(p.router_bias + lane * 4);
    const float sc[4] = {sc4.x, sc4.y, sc4.z, sc4.w};
    float bz[4] = {sc4.x + bi4.x, sc4.y + bi4.y, sc4.z + bi4.z, sc4.w + bi4.w};
    float m1 = -INFINITY, m2 = -INFINITY;
#pragma unroll
    for (int i = 0; i < 4; ++i) {
      const float v = bz[i];
      if (v > m1) { m2 = m1; m1 = v; } else if (v > m2) { m2 = v; }
    }
#pragma unroll
    for (int o = 1; o < 8; o <<= 1) {
      const float o1 = bpx(m1, lane, o), o2 = bpx(m2, lane, o);
      const float n1 = fmaxf(m1, o1);
      const float n2 = fmaxf(fminf(m1, o1), fmaxf(m2, o2));
      m1 = n1; m2 = n2;
    }
    const float gs = m1 + m2;
    const int mygrp = lane >> 3;
    int grank = 0;
#pragma unroll
    for (int g2 = 0; g2 < 8; ++g2) {
      const float og = bpl(gs, g2 * 8);
      grank += (og > gs || (og == gs && g2 < mygrp)) ? 1 : 0;
    }
    const bool gsel = grank < 4;
#pragma unroll
    for (int i = 0; i < 4; ++i) if (!gsel) bz[i] = -INFINITY;
    unsigned taken = 0;
    float wsel = 0.f;
    int esel = 0;
    float wtot = 0.f;
#pragma unroll 1
    for (int k = 0; k < TOPK; ++k) {
      float bv = -INFINITY; int bidx = 1 << 30;
#pragma unroll
      for (int i = 0; i < 4; ++i) {
        if (!((taken >> i) & 1u) && bz[i] > bv) { bv = bz[i]; bidx = lane * 4 + i; }
      }
#pragma unroll
      for (int o = 32; o > 0; o >>= 1) {
        const float ov = bpx(bv, lane, o);
        const int oi = bpxi(bidx, lane, o);
        if (ov > bv || (ov == bv && oi < bidx)) { bv = ov; bidx = oi; }
      }
      const int owner = bidx >> 2, slot = bidx & 3;
      float sv = 0.f;
      if (lane == owner) {
        taken |= 1u << slot;
        sv = (slot == 0) ? sc[0] : (slot == 1) ? sc[1] : (slot == 2) ? sc[2] : sc[3];
      }
      sv = bpl(sv, owner);
      wtot += sv;
      if (lane == k) { wsel = sv; esel = bidx; }
    }
    if (lane < TOPK) {
      p.eidx[tok * TOPK + lane] = esel;
      p.ew[tok * TOPK + lane] = wsel / wtot * 2.5f;
      atomicAdd(&p.cnt[esel], 1);
    }
  }
  gemm_phase(
      NT, D, DE, [&](int m) { return p.hs + (size_t)m * DE; }, [&](int n) { return p.wsdT + (size_t)n * 32; },
      [&](int m, int n, f32x4 v) {
        const int b = m / S;
        const f32x4 xx = *(const f32x4*)(p.xmid + (size_t)m * D + n);
        const f32x4 gt = *(const f32x4*)(p.mod + b * 6 * D + 5 * D + n);
        *(f32x4*)(p.out + (size_t)m * D + n) = xx + gt * v;
      },
      lds, D * 32);
  }
  xcd_barrier(gbar);

  {
  PHASE_IDX
  {
    int* soff = (int*)smem;
    int* srt = soff + 320;
    const int myc = p.cnt[tid];
    soff[tid] = myc;
    srt[tid] = (myc + 127) >> 7;
    __syncthreads();
    for (int st = 1; st < 256; st <<= 1) {
      const int a0 = (tid >= st) ? soff[tid - st] : 0;
      __syncthreads();
      soff[tid] += a0;
      __syncthreads();
    }
    const int exo = soff[tid] - myc;
    __syncthreads();
    soff[tid] = exo;
    if (blockIdx.x == 0) {
      p.off[tid] = exo;
      if (tid == 255) p.off[NE] = exo + myc;
    }
    __syncthreads();
    if (blockIdx.x == 0 && tid < 8) {
      int acc = 0;
      for (int i = 0; i < 32; ++i) { p.xrts[tid * 33 + i] = acc; acc += srt[tid + 8 * i]; }
      p.xrts[tid * 33 + 32] = acc;
    }
    for (int idx = gtid; idx < NASSIGN; idx += gthreads) {
      const int e = p.eidx[idx];
      const int pos = soff[e] + atomicAdd(&p.cursor[e], 1);
      p.stok[pos] = idx / TOPK;
      p.sw[pos] = p.ew[idx];
      p.apos[idx] = pos;
    }
    __syncthreads();
  }
  }
  xcd_barrier(gbar);

  {
  PHASE_IDX
  {
    const int x8 = blockIdx.x & 7, ns8 = ((int)gridDim.x - x8 + 7) >> 3;
    const int* xr = p.xrts + x8 * 33;
    const int total_rt = xr[32];
    for (int tile = blockIdx.x >> 3; tile < total_rt * 2; tile += ns8) {
      const int rt = tile >> 1, ct = tile & 1;
      const int ei = find_idx(xr, 32, rt);
      const int e = x8 + 8 * ei;
      const int pos0 = p.off[e] + (rt - xr[ei]) * 128;
      const int mvalid = min(128, p.off[e] + p.cnt[e] - pos0);
      const bf16_t* wg = p.wgT + (size_t)e * DE * D;
      const bf16_t* wu = p.wuT + (size_t)e * DE * D;
      gemm128<true>(
          D, [&](int r) { return p.h + (size_t)p.stok[pos0 + min(r, mvalid - 1)] * D; },
          [&](int c) {
            const int hid = ct * 128 + (c >> 7) * 64 + ((c >> 4) & 3) * 16 + (c & 15);
            return (((c >> 6) & 1) ? wu : wg) + (size_t)hid * 32;
          },
          [&](const f32x4 (&acc)[4][8], int wr, int wc, int fr, int fq) {
#pragma unroll
            for (int m = 0; m < 4; ++m)
#pragma unroll
              for (int n = 0; n < 4; ++n) {
                f32x4 v;
#pragma unroll
                for (int j = 0; j < 4; ++j) v[j] = siluf_(acc[m][n][j]) * acc[m][n + 4][j];
                tile_out_put(lds, wr * 64 + m * 16 + fr, wc * 64 + n * 16 + 4 * fq, pack4(v));
              }
          },
          lds, 32, DE * 32);
      tile_out_flush128(lds, mvalid, [&](int r) { return p.hr + (size_t)(pos0 + r) * DE + ct * 128; });
    }
  }
  }
  xcd_barrier(gbar);
  {
  PHASE_IDX
  {
    const int x8 = blockIdx.x & 7, ns8 = ((int)gridDim.x - x8 + 7) >> 3;
    const int* xr = p.xrts + x8 * 33;
    const int total_rt = xr[32];
    for (int tile = blockIdx.x >> 3; tile < total_rt * 4; tile += ns8) {
      const int rt = tile >> 2, ct = tile & 3;
      const int ei = find_idx(xr, 32, rt);
      const int e = x8 + 8 * ei;
      const int pos0 = p.off[e] + (rt - xr[ei]) * 128;
      const int mvalid = min(128, p.off[e] + p.cnt[e] - pos0);
      const bf16_t* wd = p.wdT + (size_t)e * D * DE + (size_t)(ct * 256) * 32;
      gemm128<true>(
          DE, [&](int r) { return p.hr + (size_t)(pos0 + min(r, mvalid - 1)) * DE; },
          [&](int c) { return wd + (size_t)c * 32; },
          [&](const f32x4 (&acc)[4][8], int wr, int wc, int fr, int fq) {
#pragma unroll
            for (int m = 0; m < 4; ++m) {
              const float wgt = p.sw[pos0 + min(wr * 64 + m * 16 + fr, mvalid - 1)];
#pragma unroll
              for (int n = 0; n < 8; ++n) tile_out_stage(lds, wr, wc, fr, fq, m, n, pack4(acc[m][n] * wgt));
            }
          },
          lds, 32, D * 32);
      tile_out_flush(lds, mvalid, [&](int r) { return p.yk + (size_t)(pos0 + r) * D + ct * 256; });
    }
  }
  }
  xcd_barrier(gbar);
  {
  PHASE_IDX
  for (int tok = gwave; tok < NT; tok += gwaves) {
    const int b = tok / S;
    const int4 ps0 = *(const int4*)(p.apos + tok * TOPK), ps1 = *(const int4*)(p.apos + tok * TOPK + 4);
    const int pos8[8] = {ps0.x, ps0.y, ps0.z, ps0.w, ps1.x, ps1.y, ps1.z, ps1.w};
    u32x4 ra_[8], rc_[8];
#pragma unroll
    for (int k = 0; k < TOPK; ++k) {
      const u32x4* src = (const u32x4*)(p.yk + (size_t)pos8[k] * D + lane * 16);
      ra_[k] = src[0]; rc_[k] = src[1];
    }
    float acc[16];
#pragma unroll
    for (int i = 0; i < 16; ++i) acc[i] = 0.f;
#pragma unroll
    for (int k = 0; k < TOPK; ++k) {
      const unsigned wv[8] = {ra_[k].x, ra_[k].y, ra_[k].z, ra_[k].w, rc_[k].x, rc_[k].y, rc_[k].z, rc_[k].w};
#pragma unroll
      for (int i = 0; i < 8; ++i) {
        acc[2 * i] += __uint_as_float(wv[i] << 16);
        acc[2 * i + 1] += __uint_as_float(wv[i] & 0xffff0000u);
      }
    }
    float* dst = p.out + (size_t)tok * D + lane * 16;
    const float* gt = p.mod + b * 6 * D + 5 * D + lane * 16;
#pragma unroll
    for (int i = 0; i < 4; ++i) {
      f32x4 o4 = *(f32x4*)(dst + 4 * i);
      const f32x4 g4 = *(const f32x4*)(gt + 4 * i);
#pragma unroll
      for (int j = 0; j < 4; ++j) o4[j] += g4[j] * acc[4 * i + j];
      *(f32x4*)(dst + 4 * i) = o4;
    }
  }
  }
}

extern "C" void kernel_launch(void* const* d_in, const int* in_sizes, int n_in, void* d_out, int out_size,
                              void* d_ws, size_t ws_size, hipStream_t stream) {
  (void)in_sizes; (void)n_in; (void)out_size;
  Params p{};
  const float* const* in = reinterpret_cast<const float* const*>(d_in);
  p.x = in[0]; p.c = in[1]; p.w_ada = in[2]; p.b_ada = in[3]; p.g_norm1 = in[4]; p.g_norm2 = in[5];
  p.w_in = in[6]; p.q_gain = in[7]; p.kc_gain = in[8]; p.ks_gain = in[9]; p.kw_gain = in[10];
  p.pe_k = in[11]; p.pe_v = in[12]; p.w_cmp_k1 = in[13]; p.w_cmp_k2 = in[14]; p.w_cmp_v1 = in[15];
  p.w_cmp_v2 = in[16]; p.a_re = in[17]; p.a_im = in[18]; p.log_dt = in[19]; p.b_re = in[20];
  p.b_im = in[21]; p.c_re = in[22]; p.c_im = in[23]; p.d_skip = in[24]; p.w_glu = in[25];
  p.b_glu = in[26]; p.w_up_attn = in[27]; p.w_up_ssm = in[28]; p.w_out = in[29]; p.w_router = in[30];
  p.router_bias = in[31]; p.w_gate = in[32]; p.w_up = in[33]; p.w_down = in[34]; p.ws_gate = in[35];
  p.ws_up = in[36]; p.ws_down = in[37];
  p.out = (float*)d_out;

  char* base = (char*)d_ws;
  size_t o = 0;
  auto take = [&](size_t bytes) { void* r = base + o; o += (bytes + 255) & ~(size_t)255; return r; };
  p.bar = (unsigned*)take(sizeof(unsigned) * XCD_BAR_WORDS);
  p.mod = (float*)take(sizeof(float) * NB * 6 * D);
  p.cbias = (float*)take(sizeof(float) * 512);
  p.w_inT = (bf16_t*)take(2 * (size_t)INC * D);
  p.wc1T = (bf16_t*)take(2 * (size_t)2 * 256 * 2048);
  p.wgluT = (bf16_t*)take(2 * (size_t)512 * 512);
  p.wuaT = (bf16_t*)take(2 * (size_t)D * 512);
  p.wusT = (bf16_t*)take(2 * (size_t)D * 512);
  p.woutT = (bf16_t*)take(2 * (size_t)D * D);
  p.wrT = (bf16_t*)take(2 * (size_t)NE * D);
  p.wsgT = (bf16_t*)take(2 * (size_t)DE * D);
  p.wsuT = (bf16_t*)take(2 * (size_t)DE * D);
  p.wsdT = (bf16_t*)take(2 * (size_t)D * DE);
  p.w1T = (bf16_t*)take(2 * (size_t)32 * 128 * 256);
  p.wyT = (bf16_t*)take(2 * (size_t)32 * 256 * 384);
  p.wgT = (bf16_t*)take(2 * (size_t)NE * DE * D);
  p.wuT = (bf16_t*)take(2 * (size_t)NE * DE * D);
  p.wdT = (bf16_t*)take(2 * (size_t)NE * D * DE);
  p.h = (bf16_t*)take(2 * (size_t)NT * D);
  p.pw = (float*)take(sizeof(float) * 2048 * 17 * 2);
  p.bbar = (float*)take(sizeof(float) * 2048 * 32);
  p.kd = (float*)take(sizeof(float) * 32 * 16 * 256);
  p.xmid = (float*)take(sizeof(float) * (size_t)NT * D);
  p.scores = (float*)take(sizeof(float) * (size_t)NT * NE);
  p.eidx = (int*)take(sizeof(int) * NASSIGN);
  p.ew = (float*)take(sizeof(float) * NASSIGN);
  p.cnt = (int*)take(sizeof(int) * NE);
  p.cursor = (int*)take(sizeof(int) * NE);
  p.off = (int*)take(sizeof(int) * (NE + 1));
  p.xrts = (int*)take(sizeof(int) * 8 * 33);
  p.stok = (int*)take(sizeof(int) * NASSIGN);
  p.sw = (float*)take(sizeof(float) * NASSIGN);
  p.apos = (int*)take(sizeof(int) * NASSIGN);
  p.hs = (bf16_t*)take(2 * (size_t)NT * DE);
  p.hr = (bf16_t*)take(2 * (size_t)NASSIGN * DE);
  const size_t early0 = o;
  p.qb = (bf16_t*)take(2 * (size_t)NT * 512);
  p.kvb = (bf16_t*)take(2 * (size_t)6 * NB * 2 * S * 64);
  p.cmpb = (bf16_t*)take(2 * (size_t)2 * NB * 2 * 256 * 64);
  p.gn = (float*)take(sizeof(float) * (size_t)NT * 24);
  p.a3 = (bf16_t*)take(2 * (size_t)32 * 1024 * 384);
  p.ga = (bf16_t*)take(2 * (size_t)NT * D);
  p.gs = (bf16_t*)take(2 * (size_t)NT * D);
  p.hidp = (float*)take(sizeof(float) * 16 * 2040 * 256);
  p.onsa = (float*)take(sizeof(float) * (size_t)NT * 512);
  p.onsab = (bf16_t*)take(2 * (size_t)NT * 512);
  p.lbuf = (float*)take(sizeof(float) * 32 * 1024 * 128);
  p.z = (bf16_t*)take(2 * (size_t)NT * 512);
  p.yssm = (bf16_t*)take(2 * (size_t)NT * 512);
  p.mtmp = (bf16_t*)take(2 * (size_t)NT * D);
  p.merged = (bf16_t*)take(2 * (size_t)NT * D);
  const size_t early1 = o;
  p.yk = (bf16_t*)(base + early0);
  const size_t yk_bytes = 2 * (size_t)NASSIGN * D;
  if (early0 + yk_bytes > o) o = early0 + yk_bytes;
  (void)early1;
  if (o > ws_size) fprintf(stderr, "workspace too small: need %zu have %zu\n", o, ws_size);

  static int grid_blocks = 0;
  if (!grid_blocks) {
    int dev = 0, cus = 0, per_cu = 0;
    (void)hipGetDevice(&dev);
    (void)hipDeviceGetAttribute(&cus, hipDeviceAttributeMultiprocessorCount, dev);
    (void)hipOccupancyMaxActiveBlocksPerMultiprocessor(&per_cu, mega, 256, 0);
    if (per_cu > 2) per_cu = 2;
    if (per_cu < 1) per_cu = 1;
    grid_blocks = cus * per_cu;
  }
  (void)hipMemsetAsync(p.bar, 0, sizeof(unsigned) * XCD_BAR_WORDS, stream);
  hipLaunchKernelGGL(mega, dim3(grid_blocks), dim3(256), 0, stream, p);
  hipError_t e = hipPeekAtLastError();
  if (e != hipSuccess) fprintf(stderr, "launch failed: %s (grid %d)\n", hipGetErrorString(e), grid_blocks);
}
```

```cpp
#include <hip/hip_runtime.h>
#include <cstdio>
#include <cstdint>

constexpr int D = 1024;
constexpr int NB = 4;
constexpr int S = 4096;
constexpr int NT = NB * S;
constexpr int INC = 3864;
constexpr int C_Q = 0, C_KC = 512, C_VC = 640, C_KS = 768, C_VS = 896, C_KW = 1024, C_VW = 1152,
              C_GN = 1280, C_U = 1304, C_GA = 1816, C_GS = 2840;
constexpr int NCMP = 255;
constexpr int NE = 256;
constexpr int TOPK = 8;
constexpr int DE = 256;
constexpr int NASSIGN = NT * TOPK;
constexpr float EPS = 1e-6f;
constexpr float ATT_SCALE = 0.125f;
typedef unsigned short bf16_t;

struct Params {
  const float* x; const float* c; const float* w_ada; const float* b_ada; const float* g_norm1;
  const float* g_norm2; const float* w_in; const float* q_gain; const float* kc_gain;
  const float* ks_gain; const float* kw_gain; const float* pe_k; const float* pe_v;
  const float* w_cmp_k1; const float* w_cmp_k2; const float* w_cmp_v1; const float* w_cmp_v2;
  const float* a_re; const float* a_im; const float* log_dt; const float* b_re; const float* b_im;
  const float* c_re; const float* c_im; const float* d_skip; const float* w_glu; const float* b_glu;
  const float* w_up_attn; const float* w_up_ssm; const float* w_out; const float* w_router;
  const float* router_bias; const float* w_gate; const float* w_up; const float* w_down;
  const float* ws_gate; const float* ws_up; const float* ws_down;
  float* out;
  unsigned* bar;
  float* mod;
  float* cbias;
  bf16_t* w_inT;
  bf16_t* wc1T;
  bf16_t* wgluT;
  bf16_t* wuaT;
  bf16_t* wusT;
  bf16_t* woutT;
  bf16_t* wrT;
  bf16_t* wsgT;
  bf16_t* wsuT;
  bf16_t* wsdT;
  bf16_t* w1T;
  bf16_t* wyT;
  bf16_t* wgT;
  bf16_t* wuT;
  bf16_t* wdT;
  bf16_t* h;
  bf16_t* qb;
  bf16_t* kvb;
  bf16_t* cmpb;
  float* gn;
  bf16_t* a3;
  bf16_t* ga;
  bf16_t* gs;
  float* hidp;
  float* onsa;
  bf16_t* onsab;
  float* pw;
  float* bbar;
  float* kd;
  float* lbuf;
  bf16_t* z;
  bf16_t* yssm;
  bf16_t* mtmp;
  bf16_t* merged;
  float* xmid;
  float* scores;
  int* eidx;
  float* ew;
  int* cnt;
  int* cursor;
  int* off;
  int* xrts;
  int* stok;
  float* sw;
  int* apos;
  bf16_t* hs;
  bf16_t* hr;
  bf16_t* yk;
};

__device__ __forceinline__ float bpx(float v, int lane, int off) {
  return __int_as_float(__builtin_amdgcn_ds_bpermute((lane ^ off) << 2, __float_as_int(v)));
}
__device__ __forceinline__ int bpxi(int v, int lane, int off) { return __builtin_amdgcn_ds_bpermute((lane ^ off) << 2, v); }
__device__ __forceinline__ unsigned bpxu(unsigned v, int lane, int off) { return (unsigned)__builtin_amdgcn_ds_bpermute((lane ^ off) << 2, (int)v); }
__device__ __forceinline__ float bpl(float v, int src) {
  return __int_as_float(__builtin_amdgcn_ds_bpermute(src << 2, __float_as_int(v)));
}
__device__ __forceinline__ float wsum(float v, int lane) {
#pragma unroll
  for (int o = 32; o > 0; o >>= 1) v += bpx(v, lane, o);
  return v;
}
#define WSYNC() do { __builtin_amdgcn_fence(__ATOMIC_ACQ_REL, "wavefront"); __builtin_amdgcn_wave_barrier(); } while (0)
__device__ __forceinline__ float fexp_(float x) { return __builtin_amdgcn_exp2f(x * 1.4426950408889634f); }
__device__ __forceinline__ float sigmoidf_(float x) { return 1.0f / (1.0f + fexp_(-x)); }
__device__ __forceinline__ float sigmoid_acc(float x) { return 1.0f / (1.0f + expf(-x)); }
__device__ __forceinline__ float siluf_(float x) { return x / (1.0f + fexp_(-x)); }
__device__ __forceinline__ float geluf_(float x) {
  const float u2 = 1.5957691216057308f * (x + 0.044715f * x * x * x);
  return x / (1.0f + fexp_(-u2));
}
#define OPAQUE(x) asm volatile("" : "+v"(x))
typedef short bf16x8 __attribute__((ext_vector_type(8)));
typedef float f32x4 __attribute__((ext_vector_type(4)));
typedef unsigned u32x4 __attribute__((ext_vector_type(4)));
#define LAS __attribute__((address_space(3)))

__device__ __forceinline__ unsigned cvt_pk_bf16(float lo, float hi) {
  unsigned r;
  asm("v_cvt_pk_bf16_f32 %0, %1, %2" : "=v"(r) : "v"(lo), "v"(hi));
  return r;
}
__device__ __forceinline__ uint2 pack4(const f32x4 v) {
  uint2 w;
  w.x = cvt_pk_bf16(v[0], v[1]); w.y = cvt_pk_bf16(v[2], v[3]);
  return w;
}
__device__ __forceinline__ f32x4 unpack4(const uint2 w) {
  return (f32x4){__uint_as_float(w.x << 16), __uint_as_float(w.x & 0xffff0000u), __uint_as_float(w.y << 16), __uint_as_float(w.y & 0xffff0000u)};
}
__device__ __forceinline__ int lds_byte(int r, int c) {
  const int st = (r >> 4) * 2 + (c >> 5), rr = r & 15, cc = c & 31, ob = rr * 64 + cc * 2;
  return st * 1024 + (ob ^ (((ob >> 9) & 1) << 5));
}
__device__ __forceinline__ int t32_byte(int r, int c) {
  const int ob = (r & 15) * 64 + c * 2;
  return (r >> 4) * 1024 + (ob ^ (((ob >> 9) & 1) << 5));
}

constexpr int GEMM_STAGE = 24576;
constexpr int GEMM_RING = 3;
constexpr int TM = 128, TNW = 256;
template <bool GL = false, class AF, class BF, class EPW>
__device__ __forceinline__ void gemm128(int K, AF arow, BF brow, EPW epiw, LAS unsigned char* lds, int aks = 32, int bks = 32) {
  int t = threadIdx.x;
  OPAQUE(t);
  const int wid = t >> 6, lane = t & 63, wr = wid >> 1, wc = wid & 1, fr = lane & 15, fq = lane >> 4;
  const int sbb = lane * 16, obb = sbb ^ (((sbb >> 9) & 1) << 5);
  const int rin = obb >> 6, cel = (obb & 63) >> 1;
  const bf16_t* ga0 = arow(wid * 16 + rin) + cel;
  const bf16_t* ga1 = arow((wid + 4) * 16 + rin) + cel;
  const bf16_t* gb0 = brow(wid * 16 + rin) + cel;
  const bf16_t* gb1 = brow((wid + 4) * 16 + rin) + cel;
  const bf16_t* gb2 = brow((wid + 8) * 16 + rin) + cel;
  const bf16_t* gb3 = brow((wid + 12) * 16 + rin) + cel;
  f32x4 acc[4][8];
#pragma unroll
  for (int m = 0; m < 4; ++m)
#pragma unroll
    for (int n = 0; n < 8; ++n) acc[m][n] = (f32x4){0.f, 0.f, 0.f, 0.f};
  const int foff = t32_byte(fr, fq * 8);
  const int nk = K >> 5;
#define GEMM_COMPUTE(sa_) do { \
    bf16x8 af[4]; \
    _Pragma("unroll") for (int m = 0; m < 4; ++m) af[m] = *(const LAS bf16x8*)((sa_) + (wr * 4 + m) * 1024 + foff); \
    _Pragma("unroll") for (int nh = 0; nh < 2; ++nh) { \
      bf16x8 bf[4]; \
      _Pragma("unroll") for (int n = 0; n < 4; ++n) bf[n] = *(const LAS bf16x8*)((sa_) + 8192 + (wc * 8 + nh * 4 + n) * 1024 + foff); \
      __builtin_amdgcn_s_setprio(1); \
      _Pragma("unroll") for (int m = 0; m < 4; ++m) { \
        _Pragma("unroll") for (int n = 0; n < 4; ++n) \
          acc[m][nh * 4 + n] = __builtin_amdgcn_mfma_f32_16x16x32_bf16(bf[n], af[m], acc[m][nh * 4 + n], 0, 0, 0); \
        GEMM_HOOK(nh * 4 + m); } \
      __builtin_amdgcn_s_setprio(0); \
      if (nh == 0) __builtin_amdgcn_sched_barrier(0); } } while (0)
  if constexpr (GL) {
  LAS unsigned char* l0 = lds + t * 16;
#define GEMM_ISSUE1(s_, pc_) do { LAS unsigned char* d_ = l0 + ((s_) % GEMM_RING) * GEMM_STAGE + (pc_) * 4096; const int ko_ = (s_) * aks, kb_ = (s_) * bks; \
    const bf16_t* src_ = (pc_) == 0 ? ga0 + ko_ : (pc_) == 1 ? ga1 + ko_ : (pc_) == 2 ? gb0 + kb_ : (pc_) == 3 ? gb1 + kb_ : (pc_) == 4 ? gb2 + kb_ : gb3 + kb_; \
    __builtin_amdgcn_global_load_lds((const unsigned*)src_, (LAS unsigned*)d_, 16, 0, 0); } while (0)
#define GEMM_HOOK(i_) do { if ((i_) < 6 && kt + GEMM_RING - 1 < nk) { GEMM_ISSUE1(kt + GEMM_RING - 1, (i_)); __builtin_amdgcn_sched_barrier(0); } } while (0)
#define GEMM_ISSUE(s_) do { LAS unsigned char* d_ = l0 + ((s_) % GEMM_RING) * GEMM_STAGE; const int ko_ = (s_) * aks, kb_ = (s_) * bks; \
    __builtin_amdgcn_global_load_lds((const unsigned*)(ga0 + ko_), (LAS unsigned*)(d_), 16, 0, 0); \
    __builtin_amdgcn_global_load_lds((const unsigned*)(ga1 + ko_), (LAS unsigned*)(d_ + 4096), 16, 0, 0); \
    __builtin_amdgcn_global_load_lds((const unsigned*)(gb0 + kb_), (LAS unsigned*)(d_ + 8192), 16, 0, 0); \
    __builtin_amdgcn_global_load_lds((const unsigned*)(gb1 + kb_), (LAS unsigned*)(d_ + 12288), 16, 0, 0); \
    __builtin_amdgcn_global_load_lds((const unsigned*)(gb2 + kb_), (LAS unsigned*)(d_ + 16384), 16, 0, 0); \
    __builtin_amdgcn_global_load_lds((const unsigned*)(gb3 + kb_), (LAS unsigned*)(d_ + 20480), 16, 0, 0); } while (0)
  asm volatile("s_waitcnt vmcnt(0)" ::: "memory");
#pragma unroll
  for (int s_ = 0; s_ < GEMM_RING - 1; ++s_)
    if (s_ < nk) GEMM_ISSUE(s_);
  for (int kt = 0; kt < nk; ++kt) {
    if (kt + 1 < nk) asm volatile("s_waitcnt vmcnt(6)" ::: "memory");
    else asm volatile("s_waitcnt vmcnt(0)" ::: "memory");
    __builtin_amdgcn_s_barrier();
    asm volatile("" ::: "memory");
    const LAS unsigned char* sa = lds + (kt % GEMM_RING) * GEMM_STAGE;
    GEMM_COMPUTE(sa);
  }
#undef GEMM_HOOK
#undef GEMM_ISSUE1
  __builtin_amdgcn_s_barrier();
  asm volatile("" ::: "memory");
#undef GEMM_ISSUE
  } else {
#define GEMM_HOOK(i_) do { } while (0)
  for (int kt = 0; kt < nk; ++kt) {
    const int ko = kt * aks, kb = kt * bks;
    const u32x4 a0 = *(const u32x4*)(ga0 + ko), a1 = *(const u32x4*)(ga1 + ko);
    const u32x4 b0 = *(const u32x4*)(gb0 + kb), b1 = *(const u32x4*)(gb1 + kb);
    const u32x4 b2 = *(const u32x4*)(gb2 + kb), b3 = *(const u32x4*)(gb3 + kb);
    *(LAS u32x4*)(lds + t * 16) = a0;
    *(LAS u32x4*)(lds + t * 16 + 4096) = a1;
    *(LAS u32x4*)(lds + t * 16 + 8192) = b0;
    *(LAS u32x4*)(lds + t * 16 + 12288) = b1;
    *(LAS u32x4*)(lds + t * 16 + 16384) = b2;
    *(LAS u32x4*)(lds + t * 16 + 20480) = b3;
    __syncthreads();
    GEMM_COMPUTE(lds);
    __syncthreads();
  }
#undef GEMM_HOOK
  }
#undef GEMM_COMPUTE
  epiw(acc, wr, wc, fr, fq);
}

template <int NCT, class AF, class BF, class EPW>
__device__ __forceinline__ void gemm128_stream(int K, AF arow, BF brow, size_t bct, EPW epiw, LAS unsigned char* lds) {
  int t = threadIdx.x;
  OPAQUE(t);
  const int wid = t >> 6, lane = t & 63, wr = wid >> 1, wc = wid & 1, fr = lane & 15, fq = lane >> 4;
  const int sbb = lane * 16, obb = sbb ^ (((sbb >> 9) & 1) << 5);
  const int rin = obb >> 6, cel = (obb & 63) >> 1;
  const bf16_t* ga0 = arow(wid * 16 + rin) + cel;
  const bf16_t* ga1 = arow((wid + 4) * 16 + rin) + cel;
  const bf16_t* gb0 = brow(wid * 16 + rin) + cel;
  const bf16_t* gb1 = brow((wid + 4) * 16 + rin) + cel;
  const bf16_t* gb2 = brow((wid + 8) * 16 + rin) + cel;
  const bf16_t* gb3 = brow((wid + 12) * 16 + rin) + cel;
  f32x4 acc[4][8];
#pragma unroll
  for (int m = 0; m < 4; ++m)
#pragma unroll
    for (int n = 0; n < 8; ++n) acc[m][n] = (f32x4){0.f, 0.f, 0.f, 0.f};
  const int foff = t32_byte(fr, fq * 8);
  const int nk = K >> 5, ns = nk * NCT;
  LAS unsigned char* l0 = lds + t * 16;
  int iss_k = 0;
  size_t iss_b = 0;
#define GEMM_ISSUE2(s_) do { LAS unsigned char* d_ = l0 + ((s_) % GEMM_RING) * GEMM_STAGE; \
    __builtin_amdgcn_global_load_lds((const unsigned*)(ga0 + iss_k), (LAS unsigned*)(d_), 16, 0, 0); \
    __builtin_amdgcn_global_load_lds((const unsigned*)(ga1 + iss_k), (LAS unsigned*)(d_ + 4096), 16, 0, 0); \
    __builtin_amdgcn_global_load_lds((const unsigned*)(gb0 + iss_b + iss_k), (LAS unsigned*)(d_ + 8192), 16, 0, 0); \
    __builtin_amdgcn_global_load_lds((const unsigned*)(gb1 + iss_b + iss_k), (LAS unsigned*)(d_ + 12288), 16, 0, 0); \
    __builtin_amdgcn_global_load_lds((const unsigned*)(gb2 + iss_b + iss_k), (LAS unsigned*)(d_ + 16384), 16, 0, 0); \
    __builtin_amdgcn_global_load_lds((const unsigned*)(gb3 + iss_b + iss_k), (LAS unsigned*)(d_ + 20480), 16, 0, 0); \
    iss_k += 32; if (iss_k == K) { iss_k = 0; iss_b += bct; } } while (0)
  asm volatile("s_waitcnt vmcnt(0)" ::: "memory");
#pragma unroll
  for (int s_ = 0; s_ < GEMM_RING - 1; ++s_)
    if (s_ < ns) GEMM_ISSUE2(s_);
  int kt = 0, ct = 0;
  for (int s_ = 0; s_ < ns; ++s_) {
    if (s_ + 1 < ns) asm volatile("s_waitcnt vmcnt(6)" ::: "memory");
    else asm volatile("s_waitcnt vmcnt(0)" ::: "memory");
    __builtin_amdgcn_s_barrier();
    asm volatile("" ::: "memory");
    if (s_ + GEMM_RING - 1 < ns) GEMM_ISSUE2(s_ + GEMM_RING - 1);
    const LAS unsigned char* sa = lds + (s_ % GEMM_RING) * GEMM_STAGE;
    {
      bf16x8 af[4];
#pragma unroll
      for (int m = 0; m < 4; ++m) af[m] = *(const LAS bf16x8*)(sa + (wr * 4 + m) * 1024 + foff);
#pragma unroll
      for (int nh = 0; nh < 2; ++nh) {
        bf16x8 bf[4];
#pragma unroll
        for (int n = 0; n < 4; ++n) bf[n] = *(const LAS bf16x8*)(sa + 8192 + (wc * 8 + nh * 4 + n) * 1024 + foff);
#pragma unroll
        for (int m = 0; m < 4; ++m)
#pragma unroll
          for (int n = 0; n < 4; ++n)
            acc[m][nh * 4 + n] = __builtin_amdgcn_mfma_f32_16x16x32_bf16(bf[n], af[m], acc[m][nh * 4 + n], 0, 0, 0);
        if (nh == 0) __builtin_amdgcn_sched_barrier(0);
      }
    }
    if (++kt == nk) {
      epiw(ct, acc, wr, wc, fr, fq);
#pragma unroll
      for (int m = 0; m < 4; ++m)
#pragma unroll
        for (int n = 0; n < 8; ++n) acc[m][n] = (f32x4){0.f, 0.f, 0.f, 0.f};
      kt = 0; ++ct;
    }
  }
  __builtin_amdgcn_s_barrier();
  asm volatile("" ::: "memory");
#undef GEMM_ISSUE2
}

constexpr int OSTRIDE = 528;
__device__ __forceinline__ void tile_out_put(LAS unsigned char* lds, int row, int col, uint2 v) {
  typedef unsigned u32x2_t __attribute__((ext_vector_type(2)));
  *(LAS u32x2_t*)(lds + row * OSTRIDE + col * 2) = (u32x2_t){v.x, v.y};
}
__device__ __forceinline__ void tile_out_stage(LAS unsigned char* lds, int wr, int wc, int fr, int fq, int m, int n, uint2 v) {
  tile_out_put(lds, wr * 64 + m * 16 + fr, wc * 128 + n * 16 + 4 * fq, v);
}
template <class RP>
__device__ __forceinline__ void tile_out_flush128(LAS unsigned char* lds, int nrows, RP rowptr) {
  int t = threadIdx.x;
  OPAQUE(t);
  __syncthreads();
#pragma unroll 4
  for (int i = 0; i < 8; ++i) {
    const int q = t + i * 256, row = q >> 4, piece = q & 15;
    if (row < nrows) *(u32x4*)(rowptr(row) + piece * 8) = *(const LAS u32x4*)(lds + row * OSTRIDE + piece * 16);
  }
  __syncthreads();
}
template <class RP>
__device__ __forceinline__ void tile_out_flush(LAS unsigned char* lds, int nrows, RP rowptr) {
  int t = threadIdx.x;
  OPAQUE(t);
  __syncthreads();
#pragma unroll 4
  for (int i = 0; i < 16; ++i) {
    const int q = t + i * 256, row = q >> 5, piece = q & 31;
    if (row < nrows) *(u32x4*)(rowptr(row) + piece * 8) = *(const LAS u32x4*)(lds + row * OSTRIDE + piece * 16);
  }
  __syncthreads();
}

__device__ __forceinline__ bool xcd_tile(int it, int tm, int tn, int& mt, int& nt) {
  const int G = gridDim.x, x = blockIdx.x & 7, slot = blockIdx.x >> 3, ns = (G - x + 7) >> 3;
  const int q = slot + it * ns;
  if (tn >= 8) {
    const int cn = (tn - x + 7) >> 3;
    if (q >= cn * tm) return false;
    mt = q / cn; nt = x + 8 * (q % cn);
  } else {
    const int cm = (tm - x + 7) >> 3;
    if (cm <= 0 || q >= cm * tn) return false;
    mt = x + 8 * (q / tn); nt = q % tn;
  }
  return true;
}
__device__ __forceinline__ int find_idx(const int* pre, int n, int v) {
  int lo = 0, hi = n;
  while (hi - lo > 1) {
    const int mid = (lo + hi) >> 1;
    if (pre[mid] <= v) lo = mid; else hi = mid;
  }
  return lo;
}

template <class AL, class BL, class EP>
__device__ __forceinline__ void gemm_phase(int M, int N, int K, AL al, BL bl, EP ep, LAS unsigned char* lds, int bks = 32) {
  const int tn = (N + TNW - 1) / TNW, tm = (M + TM - 1) / TM;
  int mt, nt;
  for (int it = 0; xcd_tile(it, tm, tn, mt, nt); ++it) {
    const int m0 = mt * TM, n0 = nt * TNW;
    gemm128<true>(
        K, [&](int r) { return al(min(m0 + r, M - 1)); }, [&](int c) { return bl(min(n0 + c, N - 1)); },
        [&](const f32x4 (&acc)[4][8], int wr, int wc, int fr, int fq) {
#pragma unroll
          for (int m = 0; m < 4; ++m)
#pragma unroll
            for (int n = 0; n < 8; ++n) {
              const int r = m0 + wr * 64 + m * 16 + fr, c = n0 + wc * 128 + n * 16 + 4 * fq;
              if (r < M && c < N) ep(r, c, acc[m][n]);
            }
        },
        lds, 32, bks);
  }
}

template <class AL, class BL, class XF>
__device__ __forceinline__ void gemm_phase_bf16(int M, int N, int K, AL al, BL bl, XF xf, bf16_t* out, int ldo, LAS unsigned char* lds, int bks = 32) {
  const int tn = N / TNW, tm = M / TM;
  int mt, nt;
  for (int it = 0; xcd_tile(it, tm, tn, mt, nt); ++it) {
    const int m0 = mt * TM, n0 = nt * TNW;
    gemm128<true>(
        K, [&](int r) { return al(m0 + r); }, [&](int c) { return bl(n0 + c); },
        [&](const f32x4 (&acc)[4][8], int wr, int wc, int fr, int fq) {
#pragma unroll
          for (int m = 0; m < 4; ++m)
#pragma unroll
            for (int n = 0; n < 8; ++n)
              tile_out_stage(lds, wr, wc, fr, fq, m, n, pack4(xf(m0 + wr * 64 + m * 16 + fr, n0 + wc * 128 + n * 16 + 4 * fq, acc[m][n])));
        },
        lds, 32, bks);
    tile_out_flush(lds, TM, [&](int r) { return out + (size_t)(m0 + r) * ldo + n0; });
  }
}

__device__ __forceinline__ void convert_tile(const float* W, int ldw, int nvalid, bf16_t* Wt, int ldt, int k0, int n0, LAS unsigned char* lds) {
  int t = threadIdx.x;
  OPAQUE(t);
  const int n4 = t & 31, kg = t >> 5;
  const int ncol = n0 + n4 * 4;
  f32x4 rb[8];
#pragma unroll
  for (int j = 0; j < 8; ++j)
    rb[j] = (ncol < nvalid) ? *(const f32x4*)(W + (size_t)(k0 + kg * 8 + j) * ldw + ncol) : (f32x4){0.f, 0.f, 0.f, 0.f};
#pragma unroll
  for (int c = 0; c < 4; ++c) {
    u32x4 w;
    w.x = cvt_pk_bf16(rb[0][c], rb[1][c]); w.y = cvt_pk_bf16(rb[2][c], rb[3][c]);
    w.z = cvt_pk_bf16(rb[4][c], rb[5][c]); w.w = cvt_pk_bf16(rb[6][c], rb[7][c]);
    *(LAS u32x4*)(lds + (n4 * 4 + c) * 144 + kg * 16) = w;
  }
  __syncthreads();
#pragma unroll
  for (int i = 0; i < 4; ++i) {
    const int q = t + i * 256, kbh = q >> 9, row = (q >> 2) & 127, pc = q & 3;
    if (n0 + row < nvalid)
      *(u32x4*)(Wt + ((size_t)((k0 >> 5) + kbh) * nvalid + n0 + row) * 32 + pc * 8) = *(const LAS u32x4*)(lds + row * 144 + (kbh * 4 + pc) * 16);
  }
  __syncthreads();
}

typedef short s16x4 __attribute__((ext_vector_type(4)));
#define REDERIVE() do { OPAQUE(t); w = t >> 6; lane = t & 63; fr = lane & 15; fq = lane >> 4; rloc = w * 16 + fr; } while (0)
constexpr int VROW = 160;

__device__ __forceinline__ bf16x8 pack8(const f32x4 a, const f32x4 b) {
  u32x4 w;
  w.x = cvt_pk_bf16(a[0], a[1]); w.y = cvt_pk_bf16(a[2], a[3]);
  w.z = cvt_pk_bf16(b[0], b[1]); w.w = cvt_pk_bf16(b[2], b[3]);
  return __builtin_bit_cast(bf16x8, w);
}
__device__ __forceinline__ void tile_fetch(bf16x8 (&r)[2], const unsigned short* base, int t) {
  const bf16x8* q = (const bf16x8*)(base + t * 16);
  r[0] = q[0];
  r[1] = q[1];
}
__device__ __forceinline__ void stage_k(const bf16x8 (&r)[2], LAS unsigned char* ldsK, int t) {
  const int row = t >> 2, c0 = (t & 3) * 16;
  *(LAS bf16x8*)(ldsK + lds_byte(row, c0)) = r[0];
  *(LAS bf16x8*)(ldsK + lds_byte(row, c0 + 8)) = r[1];
}
__device__ __forceinline__ void stage_v(const bf16x8 (&r)[2], LAS unsigned char* ldsV, int t) {
  const int row = t >> 2, c0 = (t & 3) * 16;
  *(LAS bf16x8*)(ldsV + row * VROW + c0 * 2) = r[0];
  *(LAS bf16x8*)(ldsV + row * VROW + c0 * 2 + 16) = r[1];
}
template <int H>
__device__ __forceinline__ void attn_qk_h(f32x4 (&s)[4][2], const LAS unsigned char* qf, LAS unsigned char* ldsK, int fr, int fq) {
  const int koff = lds_byte(fr, fq * 8);
#pragma unroll
  for (int m = 0; m < 4; ++m)
#pragma unroll
    for (int nn = 0; nn < 2; ++nn) s[m][nn] = (f32x4){0.f, 0.f, 0.f, 0.f};
#pragma unroll
  for (int nn = 0; nn < 2; ++nn)
#pragma unroll
    for (int ks = 0; ks < 2; ++ks) {
      const bf16x8 kf = *(const LAS bf16x8*)(ldsK + koff + (2 * H + nn) * 2048 + ks * 1024);
#pragma unroll
      for (int m = 0; m < 4; ++m)
        s[m][nn] = __builtin_amdgcn_mfma_f32_16x16x32_bf16(kf, *(const LAS bf16x8*)(qf + (m * 2 + ks) * 1024), s[m][nn], 0, 0, 0);
    }
}
template <int H>
__device__ __forceinline__ void attn_pv_h(f32x4 (&o)[4][4], const bf16x8 (&pf)[4], LAS unsigned char* ldsV, int lane) {
  const int fq = lane >> 4, i = lane & 15;
  const int vbase = (4 * fq + (i >> 2)) * VROW + (i & 3) * 8;
#pragma unroll
  for (int dt = 0; dt < 4; ++dt) {
    LAS unsigned char* a0 = ldsV + vbase + H * 32 * VROW + dt * 32;
    const s16x4 v0 = __builtin_amdgcn_ds_read_tr16_b64_v4i16((LAS s16x4*)a0);
    const s16x4 v1 = __builtin_amdgcn_ds_read_tr16_b64_v4i16((LAS s16x4*)(a0 + 16 * VROW));
    bf16x8 vf;
    vf[0] = v0[0]; vf[1] = v0[1]; vf[2] = v0[2]; vf[3] = v0[3];
    vf[4] = v1[0]; vf[5] = v1[1]; vf[6] = v1[2]; vf[7] = v1[3];
#pragma unroll
    for (int m = 0; m < 4; ++m) o[m][dt] = __builtin_amdgcn_mfma_f32_16x16x32_bf16(vf, pf[m], o[m][dt], 0, 0, 0);
  }
}
constexpr float SOFTMAX_SHIFT = 12.0f;
template <int H, bool EM>
__device__ __forceinline__ void attn_softmax_h(f32x4 (&s)[4][2], float (&lrow)[4], bf16x8 (&pf)[4], bool rowok, int lo, int hi) {
#pragma unroll
  for (int m = 0; m < 4; ++m) {
    float ls = 0.f;
#pragma unroll
    for (int nn = 0; nn < 2; ++nn)
#pragma unroll
      for (int jj = 0; jj < 4; ++jj) {
        const int kc = 16 * (2 * H + nn) + jj;
        const bool ok = rowok && (!EM || (lo < kc && hi >= kc));
        const float pv = ok ? __builtin_amdgcn_exp2f(s[m][nn][jj] - SOFTMAX_SHIFT) : 0.f;
        s[m][nn][jj] = pv;
        ls += pv;
      }
    lrow[m] += ls;
    pf[m] = pack8(s[m][0], s[m][1]);
  }
}
template <int H, bool EM>
__device__ __forceinline__ void attn_sub(f32x4 (&o)[4][4], float (&mrow)[4], float (&lrow)[4], const LAS unsigned char* qf,
                                         LAS unsigned char* ldsK, LAS unsigned char* ldsV, bool rowok, int lo, int hi, int lane) {
  f32x4 s[4][2];
  bf16x8 pf[4];
  attn_qk_h<H>(s, qf, ldsK, lane & 15, lane >> 4);
  attn_softmax_h<H, EM>(s, lrow, pf, rowok, lo, hi);
  attn_pv_h<H>(o, pf, ldsV, lane);
  if (H == 0) __builtin_amdgcn_sched_barrier(0);
}
template <bool EM>
__device__ __forceinline__ void attn_tile(f32x4 (&o)[4][4], float (&mrow)[4], float (&lrow)[4], const LAS unsigned char* qf,
                                          LAS unsigned char* ldsK, LAS unsigned char* ldsV, bool rowok, int lo, int hi, int lane) {
  attn_sub<0, EM>(o, mrow, lrow, qf, ldsK, ldsV, rowok, lo, hi, lane);
  attn_sub<1, EM>(o, mrow, lrow, qf, ldsK, ldsV, rowok, lo, hi, lane);
}
template <int H>
__device__ __forceinline__ void cmp_stats(float (&mrow)[4], float (&lrow)[4], const LAS unsigned char* qf, LAS unsigned char* ldsK, int hi, int lane) {
  const int fq = lane >> 4;
  f32x4 s[4][2];
  attn_qk_h<H>(s, qf, ldsK, lane & 15, fq);
#pragma unroll
  for (int m = 0; m < 4; ++m) {
    float ls = 0.f;
#pragma unroll
    for (int nn = 0; nn < 2; ++nn)
#pragma unroll
      for (int jj = 0; jj < 4; ++jj) {
        const int kc = 16 * (2 * H + nn) + jj;
        ls += (hi >= kc) ? __builtin_amdgcn_exp2f(s[m][nn][jj] - SOFTMAX_SHIFT) : 0.f;
      }
    lrow[m] += ls;
  }
}
template <int H>
__device__ __forceinline__ void cmp_apply(f32x4 (&o)[4][4], const float (&msf)[4], const float (&linv)[4], float& lastprev, LAS float* improw,
                                          const LAS unsigned char* qf, LAS unsigned char* ldsK, LAS unsigned char* ldsV, int hi, int lane) {
  const int fq = lane >> 4;
  f32x4 s[4][2];
  bf16x8 pf[4];
  attn_qk_h<H>(s, qf, ldsK, lane & 15, fq);
#pragma unroll
  for (int m = 0; m < 4; ++m) {
#pragma unroll
    for (int nn = 0; nn < 2; ++nn)
#pragma unroll
      for (int jj = 0; jj < 4; ++jj) {
        const int kc = 16 * (2 * H + nn) + jj;
        s[m][nn][jj] = (hi >= kc) ? __builtin_amdgcn_exp2f(s[m][nn][jj] - SOFTMAX_SHIFT) * linv[m] : 0.f;
      }
    pf[m] = pack8(s[m][0], s[m][1]);
  }
#pragma unroll
  for (int nn = 0; nn < 2; ++nn) {
    float gs = 0.f, last = 0.f;
#pragma unroll
    for (int m = 0; m < 4; ++m) {
      gs += (s[m][nn][0] + s[m][nn][1]) + (s[m][nn][2] + s[m][nn][3]);
      last += s[m][nn][3];
    }
    const float pa = bpl(last, (lane + 48) & 63);
    const float pb = bpl(lastprev, (lane + 48) & 63);
    improw[(2 * H + nn) * 4 + fq] = gs + ((fq > 0) ? pa : pb);
    lastprev = last;
  }
  attn_pv_h<H>(o, pf, ldsV, lane);
}

__device__ __forceinline__ void attn_chunk(const Params& p, LAS unsigned char* lds, int b, int g, int ci) {
  int t = threadIdx.x;
  OPAQUE(t);
  int w = t >> 6, lane = t & 63, fr = lane & 15, fq = lane >> 4;
  LAS unsigned char* ldsK = lds;
  LAS unsigned char* ldsV = lds + 8192;
  LAS float* impb = (LAS float*)(lds + 18432) + w * 1024;
  LAS unsigned* unib = (LAS unsigned*)(lds + 18432 + 16384);
  int rloc = w * 16 + fr;
  const int tq = ci * 64 + rloc;
  const size_t tok = (size_t)b * S + tq;
  const float* grow = p.gn + tok * 24 + g * 12;
  float* orow = p.onsa + tok * 512 + g * 256;
  LAS unsigned char* qf = lds + 36864 + w * 8192 + lane * 16;
#pragma unroll
  for (int m = 0; m < 4; ++m)
#pragma unroll
    for (int ks = 0; ks < 2; ++ks)
      *(LAS bf16x8*)(qf + (m * 2 + ks) * 1024) = *(const bf16x8*)(p.qb + tok * 512 + (g * 4 + m) * 64 + ks * 32 + fq * 8);
  f32x4 o[4][4];
  float mrow[4], lrow[4];
  bf16x8 rk[2], rv[2];

  const int nvis = (tq >= 31) ? ((tq - 31) / 16 + 1) : 0;
  const int nvmax = 4 * ci + 3;
  const int ntc = (nvmax + 63) >> 6;
  const unsigned short* kcb = p.cmpb + (size_t)((0 * NB + b) * 2 + g) * 256 * 64;
  const unsigned short* vcb = p.cmpb + (size_t)((1 * NB + b) * 2 + g) * 256 * 64;
#pragma unroll
  for (int m = 0; m < 4; ++m) { mrow[m] = -INFINITY; lrow[m] = 0.f; }
  REDERIVE();
  for (int tc = 0; tc < ntc; ++tc) {
    tile_fetch(rk, kcb + (size_t)tc * 4096, t);
    stage_k(rk, ldsK, t);
    __syncthreads();
    const int hi = nvis - 1 - tc * 64 - 4 * fq;
    cmp_stats<0>(mrow, lrow, qf, ldsK, hi, lane);
    cmp_stats<1>(mrow, lrow, qf, ldsK, hi, lane);
    __syncthreads();
  }
  {
    float linv[4], msf[4];
#pragma unroll
    for (int m = 0; m < 4; ++m) {
      float l = lrow[m];
      l += bpx(l, lane, 16);
      l += bpx(l, lane, 32);
      linv[m] = (l > 0.f) ? 1.0f / l : 0.f;
      msf[m] = 0.f;
    }
    REDERIVE();
#pragma unroll
    for (int m = 0; m < 4; ++m)
#pragma unroll
      for (int dt = 0; dt < 4; ++dt) o[m][dt] = (f32x4){0.f, 0.f, 0.f, 0.f};
    float lastprev = 0.f;
    for (int tc = 0; tc < ntc; ++tc) {
      tile_fetch(rk, kcb + (size_t)tc * 4096, t);
      tile_fetch(rv, vcb + (size_t)tc * 4096, t);
      stage_k(rk, ldsK, t);
      stage_v(rv, ldsV, t);
      __syncthreads();
      const int hi = nvis - 1 - tc * 64 - 4 * fq;
      cmp_apply<0>(o, msf, linv, lastprev, impb + fr * 64 + tc * 16, qf, ldsK, ldsV, hi, lane);
      cmp_apply<1>(o, msf, linv, lastprev, impb + fr * 64 + tc * 16, qf, ldsK, ldsV, hi, lane);
      __syncthreads();
    }
  }
#pragma unroll
  for (int m = 0; m < 4; ++m) {
    const float gate = grow[m * 3 + 0];
#pragma unroll
    for (int dt = 0; dt < 4; ++dt) *(f32x4*)(orow + m * 64 + dt * 16 + 4 * fq) = o[m][dt] * gate;
  }
  unsigned mlo, mhi;
  REDERIVE();
  {
    WSYNC();
    float kv[16];
    const int c0 = -fq * 16, c1 = ci - fq * 16;
#pragma unroll
    for (int i = 0; i < 16; ++i) {
      const bool forced = (c0 == i) || (c1 == i) || (c1 == i + 1);
      float v = (c1 >= i) ? impb[fr * 64 + fq * 16 + i] : -INFINITY;
      if (forced) v = INFINITY;
      kv[i] = v;
    }
    WSYNC();
#pragma unroll
    for (int i = 0; i < 16; ++i) impb[fr * 64 + fq * 16 + i] = kv[i];
    WSYNC();
    int rank[16];
#pragma unroll
    for (int i = 0; i < 16; ++i) rank[i] = 0;
#pragma unroll 2
    for (int k = 0; k < 64; ++k) {
      const float ok = impb[fr * 64 + k];
      const int kq = k - fq * 16;
#pragma unroll
      for (int i = 0; i < 16; ++i) rank[i] += (ok > kv[i] || (ok == kv[i] && kq < i)) ? 1 : 0;
    }
    unsigned piece = 0;
#pragma unroll
    for (int i = 0; i < 16; ++i) piece |= (rank[i] < 16) ? (1u << i) : 0u;
    unsigned lo32 = (fq == 0) ? piece : (fq == 1) ? (piece << 16) : 0u;
    unsigned hi32 = (fq == 2) ? piece : (fq == 3) ? (piece << 16) : 0u;
    lo32 |= bpxu(lo32, lane, 16); lo32 |= bpxu(lo32, lane, 32);
    hi32 |= bpxu(hi32, lane, 16); hi32 |= bpxu(hi32, lane, 32);
    mlo = lo32; mhi = hi32;
    unsigned ulo = lo32, uhi = hi32;
#pragma unroll
    for (int off = 1; off < 16; off <<= 1) { ulo |= bpxu(ulo, lane, off); uhi |= bpxu(uhi, lane, off); }
    if (lane == 0) { unib[w * 2] = ulo; unib[w * 2 + 1] = uhi; }
    __syncthreads();
  }
  unsigned long long un;
  {
    const unsigned ulo = unib[0] | unib[2] | unib[4] | unib[6];
    const unsigned uhi = unib[1] | unib[3] | unib[5] | unib[7];
    un = ((unsigned long long)__builtin_amdgcn_readfirstlane(uhi) << 32) | (unsigned long long)__builtin_amdgcn_readfirstlane(ulo);
  }
  const unsigned long long rowmask = ((unsigned long long)mhi << 32) | mlo;

#pragma unroll 1
  for (int pass = 0; pass < 2; ++pass) {
    REDERIVE();
#pragma unroll
    for (int m = 0; m < 4; ++m) {
      mrow[m] = -INFINITY; lrow[m] = 0.f;
#pragma unroll
      for (int dt = 0; dt < 4; ++dt) o[m][dt] = (f32x4){0.f, 0.f, 0.f, 0.f};
    }
    const unsigned short* kb = p.kvb + (size_t)(((2 + 2 * pass) * NB + b) * 2 + g) * S * 64;
    const unsigned short* vb = p.kvb + (size_t)(((3 + 2 * pass) * NB + b) * 2 + g) * S * 64;
    const unsigned long long upto = (ci == 63) ? ~0ull : ((1ull << (ci + 1)) - 1ull);
    const int jlo = max(0, ci - 8);
    unsigned long long rem = pass ? (upto & ~((1ull << jlo) - 1ull)) : (un & upto);
    const int jwin0 = pass ? ci - 8 : -100;
    int j = __ffsll((long long)rem) - 1;
    tile_fetch(rk, kb + (size_t)j * 4096, t);
    tile_fetch(rv, vb + (size_t)j * 4096, t);
    while (rem) {
      rem &= rem - 1;
      stage_k(rk, ldsK, t);
      stage_v(rv, ldsV, t);
      __syncthreads();
      const int jn = rem ? (__ffsll((long long)rem) - 1) : -1;
      if (jn >= 0) {
        tile_fetch(rk, kb + (size_t)jn * 4096, t);
        tile_fetch(rv, vb + (size_t)jn * 4096, t);
      }
      const bool rowok = pass ? true : (bool)((rowmask >> j) & 1ull);
      int hi = (j == ci) ? rloc : 63;
      const int lo = ((j == jwin0) ? rloc : -1) - 4 * fq;
      hi = (rowok ? hi : -1000) - 4 * fq;
      attn_tile<true>(o, mrow, lrow, qf, ldsK, ldsV, true, lo, hi, lane);
      __syncthreads();
      j = jn;
    }
#pragma unroll
    for (int m = 0; m < 4; ++m) {
      float l = lrow[m];
      l += bpx(l, lane, 16);
      l += bpx(l, lane, 32);
      const float sc = grow[m * 3 + 1 + pass] / l;
#pragma unroll
      for (int dt = 0; dt < 4; ++dt) {
        f32x4* dst = (f32x4*)(orow + m * 64 + dt * 16 + 4 * fq);
        const f32x4 tot = *dst + o[m][dt] * sc;
        if (pass == 0) *dst = tot;
        else *(uint2*)(p.onsab + tok * 512 + g * 256 + m * 64 + dt * 16 + 4 * fq) = pack4(tot);
      }
    }
  }
}

#define XB_TMO      128
#define XB_XCNT(j)  (256  + 64 * (j))
#define XB_XSUB(j)  (1280 + 64 * (j))
#define XB_XGEN(j)  (2304 + 64 * (j))
#define XB_TOP      3328
#define XB_TOPGEN   3392
#define XCD_BAR_WORDS 3456
#define XB_SPIN_CAP (1u << 18)

__device__ __forceinline__ unsigned xb_ld(unsigned* p)              { return __hip_atomic_load(p, __ATOMIC_RELAXED, __HIP_MEMORY_SCOPE_AGENT); }
__device__ __forceinline__ unsigned xb_add(unsigned* p, unsigned v) { return __hip_atomic_fetch_add(p, v, __ATOMIC_RELAXED, __HIP_MEMORY_SCOPE_AGENT); }
__device__ __forceinline__ unsigned xb_xcc_id() { return (unsigned)__builtin_amdgcn_s_getreg((3 << 11) | 20) & 0xFu; }
#define XB_SPIN(cond, bar) do { unsigned _sp = 0; while (cond) { __builtin_amdgcn_s_sleep(1); \
    if ((++_sp & 255u) == 0u) { if (xb_ld(&(bar)[XB_TMO])) break; if (_sp > XB_SPIN_CAP) { atomicAdd(&(bar)[XB_TMO], 1u); break; } } } } while (0)

struct XcdBarrier {
    unsigned* bar; unsigned x;
    volatile LAS unsigned* st;
};

__device__ __forceinline__ XcdBarrier xcd_barrier_post(unsigned* bar, volatile LAS unsigned* st) {
    XcdBarrier b; b.bar = bar; b.x = xb_xcc_id(); b.st = st;
    if (threadIdx.x == 0) (void)xb_add(&bar[XB_XCNT(b.x)], 1u);
    return b;
}
__device__ __forceinline__ void xcd_barrier_complete(unsigned* bar, unsigned x, unsigned& nloc, unsigned& nx) {
    const unsigned G = gridDim.x * gridDim.y * gridDim.z;
    unsigned sum, cnt, mine, sp = 0u;
    for (;;) {
        sum = 0u; cnt = 0u; mine = 0u;
#pragma unroll
        for (unsigned j = 0; j < 16; ++j) { const unsigned c = xb_ld(&bar[XB_XCNT(j)]); sum += c; cnt += (c > 0u) ? 1u : 0u; mine = (j == x) ? c : mine; }
        if (sum == G) break;
        __builtin_amdgcn_s_sleep(1);
        if ((++sp & 255u) == 0u) { if (xb_ld(&bar[XB_TMO])) break; if (sp > XB_SPIN_CAP) { atomicAdd(&bar[XB_TMO], 1u); break; } }
    }
    nloc = mine > 0u ? mine : 1u; nx = cnt > 0u ? cnt : 1u;
}

__device__ __forceinline__ void xcd_barrier(const XcdBarrier& b) {
    asm volatile("s_waitcnt vmcnt(0)" ::: "memory");
    __syncthreads();
    if (threadIdx.x == 0) {
        unsigned* bar = b.bar;
        __builtin_amdgcn_s_waitcnt(0);
        unsigned nloc = b.st[0], nx = b.st[1];
        if (nloc == 0u) { xcd_barrier_complete(bar, b.x, nloc, nx); b.st[0] = nloc; b.st[1] = nx; }
        const unsigned old = xb_add(&bar[XB_XSUB(b.x)], 1u);
        const unsigned gen = old / nloc;
        if (old + 1u == (gen + 1u) * nloc) {
            __builtin_amdgcn_fence(__ATOMIC_RELEASE, "agent");
            asm volatile("s_waitcnt vmcnt(0)" ::: "memory");
            const unsigned og = xb_add(&bar[XB_TOP], 1u);
            const unsigned tg = og / nx;
            if (og + 1u == (tg + 1u) * nx) xb_add(&bar[XB_TOPGEN], 1u);
            else XB_SPIN(xb_ld(&bar[XB_TOPGEN]) == tg, bar);
            __builtin_amdgcn_fence(__ATOMIC_ACQUIRE, "agent");
            xb_add(&bar[XB_XGEN(b.x)], 1u);
            asm volatile("s_waitcnt vmcnt(0)" ::: "memory");
        } else {
            XB_SPIN(xb_ld(&bar[XB_XGEN(b.x)]) == gen, bar);
            __builtin_amdgcn_fence(__ATOMIC_ACQUIRE, "agent");
            asm volatile("s_waitcnt vmcnt(0)" ::: "memory");
        }
    }
    __syncthreads();
}


#define PHASE_IDX int t_ = threadIdx.x; OPAQUE(t_); const int tid = t_, lane = t_ & 63, wib = t_ >> 6; \
  const int gthreads = gridDim.x * 256, gtid = blockIdx.x * 256 + t_, gwaves = gridDim.x * 4, gwave = blockIdx.x * 4 + wib; \
  (void)tid; (void)lane; (void)wib; (void)gthreads; (void)gtid; (void)gwaves; (void)gwave;

constexpr int SMEM_BYTES = GEMM_RING * GEMM_STAGE;

__device__ __forceinline__ void conv_job(const float* W, int K, int N, bf16_t* Wt, int tile, LAS unsigned char* lds) {
  const int tnn = (N + 127) >> 7;
  convert_tile(W, N, N, Wt, K, (tile / tnn) * 64, (tile % tnn) * 128, lds);
}

__global__ void __launch_bounds__(256, 2) mega(Params p) {
  __shared__ __attribute__((aligned(16))) unsigned char smem_raw[SMEM_BYTES + 16];
  float* smem = (float*)smem_raw;
  LAS unsigned char* lds = (LAS unsigned char*)smem_raw;
  volatile LAS unsigned* xb_st = (volatile LAS unsigned*)(lds + SMEM_BYTES);
  if (threadIdx.x < 4) xb_st[threadIdx.x] = 0u;
  __syncthreads();
  const XcdBarrier gbar = xcd_barrier_post(p.bar, xb_st);

  {
  PHASE_IDX
  constexpr int MODB = 192;
  if (blockIdx.x < MODB) {
    for (int i = tid; i < NB * D; i += 256) smem[i] = siluf_(p.c[i]);
    __syncthreads();
    const int j = blockIdx.x * 32 + (lane & 31), kh = lane >> 5;
    float a0 = 0.f, a1 = 0.f, a2 = 0.f, a3 = 0.f;
    const float* wp = p.w_ada + (size_t)(wib * 256 + kh) * (6 * D) + j;
#pragma unroll 32
    for (int i = 0; i < 128; ++i) {
      const float w = wp[(size_t)(2 * i) * (6 * D)];
      const int kk = wib * 256 + 2 * i + kh;
      a0 = fmaf(smem[kk], w, a0); a1 = fmaf(smem[D + kk], w, a1);
      a2 = fmaf(smem[2 * D + kk], w, a2); a3 = fmaf(smem[3 * D + kk], w, a3);
    }
    a0 += bpx(a0, lane, 32); a1 += bpx(a1, lane, 32); a2 += bpx(a2, lane, 32); a3 += bpx(a3, lane, 32);
    __syncthreads();
    if (lane < 32) {
      smem[(wib * 4 + 0) * 32 + lane] = a0; smem[(wib * 4 + 1) * 32 + lane] = a1;
      smem[(wib * 4 + 2) * 32 + lane] = a2; smem[(wib * 4 + 3) * 32 + lane] = a3;
    }
    __syncthreads();
    if (lane < 32) {
      const int b = wib;
      const float v = p.b_ada[j] + ((smem[(0 * 4 + b) * 32 + lane] + smem[(1 * 4 + b) * 32 + lane]) +
                                    (smem[(2 * 4 + b) * 32 + lane] + smem[(3 * 4 + b) * 32 + lane]));
      p.mod[b * 6 * D + j] = v;
    }
    __syncthreads();
  }
  const int sb0 = (gridDim.x >= MODB + 144) ? MODB : 0;
  for (int idx = gtid - sb0 * 256; idx >= 0 && idx < 32 * 64; idx += gthreads) {
    const int g = idx / 64;
    const double dt = exp((double)p.log_dt[g]);
    const double lr = p.a_re[idx], li = p.a_im[idx];
    const double mag1 = exp(lr * dt);
    const double br = mag1 * cos(li * dt), bi = mag1 * sin(li * dt);
    {
      double pr_ = 1.0, pi_ = 0.0;
#pragma unroll 1
      for (int d = 0; d <= 16; ++d) {
        p.pw[(idx * 17 + d) * 2] = (float)pr_;
        p.pw[(idx * 17 + d) * 2 + 1] = (float)pi_;
        const double nr_ = pr_ * br - pi_ * bi, ni_ = pr_ * bi + pi_ * br;
        pr_ = nr_; pi_ = ni_;
      }
    }
    const double nr = br - 1.0, ni = bi;
    const double den = lr * lr + li * li;
    const double cr = (nr * lr + ni * li) / den, ci = (ni * lr - nr * li) / den;
    for (int q = 0; q < 16; ++q) {
      const double wr = p.b_re[idx * 16 + q], wi = p.b_im[idx * 16 + q];
      p.bbar[(idx * 16 + q) * 2] = (float)(cr * wr - ci * wi);
      p.bbar[(idx * 16 + q) * 2 + 1] = (float)(cr * wi + ci * wr);
    }
  }
  for (int idx = gtid; idx < NE; idx += gthreads) { p.cnt[idx] = 0; p.cursor[idx] = 0; }
  for (int o = gwave - (sb0 ? (sb0 + 8) * 4 : 0); o >= 0 && o < 512; o += gwaves) {
    const int kv = o >> 8, j = o & 255;
    const float* pe = kv ? p.pe_v : p.pe_k;
    const float* w1 = kv ? p.w_cmp_v1 : p.w_cmp_k1;
    float acc = 0.f;
    for (int k = lane; k < 2048; k += 64) acc = fmaf(pe[k], w1[(size_t)k * 256 + j], acc);
    acc = wsum(acc, lane);
    if (lane == 0) p.cbias[o] = acc;
  }
  {
    const int G = gridDim.x;
    const int first = (G > MODB) ? MODB : 0, nb = G - first;
    if ((int)blockIdx.x >= first) {
      for (int job = blockIdx.x - first; job < 1040; job += nb) {
        if (job < 496) conv_job(p.w_in, D, INC, p.w_inT, job, lds);
        else if (job < 560) conv_job(p.w_cmp_k1, 2048, 256, p.wc1T, job - 496, lds);
        else if (job < 624) conv_job(p.w_cmp_v1, 2048, 256, p.wc1T + 256 * 2048, job - 560, lds);
        else if (job < 656) conv_job(p.w_glu, 512, 512, p.wgluT, job - 624, lds);
        else if (job < 720) conv_job(p.w_up_attn, 512, D, p.wuaT, job - 656, lds);
        else if (job < 784) conv_job(p.w_up_ssm, 512, D, p.wusT, job - 720, lds);
        else if (job < 912) conv_job(p.w_out, D, D, p.woutT, job - 784, lds);
        else if (job < 944) conv_job(p.w_router, D, NE, p.wrT, job - 912, lds);
        else if (job < 976) conv_job(p.ws_gate, D, DE, p.wsgT, job - 944, lds);
        else if (job < 1008) conv_job(p.ws_up, D, DE, p.wsuT, job - 976, lds);
        else conv_job(p.ws_down, DE, D, p.wsdT, job - 1008, lds);
      }
    }
  }
  }
  xcd_barrier(gbar);

  {
  PHASE_IDX
  for (int row = gwave; row < NT; row += gwaves) {
    const int b = row / S;
    const float* xr = p.x + (size_t)row * D;
    f32x4 v[4];
    float ss = 0.f;
#pragma unroll
    for (int i = 0; i < 4; ++i) {
      v[i] = *(const f32x4*)(xr + i * 256 + lane * 4);
      ss += (v[i][0] * v[i][0] + v[i][1] * v[i][1]) + (v[i][2] * v[i][2] + v[i][3] * v[i][3]);
    }
    ss = wsum(ss, lane);
    const float r = rsqrtf(ss * (1.0f / D) + EPS);
    const float* md = p.mod + b * 6 * D;
#pragma unroll
    for (int i = 0; i < 4; ++i) {
      const int col = i * 256 + lane * 4;
      const f32x4 gg = *(const f32x4*)(p.g_norm1 + col), sc = *(const f32x4*)(md + D + col), sh = *(const f32x4*)(md + col);
      *(uint2*)(p.h + (size_t)row * D + col) = pack4(v[i] * r * gg * (sc + 1.0f) + sh);
    }
  }
  for (int idx = gtid; idx < 32 * 128 * 256; idx += gthreads) {
    const int k = idx & 255, col = (idx >> 8) & 127, g = idx >> 15;
    const int n = col >> 1, ri = col & 1, sidx = k >> 4, q = k & 15;
    const int gn = g * 64 + n;
    const float pr_ = p.pw[(gn * 17 + 15 - sidx) * 2], pi_ = p.pw[(gn * 17 + 15 - sidx) * 2 + 1];
    const float br = p.bbar[(gn * 16 + q) * 2], bi = p.bbar[(gn * 16 + q) * 2 + 1];
    const float v = ri ? (pr_ * bi + pi_ * br) : (pr_ * br - pi_ * bi);
    p.w1T[idx] = (bf16_t)(cvt_pk_bf16(v, 0.f) & 0xffffu);
  }
  for (int idx = gtid; idx < 32 * 16 * 256; idx += gthreads) {
    const int q = idx & 15, pp = (idx >> 4) & 15, d = (idx >> 8) & 15, g = idx >> 12;
    float acc = (d == 0 && pp == q) ? p.d_skip[g * 16 + pp] : 0.f;
    for (int n = 0; n < 64; ++n) {
      const int gn = g * 64 + n;
      const float cr = p.c_re[(g * 16 + pp) * 64 + n], ci = p.c_im[(g * 16 + pp) * 64 + n];
      const float pr_ = p.pw[(gn * 17 + d) * 2], pi_ = p.pw[(gn * 17 + d) * 2 + 1];
      const float br = p.bbar[(gn * 16 + q) * 2], bi = p.bbar[(gn * 16 + q) * 2 + 1];
      const float tr = cr * pr_ - ci * pi_, ti = cr * pi_ + ci * pr_;
      acc += tr * br - ti * bi;
    }
    p.kd[idx] = acc;
  }
  for (int idx = gtid; idx < 32 * 256 * 128; idx += gthreads) {
    const int k = idx & 127, col = (idx >> 7) & 255, g = idx >> 15;
    const int i = col >> 4, pp = col & 15, n = k >> 1, ri = k & 1;
    const int gn = g * 64 + n;
    const float cr = p.c_re[(g * 16 + pp) * 64 + n], ci = p.c_im[(g * 16 + pp) * 64 + n];
    const float pr_ = p.pw[(gn * 17 + i + 1) * 2], pi_ = p.pw[(gn * 17 + i + 1) * 2 + 1];
    const float v = ri ? -(cr * pi_ + ci * pr_) : (cr * pr_ - ci * pi_);
    p.wyT[((size_t)g * 256 + col) * 384 + k] = (bf16_t)(cvt_pk_bf16(v, 0.f) & 0xffffu);
  }
  }
  xcd_barrier(gbar);

  {
  PHASE_IDX
  {
    constexpr int TN = (INC + TNW - 1) / TNW;
    int mt_, nt_;
    for (int it = 0; xcd_tile(it, NT / TM, TN, mt_, nt_); ++it) {
      const int m0 = mt_ * TM, n0 = nt_ * TNW;
      gemm128<true>(
          D, [&](int r) { return p.h + (size_t)(m0 + r) * D; },
          [&](int c) { return p.w_inT + (size_t)min(n0 + c, INC - 1) * 32; },
          [&](const f32x4 (&acc)[4][8], int wr, int wc, int fr, int fq) {
#pragma unroll
            for (int sg = 0; sg < 2; ++sg) {
              const int cw = n0 + wc * 128 + sg * 64;
              if (cw < C_GN) {
                const bool isq = cw < C_KC;
                const int slot = isq ? 0 : (cw - C_KC) >> 7;
                const bool norm = isq || slot == 2 || slot == 4;
                const float* gain = isq ? p.q_gain : (slot == 2 ? p.ks_gain : p.kw_gain);
                const float post = isq ? ATT_SCALE * 1.4426950408889634f : 1.0f;
#pragma unroll
                for (int m = 0; m < 4; ++m) {
                  float r = 1.0f;
                  if (norm) {
                    float ss = 0.f;
#pragma unroll
                    for (int n = 0; n < 4; ++n)
#pragma unroll
                      for (int jj = 0; jj < 4; ++jj) ss = fmaf(acc[m][sg * 4 + n][jj], acc[m][sg * 4 + n][jj], ss);
                    ss += bpx(ss, fq * 16 + fr, 16);
                    ss += bpx(ss, fq * 16 + fr, 32);
                    r = rsqrtf(ss * (1.0f / 64) + EPS) * post;
                  }
#pragma unroll
                  for (int n = 0; n < 4; ++n) {
                    f32x4 v = acc[m][sg * 4 + n] * r;
                    if (norm) v = v * *(const f32x4*)(gain + n * 16 + 4 * fq);
                    tile_out_stage(lds, wr, wc, fr, fq, m, sg * 4 + n, pack4(v));
                  }
                }
              } else {
#pragma unroll
                for (int m = 0; m < 4; ++m) {
                  const size_t tok = m0 + wr * 64 + m * 16 + fr;
#pragma unroll
                  for (int n = 0; n < 4; ++n) {
                    const int c = cw + n * 16 + 4 * fq;
                    f32x4 v = acc[m][sg * 4 + n];
                    if (c >= C_U && c < C_GA) {
                      tile_out_stage(lds, wr, wc, fr, fq, m, sg * 4 + n, pack4(v));
                    } else {
#pragma unroll
                      for (int j = 0; j < 4; ++j) v[j] = sigmoidf_(v[j]);
                      if (c < C_U) *(f32x4*)(p.gn + tok * 24 + (c - C_GN)) = v;
                      else tile_out_stage(lds, wr, wc, fr, fq, m, sg * 4 + n, pack4(v));
                    }
                  }
                }
              }
            }
          },
          lds, 32, INC * 32);
      {
        int t = threadIdx.x;
        OPAQUE(t);
        __syncthreads();
#pragma unroll 4
        for (int i = 0; i < 16; ++i) {
          const int q = t + i * 256, row = q >> 5, piece = q & 31;
          const int c = n0 + piece * 8;
          const size_t tok = m0 + row;
          bf16_t* dst = nullptr;
          if (c < C_KC) dst = p.qb + tok * 512 + c;
          else if (c < C_GN) {
            const int slot = (c - C_KC) >> 7, gg = ((c - C_KC) >> 6) & 1;
            dst = p.kvb + ((size_t)((slot * NB + (tok >> 12)) * 2 + gg) * S + (tok & (S - 1))) * 64 + (c & 63);
          } else if (c < C_U) dst = nullptr;
          else if (c < C_GA) { const int ch = c - C_U; dst = p.a3 + ((size_t)(ch >> 4) * 1024 + (tok >> 4)) * 384 + 128 + (tok & 15) * 16 + (ch & 15); }
          else if (c < C_GS) dst = p.ga + tok * D + (c - C_GA);
          else if (c < INC) dst = p.gs + tok * D + (c - C_GS);
          if (dst) *(u32x4*)dst = *(const LAS u32x4*)(lds + row * OSTRIDE + piece * 16);
        }
        __syncthreads();
      }
    }
  }
  for (int idx = gtid; idx < 32 * 256 * 256; idx += gthreads) {
    const int k = idx & 255, col = (idx >> 8) & 255, g = idx >> 16;
    const int i = col >> 4, pp = col & 15, sidx = k >> 4, q = k & 15;
    const float v = (i >= sidx) ? p.kd[((g * 16 + (i - sidx)) * 16 + pp) * 16 + q] : 0.f;
    p.wyT[((size_t)g * 256 + col) * 384 + 128 + k] = (bf16_t)(cvt_pk_bf16(v, 0.f) & 0xffffu);
  }
  }
  xcd_barrier(gbar);

  {
  PHASE_IDX
  for (int job = blockIdx.x; job < 2 * 8 * 16; job += gridDim.x) {
    const int kv = job >> 7, ks = (job >> 4) & 7, m0 = (job & 15) * 128;
    float* hp = p.hidp + (size_t)(ks * 2 + kv) * 2040 * 256;
    gemm128<true>(
        256,
        [&](int r) {
          const int rr = min(m0 + r, NB * NCMP * 2 - 1);
          const int b = rr / (NCMP * 2), n = (rr >> 1) % NCMP, g = rr & 1;
          return p.kvb + ((size_t)((kv * NB + b) * 2 + g) * S + 16 * n) * 64 + ks * 256;
        },
        [&](int c) { return p.wc1T + (size_t)kv * 256 * 2048 + (size_t)(ks * 8 * 256 + c) * 32; },
        [&](const f32x4 (&acc)[4][8], int wr, int wc, int fr, int fq) {
#pragma unroll
          for (int m = 0; m < 4; ++m) {
            const int r = m0 + wr * 64 + m * 16 + fr;
            if (r < NB * NCMP * 2) {
#pragma unroll
              for (int n = 0; n < 8; ++n) *(f32x4*)(hp + (size_t)r * 256 + wc * 128 + n * 16 + 4 * fq) = acc[m][n];
            }
          }
        },
        lds, 32, 256 * 32);
  }
  int mt_, g;
  for (int it = 0; xcd_tile(it, 8, 32, mt_, g); ++it) {
    const int m0 = mt_ * 128;
    gemm128<true>(
        256, [&](int r) { return p.a3 + ((size_t)g * 1024 + m0 + r) * 384 + 128; },
        [&](int c) { return p.w1T + ((size_t)g * 128 + (c & 127)) * 256; },
        [&](const f32x4 (&acc)[4][8], int wr, int wc, int fr, int fq) {
          if (wc == 0) {
#pragma unroll
            for (int m = 0; m < 4; ++m)
#pragma unroll
              for (int n = 0; n < 8; ++n)
                *(f32x4*)(p.lbuf + ((size_t)g * 1024 + m0 + wr * 64 + m * 16 + fr) * 128 + n * 16 + 4 * fq) = acc[m][n];
          }
        },
        lds);
  }
  }
  xcd_barrier(gbar);

  {
  PHASE_IDX
  for (int wv = gwave; wv < 2 * NB * NCMP * 2; wv += gwaves) {
    const int kv = wv / (NB * NCMP * 2), r = wv % (NB * NCMP * 2);
    const int b = r / (NCMP * 2), n = (r >> 1) % NCMP, g = r & 1;
    const float* w2 = kv ? p.w_cmp_v2 : p.w_cmp_k2;
    {
      f32x4 hsum = *(const f32x4*)(p.cbias + kv * 256 + lane * 4);
#pragma unroll
      for (int ks = 0; ks < 8; ++ks) hsum = hsum + *(const f32x4*)(p.hidp + ((size_t)(ks * 2 + kv) * 2040 + r) * 256 + lane * 4);
#pragma unroll
      for (int j = 0; j < 4; ++j) hsum[j] = geluf_(hsum[j]);
      WSYNC();
      *(f32x4*)(smem + wib * 256 + lane * 4) = hsum;
      WSYNC();
    }
    const float* hid = smem + wib * 256;
    float acc = 0.f;
    for (int j = 0; j < 256; ++j) acc = fmaf(hid[j], w2[j * 64 + lane], acc);
    if (kv == 0) {
      const float ss = wsum(acc * acc, lane);
      acc = acc * rsqrtf(ss * (1.0f / 64) + EPS) * p.kc_gain[lane];
    }
    const float other = bpx(acc, lane, 1);
    if ((lane & 1) == 0)
      *(unsigned*)(p.cmpb + ((size_t)((kv * NB + b) * 2 + g) * 256 + n) * 64 + lane) = cvt_pk_bf16(acc, other);
  }
  for (int idx = gtid; idx < 2 * NB * 2 * 32; idx += gthreads)
    *(unsigned*)(p.cmpb + ((size_t)(idx >> 5) * 256 + 255) * 64 + (idx & 31) * 2) = 0u;
  for (int idx = gtid; idx < 32 * NB * 64; idx += gthreads) {
    const int n = idx & 63, b = (idx >> 6) & 3, g = idx >> 8;
    const int gn = g * 64 + n;
    const float lr = p.pw[(gn * 17 + 16) * 2], li = p.pw[(gn * 17 + 16) * 2 + 1];
    float hr_ = 0.f, hi_ = 0.f;
    const size_t row0 = (size_t)g * 1024 + b * 256;
#pragma unroll 1
    for (int c0 = 0; c0 < 256; c0 += 16) {
      float2 l2[16];
#pragma unroll
      for (int i = 0; i < 16; ++i) l2[i] = *(const float2*)(p.lbuf + (row0 + c0 + i) * 128 + n * 2);
#pragma unroll
      for (int i = 0; i < 16; ++i) {
        *(unsigned*)(p.a3 + (row0 + c0 + i) * 384 + n * 2) = cvt_pk_bf16(hr_, hi_);
        const float nr = lr * hr_ - li * hi_ + l2[i].x;
        const float ni = lr * hi_ + li * hr_ + l2[i].y;
        hr_ = nr; hi_ = ni;
      }
    }
  }
  }
  xcd_barrier(gbar);

  {
  PHASE_IDX
  const int G = gridDim.x;
  const bool split = G >= 512;
  if (!split || blockIdx.x < 256) {
    for (int u = blockIdx.x; u < 256; u += (split ? 256 : G)) {
      const int bg = u >> 5, pr = u & 31;
      __builtin_amdgcn_s_setprio(2);
#pragma unroll 1
      for (int half = 0; half < 2; ++half) attn_chunk(p, lds, bg >> 1, bg & 1, half ? pr : 63 - pr);
      __builtin_amdgcn_s_setprio(0);
    }
  }
  if (!split || blockIdx.x >= 256) {
    const int x8 = blockIdx.x & 7, nsl = split ? ((G - 256) >> 3) : 0, sl = split ? (((int)blockIdx.x - 256) >> 3) : 0;
    for (int it = 0;; ++it) {
      int tile;
      if (split && ((G & 7) == 0)) { const int q = sl + it * nsl; if (q >= 32) break; tile = ((x8 + 8 * (q >> 3)) << 3) | (q & 7); }
      else { tile = (split ? (int)blockIdx.x - 256 : (int)blockIdx.x) + it * (split ? G - 256 : G); if (tile >= 256) break; }
      const int g = tile >> 3, m0 = (tile & 7) * 128, n0 = 0;
      gemm128(
          384, [&](int r) { return p.a3 + ((size_t)g * 1024 + m0 + r) * 384; },
          [&](int c) { return p.wyT + ((size_t)g * 256 + n0 + c) * 384; },
          [&](const f32x4 (&acc)[4][8], int wr, int wc, int fr, int fq) {
#pragma unroll
            for (int m = 0; m < 4; ++m)
#pragma unroll
              for (int n = 0; n < 8; ++n) {
                const int col = n0 + wc * 128 + n * 16 + 4 * fq;
                const size_t tok = (size_t)(m0 + wr * 64 + m * 16 + fr) * 16 + (col >> 4);
                f32x4 v = acc[m][n];
#pragma unroll
                for (int j = 0; j < 4; ++j) v[j] = geluf_(v[j]);
                *(uint2*)(p.z + tok * 512 + g * 16 + (col & 15)) = pack4(v);
              }
          },
          lds);
    }
    const int cb = split ? (int)blockIdx.x - 256 : (int)blockIdx.x, cn = split ? G - 256 : G;
    for (int job = cb; job < NE * 96; job += cn) {
      const int e = job / 96, rem = job - e * 96, which = rem >> 5, tile = rem & 31;
      if (which == 0) conv_job(p.w_gate + (size_t)e * D * DE, D, DE, p.wgT + (size_t)e * DE * D, tile, lds);
      else if (which == 1) conv_job(p.w_up + (size_t)e * D * DE, D, DE, p.wuT + (size_t)e * DE * D, tile, lds);
      else conv_job(p.w_down + (size_t)e * DE * D, DE, D, p.wdT + (size_t)e * D * DE, tile, lds);
    }
  }
  }
  xcd_barrier(gbar);

  {
  PHASE_IDX
  gemm_phase_bf16(
      NT, 512, 512, [&](int m) { return p.z + (size_t)m * 512; }, [&](int n) { return p.wgluT + (size_t)n * 32; },
      [&](int m, int n, f32x4 v) {
        const f32x4 zz = unpack4(*(const uint2*)(p.z + (size_t)m * 512 + n));
#pragma unroll
        for (int j = 0; j < 4; ++j) v[j] = zz[j] * sigmoidf_(v[j] + p.b_glu[n + j]);
        return v;
      },
      p.yssm, 512, lds, 512 * 32);
  gemm_phase_bf16(
      NT, D, 512, [&](int m) { return p.onsab + (size_t)m * 512; }, [&](int n) { return p.wuaT + (size_t)n * 32; },
      [&](int m, int n, f32x4 v) {
        const f32x4 gg = unpack4(*(const uint2*)(p.ga + (size_t)m * D + n));
        return gg * v;
      },
      p.mtmp, D, lds, D * 32);
  }
  xcd_barrier(gbar);
  {
  PHASE_IDX
  gemm_phase_bf16(
      NT, D, 512, [&](int m) { return p.yssm + (size_t)m * 512; }, [&](int n) { return p.wusT + (size_t)n * 32; },
      [&](int m, int n, f32x4 v) {
        const f32x4 gg = unpack4(*(const uint2*)(p.gs + (size_t)m * D + n));
        const f32x4 prev = unpack4(*(const uint2*)(p.mtmp + (size_t)m * D + n));
        return prev + gg * v;
      },
      p.merged, D, lds, D * 32);
  }
  xcd_barrier(gbar);
  {
  PHASE_IDX
  gemm_phase(
      NT, D, D, [&](int m) { return p.merged + (size_t)m * D; }, [&](int n) { return p.woutT + (size_t)n * 32; },
      [&](int m, int n, f32x4 v) {
        const int b = m / S;
        const f32x4 xx = *(const f32x4*)(p.x + (size_t)m * D + n);
        const f32x4 gt = *(const f32x4*)(p.mod + b * 6 * D + 2 * D + n);
        *(f32x4*)(p.xmid + (size_t)m * D + n) = xx + gt * v;
      },
      lds, D * 32);
  }
  xcd_barrier(gbar);

  {
  PHASE_IDX
  for (int row = gwave; row < NT; row += gwaves) {
    const int b = row / S;
    const float* xr = p.xmid + (size_t)row * D;
    f32x4 v[4];
    float ss = 0.f;
#pragma unroll
    for (int i = 0; i < 4; ++i) {
      v[i] = *(const f32x4*)(xr + i * 256 + lane * 4);
      ss += (v[i][0] * v[i][0] + v[i][1] * v[i][1]) + (v[i][2] * v[i][2] + v[i][3] * v[i][3]);
    }
    ss = wsum(ss, lane);
    const float r = rsqrtf(ss * (1.0f / D) + EPS);
    const float* md = p.mod + b * 6 * D;
#pragma unroll
    for (int i = 0; i < 4; ++i) {
      const int col = i * 256 + lane * 4;
      const f32x4 gg = *(const f32x4*)(p.g_norm2 + col), sc = *(const f32x4*)(md + 4 * D + col), sh = *(const f32x4*)(md + 3 * D + col);
      *(uint2*)(p.h + (size_t)row * D + col) = pack4(v[i] * r * gg * (sc + 1.0f) + sh);
    }
  }
  }
  xcd_barrier(gbar);

  {
  PHASE_IDX
  int mt_, nt_;
  for (int it = 0; xcd_tile(it, NT / TM, 3, mt_, nt_); ++it) {
    const int m0 = mt_ * TM;
    if (nt_ == 0) {
      gemm128<true>(
          D, [&](int r) { return p.h + (size_t)(m0 + r) * D; }, [&](int c) { return p.wrT + (size_t)c * 32; },
          [&](const f32x4 (&acc)[4][8], int wr, int wc, int fr, int fq) {
#pragma unroll
            for (int m = 0; m < 4; ++m)
#pragma unroll
              for (int n = 0; n < 8; ++n) {
                f32x4 v = acc[m][n];
#pragma unroll
                for (int j = 0; j < 4; ++j) v[j] = sigmoid_acc(v[j]);
                *(f32x4*)(p.scores + (size_t)(m0 + wr * 64 + m * 16 + fr) * NE + wc * 128 + n * 16 + 4 * fq) = v;
              }
          },
          lds, 32, NE * 32);
    } else {
      const int ct = nt_ - 1;
      gemm128<true>(
          D, [&](int r) { return p.h + (size_t)(m0 + r) * D; },
          [&](int c) {
            const int hid = ct * 128 + (c >> 7) * 64 + ((c >> 4) & 3) * 16 + (c & 15);
            return (((c >> 6) & 1) ? p.wsuT : p.wsgT) + (size_t)hid * 32;
          },
          [&](const f32x4 (&acc)[4][8], int wr, int wc, int fr, int fq) {
#pragma unroll
            for (int m = 0; m < 4; ++m)
#pragma unroll
              for (int n = 0; n < 4; ++n) {
                f32x4 v;
#pragma unroll
                for (int j = 0; j < 4; ++j) v[j] = siluf_(acc[m][n][j]) * acc[m][n + 4][j];
                tile_out_put(lds, wr * 64 + m * 16 + fr, wc * 64 + n * 16 + 4 * fq, pack4(v));
              }
          },
          lds, 32, DE * 32);
      tile_out_flush128(lds, 128, [&](int r) { return p.hs + (size_t)(m0 + r) * DE + ct * 128; });
    }
  }
  }
  xcd_barrier(gbar);

  {
  PHASE_IDX
  for (int tok = gwave; tok < NT; tok += gwaves) {
    const float4 sc4 = *reinterpret_cast<const float4*>(p.scores + (size_t)tok * NE + lane * 4);
    const float4 bi4 = *reinterpret_cast<const float4*>(p.router_bias + lane * 4);
    const float sc[4] = {sc4.x, sc4.y, sc4.z, sc4.w};
    float bz[4] = {sc4.x + bi4.x, sc4.y + bi4.y, sc4.z + bi4.z, sc4.w + bi4.w};
    float m1 = -INFINITY, m2 = -INFINITY;
#pragma unroll
    for (int i = 0; i < 4; ++i) {
      const float v = bz[i];
      if (v > m1) { m2 = m1; m1 = v; } else if (v > m2) { m2 = v; }
    }
#pragma unroll
    for (int o = 1; o < 8; o <<= 1) {
      const float o1 = bpx(m1, lane, o), o2 = bpx(m2, lane, o);
      const float n1 = fmaxf(m1, o1);
      const float n2 = fmaxf(fminf(m1, o1), fmaxf(m2, o2));
      m1 = n1; m2 = n2;
    }
    const float gs = m1 + m2;
    const int mygrp = lane >> 3;
    int grank = 0;
#pragma unroll
    for (int g2 = 0; g2 < 8; ++g2) {
      const float og = bpl(gs, g2 * 8);
      grank += (og > gs || (og == gs && g2 < mygrp)) ? 1 : 0;
    }
    const bool gsel = grank < 4;
#pragma unroll
    for (int i = 0; i < 4; ++i) if (!gsel) bz[i] = -INFINITY;
    unsigned taken = 0;
    float wsel = 0.f;
    int esel = 0;
    float wtot = 0.f;
#pragma unroll 1
    for (int k = 0; k < TOPK; ++k) {
      float bv = -INFINITY; int bidx = 1 << 30;
#pragma unroll
      for (int i = 0; i < 4; ++i) {
        if (!((taken >> i) & 1u) && bz[i] > bv) { bv = bz[i]; bidx = lane * 4 + i; }
      }
#pragma unroll
      for (int o = 32; o > 0; o >>= 1) {
        const float ov = bpx(bv, lane, o);
        const int oi = bpxi(bidx, lane, o);
        if (ov > bv || (ov == bv && oi < bidx)) { bv = ov; bidx = oi; }
      }
      const int owner = bidx >> 2, slot = bidx & 3;
      float sv = 0.f;
      if (lane == owner) {
        taken |= 1u << slot;
        sv = (slot == 0) ? sc[0] : (slot == 1) ? sc[1] : (slot == 2) ? sc[2] : sc[3];
      }
      sv = bpl(sv, owner);
      wtot += sv;
      if (lane == k) { wsel = sv; esel = bidx; }
    }
    if (lane < TOPK) {
      p.eidx[tok * TOPK + lane] = esel;
      p.ew[tok * TOPK + lane] = wsel / wtot * 2.5f;
      atomicAdd(&p.cnt[esel], 1);
    }
  }
  gemm_phase(
      NT, D, DE, [&](int m) { return p.hs + (size_t)m * DE; }, [&](int n) { return p.wsdT + (size_t)n * 32; },
      [&](int m, int n, f32x4 v) {
        const int b = m / S;
        const f32x4 xx = *(const f32x4*)(p.xmid + (size_t)m * D + n);
        const f32x4 gt = *(const f32x4*)(p.mod + b * 6 * D + 5 * D + n);
        *(f32x4*)(p.out + (size_t)m * D + n) = xx + gt * v;
      },
      lds, D * 32);
  }
  xcd_barrier(gbar);

  {
  PHASE_IDX
  {
    int* soff = (int*)smem;
    int* srt = soff + 320;
    const int myc = p.cnt[tid];
    soff[tid] = myc;
    srt[tid] = (myc + 127) >> 7;
    __syncthreads();
    for (int st = 1; st < 256; st <<= 1) {
      const int a0 = (tid >= st) ? soff[tid - st] : 0;
      __syncthreads();
      soff[tid] += a0;
      __syncthreads();
    }
    const int exo = soff[tid] - myc;
    __syncthreads();
    soff[tid] = exo;
    if (blockIdx.x == 0) {
      p.off[tid] = exo;
      if (tid == 255) p.off[NE] = exo + myc;
    }
    __syncthreads();
    if (blockIdx.x == 0 && tid < 8) {
      int acc = 0;
      for (int i = 0; i < 32; ++i) { p.xrts[tid * 33 + i] = acc; acc += srt[tid + 8 * i]; }
      p.xrts[tid * 33 + 32] = acc;
    }
    for (int idx = gtid; idx < NASSIGN; idx += gthreads) {
      const int e = p.eidx[idx];
      const int pos = soff[e] + atomicAdd(&p.cursor[e], 1);
      p.stok[pos] = idx / TOPK;
      p.sw[pos] = p.ew[idx];
      p.apos[idx] = pos;
    }
    __syncthreads();
  }
  }
  xcd_barrier(gbar);

  {
  PHASE_IDX
  {
    const int x8 = blockIdx.x & 7, ns8 = ((int)gridDim.x - x8 + 7) >> 3;
    const int* xr = p.xrts + x8 * 33;
    const int total_rt = xr[32];
    for (int tile = blockIdx.x >> 3; tile < total_rt * 2; tile += ns8) {
      const int rt = tile >> 1, ct = tile & 1;
      const int ei = find_idx(xr, 32, rt);
      const int e = x8 + 8 * ei;
      const int pos0 = p.off[e] + (rt - xr[ei]) * 128;
      const int mvalid = min(128, p.off[e] + p.cnt[e] - pos0);
      const bf16_t* wg = p.wgT + (size_t)e * DE * D;
      const bf16_t* wu = p.wuT + (size_t)e * DE * D;
      gemm128<true>(
          D, [&](int r) { return p.h + (size_t)p.stok[pos0 + min(r, mvalid - 1)] * D; },
          [&](int c) {
            const int hid = ct * 128 + (c >> 7) * 64 + ((c >> 4) & 3) * 16 + (c & 15);
            return (((c >> 6) & 1) ? wu : wg) + (size_t)hid * 32;
          },
          [&](const f32x4 (&acc)[4][8], int wr, int wc, int fr, int fq) {
#pragma unroll
            for (int m = 0; m < 4; ++m)
#pragma unroll
              for (int n = 0; n < 4; ++n) {
                f32x4 v;
#pragma unroll
                for (int j = 0; j < 4; ++j) v[j] = siluf_(acc[m][n][j]) * acc[m][n + 4][j];
                tile_out_put(lds, wr * 64 + m * 16 + fr, wc * 64 + n * 16 + 4 * fq, pack4(v));
              }
          },
          lds, 32, DE * 32);
      tile_out_flush128(lds, mvalid, [&](int r) { return p.hr + (size_t)(pos0 + r) * DE + ct * 128; });
    }
  }
  }
  xcd_barrier(gbar);
  {
  PHASE_IDX
  {
    const int x8 = blockIdx.x & 7, ns8 = ((int)gridDim.x - x8 + 7) >> 3;
    const int* xr = p.xrts + x8 * 33;
    const int total_rt = xr[32];
    for (int tile = blockIdx.x >> 3; tile < total_rt * 4; tile += ns8) {
      const int rt = tile >> 2, ct = tile & 3;
      const int ei = find_idx(xr, 32, rt);
      const int e = x8 + 8 * ei;
      const int pos0 = p.off[e] + (rt - xr[ei]) * 128;
      const int mvalid = min(128, p.off[e] + p.cnt[e] - pos0);
      const bf16_t* wd = p.wdT + (size_t)e * D * DE + (size_t)(ct * 256) * 32;
      gemm128<true>(
          DE, [&](int r) { return p.hr + (size_t)(pos0 + min(r, mvalid - 1)) * DE; },
          [&](int c) { return wd + (size_t)c * 32; },
          [&](const f32x4 (&acc)[4][8], int wr, int wc, int fr, int fq) {
#pragma unroll
            for (int m = 0; m < 4; ++m) {
              const float wgt = p.sw[pos0 + min(wr * 64 + m * 16 + fr, mvalid - 1)];
#pragma unroll
              for (int n = 0; n < 8; ++n) tile_out_stage(lds, wr, wc, fr, fq, m, n, pack4(acc[m][n] * wgt));
            }
          },
          lds, 32, D * 32);
      tile_out_flush(lds, mvalid, [&](int r) { return p.yk + (size_t)(pos0 + r) * D + ct * 256; });
    }
  }
  }
  xcd_barrier(gbar);
  {
  PHASE_IDX
  for (int tok = gwave; tok < NT; tok += gwaves) {
    const int b = tok / S;
    const int4 ps0 = *(const int4*)(p.apos + tok * TOPK), ps1 = *(const int4*)(p.apos + tok * TOPK + 4);
    const int pos8[8] = {ps0.x, ps0.y, ps0.z, ps0.w, ps1.x, ps1.y, ps1.z, ps1.w};
    u32x4 ra_[8], rc_[8];
#pragma unroll
    for (int k = 0; k < TOPK; ++k) {
      const u32x4* src = (const u32x4*)(p.yk + (size_t)pos8[k] * D + lane * 16);
      ra_[k] = src[0]; rc_[k] = src[1];
    }
    float acc[16];
#pragma unroll
    for (int i = 0; i < 16; ++i) acc[i] = 0.f;
#pragma unroll
    for (int k = 0; k < TOPK; ++k) {
      const unsigned wv[8] = {ra_[k].x, ra_[k].y, ra_[k].z, ra_[k].w, rc_[k].x, rc_[k].y, rc_[k].z, rc_[k].w};
#pragma unroll
      for (int i = 0; i < 8; ++i) {
        acc[2 * i] += __uint_as_float(wv[i] << 16);
        acc[2 * i + 1] += __uint_as_float(wv[i] & 0xffff0000u);
      }
    }
    float* dst = p.out + (size_t)tok * D + lane * 16;
    const float* gt = p.mod + b * 6 * D + 5 * D + lane * 16;
#pragma unroll
    for (int i = 0; i < 4; ++i) {
      f32x4 o4 = *(f32x4*)(dst + 4 * i);
      const f32x4 g4 = *(const f32x4*)(gt + 4 * i);
#pragma unroll
      for (int j = 0; j < 4; ++j) o4[j] += g4[j] * acc[4 * i + j];
      *(f32x4*)(dst + 4 * i) = o4;
    }
  }
  }
}

extern "C" void kernel_launch(void* const* d_in, const int* in_sizes, int n_in, void* d_out, int out_size,
                              void* d_ws, size_t ws_size, hipStream_t stream) {
  (void)in_sizes; (void)n_in; (void)out_size;
  Params p{};
  const float* const* in = reinterpret_cast<const float* const*>(d_in);
  p.x = in[0]; p.c = in[1]; p.w_ada = in[2]; p.b_ada = in[3]; p.g_norm1 = in[4]; p.g_norm2 = in[5];
  p.w_in = in[6]; p.q_gain = in[7]; p.kc_gain = in[8]; p.ks_gain = in[9]; p.kw_gain = in[10];
  p.pe_k = in[11]; p.pe_v = in[12]; p.w_cmp_k1 = in[13]; p.w_cmp_k2 = in[14]; p.w_cmp_v1 = in[15];
  p.w_cmp_v2 = in[16]; p.a_re = in[17]; p.a_im = in[18]; p.log_dt = in[19]; p.b_re = in[20];
  p.b_im = in[21]; p.c_re = in[22]; p.c_im = in[23]; p.d_skip = in[24]; p.w_glu = in[25];
  p.b_glu = in[26]; p.w_up_attn = in[27]; p.w_up_ssm = in[28]; p.w_out = in[29]; p.w_router = in[30];
  p.router_bias = in[31]; p.w_gate = in[32]; p.w_up = in[33]; p.w_down = in[34]; p.ws_gate = in[35];
  p.ws_up = in[36]; p.ws_down = in[37];
  p.out = (float*)d_out;

  char* base = (char*)d_ws;
  size_t o = 0;
  auto take = [&](size_t bytes) { void* r = base + o; o += (bytes + 255) & ~(size_t)255; return r; };
  p.bar = (unsigned*)take(sizeof(unsigned) * XCD_BAR_WORDS);
  p.mod = (float*)take(sizeof(float) * NB * 6 * D);
  p.cbias = (float*)take(sizeof(float) * 512);
  p.w_inT = (bf16_t*)take(2 * (size_t)INC * D);
  p.wc1T = (bf16_t*)take(2 * (size_t)2 * 256 * 2048);
  p.wgluT = (bf16_t*)take(2 * (size_t)512 * 512);
  p.wuaT = (bf16_t*)take(2 * (size_t)D * 512);
  p.wusT = (bf16_t*)take(2 * (size_t)D * 512);
  p.woutT = (bf16_t*)take(2 * (size_t)D * D);
  p.wrT = (bf16_t*)take(2 * (size_t)NE * D);
  p.wsgT = (bf16_t*)take(2 * (size_t)DE * D);
  p.wsuT = (bf16_t*)take(2 * (size_t)DE * D);
  p.wsdT = (bf16_t*)take(2 * (size_t)D * DE);
  p.w1T = (bf16_t*)take(2 * (size_t)32 * 128 * 256);
  p.wyT = (bf16_t*)take(2 * (size_t)32 * 256 * 384);
  p.wgT = (bf16_t*)take(2 * (size_t)NE * DE * D);
  p.wuT = (bf16_t*)take(2 * (size_t)NE * DE * D);
  p.wdT = (bf16_t*)take(2 * (size_t)NE * D * DE);
  p.h = (bf16_t*)take(2 * (size_t)NT * D);
  p.pw = (float*)take(sizeof(float) * 2048 * 17 * 2);
  p.bbar = (float*)take(sizeof(float) * 2048 * 32);
  p.kd = (float*)take(sizeof(float) * 32 * 16 * 256);
  p.xmid = (float*)take(sizeof(float) * (size_t)NT * D);
  p.scores = (float*)take(sizeof(float) * (size_t)NT * NE);
  p.eidx = (int*)take(sizeof(int) * NASSIGN);
  p.ew = (float*)take(sizeof(float) * NASSIGN);
  p.cnt = (int*)take(sizeof(int) * NE);
  p.cursor = (int*)take(sizeof(int) * NE);
  p.off = (int*)take(sizeof(int) * (NE + 1));
  p.xrts = (int*)take(sizeof(int) * 8 * 33);
  p.stok = (int*)take(sizeof(int) * NASSIGN);
  p.sw = (float*)take(sizeof(float) * NASSIGN);
  p.apos = (int*)take(sizeof(int) * NASSIGN);
  p.hs = (bf16_t*)take(2 * (size_t)NT * DE);
  p.hr = (bf16_t*)take(2 * (size_t)NASSIGN * DE);
  const size_t early0 = o;
  p.qb = (bf16_t*)take(2 * (size_t)NT * 512);
  p.kvb = (bf16_t*)take(2 * (size_t)6 * NB * 2 * S * 64);
  p.cmpb = (bf16_t*)take(2 * (size_t)2 * NB * 2 * 256 * 64);
  p.gn = (float*)take(sizeof(float) * (size_t)NT * 24);
  p.a3 = (bf16_t*)take(2 * (size_t)32 * 1024 * 384);
  p.ga = (bf16_t*)take(2 * (size_t)NT * D);
  p.gs = (bf16_t*)take(2 * (size_t)NT * D);
  p.hidp = (float*)take(sizeof(float) * 16 * 2040 * 256);
  p.onsa = (float*)take(sizeof(float) * (size_t)NT * 512);
  p.onsab = (bf16_t*)take(2 * (size_t)NT * 512);
  p.lbuf = (float*)take(sizeof(float) * 32 * 1024 * 128);
  p.z = (bf16_t*)take(2 * (size_t)NT * 512);
  p.yssm = (bf16_t*)take(2 * (size_t)NT * 512);
  p.mtmp = (bf16_t*)take(2 * (size_t)NT * D);
  p.merged = (bf16_t*)take(2 * (size_t)NT * D);
  const size_t early1 = o;
  p.yk = (bf16_t*)(base + early0);
  const size_t yk_bytes = 2 * (size_t)NASSIGN * D;
  if (early0 + yk_bytes > o) o = early0 + yk_bytes;
  (void)early1;
  if (o > ws_size) fprintf(stderr, "workspace too small: need %zu have %zu\n", o, ws_size);

  static int grid_blocks = 0;
  if (!grid_blocks) {
    int dev = 0, cus = 0, per_cu = 0;
    (void)hipGetDevice(&dev);
    (void)hipDeviceGetAttribute(&cus, hipDeviceAttributeMultiprocessorCount, dev);
    (void)hipOccupancyMaxActiveBlocksPerMultiprocessor(&per_cu, mega, 256, 0);
    if (per_cu > 2) per_cu = 2;
    if (per_cu < 1) per_cu = 1;
    grid_blocks = cus * per_cu;
  }
  (void)hipMemsetAsync(p.bar, 0, sizeof(unsigned) * XCD_BAR_WORDS, stream);
  hipLaunchKernelGGL(mega, dim3(grid_blocks), dim3(256), 0, stream, p);
  hipError_t e = hipPeekAtLastError();
  if (e != hipSuccess) fprintf(stderr, "launch failed: %s (grid %d)\n", hipGetErrorString(e), grid_blocks);
}
```
